# Optimizing an MI355X kernel written in HIP

```python
import jax, jax.numpy as jnp
from jax import lax
import numpy as np

D_MODEL = 1024
BATCH = 8
SEQ = 2048
DEPTH = 1
DEC_BATCH = 128
DEC_SEQ = 4
PAST_LEN = 16384
PAGE_SIZE = 128

RET_HEADS = 4
RET_DK = 128
RET_DV = 128
GLA_HEADS = 4
GLA_DK = 64
GLA_DV = 128
GLA_GATE_RANK = 16
GLA_GATE_TAU = 16.0
D_FF = 2816
CONV_WIDTH = 3
CHUNK = 64
ROPE_BASE = 10000.0
EPS = 1e-6

SPLIT_SIZES = (RET_HEADS * RET_DK, RET_HEADS * RET_DK, RET_HEADS * RET_DV, RET_HEADS * RET_DV,
               GLA_HEADS * GLA_DK, GLA_HEADS * GLA_DK, GLA_HEADS * GLA_DV, GLA_HEADS * GLA_DV,
               GLA_GATE_RANK, D_MODEL, D_MODEL)
D_IN = (2 * RET_HEADS * RET_DK + 2 * RET_HEADS * RET_DV + 2 * GLA_HEADS * GLA_DK
        + 2 * GLA_HEADS * GLA_DV + GLA_GATE_RANK + 2 * D_MODEL)

kernel_name = 'hybrid_retention_gla_convffn_step'


def rmsnorm(x, g):
    xf = x.astype(jnp.float32)
    y = xf * lax.rsqrt(jnp.mean(xf * xf, axis=-1, keepdims=True) + EPS)
    return (y * g.astype(jnp.float32)).astype(x.dtype)


def group_rmsnorm(o, g):
    B, L, H, dv = o.shape
    of = o.astype(jnp.float32)
    y = of * lax.rsqrt(jnp.mean(of * of, axis=-1, keepdims=True) + EPS)
    y = y.reshape(B, L, H * dv) * g.astype(jnp.float32)
    return y.astype(o.dtype)


def rotary(t, pos):
    half = t.shape[-1] // 2
    inv = ROPE_BASE ** (-jnp.arange(half, dtype=jnp.float32) / half)
    ang = pos[:, None] * inv[None, :]
    cos = jnp.cos(ang)[None, :, None, :]
    sin = jnp.sin(ang)[None, :, None, :]
    tf = t.astype(jnp.float32)
    t1, t2 = tf[..., :half], tf[..., half:]
    out = jnp.concatenate([t1 * cos - t2 * sin, t1 * sin + t2 * cos], axis=-1)
    return out.astype(t.dtype)


def chunked_gated_linear(q, k, v, log_a, s0):
    B, L, H, dk = q.shape
    dv = v.shape[-1]
    C = CHUNK if L % CHUNK == 0 else L
    n = L // C

    def to_chunks(t):
        return t.astype(jnp.float32).reshape(B, n, C, H, t.shape[-1]).transpose(1, 0, 3, 2, 4)

    qc, kc, vc, ac = to_chunks(q), to_chunks(k), to_chunks(v), to_chunks(log_a)
    mask = jnp.tril(jnp.ones((C, C), dtype=bool))

    def step(S, inp):
        qi, ki, vi, ai = inp
        b = jnp.cumsum(ai, axis=2)
        b_last = b[:, :, -1:, :]
        q_dec = qi * jnp.exp(b)
        k_dec = ki * jnp.exp(-b)
        scores = jnp.einsum('bhid,bhjd->bhij', q_dec, k_dec)
        scores = jnp.where(mask, scores, 0.0)
        o = (jnp.einsum('bhij,bhjv->bhiv', scores, vi)
             + jnp.einsum('bhid,bhdv->bhiv', q_dec, S))
        k_tail = ki * jnp.exp(b_last - b)
        S_new = (jnp.exp(b_last[:, :, 0, :])[..., None] * S
                 + jnp.einsum('bhjd,bhjv->bhdv', k_tail, vi))
        return S_new, o

    S, o = lax.scan(step, s0.astype(jnp.float32), (qc, kc, vc, ac))
    o = o.transpose(1, 0, 3, 2, 4).reshape(B, L, H, dv)
    return o.astype(v.dtype), S.astype(s0.dtype)


def causal_dwconv(u, prev, w, b):
    L = u.shape[1]
    ext = jnp.concatenate([prev.astype(u.dtype), u], axis=1)
    out = b + ext[:, 0:L] * w[0]
    for i in range(1, CONV_WIDTH):
        out = out + ext[:, i:i + L] * w[i]
    return out, ext[:, -(CONV_WIDTH - 1):]


def split_cols(p):
    outs, start = [], 0
    for s in SPLIT_SIZES:
        outs.append(p[..., start:start + s])
        start += s
    return outs


def layer(x, pos, s_ret, s_gla, conv_prev, ln1, w_in, w_gate_up, b_gate_up, g_ret, g_gla,
          w_ret_out, w_gla_out, w_o, ln2, w_up, conv_w, conv_b, w_down):
    B, L, _ = x.shape
    n = rmsnorm(x, ln1)
    proj = n @ w_in
    rq, rk, rv, rg, gq, gk, gv, gg, ga, m_r, m_g = split_cols(proj)

    rq = rotary(rq.reshape(B, L, RET_HEADS, RET_DK), pos)
    rk = rotary(rk.reshape(B, L, RET_HEADS, RET_DK), pos) * (RET_DK ** -0.5)
    rv = rv.reshape(B, L, RET_HEADS, RET_DV)
    log_gamma = jnp.log(1.0 - 2.0 ** (-5.0 - jnp.arange(RET_HEADS, dtype=jnp.float32)))
    log_g = jnp.broadcast_to(log_gamma[None, None, :, None], (B, L, RET_HEADS, RET_DK))
    o_r, s_ret_new = chunked_gated_linear(rq, rk, rv, log_g, s_ret)
    y_r = (group_rmsnorm(o_r, g_ret) * jax.nn.silu(rg)) @ w_ret_out

    z = (ga @ w_gate_up + b_gate_up).astype(jnp.float32)
    log_a = (jax.nn.log_sigmoid(z) / GLA_GATE_TAU).reshape(B, L, GLA_HEADS, GLA_DK)
    gq = gq.reshape(B, L, GLA_HEADS, GLA_DK) * (GLA_DK ** -0.5)
    gk = gk.reshape(B, L, GLA_HEADS, GLA_DK)
    gv = gv.reshape(B, L, GLA_HEADS, GLA_DV)
    o_g, s_gla_new = chunked_gated_linear(gq, gk, gv, log_a, s_gla)
    y_g = (group_rmsnorm(o_g, g_gla) * jax.nn.silu(gg)) @ w_gla_out

    mix = jax.nn.sigmoid(m_r) * y_r + jax.nn.sigmoid(m_g) * y_g
    h = x + mix @ w_o

    n2 = rmsnorm(h, ln2)
    up = n2 @ w_up
    u, vv = up[..., :D_FF], up[..., D_FF:]
    uc, conv_tail = causal_dwconv(u, conv_prev, conv_w, conv_b)
    h = h + (jax.nn.gelu(uc, approximate=False) * vv) @ w_down
    return h, s_ret_new, s_gla_new, conv_tail


def setup_inputs(seed: int = 0) -> dict:
    key = jax.random.key(seed)
    ks = jax.random.split(key, 24)
    f32 = jnp.float32

    def nrm(k, shape, scale):
        return jax.random.normal(k, shape, f32) * scale

    def gain(k, shape):
        return 1.0 + 0.02 * jax.random.normal(k, shape, f32)

    return {
        'x_prompt': nrm(ks[0], (BATCH, SEQ, D_MODEL), 1.0),
        'x_sample': nrm(ks[1], (DEC_BATCH, DEC_SEQ, D_MODEL), 1.0),
        'state_ret': nrm(ks[2], (DEPTH, DEC_BATCH, RET_HEADS, RET_DK, RET_DV), 0.3),
        'state_gla': nrm(ks[3], (DEPTH, DEC_BATCH, GLA_HEADS, GLA_DK, GLA_DV), 0.3),
        'cache_conv': nrm(ks[4], (DEPTH, DEC_BATCH, CONV_WIDTH - 1, D_FF), 1.0),
        'ln1': gain(ks[5], (DEPTH, D_MODEL)),
        'w_in': nrm(ks[6], (DEPTH, D_MODEL, D_IN), D_MODEL ** -0.5),
        'w_gate_up': nrm(ks[7], (DEPTH, GLA_GATE_RANK, GLA_HEADS * GLA_DK), GLA_GATE_RANK ** -0.5),
        'b_gate_up': nrm(ks[8], (DEPTH, GLA_HEADS * GLA_DK), 0.1),
        'g_ret': gain(ks[9], (DEPTH, RET_HEADS * RET_DV)),
        'g_gla': gain(ks[10], (DEPTH, GLA_HEADS * GLA_DV)),
        'w_ret_out': nrm(ks[11], (DEPTH, RET_HEADS * RET_DV, D_MODEL), (RET_HEADS * RET_DV) ** -0.5),
        'w_gla_out': nrm(ks[12], (DEPTH, GLA_HEADS * GLA_DV, D_MODEL), (GLA_HEADS * GLA_DV) ** -0.5),
        'w_o': nrm(ks[13], (DEPTH, D_MODEL, D_MODEL), D_MODEL ** -0.5),
        'ln2': gain(ks[14], (DEPTH, D_MODEL)),
        'w_up': nrm(ks[15], (DEPTH, D_MODEL, 2 * D_FF), D_MODEL ** -0.5),
        'conv_w': nrm(ks[16], (DEPTH, CONV_WIDTH, D_FF), CONV_WIDTH ** -0.5),
        'conv_b': nrm(ks[17], (DEPTH, D_FF), 0.02),
        'w_down': nrm(ks[18], (DEPTH, D_FF, D_MODEL), D_FF ** -0.5),
        'ln_f': gain(ks[19], (D_MODEL,)),
    }


def reference(x_prompt, x_sample, state_ret, state_gla, cache_conv, ln1, w_in, w_gate_up,
              b_gate_up, g_ret, g_gla, w_ret_out, w_gla_out, w_o, ln2, w_up, conv_w, conv_b,
              w_down, ln_f):
    Bp, Lp, _ = x_prompt.shape
    Ls = x_sample.shape[1]
    dt = x_prompt.dtype
    pos_p = jnp.arange(Lp, dtype=jnp.float32)
    pos_s = PAST_LEN + jnp.arange(Ls, dtype=jnp.float32)

    hp, hs = x_prompt, x_sample
    rp, rs, gp, gs, cp, cs = [], [], [], [], [], []
    for l in range(DEPTH):
        wl = (ln1[l], w_in[l], w_gate_up[l], b_gate_up[l], g_ret[l], g_gla[l], w_ret_out[l],
              w_gla_out[l], w_o[l], ln2[l], w_up[l], conv_w[l], conv_b[l], w_down[l])
        zr = jnp.zeros((Bp, RET_HEADS, RET_DK, RET_DV), dt)
        zg = jnp.zeros((Bp, GLA_HEADS, GLA_DK, GLA_DV), dt)
        zc = jnp.zeros((Bp, CONV_WIDTH - 1, D_FF), dt)
        hp, sr_p, sg_p, cv_p = layer(hp, pos_p, zr, zg, zc, *wl)
        hs, sr_s, sg_s, cv_s = layer(hs, pos_s, state_ret[l], state_gla[l], cache_conv[l], *wl)
        rp.append(sr_p); rs.append(sr_s)
        gp.append(sg_p); gs.append(sg_s)
        cp.append(cv_p); cs.append(cv_s)

    y_prompt = rmsnorm(hp, ln_f)
    y_sample = rmsnorm(hs, ln_f)
    return (y_prompt, y_sample, jnp.stack(rp), jnp.stack(rs), jnp.stack(gp), jnp.stack(gs),
            jnp.stack(cp), jnp.stack(cs))
```

```cpp
#include <hip/hip_runtime.h>
#include <hip/hip_cooperative_groups.h>
#include <cstdio>
namespace cg = cooperative_groups;

#define LAS __attribute__((address_space(3)))
#define DI __device__ __forceinline__
typedef unsigned short bf16_t;
typedef short bf16x8 __attribute__((ext_vector_type(8)));
typedef short s16x4 __attribute__((ext_vector_type(4)));
typedef float f32x4 __attribute__((ext_vector_type(4)));
typedef float f32x2 __attribute__((ext_vector_type(2)));
typedef float f32x16 __attribute__((ext_vector_type(16)));
typedef unsigned u32x4 __attribute__((ext_vector_type(4)));
typedef unsigned u32x2 __attribute__((ext_vector_type(2)));
typedef __bf16 bf16x2_t __attribute__((ext_vector_type(2)));

constexpr int T_TOK = 16896, TP = 16384, DM = 1024, DIN = 5648, NPROJ = 5632, DFF = 2816, NUP = 5632;
constexpr float EPS = 1e-6f;
constexpr size_t OUT_Y = 0, OUT_RSP = 17301504, OUT_RSS = OUT_RSP + 524288, OUT_GSP = OUT_RSS + 8388608, OUT_GSS = OUT_GSP + 262144,
                 OUT_CP = OUT_GSS + 4194304, OUT_CS = OUT_CP + 45056, OUT_END = OUT_CS + 720896;
constexpr size_t WS_WIN = 0, WS_WMIX = WS_WIN + (size_t)NPROJ * DM * 2, WS_WO = WS_WMIX + (size_t)DM * DM * 2, WS_WUP = WS_WO + (size_t)DM * DM * 2,
                 WS_WDN = WS_WUP + (size_t)NUP * DM * 2, WS_PROJ = WS_WDN + (size_t)DM * DFF * 2;
constexpr size_t SEG512 = (size_t)T_TOK * 512 * 2, SEG256 = (size_t)T_TOK * 256 * 2, SEG1024 = (size_t)T_TOK * 1024 * 2;
constexpr size_t PQ_R = WS_PROJ, PK_R = PQ_R + SEG512, PV_R = PK_R + SEG512, PG_R = PV_R + SEG512, PQ_G = PG_R + SEG512, PK_G = PQ_G + SEG256,
                 PV_G = PK_G + SEG256, PG_G = PV_G + SEG512, PM_R = PG_G + SEG512, PM_G = PM_R + SEG1024, WS_PROJ_END = PM_G + SEG1024;
constexpr size_t WS_MIX = PQ_R;
constexpr size_t WS_UP = WS_PROJ;
constexpr size_t WS_SH = WS_PROJ_END;
constexpr size_t WS_RSTD1 = WS_SH + SEG1024, WS_SSQ2 = WS_RSTD1 + (size_t)T_TOK * 4, WS_EBL = WS_SSQ2 + (size_t)T_TOK * 4,
                 WS_ROPEC = WS_EBL + (size_t)384 * 256 * 4, WS_ROPES = WS_ROPEC + (size_t)2052 * 64 * 4, WS_END = WS_ROPES + (size_t)2052 * 64 * 4;
static_assert(WS_PROJ_END - WS_PROJ == (size_t)T_TOK * NPROJ * 2, "proj layout");
static_assert(WS_END <= (size_t)256 * 1024 * 1024, "workspace");
constexpr int LDS_BYTES = 131072 + 4096;

struct Params {
    const float *x_prompt, *x_sample, *state_ret, *state_gla, *cache_conv, *ln1, *w_in, *w_gate_up, *b_gate_up, *g_ret, *g_gla, *w_ret_out, *w_gla_out,
        *w_o, *ln2, *w_up, *conv_w, *conv_b, *w_down, *ln_f;
    float* out; unsigned char* ws;
};

DI unsigned pk2(float lo, float hi) { f32x2 v = {lo, hi}; bf16x2_t b = __builtin_convertvector(v, bf16x2_t); return __builtin_bit_cast(unsigned, b); }
DI float bflo(unsigned w) { return __uint_as_float(w << 16); }
DI float bfhi(unsigned w) { return __uint_as_float(w & 0xffff0000u); }
DI float wave_sum(float v) {
#pragma unroll
    for (int o = 1; o < 64; o <<= 1) v += __shfl_xor(v, o);
    return v;
}
DI float sigmoidf_(float x) { return 1.f / (1.f + __expf(-x)); }
DI const float* x_row(const Params& p, int tok) { return tok < TP ? p.x_prompt + (size_t)tok * DM : p.x_sample + (size_t)(tok - TP) * DM; }
#define LDS_WAIT() asm volatile("s_waitcnt lgkmcnt(0)" ::: "memory")

namespace pg8 {
constexpr int BM = 256, BK = 64, HALF = 128, HTB = HALF * BK * 2, STAGE_BYTES = 8 * HTB, NXCD = 8, WGM = 8;
DI int lds_byte(int r, int c) { const int st = (r >> 4) * 2 + (c >> 5), rr = r & 15, cc = c & 31, ob = rr * 64 + cc * 2; return st * 1024 + (ob ^ (((ob >> 9) & 1) << 5)); }
DI void stage_rc(int b, int& R, int& C) { const int st = b / 1024, sb = b % 1024, swz = sb ^ (((sb >> 9) & 1) << 5); R = (st >> 1) * 16 + swz / 64; C = (st & 1) * 32 + (swz % 64) / 2; }
DI int perm32(int rho) { const int n = rho >> 4, i = rho & 15; return 8 * (i >> 2) + 4 * n + (i & 3); }
struct Unit { int pm, pn; };
struct Gemm { const bf16_t* A; const bf16_t* Bt; int M, N, K, lda, ldb; };
struct StaticOrder {
    int nM, nN, nwg, G, c;
    DI void init(int M, int N, int G_, int c_) { nM = M / BM; nN = N / BM; nwg = nM * nN; G = G_; c = c_; }
    DI bool next(int i, Unit& u) const {
        const long L = (long)i * G + c; if (L >= nwg) return false;
        int wgid = (int)L; { const int q = nwg / NXCD, r = nwg % NXCD, xcd = wgid % NXCD, off = wgid / NXCD; wgid = (xcd < r ? xcd * (q + 1) : r * (q + 1) + (xcd - r) * q) + off; }
        const int nig = WGM * nN, gid = wgid / nig, fm = gid * WGM, gsz = (nM - fm) < WGM ? (nM - fm) : WGM;
        u.pm = fm + ((wgid % nig) % gsz); u.pn = (wgid % nig) / gsz; return true;
    }
};
template <class Epi>
DI void gemm_phase(LAS unsigned char* lds, const Gemm g, const StaticOrder& S, const Epi& E) {
    int tid = threadIdx.x; asm volatile("" : "+v"(tid));
    const int wid = __builtin_amdgcn_readfirstlane(tid >> 6), lane = tid & 63, wr = wid >> 2, wc = wid & 3, fr = lane & 15, fq = lane >> 4;
    const int nt = g.K / BK;
    unsigned voffA[2], voffB[2];
#pragma unroll
    for (int i = 0; i < 2; ++i) { int R, C; stage_rc(tid * 16 + i * 8192, R, C); const int Rb = Epi::PERM ? ((R & ~31) + perm32(R & 31)) : R;
        voffA[i] = (unsigned)(R * g.lda + C) * 2u; voffB[i] = (unsigned)(Rb * g.ldb + C) * 2u; }
    const size_t kstep = (size_t)(BK * 2);
    const size_t hstepA = (size_t)HALF * g.lda * 2, hstepB = (size_t)HALF * g.ldb * 2;
    const size_t tstepA = 2 * hstepA, tstepB = 2 * hstepB;
    const unsigned ldsw = (unsigned)wid * 1024u;
    const int aoff = lds_byte(wr * 64 + fr, fq * 8), boff = lds_byte(wc * 32 + fr, fq * 8);
#define PG8_SA(b, h) (((b) * 2 + (h)) * HTB)
#define PG8_SB(b, h) ((4 + (b) * 2 + (h)) * HTB)
#define PG8_STAGE(bufoff, gbase, voff) do { _Pragma("unroll") for (int _i = 0; _i < 2; ++_i) \
        __builtin_amdgcn_global_load_lds((const unsigned*)((const char*)(gbase) + (voff)[_i]), (LAS unsigned*)(lds + (bufoff) + ldsw + _i * 8192), 16, 0, 0); } while (0)
#define PG8_LDA(dst, b, h) do { _Pragma("unroll") for (int m = 0; m < 4; ++m) _Pragma("unroll") for (int k = 0; k < 2; ++k) dst[m][k] = *(const LAS bf16x8*)(lds + PG8_SA(b, h) + aoff + m * 2048 + k * 1024); } while (0)
#define PG8_LDB(dst, b, h) do { _Pragma("unroll") for (int n = 0; n < 2; ++n) _Pragma("unroll") for (int k = 0; k < 2; ++k) dst[n][k] = *(const LAS bf16x8*)(lds + PG8_SB(b, h) + boff + n * 2048 + k * 1024); } while (0)
#define PG8_MMA(ai, bj, At, Bt) do { __builtin_amdgcn_s_setprio(1); _Pragma("unroll") for (int m = 0; m < 4; ++m) _Pragma("unroll") for (int n = 0; n < 2; ++n) _Pragma("unroll") for (int k = 0; k < 2; ++k) \
        acc[ai][bj][m][n] = __builtin_amdgcn_mfma_f32_16x16x32_bf16(Bt[n][k], At[m][k], acc[ai][bj][m][n], 0, 0, 0); __builtin_amdgcn_s_setprio(0); } while (0)
#define PG8_WAIT_V(n) asm volatile("s_waitcnt vmcnt(" #n ")" ::: "memory")
#define PG8_WAIT_L(n) asm volatile("s_waitcnt lgkmcnt(" #n ")" ::: "memory")
#define PG8_BAR __builtin_amdgcn_s_barrier()
#define PG8_SCHED __builtin_amdgcn_sched_barrier(0)
    Unit cur, nxt; int ui = 0;
    if (!S.next(0, cur)) return;
    f32x4 acc[2][2][4][2];
#pragma unroll
    for (int a = 0; a < 2; ++a)
#pragma unroll
        for (int b = 0; b < 2; ++b)
#pragma unroll
            for (int m = 0; m < 4; ++m)
#pragma unroll
                for (int n = 0; n < 2; ++n) acc[a][b][m][n] = (f32x4){0.f, 0.f, 0.f, 0.f};
    bf16x8 At[4][2], B0[2][2], B1[2][2];
    const char* cA = (const char*)g.A + (size_t)cur.pm * tstepA; const char* cB = (const char*)g.Bt + (size_t)cur.pn * tstepB;
    PG8_STAGE(PG8_SB(0, 0), cB, voffB); PG8_STAGE(PG8_SA(0, 0), cA, voffA); PG8_STAGE(PG8_SB(0, 1), cB + hstepB, voffB); PG8_STAGE(PG8_SA(0, 1), cA + hstepA, voffA);
    if (wr == 1) PG8_BAR;
    PG8_WAIT_V(4); PG8_BAR;
    PG8_STAGE(PG8_SB(1, 0), cB + kstep, voffB); PG8_STAGE(PG8_SA(1, 0), cA + kstep, voffA); PG8_STAGE(PG8_SB(1, 1), cB + hstepB + kstep, voffB);
    PG8_WAIT_V(6); PG8_BAR;
    for (;;) {
        const bool has_next = S.next(ui + 1, nxt);
        const char* nA = has_next ? (const char*)g.A + (size_t)nxt.pm * tstepA : cA; const char* nB = has_next ? (const char*)g.Bt + (size_t)nxt.pn * tstepB : cB;
        for (int t = 0; t < nt; t += 2) {
            const bool last = (t == nt - 2);
            const char* a1 = cA + (size_t)(t + 1) * kstep;
            const char* a2 = last ? nA : cA + (size_t)(t + 2) * kstep; const char* b2 = last ? nB : cB + (size_t)(t + 2) * kstep;
            const char* a3 = a2 + kstep; const char* b3 = b2 + kstep;
            if constexpr (Epi::MIDK) { if (t == (nt >> 1)) E.mid(acc, cur, wr, wc, fr, fq); }
            PG8_LDB(B0, 0, 0); PG8_SCHED; PG8_LDA(At, 0, 0); PG8_STAGE(PG8_SA(1, 1), a1 + hstepA, voffA);
            PG8_WAIT_L(8); PG8_BAR; PG8_WAIT_L(0); PG8_MMA(0, 0, At, B0); PG8_BAR; PG8_SCHED;
            PG8_LDB(B1, 0, 1); PG8_STAGE(PG8_SB(0, 0), b2, voffB);
            PG8_BAR; PG8_WAIT_L(0); PG8_MMA(0, 1, At, B1); PG8_BAR;
            PG8_LDA(At, 0, 1); PG8_STAGE(PG8_SA(0, 0), a2, voffA);
            PG8_BAR; PG8_WAIT_L(0); PG8_MMA(1, 0, At, B0); PG8_BAR; PG8_SCHED;
            PG8_STAGE(PG8_SB(0, 1), b2 + hstepB, voffB);
            PG8_WAIT_V(6); PG8_BAR; PG8_MMA(1, 1, At, B1); PG8_BAR;
            PG8_LDB(B0, 1, 0); PG8_SCHED; PG8_LDA(At, 1, 0); PG8_STAGE(PG8_SA(0, 1), a2 + hstepA, voffA);
            PG8_WAIT_L(8); PG8_BAR; PG8_WAIT_L(0); PG8_MMA(0, 0, At, B0); PG8_BAR; PG8_SCHED;
            PG8_LDB(B1, 1, 1); PG8_STAGE(PG8_SB(1, 0), b3, voffB);
            PG8_BAR; PG8_WAIT_L(0); PG8_MMA(0, 1, At, B1); PG8_BAR;
            PG8_LDA(At, 1, 1); PG8_STAGE(PG8_SA(1, 0), a3, voffA);
            PG8_BAR; PG8_WAIT_L(0); PG8_MMA(1, 0, At, B0); PG8_BAR; PG8_SCHED;
            PG8_STAGE(PG8_SB(1, 1), b3 + hstepB, voffB);
            PG8_WAIT_V(6); PG8_BAR; PG8_MMA(1, 1, At, B1); PG8_BAR;
        }
        E(acc, cur, wr, wc, fr, fq);
        if (!has_next) break;
#pragma unroll
        for (int a = 0; a < 2; ++a)
#pragma unroll
            for (int b = 0; b < 2; ++b)
#pragma unroll
                for (int m = 0; m < 4; ++m)
#pragma unroll
                    for (int n = 0; n < 2; ++n) acc[a][b][m][n] = (f32x4){0.f, 0.f, 0.f, 0.f};
        cur = nxt; cA = nA; cB = nB; ++ui;
    }
    PG8_WAIT_V(0);
    if (wr == 0) PG8_BAR;
    PG8_BAR;
#undef PG8_SA
#undef PG8_SB
#undef PG8_STAGE
#undef PG8_LDA
#undef PG8_LDB
#undef PG8_MMA
#undef PG8_WAIT_V
#undef PG8_WAIT_L
#undef PG8_BAR
#undef PG8_SCHED
}
}
using pg8::Unit;
typedef f32x4 AccT[2][2][4][2];

struct EpiProj {
    static constexpr bool PERM = true, MIDK = false;
    unsigned char* ws; const float* rstd1; const float* bcum; const float* ropec; const float* ropes;
    DI void mid(AccT&, const Unit&, int, int, int, int) const {}
    DI void operator()(const AccT& acc, const Unit& u, int wr, int wc, int fr, int fq) const {
        const int pn = u.pn; int seg, pn0;
        if (pn < 8) { seg = pn >> 1; pn0 = seg * 2; } else if (pn == 8) { seg = 4; pn0 = 8; } else if (pn == 9) { seg = 5; pn0 = 9; }
        else if (pn < 12) { seg = 6; pn0 = 10; } else if (pn < 14) { seg = 7; pn0 = 12; } else if (pn < 18) { seg = 8; pn0 = 14; } else { seg = 9; pn0 = 18; }
        size_t segoff; int ld;
        switch (seg) { case 0: segoff = PQ_R; ld = 512; break; case 1: segoff = PK_R; ld = 512; break; case 2: segoff = PV_R; ld = 512; break; case 3: segoff = PG_R; ld = 512; break;
            case 4: segoff = PQ_G; ld = 256; break; case 5: segoff = PK_G; ld = 256; break; case 6: segoff = PV_G; ld = 512; break; case 7: segoff = PG_G; ld = 512; break;
            case 8: segoff = PM_R; ld = 1024; break; default: segoff = PM_G; ld = 1024; break; }
        bf16_t* base = (bf16_t*)(ws + segoff);
        const int lc0 = (pn - pn0) * 256 + wc * 32 + 8 * fq;
        const int row0 = u.pm * 256 + wr * 64 + fr;
        if (seg <= 1) {
            const int i0 = 16 * wc + 4 * fq;
#pragma unroll
            for (int ai = 0; ai < 2; ++ai)
#pragma unroll
                for (int m = 0; m < 4; ++m) {
                    const int row = row0 + ai * 128 + m * 16; const float rs = rstd1[row];
                    int posidx, ic; if (row < TP) { posidx = row & 2047; ic = row & 63; } else { const int s = row - TP; posidx = 2048 + (s & 3); ic = s & 3; }
                    const f32x4 c4 = *(const f32x4*)(ropec + posidx * 64 + i0), s4 = *(const f32x4*)(ropes + posidx * 64 + i0);
#pragma unroll
                    for (int bj = 0; bj < 2; ++bj) {
                        const int head = (pn - pn0) * 2 + bj;
                        const float lg2 = log2f(1.f - exp2f(-5.f - (float)head));
                        const float dec = (seg == 0) ? exp2f((float)(ic + 1) * lg2) : exp2f(-(float)(ic + 1) * lg2) * 0.08838834764831845f;
                        const f32x4 t1 = acc[ai][bj][m][0] * rs, t2 = acc[ai][bj][m][1] * rs;
                        const f32x4 o1 = (t1 * c4 - t2 * s4) * dec, o2 = (t1 * s4 + t2 * c4) * dec;
                        bf16_t* rp = base + (size_t)row * 512 + head * 128 + i0;
                        u32x2 w1, w2; w1.x = pk2(o1[0], o1[1]); w1.y = pk2(o1[2], o1[3]); w2.x = pk2(o2[0], o2[1]); w2.y = pk2(o2[2], o2[3]);
                        *(u32x2*)rp = w1; *(u32x2*)(rp + 64) = w2;
                    }
                }
            return;
        }
#pragma unroll
        for (int ai = 0; ai < 2; ++ai)
#pragma unroll
            for (int m = 0; m < 4; ++m) {
                const int row = row0 + ai * 128 + m * 16; const float rs = rstd1[row];
#pragma unroll
                for (int bj = 0; bj < 2; ++bj) {
                    const int lc = lc0 + bj * 128;
                    f32x4 v0 = acc[ai][bj][m][0] * rs, v1 = acc[ai][bj][m][1] * rs;
                    if (seg == 4 || seg == 5) {
                        const f32x4 b0 = *(const f32x4*)(bcum + (size_t)row * 256 + lc), b1 = *(const f32x4*)(bcum + (size_t)row * 256 + lc + 4);
                        if (seg == 4) {
#pragma unroll
                            for (int e = 0; e < 4; ++e) { v0[e] *= 0.125f * __expf(b0[e]); v1[e] *= 0.125f * __expf(b1[e]); }
                        } else {
#pragma unroll
                            for (int e = 0; e < 4; ++e) { v0[e] *= __expf(-b0[e]); v1[e] *= __expf(-b1[e]); }
                        }
                    } else if (seg == 3 || seg == 7) {
#pragma unroll
                        for (int e = 0; e < 4; ++e) { v0[e] = v0[e] * sigmoidf_(v0[e]); v1[e] = v1[e] * sigmoidf_(v1[e]); }
                    } else if (seg >= 8) {
#pragma unroll
                        for (int e = 0; e < 4; ++e) { v0[e] = sigmoidf_(v0[e]); v1[e] = sigmoidf_(v1[e]); }
                    }
                    u32x4 w; w.x = pk2(v0[0], v0[1]); w.y = pk2(v0[2], v0[3]); w.z = pk2(v1[0], v1[1]); w.w = pk2(v1[2], v1[3]);
                    *(u32x4*)(base + (size_t)row * ld + lc) = w;
                }
            }
    }
};
struct EpiMix {
    static constexpr bool PERM = true, MIDK = true;
    const bf16_t* mr; const bf16_t* mg; bf16_t* mix;
    DI void mid(AccT& acc, const Unit& u, int wr, int wc, int fr, int fq) const {
        int row0 = u.pm * 256 + wr * 64 + fr, c0 = u.pn * 256 + wc * 32 + 8 * fq;
        asm volatile("" : "+v"(row0), "+v"(c0));
#pragma unroll
        for (int ai = 0; ai < 2; ++ai)
#pragma unroll
            for (int m = 0; m < 4; ++m) {
                const int row = row0 + ai * 128 + m * 16;
#pragma unroll
                for (int bj = 0; bj < 2; ++bj) {
                    const u32x4 a = *(const u32x4*)(mr + (size_t)row * 1024 + c0 + bj * 128), b = *(const u32x4*)(mg + (size_t)row * 1024 + c0 + bj * 128);
                    f32x4 r0, r1;
                    r0[0] = bflo(a.x) / fmaxf(bflo(b.x), 1e-30f); r0[1] = bfhi(a.x) / fmaxf(bfhi(b.x), 1e-30f); r0[2] = bflo(a.y) / fmaxf(bflo(b.y), 1e-30f); r0[3] = bfhi(a.y) / fmaxf(bfhi(b.y), 1e-30f);
                    r1[0] = bflo(a.z) / fmaxf(bflo(b.z), 1e-30f); r1[1] = bfhi(a.z) / fmaxf(bfhi(b.z), 1e-30f); r1[2] = bflo(a.w) / fmaxf(bflo(b.w), 1e-30f); r1[3] = bfhi(a.w) / fmaxf(bfhi(b.w), 1e-30f);
                    acc[ai][bj][m][0] *= r0; acc[ai][bj][m][1] *= r1;
                }
                __builtin_amdgcn_sched_barrier(0);
            }
    }
    DI void operator()(const AccT& acc, const Unit& u, int wr, int wc, int fr, int fq) const {
        const int row0 = u.pm * 256 + wr * 64 + fr, c0 = u.pn * 256 + wc * 32 + 8 * fq;
#pragma unroll
        for (int ai = 0; ai < 2; ++ai)
#pragma unroll
            for (int m = 0; m < 4; ++m) {
                const int row = row0 + ai * 128 + m * 16;
#pragma unroll
                for (int bj = 0; bj < 2; ++bj) {
                    const u32x4 b = *(const u32x4*)(mg + (size_t)row * 1024 + c0 + bj * 128);
                    const f32x4 v0 = acc[ai][bj][m][0], v1 = acc[ai][bj][m][1];
                    u32x4 w; w.x = pk2(v0[0] * bflo(b.x), v0[1] * bfhi(b.x)); w.y = pk2(v0[2] * bflo(b.y), v0[3] * bfhi(b.y));
                    w.z = pk2(v1[0] * bflo(b.z), v1[1] * bfhi(b.z)); w.w = pk2(v1[2] * bflo(b.w), v1[3] * bfhi(b.w));
                    *(u32x4*)(mix + (size_t)row * 1024 + c0 + bj * 128) = w;
                }
            }
    }
};
struct EpiH {
    static constexpr bool PERM = true, MIDK = false;
    const float* xp; const float* xs; float* h; bf16_t* hb; float* ssq;
    DI void mid(AccT&, const Unit&, int, int, int, int) const {}
    DI void operator()(const AccT& acc, const Unit& u, int wr, int wc, int fr, int fq) const {
        const int row0 = u.pm * 256 + wr * 64 + fr, c0 = u.pn * 256 + wc * 32 + 8 * fq;
#pragma unroll
        for (int ai = 0; ai < 2; ++ai)
#pragma unroll
            for (int m = 0; m < 4; ++m) {
                const int row = row0 + ai * 128 + m * 16;
                const float* xr = row < TP ? xp + (size_t)row * DM : xs + (size_t)(row - TP) * DM;
                float ss = 0.f;
#pragma unroll
                for (int bj = 0; bj < 2; ++bj) {
                    const int c = c0 + bj * 128;
                    const f32x4 v0 = acc[ai][bj][m][0] + *(const f32x4*)(xr + c), v1 = acc[ai][bj][m][1] + *(const f32x4*)(xr + c + 4);
                    *(f32x4*)(h + (size_t)row * DM + c) = v0; *(f32x4*)(h + (size_t)row * DM + c + 4) = v1;
                    u32x4 w; w.x = pk2(v0[0], v0[1]); w.y = pk2(v0[2], v0[3]); w.z = pk2(v1[0], v1[1]); w.w = pk2(v1[2], v1[3]);
                    *(u32x4*)(hb + (size_t)row * DM + c) = w;
                    ss += v0[0] * v0[0] + v0[1] * v0[1] + v0[2] * v0[2] + v0[3] * v0[3] + v1[0] * v1[0] + v1[1] * v1[1] + v1[2] * v1[2] + v1[3] * v1[3];
                }
                ss += __shfl_xor(ss, 16); ss += __shfl_xor(ss, 32);
                if (fq == 0) unsafeAtomicAdd(ssq + row, ss);
            }
    }
};
struct EpiUp {
    static constexpr bool PERM = true, MIDK = false;
    const float* ssq; bf16_t* up;
    DI void mid(AccT&, const Unit&, int, int, int, int) const {}
    DI void operator()(const AccT& acc, const Unit& u, int wr, int wc, int fr, int fq) const {
        const int row0 = u.pm * 256 + wr * 64 + fr, c0 = u.pn * 256 + wc * 32 + 8 * fq;
#pragma unroll
        for (int ai = 0; ai < 2; ++ai)
#pragma unroll
            for (int m = 0; m < 4; ++m) {
                const int row = row0 + ai * 128 + m * 16;
                const float rs = rsqrtf(ssq[row] * (1.f / DM) + EPS);
#pragma unroll
                for (int bj = 0; bj < 2; ++bj) {
                    const f32x4 v0 = acc[ai][bj][m][0] * rs, v1 = acc[ai][bj][m][1] * rs;
                    u32x4 w; w.x = pk2(v0[0], v0[1]); w.y = pk2(v0[2], v0[3]); w.z = pk2(v1[0], v1[1]); w.w = pk2(v1[2], v1[3]);
                    *(u32x4*)(up + (size_t)row * NUP + c0 + bj * 128) = w;
                }
            }
    }
};
struct EpiDown {
    static constexpr bool PERM = true, MIDK = false;
    float* h;
    DI void mid(AccT&, const Unit&, int, int, int, int) const {}
    DI void operator()(const AccT& acc, const Unit& u, int wr, int wc, int fr, int fq) const {
        const int row0 = u.pm * 256 + wr * 64 + fr, c0 = u.pn * 256 + wc * 32 + 8 * fq;
#pragma unroll
        for (int ai = 0; ai < 2; ++ai)
#pragma unroll
            for (int m = 0; m < 4; ++m) {
                const int row = row0 + ai * 128 + m * 16;
#pragma unroll
                for (int bj = 0; bj < 2; ++bj) {
                    float* hp = h + (size_t)row * DM + c0 + bj * 128;
                    const f32x4 v0 = acc[ai][bj][m][0] + *(const f32x4*)hp, v1 = acc[ai][bj][m][1] + *(const f32x4*)(hp + 4);
                    *(f32x4*)hp = v0; *(f32x4*)(hp + 4) = v1;
                }
            }
    }
};

DI void transpose_item(const float* __restrict__ src, int ldsrc, int srccol, int k0, const float* __restrict__ scale, bf16_t* dst, int lddst, int n0dst, int k0dst,
                       LAS float* scr, int lane) {
#pragma unroll 8
    for (int i = 0; i < 32; ++i) { const int kk = 2 * i + (lane >> 5); float v = src[(size_t)(k0 + kk) * ldsrc + srccol]; if (scale) v *= scale[k0 + kk]; scr[kk * 33 + (lane & 31)] = v; }
    LDS_WAIT();
    const int c = lane & 7;
#pragma unroll
    for (int j = 0; j < 4; ++j) { const int n = (lane >> 3) + 8 * j; const LAS float* s = scr + (8 * c) * 33 + n;
        u32x4 o; o.x = pk2(s[0 * 33], s[1 * 33]); o.y = pk2(s[2 * 33], s[3 * 33]); o.z = pk2(s[4 * 33], s[5 * 33]); o.w = pk2(s[6 * 33], s[7 * 33]);
        *(u32x4*)(dst + (size_t)(n0dst + n) * lddst + k0dst + 8 * c) = o; }
    LDS_WAIT();
}
DI float log_sigmoid(float z) { return fminf(z, 0.f) - log1pf(expf(-fabsf(z))); }

DI void phase0(const Params& p, LAS unsigned char* lds) {
    int tid = threadIdx.x; asm volatile("" : "+v"(tid));
    const int lane = tid & 63, wave = tid >> 6;
    unsigned char* ws = p.ws;
    LAS bf16_t* wga = (LAS bf16_t*)lds;
    LAS float* gas = (LAS float*)(lds + 33024);
    LAS float* scr = (LAS float*)(lds + 41216 + wave * 8448);
    bf16_t* xb = (bf16_t*)((unsigned char*)p.out + 0);
    float* rstd1 = (float*)(ws + WS_RSTD1); float* bcum = (float*)(ws + WS_SH); float* ebl = (float*)(ws + WS_EBL);
    { const int gt = blockIdx.x * 512 + tid, ng = gridDim.x * 512;
      float* ssq2 = (float*)(ws + WS_SSQ2);
      for (int i = gt; i < T_TOK; i += ng) ssq2[i] = 0.f;
      float* rc = (float*)(ws + WS_ROPEC); float* rsn = (float*)(ws + WS_ROPES);
      for (int i = gt; i < 2052 * 64; i += ng) { const int pi = i >> 6, fi = i & 63; const double pos = (double)(pi < 2048 ? pi : 16384 + (pi - 2048));
          const double inv = exp(-(double)fi * (9.210340371976184 / 64.0)); const double ang = pos * inv; const double kk = rint(ang * 0.15915494309189535);
          const float r = (float)(ang - kk * 6.283185307179586); rc[i] = cosf(r); rsn[i] = sinf(r); } }
    if (blockIdx.x < 132) {
        for (int k = tid; k < DM; k += 512) { const float g = p.ln1[k]; const float* s = p.w_in + (size_t)k * DIN + 3584;
#pragma unroll
            for (int r = 0; r < 16; r += 2) { const unsigned w = pk2(s[r] * g, s[r + 1] * g); wga[r * 1032 + k] = (bf16_t)(w & 0xffffu); wga[(r + 1) * 1032 + k] = (bf16_t)(w >> 16); } }
        __syncthreads();
        for (int u = blockIdx.x; u < 132; u += gridDim.x) {
            const int r16 = lane & 15, kq = lane >> 4, t0 = u * 128 + wave * 16, row = t0 + r16;
            const float* xr = x_row(p, row);
            f32x4 acc = {0.f, 0.f, 0.f, 0.f}; float ss = 0.f;
            for (int ks = 0; ks < 32; ks += 4) {
                f32x4 v[4][2];
#pragma unroll
                for (int q = 0; q < 4; ++q) { v[q][0] = *(const f32x4*)(xr + (ks + q) * 32 + kq * 8); v[q][1] = *(const f32x4*)(xr + (ks + q) * 32 + kq * 8 + 4); }
#pragma unroll
                for (int q = 0; q < 4; ++q) {
                    const f32x4 a0 = v[q][0], a1 = v[q][1];
                    ss += a0[0] * a0[0] + a0[1] * a0[1] + a0[2] * a0[2] + a0[3] * a0[3] + a1[0] * a1[0] + a1[1] * a1[1] + a1[2] * a1[2] + a1[3] * a1[3];
                    u32x4 w; w.x = pk2(a0[0], a0[1]); w.y = pk2(a0[2], a0[3]); w.z = pk2(a1[0], a1[1]); w.w = pk2(a1[2], a1[3]);
                    *(u32x4*)(xb + (size_t)row * DM + (ks + q) * 32 + kq * 8) = w;
                    const bf16x8 bfrag = *(const LAS bf16x8*)(wga + r16 * 1032 + (ks + q) * 32 + kq * 8);
                    acc = __builtin_amdgcn_mfma_f32_16x16x32_bf16(__builtin_bit_cast(bf16x8, w), bfrag, acc, 0, 0, 0);
                }
            }
            ss += __shfl_xor(ss, 16); ss += __shfl_xor(ss, 32);
            const float rs = rsqrtf(ss * (1.f / DM) + EPS);
            if (kq == 0) rstd1[row] = rs;
#pragma unroll
            for (int j = 0; j < 4; ++j) { const float rj = __shfl(rs, kq * 4 + j); gas[(wave * 16 + kq * 4 + j) * 16 + r16] = acc[j] * rj; }
            __syncthreads();
            {
                const int c = tid & 255, half = tid >> 8;
                float wg[16];
#pragma unroll
                for (int r = 0; r < 16; ++r) wg[r] = p.w_gate_up[r * 256 + c];
                const float bias = p.b_gate_up[c];
                const int tokb = u * 128 + half * 64; const bool samp = tokb >= TP;
                float cum = 0.f;
                for (int i = 0; i < 64; ++i) {
                    const LAS f32x4* gp = (const LAS f32x4*)(gas + (half * 64 + i) * 16);
                    const f32x4 g0 = gp[0], g1 = gp[1], g2 = gp[2], g3 = gp[3];
                    float z = bias;
                    z += g0[0] * wg[0] + g0[1] * wg[1] + g0[2] * wg[2] + g0[3] * wg[3] + g1[0] * wg[4] + g1[1] * wg[5] + g1[2] * wg[6] + g1[3] * wg[7];
                    z += g2[0] * wg[8] + g2[1] * wg[9] + g2[2] * wg[10] + g2[3] * wg[11] + g3[0] * wg[12] + g3[1] * wg[13] + g3[2] * wg[14] + g3[3] * wg[15];
                    const float ls = log_sigmoid(z) * (1.f / 16.f);
                    const bool reset = samp ? ((i & 3) == 0) : (i == 0);
                    cum = reset ? ls : cum + ls;
                    const int tok = tokb + i;
                    bcum[(size_t)tok * 256 + c] = cum;
                    if (samp) { if ((i & 3) == 3) ebl[(size_t)(256 + ((tok - TP) >> 2)) * 256 + c] = expf(cum); }
                    else if (i == 63) ebl[(size_t)(tok >> 6) * 256 + c] = expf(cum);
                }
            }
            __syncthreads();
        }
    }
    {
        const int gw = blockIdx.x * 8 + wave, ngw = gridDim.x * 8;
        constexpr int I_IN = 16 * 176, I_MX = 8 * 32, I_O = 16 * 32, I_UP = 16 * 176, I_DN = 44 * 32, NIT = I_IN + 2 * I_MX + I_O + I_UP + I_DN;
        for (int it = gw; it < NIT; it += ngw) {
            int r = it; const int nl = lane & 31;
            if (r < I_IN) { const int kb = r / 176, nb = r % 176, n = nb * 32 + nl; int sc;
                if (n < 1024) { const int pp = n & 127; sc = (n & ~127) + (((pp & 7) < 4) ? 4 * (pp >> 3) + (pp & 7) : 64 + 4 * (pp >> 3) + (pp & 7) - 4); }
                else sc = n < 3584 ? n : n + 16;
                transpose_item(p.w_in, DIN, sc, kb * 64, p.ln1, (bf16_t*)(ws + WS_WIN), DM, nb * 32, kb * 64, scr, lane); continue; }
            r -= I_IN;
            if (r < I_MX) { const int kb = r / 32, nb = r % 32; transpose_item(p.w_ret_out, DM, nb * 32 + nl, kb * 64, nullptr, (bf16_t*)(ws + WS_WMIX), DM, nb * 32, kb * 64, scr, lane); continue; }
            r -= I_MX;
            if (r < I_MX) { const int kb = r / 32, nb = r % 32; transpose_item(p.w_gla_out, DM, nb * 32 + nl, kb * 64, nullptr, (bf16_t*)(ws + WS_WMIX), DM, nb * 32, 512 + kb * 64, scr, lane); continue; }
            r -= I_MX;
            if (r < I_O) { const int kb = r / 32, nb = r % 32; transpose_item(p.w_o, DM, nb * 32 + nl, kb * 64, nullptr, (bf16_t*)(ws + WS_WO), DM, nb * 32, kb * 64, scr, lane); continue; }
            r -= I_O;
            if (r < I_UP) { const int kb = r / 176, nb = r % 176; transpose_item(p.w_up, NUP, nb * 32 + nl, kb * 64, p.ln2, (bf16_t*)(ws + WS_WUP), DM, nb * 32, kb * 64, scr, lane); continue; }
            r -= I_UP;
            { const int kb = r / 32, nb = r % 32; transpose_item(p.w_down, DM, nb * 32 + nl, kb * 64, nullptr, (bf16_t*)(ws + WS_WDN), DFF, nb * 32, kb * 64, scr, lane); }
        }
    }
}

template <int DK> DI unsigned img_off(int row, int ch) { return (unsigned)(row * (2 * DK) + 16 * (ch ^ ((((row & 3) << 2) | ((row >> 2) & 3)) & (DK / 8 - 1)))); }
template <int DK> DI unsigned tr_addr(int lane, int c, int ks, int t) {
    const int h = lane >> 5, blk = (lane >> 4) & 1, q = (lane & 15) >> 2, pp = lane & 3;
    return img_off<DK>(16 * ks + 8 * h + 4 * t + q, 4 * c + 2 * blk + (pp >> 1)) + 8 * (pp & 1);
}
DI bf16x8 tr_frag(LAS unsigned char* a0, LAS unsigned char* a1) {
    const s16x4 lo = __builtin_amdgcn_ds_read_tr16_b64_v4i16((LAS s16x4*)a0), hi = __builtin_amdgcn_ds_read_tr16_b64_v4i16((LAS s16x4*)a1);
    return __builtin_shufflevector(lo, hi, 0, 1, 2, 3, 4, 5, 6, 7);
}
DI bf16x8 pack8(const f32x16& x, int s) {
    u32x4 w; w.x = pk2(x[8 * s + 0], x[8 * s + 1]); w.y = pk2(x[8 * s + 2], x[8 * s + 3]); w.z = pk2(x[8 * s + 4], x[8 * s + 5]); w.w = pk2(x[8 * s + 6], x[8 * s + 7]);
    return __builtin_bit_cast(bf16x8, w);
}
#define MFMA32(a, b, c) __builtin_amdgcn_mfma_f32_32x32x16_bf16((a), (b), (c), 0, 0, 0)

constexpr int P2_BUF = 49152, P2_QO = 0, P2_KO = 16384, P2_VO = 32768, P2_P = 98304, P2_SSQ = P2_P + 64 * 144, P2_EBL = P2_SSQ + 1024;

template <int DK> DI void chain_prompt(const Params& p, LAS unsigned char* lds, const int branch, const int b, const int head) {
    constexpr int NDB = DK / 32, NCH = DK / 8, QLD = 4 * DK, NQI = (64 * NCH) / 512;
    int tid0 = threadIdx.x; asm volatile("" : "+v"(tid0));
    const int w = __builtin_amdgcn_readfirstlane(tid0 >> 6);
    int tid = tid0, lane = tid0 & 63, h = lane >> 5, r = lane & 31;
    unsigned char* ws = p.ws;
    const bf16_t* Q = (const bf16_t*)(ws + (branch == 0 ? PQ_R : PQ_G)) + head * DK;
    const bf16_t* K = (const bf16_t*)(ws + (branch == 0 ? PK_R : PK_G)) + head * DK;
    const bf16_t* V = (const bf16_t*)(ws + (branch == 0 ? PV_R : PV_G)) + head * 128;
    const bf16_t* G = (const bf16_t*)(ws + (branch == 0 ? PG_R : PG_G)) + head * 128;
    const float* ebl = (const float*)(ws + WS_EBL);
    bf16_t* arg = (bf16_t*)((unsigned char*)p.out + SEG1024) + branch * 512 + head * 128;
    const float* gain = (branch == 0 ? p.g_ret : p.g_gla) + head * 128;
    const int tok0 = b * 2048;
    const float lg2 = log2f(1.f - exp2f(-5.f - (float)head));
    const float ret_ebl = exp2f(64.f * lg2);
    f32x16 S[NDB];
#pragma unroll
    for (int d = 0; d < NDB; ++d)
#pragma unroll
        for (int i = 0; i < 16; ++i) S[d][i] = 0.f;
    u32x4 rq[NQI], rk[NQI], rv[2]; float rebl = 0.f;
#define P2_LOAD(c) do { const int tb = tok0 + 64 * (c); \
        _Pragma("unroll") for (int i = 0; i < NQI; ++i) { const int idx = tid + 512 * i, rr = idx / NCH, ch = idx % NCH; \
            rq[i] = *(const u32x4*)(Q + (size_t)(tb + rr) * QLD + ch * 8); rk[i] = *(const u32x4*)(K + (size_t)(tb + rr) * QLD + ch * 8); } \
        _Pragma("unroll") for (int i = 0; i < 2; ++i) { const int idx = tid + 512 * i, rr = idx >> 4, ch = idx & 15; rv[i] = *(const u32x4*)(V + (size_t)(tb + rr) * 512 + ch * 8); } \
        if (DK == 64 && tid < 64) rebl = ebl[(size_t)(b * 32 + (c)) * 256 + head * 64 + tid]; } while (0)
#define P2_STORE(buf) do { LAS unsigned char* bb = lds + (buf) * P2_BUF; \
        _Pragma("unroll") for (int i = 0; i < NQI; ++i) { const int idx = tid + 512 * i, rr = idx / NCH, ch = idx % NCH; \
            *(LAS u32x4*)(bb + P2_QO + img_off<DK>(rr, ch)) = rq[i]; *(LAS u32x4*)(bb + P2_KO + img_off<DK>(rr, ch)) = rk[i]; } \
        _Pragma("unroll") for (int i = 0; i < 2; ++i) { const int idx = tid + 512 * i, rr = idx >> 4, ch = idx & 15; *(LAS u32x4*)(bb + P2_VO + img_off<128>(rr, ch)) = rv[i]; } \
        if (DK == 64 && tid < 64) *(LAS float*)(lds + P2_EBL + (buf) * 256 + tid * 4) = rebl; } while (0)
    P2_LOAD(0); P2_STORE(0);
    __syncthreads();
    for (int c = 0; c < 32; ++c) {
        tid = tid0; asm volatile("" : "+v"(tid)); lane = tid & 63; h = lane >> 5; r = lane & 31;
        LAS unsigned char* bb = lds + (c & 1) * P2_BUF;
        LAS unsigned char* qi = bb + P2_QO; LAS unsigned char* ki = bb + P2_KO; LAS unsigned char* vi = bb + P2_VO;
        if (c + 1 < 32) P2_LOAD(c + 1);
        if (w < 4) {
            if (w < 3) {
                const int jb = (w == 2) ? 1 : 0, ib = (w == 0) ? 0 : 1;
                f32x16 pt;
#pragma unroll
                for (int i = 0; i < 16; ++i) pt[i] = 0.f;
#pragma unroll
                for (int s = 0; s < DK / 16; ++s) {
                    const bf16x8 a = *(const LAS bf16x8*)(ki + img_off<DK>(32 * jb + r, 2 * s + h)), bq = *(const LAS bf16x8*)(qi + img_off<DK>(32 * ib + r, 2 * s + h));
                    pt = MFMA32(a, bq, pt);
                }
                if (jb == ib) {
#pragma unroll
                    for (int i = 0; i < 16; ++i) { const int j = (i & 3) + 8 * (i >> 2) + 4 * h; pt[i] = (j <= r) ? pt[i] : 0.f; }
                }
#pragma unroll
                for (int g = 0; g < 4; ++g) { u32x2 o; o.x = pk2(pt[4 * g], pt[4 * g + 1]); o.y = pk2(pt[4 * g + 2], pt[4 * g + 3]);
                    *(LAS u32x2*)(lds + P2_P + (32 * ib + r) * 144 + (32 * jb + 8 * g + 4 * h) * 2) = o; }
            }
        }
        __syncthreads();
        f32x16 ot[2];
        if (w < 4) {
            bf16x8 vf[4];
#pragma unroll
            for (int s = 0; s < 4; ++s) vf[s] = tr_frag(vi + tr_addr<128>(lane, w, s, 0), vi + tr_addr<128>(lane, w, s, 1));
#pragma unroll
            for (int ib = 0; ib < 2; ++ib) {
#pragma unroll
                for (int i = 0; i < 16; ++i) ot[ib][i] = 0.f;
#pragma unroll
                for (int s = 0; s < (ib == 0 ? 2 : 4); ++s) {
                    const bf16x8 bp = *(const LAS bf16x8*)(lds + P2_P + (32 * ib + r) * 144 + (16 * s + 8 * h) * 2);
                    ot[ib] = MFMA32(vf[s], bp, ot[ib]);
                }
            }
#pragma unroll
            for (int d = 0; d < NDB; ++d)
#pragma unroll
                for (int s2 = 0; s2 < 2; ++s2) {
                    const bf16x8 sfr = pack8(S[d], s2);
#pragma unroll
                    for (int ib = 0; ib < 2; ++ib) {
                        const s16x4 lo = *(const LAS s16x4*)(qi + img_off<DK>(32 * ib + r, 4 * d + 2 * s2) + 8 * h), hi = *(const LAS s16x4*)(qi + img_off<DK>(32 * ib + r, 4 * d + 2 * s2 + 1) + 8 * h);
                        const bf16x8 bq = __builtin_shufflevector(lo, hi, 0, 1, 2, 3, 4, 5, 6, 7);
                        ot[ib] = MFMA32(sfr, bq, ot[ib]);
                    }
                }
#pragma unroll
            for (int d = 0; d < NDB; ++d) {
#pragma unroll
                for (int s = 0; s < 4; ++s) {
                    const bf16x8 a = tr_frag(ki + tr_addr<DK>(lane, d, s, 0), ki + tr_addr<DK>(lane, d, s, 1));
                    S[d] = MFMA32(a, vf[s], S[d]);
                }
                if (DK == 128) {
#pragma unroll
                    for (int i = 0; i < 16; ++i) S[d][i] *= ret_ebl;
                } else {
                    const LAS float* eb = (const LAS float*)(lds + P2_EBL + (c & 1) * 256) + 32 * d + 4 * h;
#pragma unroll
                    for (int g = 0; g < 4; ++g) { const f32x4 e4 = *(const LAS f32x4*)(eb + 8 * g);
#pragma unroll
                        for (int e = 0; e < 4; ++e) S[d][4 * g + e] *= e4[e]; }
                }
            }
#pragma unroll
            for (int ib = 0; ib < 2; ++ib) { float ss = 0.f;
#pragma unroll
                for (int i = 0; i < 16; ++i) ss += ot[ib][i] * ot[ib][i];
                ss += __shfl_xor(ss, 32);
                if (h == 0) *(LAS float*)(lds + P2_SSQ + (w * 64 + 32 * ib + r) * 4) = ss; }
        }
        if (c + 1 < 32) P2_STORE((c + 1) & 1);
        __syncthreads();
        if (w < 4) {
            asm volatile("" : "+v"(lane)); h = lane >> 5; r = lane & 31;
            const int tb = tok0 + 64 * c;
#pragma unroll
            for (int ib = 0; ib < 2; ++ib) {
                const LAS float* sq = (const LAS float*)(lds + P2_SSQ) + 32 * ib + r;
                const float tot = sq[0] + sq[64] + sq[128] + sq[192];
                const float rs = rsqrtf(tot * (1.f / 128.f) + EPS);
#pragma unroll
                for (int g = 0; g < 4; ++g) {
                    const u32x2 gg = *(const u32x2*)(G + (size_t)(tb + 32 * ib + r) * 512 + 32 * w + 8 * g + 4 * h);
                    const f32x4 gn = *(const f32x4*)(gain + 32 * w + 8 * g + 4 * h);
                    u32x2 o; o.x = pk2(ot[ib][4 * g] * rs * gn[0] * bflo(gg.x), ot[ib][4 * g + 1] * rs * gn[1] * bfhi(gg.x));
                    o.y = pk2(ot[ib][4 * g + 2] * rs * gn[2] * bflo(gg.y), ot[ib][4 * g + 3] * rs * gn[3] * bfhi(gg.y));
                    *(u32x2*)(arg + (size_t)(tb + 32 * ib + r) * 1024 + 32 * w + 8 * g + 4 * h) = o;
                }
            }
        }
    }
#undef P2_LOAD
#undef P2_STORE
    if (w < 4) {
        lane = tid0 & 63; h = lane >> 5; r = lane & 31;
        float* so = p.out + (branch == 0 ? OUT_RSP : OUT_GSP) + (size_t)(b * 4 + head) * DK * 128;
#pragma unroll
        for (int d = 0; d < NDB; ++d)
#pragma unroll
            for (int i = 0; i < 16; ++i) so[(size_t)(32 * d + (i & 3) + 8 * (i >> 2) + 4 * h) * 128 + 32 * w + r] = S[d][i];
    }
    __syncthreads();
}

template <int DK> DI void sample_unit(const Params& p, LAS unsigned char* lds, const int branch, const int b, const int head) {
    int tid = threadIdx.x; asm volatile("" : "+v"(tid));
    unsigned char* ws = p.ws;
    const bf16_t* Q = (const bf16_t*)(ws + (branch == 0 ? PQ_R : PQ_G)) + head * DK;
    const bf16_t* K = (const bf16_t*)(ws + (branch == 0 ? PK_R : PK_G)) + head * DK;
    const bf16_t* V = (const bf16_t*)(ws + (branch == 0 ? PV_R : PV_G)) + head * 128;
    const bf16_t* G = (const bf16_t*)(ws + (branch == 0 ? PG_R : PG_G)) + head * 128;
    bf16_t* arg = (bf16_t*)((unsigned char*)p.out + SEG1024) + branch * 512 + head * 128;
    const float* gain = (branch == 0 ? p.g_ret : p.g_gla) + head * 128;
    const float* sin_ = (branch == 0 ? p.state_ret : p.state_gla) + (size_t)(b * 4 + head) * DK * 128;
    float* sout = p.out + (branch == 0 ? OUT_RSS : OUT_GSS) + (size_t)(b * 4 + head) * DK * 128;
    const int tok0 = TP + 4 * b;
    LAS float* qs = (LAS float*)lds;
    LAS float* ks = qs + 4 * 128;
    LAS float* vs = ks + 4 * 128;
    LAS float* es = vs + 4 * 128;
    LAS float* Ps = es + 128;
    LAS float* ssq = Ps + 16;
    LAS float* op = ssq + 16;
    for (int i = tid; i < 4 * DK; i += 512) { const int t = i / DK, d = i % DK;
        qs[t * DK + d] = __uint_as_float((unsigned)Q[(size_t)(tok0 + t) * (4 * DK) + d] << 16); ks[t * DK + d] = __uint_as_float((unsigned)K[(size_t)(tok0 + t) * (4 * DK) + d] << 16); }
    { const int t = tid >> 7, v = tid & 127; vs[t * 128 + v] = __uint_as_float((unsigned)V[(size_t)(tok0 + t) * 512 + v] << 16); }
    if (tid < DK) {
        if (DK == 128) { const float lg2 = log2f(1.f - exp2f(-5.f - (float)head)); es[tid] = exp2f(4.f * lg2); }
        else es[tid] = ((const float*)(ws + WS_EBL))[(size_t)(256 + b) * 256 + head * 64 + tid];
    }
    __syncthreads();
    if (tid < 16) { const int i = tid >> 2, j = tid & 3; float s = 0.f; if (j <= i) { for (int d = 0; d < DK; ++d) s += qs[i * DK + d] * ks[j * DK + d]; } Ps[tid] = s; }
    {
        const int vq = tid & 31, dg = tid >> 5;
        f32x4 oa[4];
#pragma unroll
        for (int i = 0; i < 4; ++i) oa[i] = (f32x4){0.f, 0.f, 0.f, 0.f};
        f32x4 v4[4];
#pragma unroll
        for (int j = 0; j < 4; ++j) v4[j] = *(const LAS f32x4*)(vs + j * 128 + 4 * vq);
        f32x4 s0[DK / 16];
#pragma unroll
        for (int rr = 0; rr < DK / 16; ++rr) s0[rr] = *(const f32x4*)(sin_ + (size_t)(dg + 16 * rr) * 128 + 4 * vq);
#pragma unroll
        for (int rr = 0; rr < DK / 16; ++rr) {
            const int d = dg + 16 * rr;
            f32x4 sn = s0[rr];
#pragma unroll
            for (int i = 0; i < 4; ++i) { oa[i] += s0[rr] * qs[i * DK + d]; sn += v4[i] * ks[i * DK + d]; }
            sn *= es[d];
            *(f32x4*)(sout + (size_t)d * 128 + 4 * vq) = sn;
        }
#pragma unroll
        for (int i = 0; i < 4; ++i) *(LAS f32x4*)(op + (dg * 4 + i) * 128 + 4 * vq) = oa[i];
    }
    __syncthreads();
    {
        const int i = tid >> 7, v = tid & 127;
        float o = 0.f;
#pragma unroll
        for (int dg = 0; dg < 16; ++dg) o += op[(dg * 4 + i) * 128 + v];
#pragma unroll
        for (int j = 0; j < 4; ++j) o += Ps[i * 4 + j] * vs[j * 128 + v];
        const float s = wave_sum(o * o);
        if ((tid & 63) == 0) ssq[tid >> 6] = s;
        __syncthreads();
        const float rs = rsqrtf((ssq[2 * i] + ssq[2 * i + 1]) * (1.f / 128.f) + EPS);
        const float gate = __uint_as_float((unsigned)G[(size_t)(tok0 + i) * 512 + v] << 16);
        const unsigned wv = pk2(o * rs * gain[v] * gate, 0.f);
        arg[(size_t)(tok0 + i) * 1024 + v] = (bf16_t)(wv & 0xffffu);
    }
    __syncthreads();
}

DI void phase2(const Params& p, LAS unsigned char* lds) {
    const int G = gridDim.x, bx = blockIdx.x;
    const int nchb = G > 64 ? 64 : G;
    if (bx < nchb) {
        for (int c = bx; c < 64; c += nchb) {
            const int branch = c >> 5, bh = c & 31;
#ifndef NO_CH128
            if (branch == 0) chain_prompt<128>(p, lds, 0, bh >> 2, bh & 3);
#endif
#ifndef NO_CH64
            if (branch == 1) chain_prompt<64>(p, lds, 1, bh >> 2, bh & 3);
#endif
        }
    }
    const int nsb = G > 64 ? G - 64 : G, sb = G > 64 ? bx - 64 : bx;
    if (sb >= 0) {
        for (int u = sb; u < 1024; u += nsb) {
            const int branch = u >> 9, bh = u & 511;
#ifndef NO_SMP
            if (branch == 0) sample_unit<128>(p, lds, 0, bh >> 2, bh & 3); else sample_unit<64>(p, lds, 1, bh >> 2, bh & 3);
#endif
        }
    }
}

DI void phase_conv(const Params& p) {
    bf16_t* up = (bf16_t*)(p.ws + WS_UP);
    const int gt = blockIdx.x * 512 + threadIdx.x, ng = gridDim.x * 512;
    constexpr int NC8 = DFF / 8;
    for (int it = gt; it < T_TOK * NC8; it += ng) {
        const int tok = it / NC8, f = (it % NC8) * 8;
        int l, bidx; bool samp = tok >= TP;
        if (!samp) { l = tok & 2047; bidx = tok >> 11; } else { l = (tok - TP) & 3; bidx = (tok - TP) >> 2; }
        float u0[8], u1[8], u2[8], vv[8];
        { const u32x4 a = *(const u32x4*)(up + (size_t)tok * NUP + f); u2[0] = bflo(a.x); u2[1] = bfhi(a.x); u2[2] = bflo(a.y); u2[3] = bfhi(a.y); u2[4] = bflo(a.z); u2[5] = bfhi(a.z); u2[6] = bflo(a.w); u2[7] = bfhi(a.w); }
        { const u32x4 a = *(const u32x4*)(up + (size_t)tok * NUP + DFF + f); vv[0] = bflo(a.x); vv[1] = bfhi(a.x); vv[2] = bflo(a.y); vv[3] = bfhi(a.y); vv[4] = bflo(a.z); vv[5] = bfhi(a.z); vv[6] = bflo(a.w); vv[7] = bfhi(a.w); }
        if (l >= 1) { const u32x4 a = *(const u32x4*)(up + (size_t)(tok - 1) * NUP + f); u1[0] = bflo(a.x); u1[1] = bfhi(a.x); u1[2] = bflo(a.y); u1[3] = bfhi(a.y); u1[4] = bflo(a.z); u1[5] = bfhi(a.z); u1[6] = bflo(a.w); u1[7] = bfhi(a.w); }
        else if (samp) { const float* cp = p.cache_conv + ((size_t)bidx * 2 + 1) * DFF + f;
#pragma unroll
            for (int e = 0; e < 8; ++e) u1[e] = cp[e]; }
        else {
#pragma unroll
            for (int e = 0; e < 8; ++e) u1[e] = 0.f; }
        if (l >= 2) { const u32x4 a = *(const u32x4*)(up + (size_t)(tok - 2) * NUP + f); u0[0] = bflo(a.x); u0[1] = bfhi(a.x); u0[2] = bflo(a.y); u0[3] = bfhi(a.y); u0[4] = bflo(a.z); u0[5] = bfhi(a.z); u0[6] = bflo(a.w); u0[7] = bfhi(a.w); }
        else if (samp) { const float* cp = p.cache_conv + ((size_t)bidx * 2 + l) * DFF + f;
#pragma unroll
            for (int e = 0; e < 8; ++e) u0[e] = cp[e]; }
        else {
#pragma unroll
            for (int e = 0; e < 8; ++e) u0[e] = 0.f; }
        float a8[8];
#pragma unroll
        for (int e = 0; e < 8; ++e) {
            const float uc = p.conv_b[f + e] + p.conv_w[f + e] * u0[e] + p.conv_w[DFF + f + e] * u1[e] + p.conv_w[2 * DFF + f + e] * u2[e];
            a8[e] = 0.5f * uc * (1.f + erff(uc * 0.70710678118654752f)) * vv[e];
        }
        u32x4 w; w.x = pk2(a8[0], a8[1]); w.y = pk2(a8[2], a8[3]); w.z = pk2(a8[4], a8[5]); w.w = pk2(a8[6], a8[7]);
        *(u32x4*)(up + (size_t)tok * NUP + DFF + f) = w;
        if (!samp) { if (l >= 2046) { float* o = p.out + OUT_CP + ((size_t)bidx * 2 + (l - 2046)) * DFF + f;
#pragma unroll
                for (int e = 0; e < 8; ++e) o[e] = u2[e]; } }
        else if (l >= 2) { float* o = p.out + OUT_CS + ((size_t)bidx * 2 + (l - 2)) * DFF + f;
#pragma unroll
            for (int e = 0; e < 8; ++e) o[e] = u2[e]; }
    }
}

DI void phase_final(const Params& p) {
    const int lane = threadIdx.x & 63, gw = blockIdx.x * 8 + (threadIdx.x >> 6), ngw = gridDim.x * 8;
    for (int row = gw; row < T_TOK; row += ngw) {
        f32x4* hp = (f32x4*)(p.out + (size_t)row * DM) + lane;
        f32x4 v[4]; float s = 0.f;
#pragma unroll
        for (int j = 0; j < 4; ++j) { v[j] = hp[64 * j]; s += v[j][0] * v[j][0] + v[j][1] * v[j][1] + v[j][2] * v[j][2] + v[j][3] * v[j][3]; }
        const float rs = rsqrtf(wave_sum(s) * (1.f / DM) + EPS);
#pragma unroll
        for (int j = 0; j < 4; ++j) { const f32x4 g = *((const f32x4*)p.ln_f + lane + 64 * j); hp[64 * j] = v[j] * rs * g; }
    }
}

__global__ void __launch_bounds__(512, 2) fwd_megakernel(Params p) {
    extern __shared__ __attribute__((aligned(16))) unsigned char shm[];
    LAS unsigned char* lds = (LAS unsigned char*)shm;
    cg::grid_group grid = cg::this_grid();
    unsigned char* ws = p.ws;
    const int G = gridDim.x, bx = blockIdx.x;
    bf16_t* xb = (bf16_t*)p.out;
    bf16_t* arg = (bf16_t*)((unsigned char*)p.out + SEG1024);

#ifndef PHMASK
#define PHMASK 0x1ff
#endif
#define PH(n) if ((PHMASK >> (n)) & 1)
    PH(0) phase0(p, lds);
    grid.sync();
    PH(1) {
        pg8::Gemm g{xb, (const bf16_t*)(ws + WS_WIN), T_TOK, NPROJ, DM, DM, DM}; pg8::StaticOrder S; S.init(T_TOK, NPROJ, G, bx);
        EpiProj E{ws, (const float*)(ws + WS_RSTD1), (const float*)(ws + WS_SH), (const float*)(ws + WS_ROPEC), (const float*)(ws + WS_ROPES)};
        pg8::gemm_phase<EpiProj>(lds, g, S, E);
    }
    grid.sync();
    PH(2) phase2(p, lds);
    grid.sync();
    PH(3) {
        pg8::Gemm g{arg, (const bf16_t*)(ws + WS_WMIX), T_TOK, DM, DM, DM, DM}; pg8::StaticOrder S; S.init(T_TOK, DM, G, bx);
        EpiMix E{(const bf16_t*)(ws + PM_R), (const bf16_t*)(ws + PM_G), (bf16_t*)(ws + WS_MIX)};
        pg8::gemm_phase<EpiMix>(lds, g, S, E);
    }
    grid.sync();
    PH(4) {
        pg8::Gemm g{(const bf16_t*)(ws + WS_MIX), (const bf16_t*)(ws + WS_WO), T_TOK, DM, DM, DM, DM}; pg8::StaticOrder S; S.init(T_TOK, DM, G, bx);
        EpiH E{p.x_prompt, p.x_sample, p.out, (bf16_t*)(ws + WS_SH), (float*)(ws + WS_SSQ2)};
        pg8::gemm_phase<EpiH>(lds, g, S, E);
    }
    grid.sync();
    PH(5) {
        pg8::Gemm g{(const bf16_t*)(ws + WS_SH), (const bf16_t*)(ws + WS_WUP), T_TOK, NUP, DM, DM, DM}; pg8::StaticOrder S; S.init(T_TOK, NUP, G, bx);
        EpiUp E{(const float*)(ws + WS_SSQ2), (bf16_t*)(ws + WS_UP)};
        pg8::gemm_phase<EpiUp>(lds, g, S, E);
    }
    grid.sync();
    PH(6) phase_conv(p);
    grid.sync();
    PH(7) {
        pg8::Gemm g{(const bf16_t*)(ws + WS_UP) + DFF, (const bf16_t*)(ws + WS_WDN), T_TOK, DM, DFF, NUP, DFF}; pg8::StaticOrder S; S.init(T_TOK, DM, G, bx);
        EpiDown E{p.out};
        pg8::gemm_phase<EpiDown>(lds, g, S, E);
    }
    grid.sync();
    PH(8) phase_final(p);
}

extern "C" void kernel_launch(void* const* d_in, const int* in_sizes, int n_in, void* d_out, int out_size, void* d_ws, size_t ws_size, hipStream_t stream) {
    static int grid = 0;
    if (grid == 0) {
        if (n_in != 20 || out_size != (int)OUT_END || ws_size < WS_END) { fprintf(stderr, "kernel_launch: unexpected shapes (n_in %d, out %d, ws %zu)\n", n_in, out_size, ws_size); grid = -1; return; }
        int dev = 0, cus = 0, per_cu = 0;
        hipGetDevice(&dev);
        hipDeviceGetAttribute(&cus, hipDeviceAttributeMultiprocessorCount, dev);
        if (hipFuncSetAttribute((const void*)fwd_megakernel, hipFuncAttributeMaxDynamicSharedMemorySize, LDS_BYTES) != hipSuccess) { fprintf(stderr, "kernel_launch: hipFuncSetAttribute failed\n"); grid = -1; return; }
        hipOccupancyMaxActiveBlocksPerMultiprocessor(&per_cu, (const void*)fwd_megakernel, 512, LDS_BYTES);
        if (per_cu < 1) { fprintf(stderr, "kernel_launch: occupancy query gave %d\n", per_cu); per_cu = 1; }
        grid = cus * 1;
        (void)hipGetLastError();
    }
    if (grid < 0) return;
    Params p{};
    const float** f = (const float**)&p;
    for (int i = 0; i < 20; ++i) f[i] = (const float*)d_in[i];
    p.out = (float*)d_out; p.ws = (unsigned char*)d_ws;
    void* args[] = {&p};
    hipError_t e = hipLaunchCooperativeKernel((const void*)fwd_megakernel, dim3(grid), dim3(512), args, LDS_BYTES, stream);
    if (e != hipSuccess) fprintf(stderr, "cooperative launch failed: %s (grid %d)\n", hipGetErrorString(e), grid);
}
```

```cpp
#include <hip/hip_runtime.h>
#include <hip/hip_cooperative_groups.h>
#include <cstdio>
namespace cg = cooperative_groups;

#define LAS __attribute__((address_space(3)))
#define DI __device__ __forceinline__
typedef unsigned short bf16_t;
typedef short bf16x8 __attribute__((ext_vector_type(8)));
typedef short s16x4 __attribute__((ext_vector_type(4)));
typedef float f32x4 __attribute__((ext_vector_type(4)));
typedef float f32x2 __attribute__((ext_vector_type(2)));
typedef float f32x16 __attribute__((ext_vector_type(16)));
typedef unsigned u32x4 __attribute__((ext_vector_type(4)));
typedef unsigned u32x2 __attribute__((ext_vector_type(2)));
typedef __bf16 bf16x2_t __attribute__((ext_vector_type(2)));

constexpr int T_TOK = 16896, TP = 16384, DM = 1024, DIN = 5648, NPROJ = 5632, DFF = 2816, NUP = 5632;
constexpr float EPS = 1e-6f;
constexpr size_t OUT_Y = 0, OUT_RSP = 17301504, OUT_RSS = OUT_RSP + 524288, OUT_GSP = OUT_RSS + 8388608, OUT_GSS = OUT_GSP + 262144,
                 OUT_CP = OUT_GSS + 4194304, OUT_CS = OUT_CP + 45056, OUT_END = OUT_CS + 720896;
constexpr size_t WS_WIN = 0, WS_WMIX = WS_WIN + (size_t)NPROJ * DM * 2, WS_WO = WS_WMIX + (size_t)DM * DM * 2, WS_WUP = WS_WO + (size_t)DM * DM * 2,
                 WS_WDN = WS_WUP + (size_t)NUP * DM * 2, WS_PROJ = WS_WDN + (size_t)DM * DFF * 2;
constexpr size_t SEG512 = (size_t)T_TOK * 512 * 2, SEG256 = (size_t)T_TOK * 256 * 2, SEG1024 = (size_t)T_TOK * 1024 * 2;
constexpr size_t PQ_R = WS_PROJ, PK_R = PQ_R + SEG512, PV_R = PK_R + SEG512, PG_R = PV_R + SEG512, PQ_G = PG_R + SEG512, PK_G = PQ_G + SEG256,
                 PV_G = PK_G + SEG256, PG_G = PV_G + SEG512, PM_R = PG_G + SEG512, PM_G = PM_R + SEG1024, WS_PROJ_END = PM_G + SEG1024;
constexpr size_t WS_MIX = PQ_R;
constexpr size_t WS_ACT = WS_PROJ;
constexpr size_t WS_SH = WS_PROJ_END;
constexpr size_t WS_RSTD1 = WS_SH + SEG1024, WS_SSQ2 = WS_RSTD1 + (size_t)T_TOK * 4, WS_EBL = WS_SSQ2 + (size_t)T_TOK * 4,
                 WS_ROPEC = WS_EBL + (size_t)384 * 256 * 4, WS_ROPES = WS_ROPEC + (size_t)2052 * 64 * 4, WS_END = WS_ROPES + (size_t)2052 * 64 * 4;
static_assert(WS_PROJ_END - WS_PROJ == (size_t)T_TOK * NPROJ * 2, "proj layout");
static_assert(WS_END <= (size_t)256 * 1024 * 1024, "workspace");
constexpr int LDS_BYTES = 131072 + 4096;

struct Params {
    const float *x_prompt, *x_sample, *state_ret, *state_gla, *cache_conv, *ln1, *w_in, *w_gate_up, *b_gate_up, *g_ret, *g_gla, *w_ret_out, *w_gla_out,
        *w_o, *ln2, *w_up, *conv_w, *conv_b, *w_down, *ln_f;
    float* out; unsigned char* ws;
};

DI unsigned pk2(float lo, float hi) { f32x2 v = {lo, hi}; bf16x2_t b = __builtin_convertvector(v, bf16x2_t); return __builtin_bit_cast(unsigned, b); }
DI float bflo(unsigned w) { return __uint_as_float(w << 16); }
DI float bfhi(unsigned w) { return __uint_as_float(w & 0xffff0000u); }
DI float wave_sum(float v) {
#pragma unroll
    for (int o = 1; o < 64; o <<= 1) v += __shfl_xor(v, o);
    return v;
}
DI float sigmoidf_(float x) { return 1.f / (1.f + __expf(-x)); }
DI const float* x_row(const Params& p, int tok) { return tok < TP ? p.x_prompt + (size_t)tok * DM : p.x_sample + (size_t)(tok - TP) * DM; }
#define LDS_WAIT() asm volatile("s_waitcnt lgkmcnt(0)" ::: "memory")

namespace pg8 {
constexpr int BM = 256, BK = 64, HALF = 128, HTB = HALF * BK * 2, STAGE_BYTES = 8 * HTB, NXCD = 8, WGM = 8;
DI int lds_byte(int r, int c) { const int st = (r >> 4) * 2 + (c >> 5), rr = r & 15, cc = c & 31, ob = rr * 64 + cc * 2; return st * 1024 + (ob ^ (((ob >> 9) & 1) << 5)); }
DI void stage_rc(int b, int& R, int& C) { const int st = b / 1024, sb = b % 1024, swz = sb ^ (((sb >> 9) & 1) << 5); R = (st >> 1) * 16 + swz / 64; C = (st & 1) * 32 + (swz % 64) / 2; }
DI int perm32(int rho) { const int n = rho >> 4, i = rho & 15; return 8 * (i >> 2) + 4 * n + (i & 3); }
struct Unit { int pm, pn; };
struct Gemm { const bf16_t* A; const bf16_t* Bt; int M, N, K, lda, ldb, mstep; };
struct StaticOrder {
    int nM, nN, nwg, G, c;
    DI void init(int M, int N, int G_, int c_) { nM = M / BM; nN = N / BM; nwg = nM * nN; G = G_; c = c_; }
    DI void init_tiles(int nM_, int nN_, int G_, int c_) { nM = nM_; nN = nN_; nwg = nM * nN; G = G_; c = c_; }
    DI bool next(int i, Unit& u) const {
        const long L = (long)i * G + c; if (L >= nwg) return false;
        int wgid = (int)L; { const int q = nwg / NXCD, r = nwg % NXCD, xcd = wgid % NXCD, off = wgid / NXCD; wgid = (xcd < r ? xcd * (q + 1) : r * (q + 1) + (xcd - r) * q) + off; }
        const int nig = WGM * nN, gid = wgid / nig, fm = gid * WGM, gsz = (nM - fm) < WGM ? (nM - fm) : WGM;
        u.pm = fm + ((wgid % nig) % gsz); u.pn = (wgid % nig) / gsz; return true;
    }
};
template <class Epi>
DI void gemm_phase(LAS unsigned char* lds, const Gemm g, const StaticOrder& S, const Epi& E) {
    int tid = threadIdx.x; asm volatile("" : "+v"(tid));
    const int wid = __builtin_amdgcn_readfirstlane(tid >> 6), lane = tid & 63, wr = wid >> 2, wc = wid & 3, fr = lane & 15, fq = lane >> 4;
    const int nt = g.K / BK;
    unsigned voffA[2], voffB[2];
#pragma unroll
    for (int i = 0; i < 2; ++i) { int R, C; stage_rc(tid * 16 + i * 8192, R, C); const int Rb = Epi::PERM ? ((R & ~31) + perm32(R & 31)) : R;
        voffA[i] = (unsigned)(R * g.lda + C) * 2u; voffB[i] = (unsigned)(Rb * g.ldb + C) * 2u; }
    const size_t kstep = (size_t)(BK * 2);
    const size_t hstepA = (size_t)HALF * g.lda * 2, hstepB = (size_t)HALF * g.ldb * 2;
    const size_t tstepA = (size_t)g.mstep * g.lda * 2, tstepB = 2 * hstepB;
    const unsigned ldsw = (unsigned)wid * 1024u;
    const int aoff = lds_byte(wr * 64 + fr, fq * 8), boff = lds_byte(wc * 32 + fr, fq * 8);
#define PG8_SA(b, h) (((b) * 2 + (h)) * HTB)
#define PG8_SB(b, h) ((4 + (b) * 2 + (h)) * HTB)
#define PG8_STAGE(bufoff, gbase, voff) do { _Pragma("unroll") for (int _i = 0; _i < 2; ++_i) \
        __builtin_amdgcn_global_load_lds((const unsigned*)((const char*)(gbase) + (voff)[_i]), (LAS unsigned*)(lds + (bufoff) + ldsw + _i * 8192), 16, 0, 0); } while (0)
#define PG8_LDA(dst, b, h) do { _Pragma("unroll") for (int m = 0; m < 4; ++m) _Pragma("unroll") for (int k = 0; k < 2; ++k) dst[m][k] = *(const LAS bf16x8*)(lds + PG8_SA(b, h) + aoff + m * 2048 + k * 1024); } while (0)
#define PG8_LDB(dst, b, h) do { _Pragma("unroll") for (int n = 0; n < 2; ++n) _Pragma("unroll") for (int k = 0; k < 2; ++k) dst[n][k] = *(const LAS bf16x8*)(lds + PG8_SB(b, h) + boff + n * 2048 + k * 1024); } while (0)
#define PG8_MMA(ai, bj, At, Bt) do { __builtin_amdgcn_s_setprio(1); _Pragma("unroll") for (int m = 0; m < 4; ++m) _Pragma("unroll") for (int n = 0; n < 2; ++n) _Pragma("unroll") for (int k = 0; k < 2; ++k) \
        acc[ai][bj][m][n] = __builtin_amdgcn_mfma_f32_16x16x32_bf16(Bt[n][k], At[m][k], acc[ai][bj][m][n], 0, 0, 0); __builtin_amdgcn_s_setprio(0); } while (0)
#define PG8_WAIT_V(n) asm volatile("s_waitcnt vmcnt(" #n ")" ::: "memory")
#define PG8_WAIT_L(n) asm volatile("s_waitcnt lgkmcnt(" #n ")" ::: "memory")
#define PG8_BAR __builtin_amdgcn_s_barrier()
#define PG8_SCHED __builtin_amdgcn_sched_barrier(0)
    Unit cur, nxt; int ui = 0;
    if (!S.next(0, cur)) return;
    f32x4 acc[2][2][4][2];
#pragma unroll
    for (int a = 0; a < 2; ++a)
#pragma unroll
        for (int b = 0; b < 2; ++b)
#pragma unroll
            for (int m = 0; m < 4; ++m)
#pragma unroll
                for (int n = 0; n < 2; ++n) acc[a][b][m][n] = (f32x4){0.f, 0.f, 0.f, 0.f};
    bf16x8 At[4][2], B0[2][2], B1[2][2];
    const char* cA = (const char*)g.A + (size_t)cur.pm * tstepA; const char* cB = (const char*)g.Bt + (size_t)cur.pn * tstepB;
    PG8_STAGE(PG8_SB(0, 0), cB, voffB); PG8_STAGE(PG8_SA(0, 0), cA, voffA); PG8_STAGE(PG8_SB(0, 1), cB + hstepB, voffB); PG8_STAGE(PG8_SA(0, 1), cA + hstepA, voffA);
    if (wr == 1) PG8_BAR;
    PG8_WAIT_V(4); PG8_BAR;
    PG8_STAGE(PG8_SB(1, 0), cB + kstep, voffB); PG8_STAGE(PG8_SA(1, 0), cA + kstep, voffA); PG8_STAGE(PG8_SB(1, 1), cB + hstepB + kstep, voffB);
    PG8_WAIT_V(6); PG8_BAR;
    for (;;) {
        const bool has_next = S.next(ui + 1, nxt);
        const char* nA = has_next ? (const char*)g.A + (size_t)nxt.pm * tstepA : cA; const char* nB = has_next ? (const char*)g.Bt + (size_t)nxt.pn * tstepB : cB;
        for (int t = 0; t < nt; t += 2) {
            const bool last = (t == nt - 2);
            const char* a1 = cA + (size_t)(t + 1) * kstep;
            const char* a2 = last ? nA : cA + (size_t)(t + 2) * kstep; const char* b2 = last ? nB : cB + (size_t)(t + 2) * kstep;
            const char* a3 = a2 + kstep; const char* b3 = b2 + kstep;
            if constexpr (Epi::MIDK) { if (t == (nt >> 1)) E.mid(acc, cur, wr, wc, fr, fq); }
            PG8_LDB(B0, 0, 0); PG8_SCHED; PG8_LDA(At, 0, 0); PG8_STAGE(PG8_SA(1, 1), a1 + hstepA, voffA);
            PG8_WAIT_L(8); PG8_BAR; PG8_WAIT_L(0); PG8_MMA(0, 0, At, B0); PG8_BAR; PG8_SCHED;
            PG8_LDB(B1, 0, 1); PG8_STAGE(PG8_SB(0, 0), b2, voffB);
            PG8_BAR; PG8_WAIT_L(0); PG8_MMA(0, 1, At, B1); PG8_BAR;
            PG8_LDA(At, 0, 1); PG8_STAGE(PG8_SA(0, 0), a2, voffA);
            PG8_BAR; PG8_WAIT_L(0); PG8_MMA(1, 0, At, B0); PG8_BAR; PG8_SCHED;
            PG8_STAGE(PG8_SB(0, 1), b2 + hstepB, voffB);
            PG8_WAIT_V(6); PG8_BAR; PG8_MMA(1, 1, At, B1); PG8_BAR;
            PG8_LDB(B0, 1, 0); PG8_SCHED; PG8_LDA(At, 1, 0); PG8_STAGE(PG8_SA(0, 1), a2 + hstepA, voffA);
            PG8_WAIT_L(8); PG8_BAR; PG8_WAIT_L(0); PG8_MMA(0, 0, At, B0); PG8_BAR; PG8_SCHED;
            PG8_LDB(B1, 1, 1); PG8_STAGE(PG8_SB(1, 0), b3, voffB);
            PG8_BAR; PG8_WAIT_L(0); PG8_MMA(0, 1, At, B1); PG8_BAR;
            PG8_LDA(At, 1, 1); PG8_STAGE(PG8_SA(1, 0), a3, voffA);
            PG8_BAR; PG8_WAIT_L(0); PG8_MMA(1, 0, At, B0); PG8_BAR; PG8_SCHED;
            PG8_STAGE(PG8_SB(1, 1), b3 + hstepB, voffB);
            PG8_WAIT_V(6); PG8_BAR; PG8_MMA(1, 1, At, B1); PG8_BAR;
        }
        E(acc, cur, wr, wc, fr, fq);
        if (!has_next) break;
#pragma unroll
        for (int a = 0; a < 2; ++a)
#pragma unroll
            for (int b = 0; b < 2; ++b)
#pragma unroll
                for (int m = 0; m < 4; ++m)
#pragma unroll
                    for (int n = 0; n < 2; ++n) acc[a][b][m][n] = (f32x4){0.f, 0.f, 0.f, 0.f};
        cur = nxt; cA = nA; cB = nB; ++ui;
    }
    PG8_WAIT_V(0);
    if (wr == 0) PG8_BAR;
    PG8_BAR;
#undef PG8_SA
#undef PG8_SB
#undef PG8_STAGE
#undef PG8_LDA
#undef PG8_LDB
#undef PG8_MMA
#undef PG8_WAIT_V
#undef PG8_WAIT_L
#undef PG8_BAR
#undef PG8_SCHED
}
}
using pg8::Unit;
typedef f32x4 AccT[2][2][4][2];

struct EpiProj {
    static constexpr bool PERM = true, MIDK = false;
    unsigned char* ws; const float* rstd1; const float* bcum; const float* ropec; const float* ropes;
    DI void mid(AccT&, const Unit&, int, int, int, int) const {}
    DI void operator()(const AccT& acc, const Unit& u, int wr, int wc, int fr, int fq) const {
        const int pn = u.pn; int seg, pn0;
        if (pn < 8) { seg = pn >> 1; pn0 = seg * 2; } else if (pn == 8) { seg = 4; pn0 = 8; } else if (pn == 9) { seg = 5; pn0 = 9; }
        else if (pn < 12) { seg = 6; pn0 = 10; } else if (pn < 14) { seg = 7; pn0 = 12; } else if (pn < 18) { seg = 8; pn0 = 14; } else { seg = 9; pn0 = 18; }
        size_t segoff; int ld;
        switch (seg) { case 0: segoff = PQ_R; ld = 512; break; case 1: segoff = PK_R; ld = 512; break; case 2: segoff = PV_R; ld = 512; break; case 3: segoff = PG_R; ld = 512; break;
            case 4: segoff = PQ_G; ld = 256; break; case 5: segoff = PK_G; ld = 256; break; case 6: segoff = PV_G; ld = 512; break; case 7: segoff = PG_G; ld = 512; break;
            case 8: segoff = PM_R; ld = 1024; break; default: segoff = PM_G; ld = 1024; break; }
        bf16_t* base = (bf16_t*)(ws + segoff);
        const int lc0 = (pn - pn0) * 256 + wc * 32 + 8 * fq;
        const int row0 = u.pm * 256 + wr * 64 + fr;
        if (seg <= 1) {
            const int i0 = 16 * wc + 4 * fq;
#pragma unroll
            for (int ai = 0; ai < 2; ++ai)
#pragma unroll
                for (int m = 0; m < 4; ++m) {
                    const int row = row0 + ai * 128 + m * 16; const float rs = rstd1[row];
                    int posidx, ic; if (row < TP) { posidx = row & 2047; ic = row & 63; } else { const int s = row - TP; posidx = 2048 + (s & 3); ic = s & 3; }
                    const f32x4 c4 = *(const f32x4*)(ropec + posidx * 64 + i0), s4 = *(const f32x4*)(ropes + posidx * 64 + i0);
#pragma unroll
                    for (int bj = 0; bj < 2; ++bj) {
                        const int head = (pn - pn0) * 2 + bj;
                        const float lg2 = log2f(1.f - exp2f(-5.f - (float)head));
                        const float dec = (seg == 0) ? exp2f((float)(ic + 1) * lg2) : exp2f(-(float)(ic + 1) * lg2) * 0.08838834764831845f;
                        const f32x4 t1 = acc[ai][bj][m][0] * rs, t2 = acc[ai][bj][m][1] * rs;
                        const f32x4 o1 = (t1 * c4 - t2 * s4) * dec, o2 = (t1 * s4 + t2 * c4) * dec;
                        bf16_t* rp = base + (size_t)row * 512 + head * 128 + i0;
                        u32x2 w1, w2; w1.x = pk2(o1[0], o1[1]); w1.y = pk2(o1[2], o1[3]); w2.x = pk2(o2[0], o2[1]); w2.y = pk2(o2[2], o2[3]);
                        *(u32x2*)rp = w1; *(u32x2*)(rp + 64) = w2;
                    }
                }
            return;
        }
#pragma unroll
        for (int ai = 0; ai < 2; ++ai)
#pragma unroll
            for (int m = 0; m < 4; ++m) {
                const int row = row0 + ai * 128 + m * 16; const float rs = rstd1[row];
#pragma unroll
                for (int bj = 0; bj < 2; ++bj) {
                    const int lc = lc0 + bj * 128;
                    f32x4 v0 = acc[ai][bj][m][0] * rs, v1 = acc[ai][bj][m][1] * rs;
                    if (seg == 4 || seg == 5) {
                        const f32x4 b0 = *(const f32x4*)(bcum + (size_t)row * 256 + lc), b1 = *(const f32x4*)(bcum + (size_t)row * 256 + lc + 4);
                        if (seg == 4) {
#pragma unroll
                            for (int e = 0; e < 4; ++e) { v0[e] *= 0.125f * __expf(b0[e]); v1[e] *= 0.125f * __expf(b1[e]); }
                        } else {
#pragma unroll
                            for (int e = 0; e < 4; ++e) { v0[e] *= __expf(-b0[e]); v1[e] *= __expf(-b1[e]); }
                        }
                    } else if (seg == 3 || seg == 7) {
#pragma unroll
                        for (int e = 0; e < 4; ++e) { v0[e] = v0[e] * sigmoidf_(v0[e]); v1[e] = v1[e] * sigmoidf_(v1[e]); }
                    } else if (seg >= 8) {
#pragma unroll
                        for (int e = 0; e < 4; ++e) { v0[e] = sigmoidf_(v0[e]); v1[e] = sigmoidf_(v1[e]); }
                    }
                    u32x4 w; w.x = pk2(v0[0], v0[1]); w.y = pk2(v0[2], v0[3]); w.z = pk2(v1[0], v1[1]); w.w = pk2(v1[2], v1[3]);
                    *(u32x4*)(base + (size_t)row * ld + lc) = w;
                }
            }
    }
};
struct EpiMix {
    static constexpr bool PERM = true, MIDK = true;
    const bf16_t* mr; const bf16_t* mg; bf16_t* mix;
    DI void mid(AccT& acc, const Unit& u, int wr, int wc, int fr, int fq) const {
        int row0 = u.pm * 256 + wr * 64 + fr, c0 = u.pn * 256 + wc * 32 + 8 * fq;
        asm volatile("" : "+v"(row0), "+v"(c0));
#pragma unroll
        for (int ai = 0; ai < 2; ++ai)
#pragma unroll
            for (int m = 0; m < 4; ++m) {
                const int row = row0 + ai * 128 + m * 16;
#pragma unroll
                for (int bj = 0; bj < 2; ++bj) {
                    const u32x4 a = *(const u32x4*)(mr + (size_t)row * 1024 + c0 + bj * 128), b = *(const u32x4*)(mg + (size_t)row * 1024 + c0 + bj * 128);
                    f32x4 r0, r1;
                    r0[0] = bflo(a.x) / fmaxf(bflo(b.x), 1e-30f); r0[1] = bfhi(a.x) / fmaxf(bfhi(b.x), 1e-30f); r0[2] = bflo(a.y) / fmaxf(bflo(b.y), 1e-30f); r0[3] = bfhi(a.y) / fmaxf(bfhi(b.y), 1e-30f);
                    r1[0] = bflo(a.z) / fmaxf(bflo(b.z), 1e-30f); r1[1] = bfhi(a.z) / fmaxf(bfhi(b.z), 1e-30f); r1[2] = bflo(a.w) / fmaxf(bflo(b.w), 1e-30f); r1[3] = bfhi(a.w) / fmaxf(bfhi(b.w), 1e-30f);
                    acc[ai][bj][m][0] *= r0; acc[ai][bj][m][1] *= r1;
                }
                __builtin_amdgcn_sched_barrier(0);
            }
    }
    DI void operator()(const AccT& acc, const Unit& u, int wr, int wc, int fr, int fq) const {
        const int row0 = u.pm * 256 + wr * 64 + fr, c0 = u.pn * 256 + wc * 32 + 8 * fq;
#pragma unroll
        for (int ai = 0; ai < 2; ++ai)
#pragma unroll
            for (int m = 0; m < 4; ++m) {
                const int row = row0 + ai * 128 + m * 16;
#pragma unroll
                for (int bj = 0; bj < 2; ++bj) {
                    const u32x4 b = *(const u32x4*)(mg + (size_t)row * 1024 + c0 + bj * 128);
                    const f32x4 v0 = acc[ai][bj][m][0], v1 = acc[ai][bj][m][1];
                    u32x4 w; w.x = pk2(v0[0] * bflo(b.x), v0[1] * bfhi(b.x)); w.y = pk2(v0[2] * bflo(b.y), v0[3] * bfhi(b.y));
                    w.z = pk2(v1[0] * bflo(b.z), v1[1] * bfhi(b.z)); w.w = pk2(v1[2] * bflo(b.w), v1[3] * bfhi(b.w));
                    *(u32x4*)(mix + (size_t)row * 1024 + c0 + bj * 128) = w;
                }
            }
    }
};
struct EpiH {
    static constexpr bool PERM = true, MIDK = false;
    const float* xp; const float* xs; float* h; bf16_t* hb; float* ssq;
    DI void mid(AccT&, const Unit&, int, int, int, int) const {}
    DI void operator()(const AccT& acc, const Unit& u, int wr, int wc, int fr, int fq) const {
        const int row0 = u.pm * 256 + wr * 64 + fr, c0 = u.pn * 256 + wc * 32 + 8 * fq;
#pragma unroll
        for (int ai = 0; ai < 2; ++ai)
#pragma unroll
            for (int m = 0; m < 4; ++m) {
                const int row = row0 + ai * 128 + m * 16;
                const float* xr = row < TP ? xp + (size_t)row * DM : xs + (size_t)(row - TP) * DM;
                float ss = 0.f;
#pragma unroll
                for (int bj = 0; bj < 2; ++bj) {
                    const int c = c0 + bj * 128;
                    const f32x4 v0 = acc[ai][bj][m][0] + *(const f32x4*)(xr + c), v1 = acc[ai][bj][m][1] + *(const f32x4*)(xr + c + 4);
                    *(f32x4*)(h + (size_t)row * DM + c) = v0; *(f32x4*)(h + (size_t)row * DM + c + 4) = v1;
                    u32x4 w; w.x = pk2(v0[0], v0[1]); w.y = pk2(v0[2], v0[3]); w.z = pk2(v1[0], v1[1]); w.w = pk2(v1[2], v1[3]);
                    *(u32x4*)(hb + (size_t)row * DM + c) = w;
                    ss += v0[0] * v0[0] + v0[1] * v0[1] + v0[2] * v0[2] + v0[3] * v0[3] + v1[0] * v1[0] + v1[1] * v1[1] + v1[2] * v1[2] + v1[3] * v1[3];
                }
                ss += __shfl_xor(ss, 16); ss += __shfl_xor(ss, 32);
                if (fq == 0) unsafeAtomicAdd(ssq + row, ss);
            }
    }
};
DI f32x2 gelu_pk(f32x2 v) {
    const f32x2 av = __builtin_elementwise_abs(v), d = av * 0.2316418882f + 1.0f;
    f32x2 t; t.x = __builtin_amdgcn_rcpf(d.x); t.y = __builtin_amdgcn_rcpf(d.y);
    f32x2 q = t * 0.5307027145f + (-0.7265760135f); q = q * t + 0.7107068705f; q = q * t + (-0.142248368f); q = q * t + 0.127414796f; q = q * t;
    const f32x2 s = (v * v) * (-0.72134752044f);
    f32x2 e; e.x = __builtin_amdgcn_exp2f(s.x); e.y = __builtin_amdgcn_exp2f(s.y);
    const f32x2 m = v * (q * e), r = v - m;
    f32x2 o; o.x = v.x < 0.f ? m.x : r.x; o.y = v.y < 0.f ? m.y : r.y; return o;
}
#define DPPF(old_, src_, ctrl_) __int_as_float(__builtin_amdgcn_update_dpp(__float_as_int(old_), __float_as_int(src_), (ctrl_), 0xf, 0xf, false))
struct EpiUpConv {
    static constexpr bool PERM = true, MIDK = false;
    const float* ssq; bf16_t* act; const float* cw; const float* cb; const float* cache; float* out; LAS float* xch;
    DI void mid(AccT&, const Unit&, int, int, int, int) const {}
    DI void operator()(const AccT& acc, const Unit& u, int wr, int wc, int fr, int fq) const {
        const int tokbase = u.pm * 254 - 2, cl = wc * 32 + 8 * fq, f0 = u.pn * 128 + cl;
        float rs[2][4];
#pragma unroll
        for (int ai = 0; ai < 2; ++ai)
#pragma unroll
            for (int m = 0; m < 4; ++m) { const int tok = tokbase + ai * 128 + wr * 64 + m * 16 + fr; rs[ai][m] = (tok >= 0 && tok < T_TOK) ? rsqrtf(ssq[tok] * (1.f / DM) + EPS) : 0.f; }
        if (fr >= 14) {
#pragma unroll
            for (int ai = 0; ai < 2; ++ai) { LAS float* xp = xch + ((2 * ai + wr) * 2 + (fr - 14)) * 128 + cl;
                *(LAS f32x4*)xp = acc[ai][0][3][0] * rs[ai][3]; *(LAS f32x4*)(xp + 4) = acc[ai][0][3][1] * rs[ai][3]; }
        }
        asm volatile("s_waitcnt lgkmcnt(0)" ::: "memory"); __builtin_amdgcn_s_barrier(); __builtin_amdgcn_s_barrier(); asm volatile("" ::: "memory");
        const bool samp_tile = (tokbase + 255 >= TP);
#pragma unroll
        for (int n = 0; n < 2; ++n) {
            const f32x4 cb4 = *(const f32x4*)(cb + f0 + 4 * n), w04 = *(const f32x4*)(cw + f0 + 4 * n), w14 = *(const f32x4*)(cw + DFF + f0 + 4 * n), w24 = *(const f32x4*)(cw + 2 * DFF + f0 + 4 * n);
#pragma unroll
            for (int ai = 0; ai < 2; ++ai) {
                const int g = 2 * ai + wr;
                f32x4 h1 = {0.f, 0.f, 0.f, 0.f}, h2 = {0.f, 0.f, 0.f, 0.f};
                if (g >= 1) { h1 = *(const LAS f32x4*)(xch + ((g - 1) * 2 + 1) * 128 + cl + 4 * n); h2 = *(const LAS f32x4*)(xch + ((g - 1) * 2 + (fr == 0 ? 0 : 1)) * 128 + cl + 4 * n); }
                f32x4 prev = {0.f, 0.f, 0.f, 0.f};
#pragma unroll
                for (int m = 0; m < 4; ++m) {
                    const int i = ai * 128 + wr * 64 + m * 16 + fr, tok = tokbase + i;
                    const f32x4 cur = acc[ai][0][m][n] * rs[ai][m], vv = acc[ai][1][m][n] * rs[ai][m];
                    f32x4 x1, x2;
#pragma unroll
                    for (int e = 0; e < 4; ++e) {
                        const float o1 = (m == 0) ? h1[e] : DPPF(0.f, prev[e], 0x121), o2 = (m == 0) ? h2[e] : DPPF(0.f, prev[e], 0x122);
                        x1[e] = DPPF(o1, cur[e], 0x111); x2[e] = DPPF(o2, cur[e], 0x112);
                    }
                    prev = cur;
                    int l; const bool samp = tok >= TP;
                    if (!samp) l = tok & 2047; else l = (tok - TP) & 3;
                    if (l < 2) {
                        if (samp_tile && samp) {
                            const int bidx = (tok - TP) >> 2;
                            if (tok < T_TOK) { const f32x4 c1 = *(const f32x4*)(cache + ((size_t)bidx * 2 + 1) * DFF + f0 + 4 * n), c0 = *(const f32x4*)(cache + ((size_t)bidx * 2 + l) * DFF + f0 + 4 * n);
                                x2 = c0; if (l == 0) x1 = c1; }
                        } else { x2 = (f32x4){0.f, 0.f, 0.f, 0.f}; if (l == 0) x1 = x2; }
                    }
                    const f32x4 uc = cb4 + w04 * x2 + w14 * x1 + w24 * cur;
                    const f32x2 ga = gelu_pk((f32x2){uc[0], uc[1]}), gb = gelu_pk((f32x2){uc[2], uc[3]});
                    if (i >= 2 && tok < T_TOK) {
                        u32x2 w; w.x = pk2(ga.x * vv[0], ga.y * vv[1]); w.y = pk2(gb.x * vv[2], gb.y * vv[3]);
                        *(u32x2*)(act + (size_t)tok * DFF + f0 + 4 * n) = w;
                        if (!samp) { if (l >= 2046) *(f32x4*)(out + OUT_CP + ((size_t)(tok >> 11) * 2 + (l - 2046)) * DFF + f0 + 4 * n) = cur; }
                        else if (l >= 2) *(f32x4*)(out + OUT_CS + ((size_t)((tok - TP) >> 2) * 2 + (l - 2)) * DFF + f0 + 4 * n) = cur;
                    }
                }
            }
        }
    }
};
template <bool DRY> struct EpiDownT {
    static constexpr bool PERM = true, MIDK = false;
    float* h;
    DI void mid(AccT&, const Unit&, int, int, int, int) const {}
    DI void operator()(const AccT& acc, const Unit& u, int wr, int wc, int fr, int fq) const {
        const int row0 = u.pm * 256 + wr * 64 + fr, c0 = u.pn * 256 + wc * 32 + 8 * fq;
#pragma unroll
        for (int ai = 0; ai < 2; ++ai)
#pragma unroll
            for (int m = 0; m < 4; ++m) {
                const int row = row0 + ai * 128 + m * 16;
#pragma unroll
                for (int bj = 0; bj < 2; ++bj) {
                    float* hp = h + (size_t)row * DM + c0 + bj * 128;
                    const f32x4 h0 = *(const f32x4*)hp, h1 = *(const f32x4*)(hp + 4);
                    f32x4 v0 = acc[ai][bj][m][0] + h0, v1 = acc[ai][bj][m][1] + h1;
                    if (DRY && h != nullptr) { v0 = h0; v1 = h1; }
                    *(f32x4*)hp = v0; *(f32x4*)(hp + 4) = v1;
                }
            }
    }
};

DI void transpose_item(const float* __restrict__ src, int ldsrc, int srccol, int k0, const float* __restrict__ scale, bf16_t* dst, int lddst, int n0dst, int k0dst,
                       LAS float* scr, int lane) {
#pragma unroll 8
    for (int i = 0; i < 32; ++i) { const int kk = 2 * i + (lane >> 5); float v = src[(size_t)(k0 + kk) * ldsrc + srccol]; if (scale) v *= scale[k0 + kk]; scr[kk * 33 + (lane & 31)] = v; }
    LDS_WAIT();
    const int c = lane & 7;
#pragma unroll
    for (int j = 0; j < 4; ++j) { const int n = (lane >> 3) + 8 * j; const LAS float* s = scr + (8 * c) * 33 + n;
        u32x4 o; o.x = pk2(s[0 * 33], s[1 * 33]); o.y = pk2(s[2 * 33], s[3 * 33]); o.z = pk2(s[4 * 33], s[5 * 33]); o.w = pk2(s[6 * 33], s[7 * 33]);
        *(u32x4*)(dst + (size_t)(n0dst + n) * lddst + k0dst + 8 * c) = o; }
    LDS_WAIT();
}
DI float log_sigmoid(float z) { return fminf(z, 0.f) - log1pf(expf(-fabsf(z))); }

DI void phase0(const Params& p, LAS unsigned char* lds) {
    int tid = threadIdx.x; asm volatile("" : "+v"(tid));
    const int lane = tid & 63, wave = tid >> 6;
    unsigned char* ws = p.ws;
    LAS bf16_t* wga = (LAS bf16_t*)lds;
    LAS float* gas = (LAS float*)(lds + 33024);
    LAS float* scr = (LAS float*)(lds + 41216 + wave * 8448);
    bf16_t* xb = (bf16_t*)((unsigned char*)p.out + 0);
    float* rstd1 = (float*)(ws + WS_RSTD1); float* bcum = (float*)(ws + WS_SH); float* ebl = (float*)(ws + WS_EBL);
    { const int gt = blockIdx.x * 512 + tid, ng = gridDim.x * 512;
      float* ssq2 = (float*)(ws + WS_SSQ2);
      for (int i = gt; i < T_TOK; i += ng) ssq2[i] = 0.f;
      float* rc = (float*)(ws + WS_ROPEC); float* rsn = (float*)(ws + WS_ROPES);
      for (int i = gt; i < 2052 * 64; i += ng) { const int pi = i >> 6, fi = i & 63; const double pos = (double)(pi < 2048 ? pi : 16384 + (pi - 2048));
          const double inv = exp(-(double)fi * (9.210340371976184 / 64.0)); const double ang = pos * inv; const double kk = rint(ang * 0.15915494309189535);
          const float r = (float)(ang - kk * 6.283185307179586); rc[i] = cosf(r); rsn[i] = sinf(r); } }
    if (blockIdx.x < 132) {
        for (int k = tid; k < DM; k += 512) { const float g = p.ln1[k]; const float* s = p.w_in + (size_t)k * DIN + 3584;
#pragma unroll
            for (int r = 0; r < 16; r += 2) { const unsigned w = pk2(s[r] * g, s[r + 1] * g); wga[r * 1032 + k] = (bf16_t)(w & 0xffffu); wga[(r + 1) * 1032 + k] = (bf16_t)(w >> 16); } }
        __syncthreads();
        for (int u = blockIdx.x; u < 132; u += gridDim.x) {
            const int r16 = lane & 15, kq = lane >> 4, t0 = u * 128 + wave * 16, row = t0 + r16;
            const float* xr = x_row(p, row);
            f32x4 acc = {0.f, 0.f, 0.f, 0.f}; float ss = 0.f;
            for (int ks = 0; ks < 32; ks += 4) {
                f32x4 v[4][2];
#pragma unroll
                for (int q = 0; q < 4; ++q) { v[q][0] = *(const f32x4*)(xr + (ks + q) * 32 + kq * 8); v[q][1] = *(const f32x4*)(xr + (ks + q) * 32 + kq * 8 + 4); }
#pragma unroll
                for (int q = 0; q < 4; ++q) {
                    const f32x4 a0 = v[q][0], a1 = v[q][1];
                    ss += a0[0] * a0[0] + a0[1] * a0[1] + a0[2] * a0[2] + a0[3] * a0[3] + a1[0] * a1[0] + a1[1] * a1[1] + a1[2] * a1[2] + a1[3] * a1[3];
                    u32x4 w; w.x = pk2(a0[0], a0[1]); w.y = pk2(a0[2], a0[3]); w.z = pk2(a1[0], a1[1]); w.w = pk2(a1[2], a1[3]);
                    *(u32x4*)(xb + (size_t)row * DM + (ks + q) * 32 + kq * 8) = w;
                    const bf16x8 bfrag = *(const LAS bf16x8*)(wga + r16 * 1032 + (ks + q) * 32 + kq * 8);
                    acc = __builtin_amdgcn_mfma_f32_16x16x32_bf16(__builtin_bit_cast(bf16x8, w), bfrag, acc, 0, 0, 0);
                }
            }
            ss += __shfl_xor(ss, 16); ss += __shfl_xor(ss, 32);
            const float rs = rsqrtf(ss * (1.f / DM) + EPS);
            if (kq == 0) rstd1[row] = rs;
#pragma unroll
            for (int j = 0; j < 4; ++j) { const float rj = __shfl(rs, kq * 4 + j); gas[(wave * 16 + kq * 4 + j) * 16 + r16] = acc[j] * rj; }
            __syncthreads();
            {
                const int c = tid & 255, half = tid >> 8;
                float wg[16];
#pragma unroll
                for (int r = 0; r < 16; ++r) wg[r] = p.w_gate_up[r * 256 + c];
                const float bias = p.b_gate_up[c];
                const int tokb = u * 128 + half * 64; const bool samp = tokb >= TP;
                float cum = 0.f;
                for (int i = 0; i < 64; ++i) {
                    const LAS f32x4* gp = (const LAS f32x4*)(gas + (half * 64 + i) * 16);
                    const f32x4 g0 = gp[0], g1 = gp[1], g2 = gp[2], g3 = gp[3];
                    float z = bias;
                    z += g0[0] * wg[0] + g0[1] * wg[1] + g0[2] * wg[2] + g0[3] * wg[3] + g1[0] * wg[4] + g1[1] * wg[5] + g1[2] * wg[6] + g1[3] * wg[7];
                    z += g2[0] * wg[8] + g2[1] * wg[9] + g2[2] * wg[10] + g2[3] * wg[11] + g3[0] * wg[12] + g3[1] * wg[13] + g3[2] * wg[14] + g3[3] * wg[15];
                    const float ls = log_sigmoid(z) * (1.f / 16.f);
                    const bool reset = samp ? ((i & 3) == 0) : (i == 0);
                    cum = reset ? ls : cum + ls;
                    const int tok = tokb + i;
                    bcum[(size_t)tok * 256 + c] = cum;
                    if (samp) { if ((i & 3) == 3) ebl[(size_t)(256 + ((tok - TP) >> 2)) * 256 + c] = expf(cum); }
                    else if (i == 63) ebl[(size_t)(tok >> 6) * 256 + c] = expf(cum);
                }
            }
            __syncthreads();
        }
    }
    {
        const int gw = blockIdx.x * 8 + wave, ngw = gridDim.x * 8;
        constexpr int I_IN = 16 * 176, I_MX = 8 * 32, I_O = 16 * 32, I_UP = 16 * 176, I_DN = 44 * 32, NIT = I_IN + 2 * I_MX + I_O + I_UP + I_DN;
        for (int it = gw; it < NIT; it += ngw) {
            int r = it; const int nl = lane & 31;
            if (r < I_IN) { const int kb = r / 176, nb = r % 176, n = nb * 32 + nl; int sc;
                if (n < 1024) { const int pp = n & 127; sc = (n & ~127) + (((pp & 7) < 4) ? 4 * (pp >> 3) + (pp & 7) : 64 + 4 * (pp >> 3) + (pp & 7) - 4); }
                else sc = n < 3584 ? n : n + 16;
                transpose_item(p.w_in, DIN, sc, kb * 64, p.ln1, (bf16_t*)(ws + WS_WIN), DM, nb * 32, kb * 64, scr, lane); continue; }
            r -= I_IN;
            if (r < I_MX) { const int kb = r / 32, nb = r % 32; transpose_item(p.w_ret_out, DM, nb * 32 + nl, kb * 64, nullptr, (bf16_t*)(ws + WS_WMIX), DM, nb * 32, kb * 64, scr, lane); continue; }
            r -= I_MX;
            if (r < I_MX) { const int kb = r / 32, nb = r % 32; transpose_item(p.w_gla_out, DM, nb * 32 + nl, kb * 64, nullptr, (bf16_t*)(ws + WS_WMIX), DM, nb * 32, 512 + kb * 64, scr, lane); continue; }
            r -= I_MX;
            if (r < I_O) { const int kb = r / 32, nb = r % 32; transpose_item(p.w_o, DM, nb * 32 + nl, kb * 64, nullptr, (bf16_t*)(ws + WS_WO), DM, nb * 32, kb * 64, scr, lane); continue; }
            r -= I_O;
            if (r < I_UP) { const int kb = r / 176, nb = r % 176, n = nb * 32 + nl; const int sc = ((n >> 7) & 1) * DFF + (n >> 8) * 128 + (n & 127);
                transpose_item(p.w_up, NUP, sc, kb * 64, p.ln2, (bf16_t*)(ws + WS_WUP), DM, nb * 32, kb * 64, scr, lane); continue; }
            r -= I_UP;
            { const int kb = r / 32, nb = r % 32; transpose_item(p.w_down, DM, nb * 32 + nl, kb * 64, nullptr, (bf16_t*)(ws + WS_WDN), DFF, nb * 32, kb * 64, scr, lane); }
        }
    }
}

template <int DK> DI unsigned img_off(int row, int ch) { return (unsigned)(row * (2 * DK) + 16 * (ch ^ ((((row & 3) << 2) | ((row >> 2) & 3)) & (DK / 8 - 1)))); }
template <int DK> DI unsigned tr_addr(int lane, int c, int ks, int t) {
    const int h = lane >> 5, blk = (lane >> 4) & 1, q = (lane & 15) >> 2, pp = lane & 3;
    return img_off<DK>(16 * ks + 8 * h + 4 * t + q, 4 * c + 2 * blk + (pp >> 1)) + 8 * (pp & 1);
}
DI bf16x8 tr_frag(LAS unsigned char* a0, LAS unsigned char* a1) {
    const s16x4 lo = __builtin_amdgcn_ds_read_tr16_b64_v4i16((LAS s16x4*)a0), hi = __builtin_amdgcn_ds_read_tr16_b64_v4i16((LAS s16x4*)a1);
    return __builtin_shufflevector(lo, hi, 0, 1, 2, 3, 4, 5, 6, 7);
}
DI bf16x8 pack8(const f32x16& x, int s) {
    u32x4 w; w.x = pk2(x[8 * s + 0], x[8 * s + 1]); w.y = pk2(x[8 * s + 2], x[8 * s + 3]); w.z = pk2(x[8 * s + 4], x[8 * s + 5]); w.w = pk2(x[8 * s + 6], x[8 * s + 7]);
    return __builtin_bit_cast(bf16x8, w);
}
#define MFMA32(a, b, c) __builtin_amdgcn_mfma_f32_32x32x16_bf16((a), (b), (c), 0, 0, 0)

constexpr int P2_BUF = 49152, P2_QO = 0, P2_KO = 16384, P2_VO = 32768, P2_P = 98304, P2_SSQ = P2_P + 64 * 144, P2_EBL = P2_SSQ + 1024;

template <int DK> DI void chain_prompt(const Params& p, LAS unsigned char* lds, const int branch, const int b, const int head) {
    constexpr int NDB = DK / 32, NCH = DK / 8, QLD = 4 * DK, NQI = (64 * NCH) / 512;
    int tid0 = threadIdx.x; asm volatile("" : "+v"(tid0));
    const int w = __builtin_amdgcn_readfirstlane(tid0 >> 6);
    int tid = tid0, lane = tid0 & 63, h = lane >> 5, r = lane & 31;
    unsigned char* ws = p.ws;
    const bf16_t* Q = (const bf16_t*)(ws + (branch == 0 ? PQ_R : PQ_G)) + head * DK;
    const bf16_t* K = (const bf16_t*)(ws + (branch == 0 ? PK_R : PK_G)) + head * DK;
    const bf16_t* V = (const bf16_t*)(ws + (branch == 0 ? PV_R : PV_G)) + head * 128;
    const bf16_t* G = (const bf16_t*)(ws + (branch == 0 ? PG_R : PG_G)) + head * 128;
    const float* ebl = (const float*)(ws + WS_EBL);
    bf16_t* arg = (bf16_t*)((unsigned char*)p.out + SEG1024) + branch * 512 + head * 128;
    const float* gain = (branch == 0 ? p.g_ret : p.g_gla) + head * 128;
    const int tok0 = b * 2048;
    const float lg2 = log2f(1.f - exp2f(-5.f - (float)head));
    const float ret_ebl = exp2f(64.f * lg2);
    f32x16 S[NDB];
#pragma unroll
    for (int d = 0; d < NDB; ++d)
#pragma unroll
        for (int i = 0; i < 16; ++i) S[d][i] = 0.f;
    u32x4 rq[NQI], rk[NQI], rv[2]; float rebl = 0.f;
#define P2_LOAD(c) do { const int tb = tok0 + 64 * (c); \
        _Pragma("unroll") for (int i = 0; i < NQI; ++i) { const int idx = tid + 512 * i, rr = idx / NCH, ch = idx % NCH; \
            rq[i] = *(const u32x4*)(Q + (size_t)(tb + rr) * QLD + ch * 8); rk[i] = *(const u32x4*)(K + (size_t)(tb + rr) * QLD + ch * 8); } \
        _Pragma("unroll") for (int i = 0; i < 2; ++i) { const int idx = tid + 512 * i, rr = idx >> 4, ch = idx & 15; rv[i] = *(const u32x4*)(V + (size_t)(tb + rr) * 512 + ch * 8); } \
        if (DK == 64 && tid < 64) rebl = ebl[(size_t)(b * 32 + (c)) * 256 + head * 64 + tid]; } while (0)
#define P2_STORE(buf) do { LAS unsigned char* bb = lds + (buf) * P2_BUF; \
        _Pragma("unroll") for (int i = 0; i < NQI; ++i) { const int idx = tid + 512 * i, rr = idx / NCH, ch = idx % NCH; \
            *(LAS u32x4*)(bb + P2_QO + img_off<DK>(rr, ch)) = rq[i]; *(LAS u32x4*)(bb + P2_KO + img_off<DK>(rr, ch)) = rk[i]; } \
        _Pragma("unroll") for (int i = 0; i < 2; ++i) { const int idx = tid + 512 * i, rr = idx >> 4, ch = idx & 15; *(LAS u32x4*)(bb + P2_VO + img_off<128>(rr, ch)) = rv[i]; } \
        if (DK == 64 && tid < 64) *(LAS float*)(lds + P2_EBL + (buf) * 256 + tid * 4) = rebl; } while (0)
    P2_LOAD(0); P2_STORE(0);
    __syncthreads();
    for (int c = 0; c < 32; ++c) {
        tid = tid0; asm volatile("" : "+v"(tid)); lane = tid & 63; h = lane >> 5; r = lane & 31;
        LAS unsigned char* bb = lds + (c & 1) * P2_BUF;
        LAS unsigned char* qi = bb + P2_QO; LAS unsigned char* ki = bb + P2_KO; LAS unsigned char* vi = bb + P2_VO;
        if (c + 1 < 32) P2_LOAD(c + 1);
        if (w < 4) {
            if (w < 3) {
                const int jb = (w == 2) ? 1 : 0, ib = (w == 0) ? 0 : 1;
                f32x16 pt;
#pragma unroll
                for (int i = 0; i < 16; ++i) pt[i] = 0.f;
#pragma unroll
                for (int s = 0; s < DK / 16; ++s) {
                    const bf16x8 a = *(const LAS bf16x8*)(ki + img_off<DK>(32 * jb + r, 2 * s + h)), bq = *(const LAS bf16x8*)(qi + img_off<DK>(32 * ib + r, 2 * s + h));
                    pt = MFMA32(a, bq, pt);
                }
                if (jb == ib) {
#pragma unroll
                    for (int i = 0; i < 16; ++i) { const int j = (i & 3) + 8 * (i >> 2) + 4 * h; pt[i] = (j <= r) ? pt[i] : 0.f; }
                }
#pragma unroll
                for (int g = 0; g < 4; ++g) { u32x2 o; o.x = pk2(pt[4 * g], pt[4 * g + 1]); o.y = pk2(pt[4 * g + 2], pt[4 * g + 3]);
                    *(LAS u32x2*)(lds + P2_P + (32 * ib + r) * 144 + (32 * jb + 8 * g + 4 * h) * 2) = o; }
            }
        }
        __syncthreads();
        f32x16 ot[2];
        if (w < 4) {
            bf16x8 vf[4];
#pragma unroll
            for (int s = 0; s < 4; ++s) vf[s] = tr_frag(vi + tr_addr<128>(lane, w, s, 0), vi + tr_addr<128>(lane, w, s, 1));
#pragma unroll
            for (int ib = 0; ib < 2; ++ib) {
#pragma unroll
                for (int i = 0; i < 16; ++i) ot[ib][i] = 0.f;
#pragma unroll
                for (int s = 0; s < (ib == 0 ? 2 : 4); ++s) {
                    const bf16x8 bp = *(const LAS bf16x8*)(lds + P2_P + (32 * ib + r) * 144 + (16 * s + 8 * h) * 2);
                    ot[ib] = MFMA32(vf[s], bp, ot[ib]);
                }
            }
#pragma unroll
            for (int d = 0; d < NDB; ++d)
#pragma unroll
                for (int s2 = 0; s2 < 2; ++s2) {
                    const bf16x8 sfr = pack8(S[d], s2);
#pragma unroll
                    for (int ib = 0; ib < 2; ++ib) {
                        const s16x4 lo = *(const LAS s16x4*)(qi + img_off<DK>(32 * ib + r, 4 * d + 2 * s2) + 8 * h), hi = *(const LAS s16x4*)(qi + img_off<DK>(32 * ib + r, 4 * d + 2 * s2 + 1) + 8 * h);
                        const bf16x8 bq = __builtin_shufflevector(lo, hi, 0, 1, 2, 3, 4, 5, 6, 7);
                        ot[ib] = MFMA32(sfr, bq, ot[ib]);
                    }
                }
#pragma unroll
            for (int d = 0; d < NDB; ++d) {
#pragma unroll
                for (int s = 0; s < 4; ++s) {
                    const bf16x8 a = tr_frag(ki + tr_addr<DK>(lane, d, s, 0), ki + tr_addr<DK>(lane, d, s, 1));
                    S[d] = MFMA32(a, vf[s], S[d]);
                }
                if (DK == 128) {
#pragma unroll
                    for (int i = 0; i < 16; ++i) S[d][i] *= ret_ebl;
                } else {
                    const LAS float* eb = (const LAS float*)(lds + P2_EBL + (c & 1) * 256) + 32 * d + 4 * h;
#pragma unroll
                    for (int g = 0; g < 4; ++g) { const f32x4 e4 = *(const LAS f32x4*)(eb + 8 * g);
#pragma unroll
                        for (int e = 0; e < 4; ++e) S[d][4 * g + e] *= e4[e]; }
                }
            }
#pragma unroll
            for (int ib = 0; ib < 2; ++ib) { float ss = 0.f;
#pragma unroll
                for (int i = 0; i < 16; ++i) ss += ot[ib][i] * ot[ib][i];
                ss += __shfl_xor(ss, 32);
                if (h == 0) *(LAS float*)(lds + P2_SSQ + (w * 64 + 32 * ib + r) * 4) = ss; }
        }
        if (c + 1 < 32) P2_STORE((c + 1) & 1);
        __syncthreads();
        if (w < 4) {
            asm volatile("" : "+v"(lane)); h = lane >> 5; r = lane & 31;
            const int tb = tok0 + 64 * c;
#pragma unroll
            for (int ib = 0; ib < 2; ++ib) {
                const LAS float* sq = (const LAS float*)(lds + P2_SSQ) + 32 * ib + r;
                const float tot = sq[0] + sq[64] + sq[128] + sq[192];
                const float rs = rsqrtf(tot * (1.f / 128.f) + EPS);
#pragma unroll
                for (int g = 0; g < 4; ++g) {
                    const u32x2 gg = *(const u32x2*)(G + (size_t)(tb + 32 * ib + r) * 512 + 32 * w + 8 * g + 4 * h);
                    const f32x4 gn = *(const f32x4*)(gain + 32 * w + 8 * g + 4 * h);
                    u32x2 o; o.x = pk2(ot[ib][4 * g] * rs * gn[0] * bflo(gg.x), ot[ib][4 * g + 1] * rs * gn[1] * bfhi(gg.x));
                    o.y = pk2(ot[ib][4 * g + 2] * rs * gn[2] * bflo(gg.y), ot[ib][4 * g + 3] * rs * gn[3] * bfhi(gg.y));
                    *(u32x2*)(arg + (size_t)(tb + 32 * ib + r) * 1024 + 32 * w + 8 * g + 4 * h) = o;
                }
            }
        }
    }
#undef P2_LOAD
#undef P2_STORE
    if (w < 4) {
        lane = tid0 & 63; h = lane >> 5; r = lane & 31;
        float* so = p.out + (branch == 0 ? OUT_RSP : OUT_GSP) + (size_t)(b * 4 + head) * DK * 128;
#pragma unroll
        for (int d = 0; d < NDB; ++d)
#pragma unroll
            for (int i = 0; i < 16; ++i) so[(size_t)(32 * d + (i & 3) + 8 * (i >> 2) + 4 * h) * 128 + 32 * w + r] = S[d][i];
    }
    __syncthreads();
}

template <int DK> DI void sample_unit(const Params& p, LAS unsigned char* lds, const int branch, const int b, const int head) {
    int tid = threadIdx.x; asm volatile("" : "+v"(tid));
    unsigned char* ws = p.ws;
    const bf16_t* Q = (const bf16_t*)(ws + (branch == 0 ? PQ_R : PQ_G)) + head * DK;
    const bf16_t* K = (const bf16_t*)(ws + (branch == 0 ? PK_R : PK_G)) + head * DK;
    const bf16_t* V = (const bf16_t*)(ws + (branch == 0 ? PV_R : PV_G)) + head * 128;
    const bf16_t* G = (const bf16_t*)(ws + (branch == 0 ? PG_R : PG_G)) + head * 128;
    bf16_t* arg = (bf16_t*)((unsigned char*)p.out + SEG1024) + branch * 512 + head * 128;
    const float* gain = (branch == 0 ? p.g_ret : p.g_gla) + head * 128;
    const float* sin_ = (branch == 0 ? p.state_ret : p.state_gla) + (size_t)(b * 4 + head) * DK * 128;
    float* sout = p.out + (branch == 0 ? OUT_RSS : OUT_GSS) + (size_t)(b * 4 + head) * DK * 128;
    const int tok0 = TP + 4 * b;
    LAS float* qs = (LAS float*)lds;
    LAS float* ks = qs + 4 * 128;
    LAS float* vs = ks + 4 * 128;
    LAS float* es = vs + 4 * 128;
    LAS float* Ps = es + 128;
    LAS float* ssq = Ps + 16;
    LAS float* op = ssq + 16;
    for (int i = tid; i < 4 * DK; i += 512) { const int t = i / DK, d = i % DK;
        qs[t * DK + d] = __uint_as_float((unsigned)Q[(size_t)(tok0 + t) * (4 * DK) + d] << 16); ks[t * DK + d] = __uint_as_float((unsigned)K[(size_t)(tok0 + t) * (4 * DK) + d] << 16); }
    { const int t = tid >> 7, v = tid & 127; vs[t * 128 + v] = __uint_as_float((unsigned)V[(size_t)(tok0 + t) * 512 + v] << 16); }
    if (tid < DK) {
        if (DK == 128) { const float lg2 = log2f(1.f - exp2f(-5.f - (float)head)); es[tid] = exp2f(4.f * lg2); }
        else es[tid] = ((const float*)(ws + WS_EBL))[(size_t)(256 + b) * 256 + head * 64 + tid];
    }
    __syncthreads();
    if (tid < 16) { const int i = tid >> 2, j = tid & 3; float s = 0.f; if (j <= i) { for (int d = 0; d < DK; ++d) s += qs[i * DK + d] * ks[j * DK + d]; } Ps[tid] = s; }
    {
        const int vq = tid & 31, dg = tid >> 5;
        f32x4 oa[4];
#pragma unroll
        for (int i = 0; i < 4; ++i) oa[i] = (f32x4){0.f, 0.f, 0.f, 0.f};
        f32x4 v4[4];
#pragma unroll
        for (int j = 0; j < 4; ++j) v4[j] = *(const LAS f32x4*)(vs + j * 128 + 4 * vq);
        f32x4 s0[DK / 16];
#pragma unroll
        for (int rr = 0; rr < DK / 16; ++rr) s0[rr] = *(const f32x4*)(sin_ + (size_t)(dg + 16 * rr) * 128 + 4 * vq);
#pragma unroll
        for (int rr = 0; rr < DK / 16; ++rr) {
            const int d = dg + 16 * rr;
            f32x4 sn = s0[rr];
#pragma unroll
            for (int i = 0; i < 4; ++i) { oa[i] += s0[rr] * qs[i * DK + d]; sn += v4[i] * ks[i * DK + d]; }
            sn *= es[d];
            *(f32x4*)(sout + (size_t)d * 128 + 4 * vq) = sn;
        }
#pragma unroll
        for (int i = 0; i < 4; ++i) *(LAS f32x4*)(op + (dg * 4 + i) * 128 + 4 * vq) = oa[i];
    }
    __syncthreads();
    {
        const int i = tid >> 7, v = tid & 127;
        float o = 0.f;
#pragma unroll
        for (int dg = 0; dg < 16; ++dg) o += op[(dg * 4 + i) * 128 + v];
#pragma unroll
        for (int j = 0; j < 4; ++j) o += Ps[i * 4 + j] * vs[j * 128 + v];
        const float s = wave_sum(o * o);
        if ((tid & 63) == 0) ssq[tid >> 6] = s;
        __syncthreads();
        const float rs = rsqrtf((ssq[2 * i] + ssq[2 * i + 1]) * (1.f / 128.f) + EPS);
        const float gate = __uint_as_float((unsigned)G[(size_t)(tok0 + i) * 512 + v] << 16);
        const unsigned wv = pk2(o * rs * gain[v] * gate, 0.f);
        arg[(size_t)(tok0 + i) * 1024 + v] = (bf16_t)(wv & 0xffffu);
    }
    __syncthreads();
}

DI void phase2(const Params& p, LAS unsigned char* lds) {
    const int G = gridDim.x, bx = blockIdx.x;
    const int nchb = G > 64 ? 64 : G;
    if (bx < nchb) {
        for (int c = bx; c < 64; c += nchb) {
            const int branch = c >> 5, bh = c & 31;
#ifndef NO_CH128
            if (branch == 0) chain_prompt<128>(p, lds, 0, bh >> 2, bh & 3);
#endif
#ifndef NO_CH64
            if (branch == 1) chain_prompt<64>(p, lds, 1, bh >> 2, bh & 3);
#endif
        }
    }
    const int nsb = G > 64 ? G - 64 : G, sb = G > 64 ? bx - 64 : bx;
    if (sb >= 0) {
        for (int u = sb; u < 1024; u += nsb) {
            const int branch = u >> 9, bh = u & 511;
#ifndef NO_SMP
            if (branch == 0) sample_unit<128>(p, lds, 0, bh >> 2, bh & 3); else sample_unit<64>(p, lds, 1, bh >> 2, bh & 3);
#endif
        }
    }
}

template <bool DRY> DI void phase_final(const Params& p) {
    const int lane = threadIdx.x & 63, gw = blockIdx.x * 8 + (threadIdx.x >> 6), ngw = gridDim.x * 8;
    for (int row = gw; row < T_TOK; row += ngw) {
        f32x4* hp = (f32x4*)(p.out + (size_t)row * DM) + lane;
        f32x4 v[4]; float s = 0.f;
#pragma unroll
        for (int j = 0; j < 4; ++j) { v[j] = hp[64 * j]; s += v[j][0] * v[j][0] + v[j][1] * v[j][1] + v[j][2] * v[j][2] + v[j][3] * v[j][3]; }
        const float rs = rsqrtf(wave_sum(s) * (1.f / DM) + EPS);
#pragma unroll
        for (int j = 0; j < 4; ++j) { const f32x4 g = *((const f32x4*)p.ln_f + lane + 64 * j); f32x4 o = v[j] * rs * g; if (DRY && p.out != nullptr) o = v[j]; hp[64 * j] = o; }
    }
}

__global__ void __launch_bounds__(512, 2) fwd_megakernel(Params p) {
    extern __shared__ __attribute__((aligned(16))) unsigned char shm[];
    LAS unsigned char* lds = (LAS unsigned char*)shm;
    cg::grid_group grid = cg::this_grid();
    unsigned char* ws = p.ws;
    const int G = gridDim.x, bx = blockIdx.x;
    bf16_t* xb = (bf16_t*)p.out;
    bf16_t* arg = (bf16_t*)((unsigned char*)p.out + SEG1024);

#ifndef PHMASK
#define PHMASK 0x1ff
#endif
#define PH(n) if ((PHMASK >> (n)) & 1)
    PH(0) phase0(p, lds);
    grid.sync();
#if defined(DUP_PH) && DUP_PH == 0
    phase0(p, lds);
    grid.sync();
#endif
    PH(1) {
        pg8::Gemm g{xb, (const bf16_t*)(ws + WS_WIN), T_TOK, NPROJ, DM, DM, DM, 256}; pg8::StaticOrder S; S.init(T_TOK, NPROJ, G, bx);
        EpiProj E{ws, (const float*)(ws + WS_RSTD1), (const float*)(ws + WS_SH), (const float*)(ws + WS_ROPEC), (const float*)(ws + WS_ROPES)};
        pg8::gemm_phase<EpiProj>(lds, g, S, E);
#if defined(DUP_PH) && DUP_PH == 1
        grid.sync();
        pg8::gemm_phase<EpiProj>(lds, g, S, E);
#endif
    }
    grid.sync();
    PH(2) phase2(p, lds);
    grid.sync();
#if defined(DUP_PH) && DUP_PH == 2
    phase2(p, lds);
    grid.sync();
#endif
    PH(3) {
        pg8::Gemm g{arg, (const bf16_t*)(ws + WS_WMIX), T_TOK, DM, DM, DM, DM, 256}; pg8::StaticOrder S; S.init(T_TOK, DM, G, bx);
        EpiMix E{(const bf16_t*)(ws + PM_R), (const bf16_t*)(ws + PM_G), (bf16_t*)(ws + WS_MIX)};
        pg8::gemm_phase<EpiMix>(lds, g, S, E);
#if defined(DUP_PH) && DUP_PH == 3
        grid.sync();
        pg8::gemm_phase<EpiMix>(lds, g, S, E);
#endif
    }
    grid.sync();
    PH(4) {
        pg8::Gemm g{(const bf16_t*)(ws + WS_MIX), (const bf16_t*)(ws + WS_WO), T_TOK, DM, DM, DM, DM, 256}; pg8::StaticOrder S; S.init(T_TOK, DM, G, bx);
        EpiH E{p.x_prompt, p.x_sample, p.out, (bf16_t*)(ws + WS_SH), (float*)(ws + WS_SSQ2)};
        pg8::gemm_phase<EpiH>(lds, g, S, E);
    }
    grid.sync();
    PH(5) {
        pg8::Gemm g{(const bf16_t*)(ws + WS_SH) - 2 * DM, (const bf16_t*)(ws + WS_WUP), T_TOK, NUP, DM, DM, DM, 254}; pg8::StaticOrder S; S.init_tiles(67, 22, G, bx);
        EpiUpConv E{(const float*)(ws + WS_SSQ2), (bf16_t*)(ws + WS_ACT), p.conv_w, p.conv_b, p.cache_conv, p.out, (LAS float*)(lds + 131072)};
        pg8::gemm_phase<EpiUpConv>(lds, g, S, E);
    }
    grid.sync();
    PH(7) {
        pg8::Gemm g{(const bf16_t*)(ws + WS_ACT), (const bf16_t*)(ws + WS_WDN), T_TOK, DM, DFF, DFF, DFF, 256}; pg8::StaticOrder S; S.init(T_TOK, DM, G, bx);
#if defined(DUP_PH) && DUP_PH == 7
        { EpiDownT<true> E0{p.out}; pg8::gemm_phase<EpiDownT<true>>(lds, g, S, E0); grid.sync(); }
#endif
        EpiDownT<false> E{p.out};
        pg8::gemm_phase<EpiDownT<false>>(lds, g, S, E);
    }
    grid.sync();
#if defined(DUP_PH) && DUP_PH == 8
    phase_final<true>(p);
    grid.sync();
#endif
    PH(8) phase_final<false>(p);
}

extern "C" void kernel_launch(void* const* d_in, const int* in_sizes, int n_in, void* d_out, int out_size, void* d_ws, size_t ws_size, hipStream_t stream) {
    static int grid = 0;
    if (grid == 0) {
        if (n_in != 20 || out_size != (int)OUT_END || ws_size < WS_END) { fprintf(stderr, "kernel_launch: unexpected shapes (n_in %d, out %d, ws %zu)\n", n_in, out_size, ws_size); grid = -1; return; }
        int dev = 0, cus = 0, per_cu = 0;
        hipGetDevice(&dev);
        hipDeviceGetAttribute(&cus, hipDeviceAttributeMultiprocessorCount, dev);
        if (hipFuncSetAttribute((const void*)fwd_megakernel, hipFuncAttributeMaxDynamicSharedMemorySize, LDS_BYTES) != hipSuccess) { fprintf(stderr, "kernel_launch: hipFuncSetAttribute failed\n"); grid = -1; return; }
        hipOccupancyMaxActiveBlocksPerMultiprocessor(&per_cu, (const void*)fwd_megakernel, 512, LDS_BYTES);
        if (per_cu < 1) { fprintf(stderr, "kernel_launch: occupancy query gave %d\n", per_cu); per_cu = 1; }
        grid = cus * 1;
        (void)hipGetLastError();
    }
    if (grid < 0) return;
    Params p{};
    const float** f = (const float**)&p;
    for (int i = 0; i < 20; ++i) f[i] = (const float*)d_in[i];
    p.out = (float*)d_out; p.ws = (unsigned char*)d_ws;
    void* args[] = {&p};
    hipError_t e = hipLaunchCooperativeKernel((const void*)fwd_megakernel, dim3(grid), dim3(512), args, LDS_BYTES, stream);
    if (e != hipSuccess) fprintf(stderr, "cooperative launch failed: %s (grid %d)\n", hipGetErrorString(e), grid);
}
```

```cpp
#include <hip/hip_runtime.h>
#include <hip/hip_cooperative_groups.h>
#include <cstdio>
namespace cg = cooperative_groups;

#define LAS __attribute__((address_space(3)))
#define DI __device__ __forceinline__
typedef unsigned short bf16_t;
typedef short bf16x8 __attribute__((ext_vector_type(8)));
typedef short s16x4 __attribute__((ext_vector_type(4)));
typedef float f32x4 __attribute__((ext_vector_type(4)));
typedef float f32x2 __attribute__((ext_vector_type(2)));
typedef float f32x16 __attribute__((ext_vector_type(16)));
typedef unsigned u32x4 __attribute__((ext_vector_type(4)));
typedef unsigned u32x2 __attribute__((ext_vector_type(2)));
typedef __bf16 bf16x2_t __attribute__((ext_vector_type(2)));

constexpr int T_TOK = 16896, TP = 16384, DM = 1024, DIN = 5648, NPROJ = 5632, DFF = 2816, NUP = 5632;
constexpr float EPS = 1e-6f;
constexpr size_t OUT_Y = 0, OUT_RSP = 17301504, OUT_RSS = OUT_RSP + 524288, OUT_GSP = OUT_RSS + 8388608, OUT_GSS = OUT_GSP + 262144,
                 OUT_CP = OUT_GSS + 4194304, OUT_CS = OUT_CP + 45056, OUT_END = OUT_CS + 720896;
constexpr size_t WS_WIN = 0, WS_WMIX = WS_WIN + (size_t)NPROJ * DM * 2, WS_WO = WS_WMIX + (size_t)DM * DM * 2, WS_WUP = WS_WO + (size_t)DM * DM * 2,
                 WS_WDN = WS_WUP + (size_t)NUP * DM * 2, WS_PROJ = WS_WDN + (size_t)DM * DFF * 2;
constexpr size_t SEG512 = (size_t)T_TOK * 512 * 2, SEG256 = (size_t)T_TOK * 256 * 2, SEG1024 = (size_t)T_TOK * 1024 * 2;
constexpr size_t PQ_R = WS_PROJ, PK_R = PQ_R + SEG512, PV_R = PK_R + SEG512, PG_R = PV_R + SEG512, PQ_G = PG_R + SEG512, PK_G = PQ_G + SEG256,
                 PV_G = PK_G + SEG256, PG_G = PV_G + SEG512, PM_R = PG_G + SEG512, PM_G = PM_R + SEG1024, WS_PROJ_END = PM_G + SEG1024;
constexpr size_t WS_MIX = PQ_R;
constexpr size_t WS_ACT = WS_PROJ;
constexpr size_t WS_SH = WS_PROJ_END;
constexpr size_t WS_RSTD1 = WS_SH + SEG1024, WS_SSQ2 = WS_RSTD1 + (size_t)T_TOK * 4, WS_EBL = WS_SSQ2 + (size_t)T_TOK * 4,
                 WS_ROPEC = WS_EBL + (size_t)384 * 256 * 4, WS_ROPES = WS_ROPEC + (size_t)2052 * 64 * 4, WS_BAR = WS_ROPES + (size_t)2052 * 64 * 4, WS_END = WS_BAR + 16384;
static_assert(WS_PROJ_END - WS_PROJ == (size_t)T_TOK * NPROJ * 2, "proj layout");
static_assert(WS_END <= (size_t)256 * 1024 * 1024, "workspace");
constexpr int LDS_BYTES = 131072 + 4096 + 16;

struct Params {
    const float *x_prompt, *x_sample, *state_ret, *state_gla, *cache_conv, *ln1, *w_in, *w_gate_up, *b_gate_up, *g_ret, *g_gla, *w_ret_out, *w_gla_out,
        *w_o, *ln2, *w_up, *conv_w, *conv_b, *w_down, *ln_f;
    float* out; unsigned char* ws;
};

DI unsigned pk2(float lo, float hi) { f32x2 v = {lo, hi}; bf16x2_t b = __builtin_convertvector(v, bf16x2_t); return __builtin_bit_cast(unsigned, b); }
DI float bflo(unsigned w) { return __uint_as_float(w << 16); }
DI float bfhi(unsigned w) { return __uint_as_float(w & 0xffff0000u); }
DI float wave_sum(float v) {
#pragma unroll
    for (int o = 1; o < 64; o <<= 1) v += __shfl_xor(v, o);
    return v;
}
DI float sigmoidf_(float x) { return 1.f / (1.f + __expf(-x)); }
DI const float* x_row(const Params& p, int tok) { return tok < TP ? p.x_prompt + (size_t)tok * DM : p.x_sample + (size_t)(tok - TP) * DM; }
#define LDS_WAIT() asm volatile("s_waitcnt lgkmcnt(0)" ::: "memory")

#define XB_TMO      128
#define XB_XCNT(j)  (256  + 64 * (j))
#define XB_XSUB(j)  (1280 + 64 * (j))
#define XB_XGEN(j)  (2304 + 64 * (j))
#define XB_TOP      3328
#define XB_TOPGEN   3392
#define XCD_BAR_WORDS 3456
#define XB_SPIN_CAP (1u << 22)
DI unsigned xb_ld(unsigned* p) { return __hip_atomic_load(p, __ATOMIC_RELAXED, __HIP_MEMORY_SCOPE_AGENT); }
DI unsigned xb_add(unsigned* p, unsigned v) { return __hip_atomic_fetch_add(p, v, __ATOMIC_RELAXED, __HIP_MEMORY_SCOPE_AGENT); }
DI unsigned xb_xcc_id() { return (unsigned)__builtin_amdgcn_s_getreg((3 << 11) | 20) & 0xFu; }
#define XB_SPIN(cond, bar) do { unsigned _sp = 0; while (cond) { __builtin_amdgcn_s_sleep(1); \
    if ((++_sp & 255u) == 0u) { if (xb_ld(&(bar)[XB_TMO])) break; if (_sp > XB_SPIN_CAP) { atomicAdd(&(bar)[XB_TMO], 1u); break; } } } } while (0)
struct XcdBarrier { unsigned* bar; unsigned x; volatile LAS unsigned* st; };
DI XcdBarrier xcd_barrier_post(unsigned* bar, volatile LAS unsigned* st) {
    XcdBarrier b; b.bar = bar; b.x = xb_xcc_id(); b.st = st;
    if (threadIdx.x == 0) (void)xb_add(&bar[XB_XCNT(b.x)], 1u);
    return b;
}
DI void xcd_barrier_complete(unsigned* bar, unsigned x, unsigned& nloc, unsigned& nx) {
    const unsigned G = gridDim.x * gridDim.y * gridDim.z;
    unsigned sum, cnt, mine, sp = 0u;
    for (;;) {
        sum = 0u; cnt = 0u; mine = 0u;
#pragma unroll
        for (unsigned j = 0; j < 16; ++j) { const unsigned c = xb_ld(&bar[XB_XCNT(j)]); sum += c; cnt += (c > 0u) ? 1u : 0u; mine = (j == x) ? c : mine; }
        if (sum == G) break;
        __builtin_amdgcn_s_sleep(1);
        if ((++sp & 255u) == 0u) { if (xb_ld(&bar[XB_TMO])) break; if (sp > XB_SPIN_CAP) { atomicAdd(&bar[XB_TMO], 1u); break; } }
    }
    nloc = mine > 0u ? mine : 1u; nx = cnt > 0u ? cnt : 1u;
}
DI void xcd_barrier(const XcdBarrier& b) {
    asm volatile("s_waitcnt vmcnt(0)" ::: "memory");
    __syncthreads();
    if (threadIdx.x == 0) {
        unsigned* bar = b.bar;
        __builtin_amdgcn_s_waitcnt(0);
        unsigned nloc = b.st[0], nx = b.st[1];
        if (nloc == 0u) { xcd_barrier_complete(bar, b.x, nloc, nx); b.st[0] = nloc; b.st[1] = nx; }
        const unsigned old = xb_add(&bar[XB_XSUB(b.x)], 1u);
        const unsigned gen = old / nloc;
        if (old + 1u == (gen + 1u) * nloc) {
            __builtin_amdgcn_fence(__ATOMIC_RELEASE, "agent");
            asm volatile("s_waitcnt vmcnt(0)" ::: "memory");
            const unsigned og = xb_add(&bar[XB_TOP], 1u);
            const unsigned tg = og / nx;
            if (og + 1u == (tg + 1u) * nx) xb_add(&bar[XB_TOPGEN], 1u);
            else XB_SPIN(xb_ld(&bar[XB_TOPGEN]) == tg, bar);
            __builtin_amdgcn_fence(__ATOMIC_ACQUIRE, "agent");
            xb_add(&bar[XB_XGEN(b.x)], 1u);
            asm volatile("s_waitcnt vmcnt(0)" ::: "memory");
        } else {
            XB_SPIN(xb_ld(&bar[XB_XGEN(b.x)]) == gen, bar);
            __builtin_amdgcn_fence(__ATOMIC_ACQUIRE, "agent");
            asm volatile("s_waitcnt vmcnt(0)" ::: "memory");
        }
    }
    __syncthreads();
}

namespace pg8 {
constexpr int BM = 256, BK = 64, HALF = 128, HTB = HALF * BK * 2, STAGE_BYTES = 8 * HTB, NXCD = 8, WGM = 8;
DI int lds_byte(int r, int c) { const int st = (r >> 4) * 2 + (c >> 5), rr = r & 15, cc = c & 31, ob = rr * 64 + cc * 2; return st * 1024 + (ob ^ (((ob >> 9) & 1) << 5)); }
DI void stage_rc(int b, int& R, int& C) { const int st = b / 1024, sb = b % 1024, swz = sb ^ (((sb >> 9) & 1) << 5); R = (st >> 1) * 16 + swz / 64; C = (st & 1) * 32 + (swz % 64) / 2; }
DI int perm32(int rho) { const int n = rho >> 4, i = rho & 15; return 8 * (i >> 2) + 4 * n + (i & 3); }
struct Unit { int pm, pn; };
struct Gemm { const bf16_t* A; const bf16_t* Bt; int M, N, K, lda, ldb, mstep; };
struct StaticOrder {
    int nM, nN, nwg, G, c;
    DI void init(int M, int N, int G_, int c_) { nM = M / BM; nN = N / BM; nwg = nM * nN; G = G_; c = c_; }
    DI void init_tiles(int nM_, int nN_, int G_, int c_) { nM = nM_; nN = nN_; nwg = nM * nN; G = G_; c = c_; }
    DI bool next(int i, Unit& u) const {
        const long L = (long)i * G + c; if (L >= nwg) return false;
        int wgid = (int)L; { const int q = nwg / NXCD, r = nwg % NXCD, xcd = wgid % NXCD, off = wgid / NXCD; wgid = (xcd < r ? xcd * (q + 1) : r * (q + 1) + (xcd - r) * q) + off; }
        const int nig = WGM * nN, gid = wgid / nig, fm = gid * WGM, gsz = (nM - fm) < WGM ? (nM - fm) : WGM;
        u.pm = fm + ((wgid % nig) % gsz); u.pn = (wgid % nig) / gsz; return true;
    }
};
template <class Epi>
DI void gemm_phase(LAS unsigned char* lds, const Gemm g, const StaticOrder& S, const Epi& E) {
    int tid = threadIdx.x; asm volatile("" : "+v"(tid));
    const int wid = __builtin_amdgcn_readfirstlane(tid >> 6), lane = tid & 63, wr = wid >> 2, wc = wid & 3, fr = lane & 15, fq = lane >> 4;
    const int nt = g.K / BK;
    unsigned voffA[2], voffB[2];
#pragma unroll
    for (int i = 0; i < 2; ++i) { int R, C; stage_rc(tid * 16 + i * 8192, R, C); const int Rb = Epi::PERM ? ((R & ~31) + perm32(R & 31)) : R;
        voffA[i] = (unsigned)(R * g.lda + C) * 2u; voffB[i] = (unsigned)(Rb * g.ldb + C) * 2u; }
    const size_t kstep = (size_t)(BK * 2);
    const size_t hstepA = (size_t)HALF * g.lda * 2, hstepB = (size_t)HALF * g.ldb * 2;
    const size_t tstepA = (size_t)g.mstep * g.lda * 2, tstepB = 2 * hstepB;
    const unsigned ldsw = (unsigned)wid * 1024u;
    const int aoff = lds_byte(wr * 64 + fr, fq * 8), boff = lds_byte(wc * 32 + fr, fq * 8);
#define PG8_SA(b, h) (((b) * 2 + (h)) * HTB)
#define PG8_SB(b, h) ((4 + (b) * 2 + (h)) * HTB)
#define PG8_STAGE(bufoff, gbase, voff) do { _Pragma("unroll") for (int _i = 0; _i < 2; ++_i) \
        __builtin_amdgcn_global_load_lds((const unsigned*)((const char*)(gbase) + (voff)[_i]), (LAS unsigned*)(lds + (bufoff) + ldsw + _i * 8192), 16, 0, 0); } while (0)
#define PG8_LDA(dst, b, h) do { _Pragma("unroll") for (int m = 0; m < 4; ++m) _Pragma("unroll") for (int k = 0; k < 2; ++k) dst[m][k] = *(const LAS bf16x8*)(lds + PG8_SA(b, h) + aoff + m * 2048 + k * 1024); } while (0)
#define PG8_LDB(dst, b, h) do { _Pragma("unroll") for (int n = 0; n < 2; ++n) _Pragma("unroll") for (int k = 0; k < 2; ++k) dst[n][k] = *(const LAS bf16x8*)(lds + PG8_SB(b, h) + boff + n * 2048 + k * 1024); } while (0)
#define PG8_MMA(ai, bj, At, Bt) do { __builtin_amdgcn_s_setprio(1); _Pragma("unroll") for (int m = 0; m < 4; ++m) _Pragma("unroll") for (int n = 0; n < 2; ++n) _Pragma("unroll") for (int k = 0; k < 2; ++k) \
        acc[ai][bj][m][n] = __builtin_amdgcn_mfma_f32_16x16x32_bf16(Bt[n][k], At[m][k], acc[ai][bj][m][n], 0, 0, 0); __builtin_amdgcn_s_setprio(0); } while (0)
#define PG8_WAIT_V(n) asm volatile("s_waitcnt vmcnt(" #n ")" ::: "memory")
#define PG8_WAIT_L(n) asm volatile("s_waitcnt lgkmcnt(" #n ")" ::: "memory")
#define PG8_BAR __builtin_amdgcn_s_barrier()
#define PG8_SCHED __builtin_amdgcn_sched_barrier(0)
    Unit cur, nxt; int ui = 0;
    if (!S.next(0, cur)) return;
    f32x4 acc[2][2][4][2];
#pragma unroll
    for (int a = 0; a < 2; ++a)
#pragma unroll
        for (int b = 0; b < 2; ++b)
#pragma unroll
            for (int m = 0; m < 4; ++m)
#pragma unroll
                for (int n = 0; n < 2; ++n) acc[a][b][m][n] = (f32x4){0.f, 0.f, 0.f, 0.f};
    bf16x8 At[4][2], B0[2][2], B1[2][2];
    const char* cA = (const char*)g.A + (size_t)cur.pm * tstepA; const char* cB = (const char*)g.Bt + (size_t)cur.pn * tstepB;
    PG8_STAGE(PG8_SB(0, 0), cB, voffB); PG8_STAGE(PG8_SA(0, 0), cA, voffA); PG8_STAGE(PG8_SB(0, 1), cB + hstepB, voffB); PG8_STAGE(PG8_SA(0, 1), cA + hstepA, voffA);
    if (wr == 1) PG8_BAR;
    PG8_WAIT_V(4); PG8_BAR;
    PG8_STAGE(PG8_SB(1, 0), cB + kstep, voffB); PG8_STAGE(PG8_SA(1, 0), cA + kstep, voffA); PG8_STAGE(PG8_SB(1, 1), cB + hstepB + kstep, voffB);
    PG8_WAIT_V(6); PG8_BAR;
    for (;;) {
        const bool has_next = S.next(ui + 1, nxt);
        const char* nA = has_next ? (const char*)g.A + (size_t)nxt.pm * tstepA : cA; const char* nB = has_next ? (const char*)g.Bt + (size_t)nxt.pn * tstepB : cB;
        for (int t = 0; t < nt; t += 2) {
            const bool last = (t == nt - 2);
            const char* a1 = cA + (size_t)(t + 1) * kstep;
            const char* a2 = last ? nA : cA + (size_t)(t + 2) * kstep; const char* b2 = last ? nB : cB + (size_t)(t + 2) * kstep;
            const char* a3 = a2 + kstep; const char* b3 = b2 + kstep;
            if constexpr (Epi::MIDK) { if (t == (nt >> 1)) E.mid(acc, cur, wr, wc, fr, fq); }
            PG8_LDB(B0, 0, 0); PG8_SCHED; PG8_LDA(At, 0, 0); PG8_STAGE(PG8_SA(1, 1), a1 + hstepA, voffA);
            PG8_WAIT_L(8); PG8_BAR; PG8_WAIT_L(0); PG8_MMA(0, 0, At, B0); PG8_BAR; PG8_SCHED;
            PG8_LDB(B1, 0, 1); PG8_STAGE(PG8_SB(0, 0), b2, voffB);
            PG8_BAR; PG8_WAIT_L(0); PG8_MMA(0, 1, At, B1); PG8_BAR;
            PG8_LDA(At, 0, 1); PG8_STAGE(PG8_SA(0, 0), a2, voffA);
            PG8_BAR; PG8_WAIT_L(0); PG8_MMA(1, 0, At, B0); PG8_BAR; PG8_SCHED;
            PG8_STAGE(PG8_SB(0, 1), b2 + hstepB, voffB);
            PG8_WAIT_V(6); PG8_BAR; PG8_MMA(1, 1, At, B1); PG8_BAR;
            PG8_LDB(B0, 1, 0); PG8_SCHED; PG8_LDA(At, 1, 0); PG8_STAGE(PG8_SA(0, 1), a2 + hstepA, voffA);
            PG8_WAIT_L(8); PG8_BAR; PG8_WAIT_L(0); PG8_MMA(0, 0, At, B0); PG8_BAR; PG8_SCHED;
            PG8_LDB(B1, 1, 1); PG8_STAGE(PG8_SB(1, 0), b3, voffB);
            PG8_BAR; PG8_WAIT_L(0); PG8_MMA(0, 1, At, B1); PG8_BAR;
            PG8_LDA(At, 1, 1); PG8_STAGE(PG8_SA(1, 0), a3, voffA);
            PG8_BAR; PG8_WAIT_L(0); PG8_MMA(1, 0, At, B0); PG8_BAR; PG8_SCHED;
            PG8_STAGE(PG8_SB(1, 1), b3 + hstepB, voffB);
            PG8_WAIT_V(6); PG8_BAR; PG8_MMA(1, 1, At, B1); PG8_BAR;
        }
        E(acc, cur, wr, wc, fr, fq);
        if (!has_next) break;
#pragma unroll
        for (int a = 0; a < 2; ++a)
#pragma unroll
            for (int b = 0; b < 2; ++b)
#pragma unroll
                for (int m = 0; m < 4; ++m)
#pragma unroll
                    for (int n = 0; n < 2; ++n) acc[a][b][m][n] = (f32x4){0.f, 0.f, 0.f, 0.f};
        cur = nxt; cA = nA; cB = nB; ++ui;
    }
    PG8_WAIT_V(0);
    if (wr == 0) PG8_BAR;
    PG8_BAR;
#undef PG8_SA
#undef PG8_SB
#undef PG8_STAGE
#undef PG8_LDA
#undef PG8_LDB
#undef PG8_MMA
#undef PG8_WAIT_V
#undef PG8_WAIT_L
#undef PG8_BAR
#undef PG8_SCHED
}
}
using pg8::Unit;
typedef f32x4 AccT[2][2][4][2];

struct EpiProj {
    static constexpr bool PERM = true, MIDK = false;
    unsigned char* ws; const float* rstd1; const float* bcum; const float* ropec; const float* ropes;
    DI void mid(AccT&, const Unit&, int, int, int, int) const {}
    DI void operator()(const AccT& acc, const Unit& u, int wr, int wc, int fr, int fq) const {
        const int pn = u.pn; int seg, pn0;
        if (pn < 8) { seg = pn >> 1; pn0 = seg * 2; } else if (pn == 8) { seg = 4; pn0 = 8; } else if (pn == 9) { seg = 5; pn0 = 9; }
        else if (pn < 12) { seg = 6; pn0 = 10; } else if (pn < 14) { seg = 7; pn0 = 12; } else if (pn < 18) { seg = 8; pn0 = 14; } else { seg = 9; pn0 = 18; }
        size_t segoff; int ld;
        switch (seg) { case 0: segoff = PQ_R; ld = 512; break; case 1: segoff = PK_R; ld = 512; break; case 2: segoff = PV_R; ld = 512; break; case 3: segoff = PG_R; ld = 512; break;
            case 4: segoff = PQ_G; ld = 256; break; case 5: segoff = PK_G; ld = 256; break; case 6: segoff = PV_G; ld = 512; break; case 7: segoff = PG_G; ld = 512; break;
            case 8: segoff = PM_R; ld = 1024; break; default: segoff = PM_G; ld = 1024; break; }
        bf16_t* base = (bf16_t*)(ws + segoff);
        const int lc0 = (pn - pn0) * 256 + wc * 32 + 8 * fq;
        const int row0 = u.pm * 256 + wr * 64 + fr;
        if (seg <= 1) {
            const int i0 = 16 * wc + 4 * fq;
#pragma unroll
            for (int ai = 0; ai < 2; ++ai)
#pragma unroll
                for (int m = 0; m < 4; ++m) {
                    const int row = row0 + ai * 128 + m * 16; const float rs = rstd1[row];
                    int posidx, ic; if (row < TP) { posidx = row & 2047; ic = row & 63; } else { const int s = row - TP; posidx = 2048 + (s & 3); ic = s & 3; }
                    const f32x4 c4 = *(const f32x4*)(ropec + posidx * 64 + i0), s4 = *(const f32x4*)(ropes + posidx * 64 + i0);
#pragma unroll
                    for (int bj = 0; bj < 2; ++bj) {
                        const int head = (pn - pn0) * 2 + bj;
                        const float lg2 = log2f(1.f - exp2f(-5.f - (float)head));
                        const float dec = (seg == 0) ? exp2f((float)(ic + 1) * lg2) : exp2f(-(float)(ic + 1) * lg2) * 0.08838834764831845f;
                        const f32x4 t1 = acc[ai][bj][m][0] * rs, t2 = acc[ai][bj][m][1] * rs;
                        const f32x4 o1 = (t1 * c4 - t2 * s4) * dec, o2 = (t1 * s4 + t2 * c4) * dec;
                        bf16_t* rp = base + (size_t)row * 512 + head * 128 + i0;
                        u32x2 w1, w2; w1.x = pk2(o1[0], o1[1]); w1.y = pk2(o1[2], o1[3]); w2.x = pk2(o2[0], o2[1]); w2.y = pk2(o2[2], o2[3]);
                        *(u32x2*)rp = w1; *(u32x2*)(rp + 64) = w2;
                    }
                }
            return;
        }
#pragma unroll
        for (int ai = 0; ai < 2; ++ai)
#pragma unroll
            for (int m = 0; m < 4; ++m) {
                const int row = row0 + ai * 128 + m * 16; const float rs = rstd1[row];
#pragma unroll
                for (int bj = 0; bj < 2; ++bj) {
                    const int lc = lc0 + bj * 128;
                    f32x4 v0 = acc[ai][bj][m][0] * rs, v1 = acc[ai][bj][m][1] * rs;
                    if (seg == 4 || seg == 5) {
                        const f32x4 b0 = *(const f32x4*)(bcum + (size_t)row * 256 + lc), b1 = *(const f32x4*)(bcum + (size_t)row * 256 + lc + 4);
                        if (seg == 4) {
#pragma unroll
                            for (int e = 0; e < 4; ++e) { v0[e] *= 0.125f * __expf(b0[e]); v1[e] *= 0.125f * __expf(b1[e]); }
                        } else {
#pragma unroll
                            for (int e = 0; e < 4; ++e) { v0[e] *= __expf(-b0[e]); v1[e] *= __expf(-b1[e]); }
                        }
                    } else if (seg == 3 || seg == 7) {
#pragma unroll
                        for (int e = 0; e < 4; ++e) { v0[e] = v0[e] * sigmoidf_(v0[e]); v1[e] = v1[e] * sigmoidf_(v1[e]); }
                    } else if (seg >= 8) {
#pragma unroll
                        for (int e = 0; e < 4; ++e) { v0[e] = sigmoidf_(v0[e]); v1[e] = sigmoidf_(v1[e]); }
                    }
                    u32x4 w; w.x = pk2(v0[0], v0[1]); w.y = pk2(v0[2], v0[3]); w.z = pk2(v1[0], v1[1]); w.w = pk2(v1[2], v1[3]);
                    *(u32x4*)(base + (size_t)row * ld + lc) = w;
                }
            }
    }
};
struct EpiMix {
    static constexpr bool PERM = true, MIDK = true;
    const bf16_t* mr; const bf16_t* mg; bf16_t* mix;
    DI void mid(AccT& acc, const Unit& u, int wr, int wc, int fr, int fq) const {
        int row0 = u.pm * 256 + wr * 64 + fr, c0 = u.pn * 256 + wc * 32 + 8 * fq;
        asm volatile("" : "+v"(row0), "+v"(c0));
#pragma unroll
        for (int ai = 0; ai < 2; ++ai)
#pragma unroll
            for (int m = 0; m < 4; ++m) {
                const int row = row0 + ai * 128 + m * 16;
#pragma unroll
                for (int bj = 0; bj < 2; ++bj) {
                    const u32x4 a = *(const u32x4*)(mr + (size_t)row * 1024 + c0 + bj * 128), b = *(const u32x4*)(mg + (size_t)row * 1024 + c0 + bj * 128);
                    f32x4 r0, r1;
                    r0[0] = bflo(a.x) / fmaxf(bflo(b.x), 1e-30f); r0[1] = bfhi(a.x) / fmaxf(bfhi(b.x), 1e-30f); r0[2] = bflo(a.y) / fmaxf(bflo(b.y), 1e-30f); r0[3] = bfhi(a.y) / fmaxf(bfhi(b.y), 1e-30f);
                    r1[0] = bflo(a.z) / fmaxf(bflo(b.z), 1e-30f); r1[1] = bfhi(a.z) / fmaxf(bfhi(b.z), 1e-30f); r1[2] = bflo(a.w) / fmaxf(bflo(b.w), 1e-30f); r1[3] = bfhi(a.w) / fmaxf(bfhi(b.w), 1e-30f);
                    acc[ai][bj][m][0] *= r0; acc[ai][bj][m][1] *= r1;
                }
                __builtin_amdgcn_sched_barrier(0);
            }
    }
    DI void operator()(const AccT& acc, const Unit& u, int wr, int wc, int fr, int fq) const {
        const int row0 = u.pm * 256 + wr * 64 + fr, c0 = u.pn * 256 + wc * 32 + 8 * fq;
#pragma unroll
        for (int ai = 0; ai < 2; ++ai)
#pragma unroll
            for (int m = 0; m < 4; ++m) {
                const int row = row0 + ai * 128 + m * 16;
#pragma unroll
                for (int bj = 0; bj < 2; ++bj) {
                    const u32x4 b = *(const u32x4*)(mg + (size_t)row * 1024 + c0 + bj * 128);
                    const f32x4 v0 = acc[ai][bj][m][0], v1 = acc[ai][bj][m][1];
                    u32x4 w; w.x = pk2(v0[0] * bflo(b.x), v0[1] * bfhi(b.x)); w.y = pk2(v0[2] * bflo(b.y), v0[3] * bfhi(b.y));
                    w.z = pk2(v1[0] * bflo(b.z), v1[1] * bfhi(b.z)); w.w = pk2(v1[2] * bflo(b.w), v1[3] * bfhi(b.w));
                    *(u32x4*)(mix + (size_t)row * 1024 + c0 + bj * 128) = w;
                }
            }
    }
};
struct EpiH {
    static constexpr bool PERM = true, MIDK = false;
    const float* xp; const float* xs; float* h; bf16_t* hb; float* ssq;
    DI void mid(AccT&, const Unit&, int, int, int, int) const {}
    DI void operator()(const AccT& acc, const Unit& u, int wr, int wc, int fr, int fq) const {
        const int row0 = u.pm * 256 + wr * 64 + fr, c0 = u.pn * 256 + wc * 32 + 8 * fq;
#pragma unroll
        for (int ai = 0; ai < 2; ++ai)
#pragma unroll
            for (int m = 0; m < 4; ++m) {
                const int row = row0 + ai * 128 + m * 16;
                const float* xr = row < TP ? xp + (size_t)row * DM : xs + (size_t)(row - TP) * DM;
                float ss = 0.f;
#pragma unroll
                for (int bj = 0; bj < 2; ++bj) {
                    const int c = c0 + bj * 128;
                    const f32x4 v0 = acc[ai][bj][m][0] + *(const f32x4*)(xr + c), v1 = acc[ai][bj][m][1] + *(const f32x4*)(xr + c + 4);
                    *(f32x4*)(h + (size_t)row * DM + c) = v0; *(f32x4*)(h + (size_t)row * DM + c + 4) = v1;
                    u32x4 w; w.x = pk2(v0[0], v0[1]); w.y = pk2(v0[2], v0[3]); w.z = pk2(v1[0], v1[1]); w.w = pk2(v1[2], v1[3]);
                    *(u32x4*)(hb + (size_t)row * DM + c) = w;
                    ss += v0[0] * v0[0] + v0[1] * v0[1] + v0[2] * v0[2] + v0[3] * v0[3] + v1[0] * v1[0] + v1[1] * v1[1] + v1[2] * v1[2] + v1[3] * v1[3];
                }
                ss += __shfl_xor(ss, 16); ss += __shfl_xor(ss, 32);
                if (fq == 0) unsafeAtomicAdd(ssq + row, ss);
            }
    }
};
DI f32x2 gelu_pk(f32x2 v) {
    const f32x2 av = __builtin_elementwise_abs(v), d = av * 0.2316418882f + 1.0f;
    f32x2 t; t.x = __builtin_amdgcn_rcpf(d.x); t.y = __builtin_amdgcn_rcpf(d.y);
    f32x2 q = t * 0.5307027145f + (-0.7265760135f); q = q * t + 0.7107068705f; q = q * t + (-0.142248368f); q = q * t + 0.127414796f; q = q * t;
    const f32x2 s = (v * v) * (-0.72134752044f);
    f32x2 e; e.x = __builtin_amdgcn_exp2f(s.x); e.y = __builtin_amdgcn_exp2f(s.y);
    const f32x2 m = v * (q * e), r = v - m;
    f32x2 o; o.x = v.x < 0.f ? m.x : r.x; o.y = v.y < 0.f ? m.y : r.y; return o;
}
#define DPPF(old_, src_, ctrl_) __int_as_float(__builtin_amdgcn_update_dpp(__float_as_int(old_), __float_as_int(src_), (ctrl_), 0xf, 0xf, false))
struct EpiUpConv {
    static constexpr bool PERM = true, MIDK = false;
    const float* ssq; bf16_t* act; const float* cw; const float* cb; const float* cache; float* out; LAS float* xch;
    DI void mid(AccT&, const Unit&, int, int, int, int) const {}
    DI void operator()(const AccT& acc, const Unit& u, int wr, int wc, int fr, int fq) const {
        const int tokbase = u.pm * 254 - 2, cl = wc * 32 + 8 * fq, f0 = u.pn * 128 + cl;
        float rs[2][4];
#pragma unroll
        for (int ai = 0; ai < 2; ++ai)
#pragma unroll
            for (int m = 0; m < 4; ++m) { const int tok = tokbase + ai * 128 + wr * 64 + m * 16 + fr; rs[ai][m] = (tok >= 0 && tok < T_TOK) ? rsqrtf(ssq[tok] * (1.f / DM) + EPS) : 0.f; }
        if (fr >= 14) {
#pragma unroll
            for (int ai = 0; ai < 2; ++ai) { LAS float* xp = xch + ((2 * ai + wr) * 2 + (fr - 14)) * 128 + cl;
                *(LAS f32x4*)xp = acc[ai][0][3][0] * rs[ai][3]; *(LAS f32x4*)(xp + 4) = acc[ai][0][3][1] * rs[ai][3]; }
        }
        asm volatile("s_waitcnt lgkmcnt(0)" ::: "memory"); __builtin_amdgcn_s_barrier(); __builtin_amdgcn_s_barrier(); asm volatile("" ::: "memory");
        const bool samp_tile = (tokbase + 255 >= TP);
#pragma unroll
        for (int n = 0; n < 2; ++n) {
            const f32x4 cb4 = *(const f32x4*)(cb + f0 + 4 * n), w04 = *(const f32x4*)(cw + f0 + 4 * n), w14 = *(const f32x4*)(cw + DFF + f0 + 4 * n), w24 = *(const f32x4*)(cw + 2 * DFF + f0 + 4 * n);
#pragma unroll
            for (int ai = 0; ai < 2; ++ai) {
                const int g = 2 * ai + wr;
                f32x4 h1 = {0.f, 0.f, 0.f, 0.f}, h2 = {0.f, 0.f, 0.f, 0.f};
                if (g >= 1) { h1 = *(const LAS f32x4*)(xch + ((g - 1) * 2 + 1) * 128 + cl + 4 * n); h2 = *(const LAS f32x4*)(xch + ((g - 1) * 2 + (fr == 0 ? 0 : 1)) * 128 + cl + 4 * n); }
                f32x4 prev = {0.f, 0.f, 0.f, 0.f};
#pragma unroll
                for (int m = 0; m < 4; ++m) {
                    const int i = ai * 128 + wr * 64 + m * 16 + fr, tok = tokbase + i;
                    const f32x4 cur = acc[ai][0][m][n] * rs[ai][m], vv = acc[ai][1][m][n] * rs[ai][m];
                    f32x4 x1, x2;
#pragma unroll
                    for (int e = 0; e < 4; ++e) {
                        const float o1 = (m == 0) ? h1[e] : DPPF(0.f, prev[e], 0x121), o2 = (m == 0) ? h2[e] : DPPF(0.f, prev[e], 0x122);
                        x1[e] = DPPF(o1, cur[e], 0x111); x2[e] = DPPF(o2, cur[e], 0x112);
                    }
                    prev = cur;
                    int l; const bool samp = tok >= TP;
                    if (!samp) l = tok & 2047; else l = (tok - TP) & 3;
                    if (l < 2) {
                        if (samp_tile && samp) {
                            const int bidx = (tok - TP) >> 2;
                            if (tok < T_TOK) { const f32x4 c1 = *(const f32x4*)(cache + ((size_t)bidx * 2 + 1) * DFF + f0 + 4 * n), c0 = *(const f32x4*)(cache + ((size_t)bidx * 2 + l) * DFF + f0 + 4 * n);
                                x2 = c0; if (l == 0) x1 = c1; }
                        } else { x2 = (f32x4){0.f, 0.f, 0.f, 0.f}; if (l == 0) x1 = x2; }
                    }
                    const f32x4 uc = cb4 + w04 * x2 + w14 * x1 + w24 * cur;
                    const f32x2 ga = gelu_pk((f32x2){uc[0], uc[1]}), gb = gelu_pk((f32x2){uc[2], uc[3]});
                    if (i >= 2 && tok < T_TOK) {
                        u32x2 w; w.x = pk2(ga.x * vv[0], ga.y * vv[1]); w.y = pk2(gb.x * vv[2], gb.y * vv[3]);
                        *(u32x2*)(act + (size_t)tok * DFF + f0 + 4 * n) = w;
                        if (!samp) { if (l >= 2046) *(f32x4*)(out + OUT_CP + ((size_t)(tok >> 11) * 2 + (l - 2046)) * DFF + f0 + 4 * n) = cur; }
                        else if (l >= 2) *(f32x4*)(out + OUT_CS + ((size_t)((tok - TP) >> 2) * 2 + (l - 2)) * DFF + f0 + 4 * n) = cur;
                    }
                }
            }
        }
    }
};
template <bool DRY> struct EpiDownT {
    static constexpr bool PERM = true, MIDK = false;
    float* h;
    DI void mid(AccT&, const Unit&, int, int, int, int) const {}
    DI void operator()(const AccT& acc, const Unit& u, int wr, int wc, int fr, int fq) const {
        const int row0 = u.pm * 256 + wr * 64 + fr, c0 = u.pn * 256 + wc * 32 + 8 * fq;
#pragma unroll
        for (int ai = 0; ai < 2; ++ai)
#pragma unroll
            for (int m = 0; m < 4; ++m) {
                const int row = row0 + ai * 128 + m * 16;
#pragma unroll
                for (int bj = 0; bj < 2; ++bj) {
                    float* hp = h + (size_t)row * DM + c0 + bj * 128;
                    const f32x4 h0 = *(const f32x4*)hp, h1 = *(const f32x4*)(hp + 4);
                    f32x4 v0 = acc[ai][bj][m][0] + h0, v1 = acc[ai][bj][m][1] + h1;
                    if (DRY && h != nullptr) { v0 = h0; v1 = h1; }
                    *(f32x4*)hp = v0; *(f32x4*)(hp + 4) = v1;
                }
            }
    }
};

DI void transpose_item(const float* __restrict__ src, int ldsrc, int srccol, int k0, const float* __restrict__ scale, bf16_t* dst, int lddst, int n0dst, int k0dst,
                       LAS float* scr, int lane) {
#pragma unroll 8
    for (int i = 0; i < 32; ++i) { const int kk = 2 * i + (lane >> 5); float v = src[(size_t)(k0 + kk) * ldsrc + srccol]; if (scale) v *= scale[k0 + kk]; scr[kk * 33 + (lane & 31)] = v; }
    LDS_WAIT();
    const int c = lane & 7;
#pragma unroll
    for (int j = 0; j < 4; ++j) { const int n = (lane >> 3) + 8 * j; const LAS float* s = scr + (8 * c) * 33 + n;
        u32x4 o; o.x = pk2(s[0 * 33], s[1 * 33]); o.y = pk2(s[2 * 33], s[3 * 33]); o.z = pk2(s[4 * 33], s[5 * 33]); o.w = pk2(s[6 * 33], s[7 * 33]);
        *(u32x4*)(dst + (size_t)(n0dst + n) * lddst + k0dst + 8 * c) = o; }
    LDS_WAIT();
}
DI float log_sigmoid(float z) { return fminf(z, 0.f) - log1pf(expf(-fabsf(z))); }

DI void phase0(const Params& p, LAS unsigned char* lds) {
    int tid = threadIdx.x; asm volatile("" : "+v"(tid));
    const int lane = tid & 63, wave = tid >> 6;
    unsigned char* ws = p.ws;
    LAS bf16_t* wga = (LAS bf16_t*)lds;
    LAS float* gas = (LAS float*)(lds + 33024);
    LAS float* scr = (LAS float*)(lds + 41216 + wave * 8448);
    bf16_t* xb = (bf16_t*)((unsigned char*)p.out + 0);
    float* rstd1 = (float*)(ws + WS_RSTD1); float* bcum = (float*)(ws + WS_SH); float* ebl = (float*)(ws + WS_EBL);
    { const int gt = blockIdx.x * 512 + tid, ng = gridDim.x * 512;
      float* ssq2 = (float*)(ws + WS_SSQ2);
      for (int i = gt; i < T_TOK; i += ng) ssq2[i] = 0.f;
      float* rc = (float*)(ws + WS_ROPEC); float* rsn = (float*)(ws + WS_ROPES);
      for (int i = gt; i < 2052 * 64; i += ng) { const int pi = i >> 6, fi = i & 63; const double pos = (double)(pi < 2048 ? pi : 16384 + (pi - 2048));
          const double inv = exp(-(double)fi * (9.210340371976184 / 64.0)); const double ang = pos * inv; const double kk = rint(ang * 0.15915494309189535);
          const float r = (float)(ang - kk * 6.283185307179586); rc[i] = cosf(r); rsn[i] = sinf(r); } }
    if (blockIdx.x < 132) {
        for (int k = tid; k < DM; k += 512) { const float g = p.ln1[k]; const float* s = p.w_in + (size_t)k * DIN + 3584;
#pragma unroll
            for (int r = 0; r < 16; r += 2) { const unsigned w = pk2(s[r] * g, s[r + 1] * g); wga[r * 1032 + k] = (bf16_t)(w & 0xffffu); wga[(r + 1) * 1032 + k] = (bf16_t)(w >> 16); } }
        __syncthreads();
        for (int u = blockIdx.x; u < 132; u += gridDim.x) {
            const int r16 = lane & 15, kq = lane >> 4, t0 = u * 128 + wave * 16, row = t0 + r16;
            const float* xr = x_row(p, row);
            f32x4 acc = {0.f, 0.f, 0.f, 0.f}; float ss = 0.f;
            for (int ks = 0; ks < 32; ks += 4) {
                f32x4 v[4][2];
#pragma unroll
                for (int q = 0; q < 4; ++q) { v[q][0] = *(const f32x4*)(xr + (ks + q) * 32 + kq * 8); v[q][1] = *(const f32x4*)(xr + (ks + q) * 32 + kq * 8 + 4); }
#pragma unroll
                for (int q = 0; q < 4; ++q) {
                    const f32x4 a0 = v[q][0], a1 = v[q][1];
                    ss += a0[0] * a0[0] + a0[1] * a0[1] + a0[2] * a0[2] + a0[3] * a0[3] + a1[0] * a1[0] + a1[1] * a1[1] + a1[2] * a1[2] + a1[3] * a1[3];
                    u32x4 w; w.x = pk2(a0[0], a0[1]); w.y = pk2(a0[2], a0[3]); w.z = pk2(a1[0], a1[1]); w.w = pk2(a1[2], a1[3]);
                    *(u32x4*)(xb + (size_t)row * DM + (ks + q) * 32 + kq * 8) = w;
                    const bf16x8 bfrag = *(const LAS bf16x8*)(wga + r16 * 1032 + (ks + q) * 32 + kq * 8);
                    acc = __builtin_amdgcn_mfma_f32_16x16x32_bf16(__builtin_bit_cast(bf16x8, w), bfrag, acc, 0, 0, 0);
                }
            }
            ss += __shfl_xor(ss, 16); ss += __shfl_xor(ss, 32);
            const float rs = rsqrtf(ss * (1.f / DM) + EPS);
            if (kq == 0) rstd1[row] = rs;
#pragma unroll
            for (int j = 0; j < 4; ++j) { const float rj = __shfl(rs, kq * 4 + j); gas[(wave * 16 + kq * 4 + j) * 16 + r16] = acc[j] * rj; }
            __syncthreads();
            {
                const int c = tid & 255, half = tid >> 8;
                float wg[16];
#pragma unroll
                for (int r = 0; r < 16; ++r) wg[r] = p.w_gate_up[r * 256 + c];
                const float bias = p.b_gate_up[c];
                const int tokb = u * 128 + half * 64; const bool samp = tokb >= TP;
                float cum = 0.f;
                for (int i = 0; i < 64; ++i) {
                    const LAS f32x4* gp = (const LAS f32x4*)(gas + (half * 64 + i) * 16);
                    const f32x4 g0 = gp[0], g1 = gp[1], g2 = gp[2], g3 = gp[3];
                    float z = bias;
                    z += g0[0] * wg[0] + g0[1] * wg[1] + g0[2] * wg[2] + g0[3] * wg[3] + g1[0] * wg[4] + g1[1] * wg[5] + g1[2] * wg[6] + g1[3] * wg[7];
                    z += g2[0] * wg[8] + g2[1] * wg[9] + g2[2] * wg[10] + g2[3] * wg[11] + g3[0] * wg[12] + g3[1] * wg[13] + g3[2] * wg[14] + g3[3] * wg[15];
                    const float ls = log_sigmoid(z) * (1.f / 16.f);
                    const bool reset = samp ? ((i & 3) == 0) : (i == 0);
                    cum = reset ? ls : cum + ls;
                    const int tok = tokb + i;
                    bcum[(size_t)tok * 256 + c] = cum;
                    if (samp) { if ((i & 3) == 3) ebl[(size_t)(256 + ((tok - TP) >> 2)) * 256 + c] = expf(cum); }
                    else if (i == 63) ebl[(size_t)(tok >> 6) * 256 + c] = expf(cum);
                }
            }
            __syncthreads();
        }
    }
    {
        const int gw = blockIdx.x * 8 + wave, ngw = gridDim.x * 8;
        constexpr int I_IN = 16 * 176, I_MX = 8 * 32, I_O = 16 * 32, I_UP = 16 * 176, I_DN = 44 * 32, NIT = I_IN + 2 * I_MX + I_O + I_UP + I_DN;
        for (int it = gw; it < NIT; it += ngw) {
            int r = it; const int nl = lane & 31;
            if (r < I_IN) { const int kb = r / 176, nb = r % 176, n = nb * 32 + nl; int sc;
                if (n < 1024) { const int pp = n & 127; sc = (n & ~127) + (((pp & 7) < 4) ? 4 * (pp >> 3) + (pp & 7) : 64 + 4 * (pp >> 3) + (pp & 7) - 4); }
                else sc = n < 3584 ? n : n + 16;
                transpose_item(p.w_in, DIN, sc, kb * 64, p.ln1, (bf16_t*)(ws + WS_WIN), DM, nb * 32, kb * 64, scr, lane); continue; }
            r -= I_IN;
            if (r < I_MX) { const int kb = r / 32, nb = r % 32; transpose_item(p.w_ret_out, DM, nb * 32 + nl, kb * 64, nullptr, (bf16_t*)(ws + WS_WMIX), DM, nb * 32, kb * 64, scr, lane); continue; }
            r -= I_MX;
            if (r < I_MX) { const int kb = r / 32, nb = r % 32; transpose_item(p.w_gla_out, DM, nb * 32 + nl, kb * 64, nullptr, (bf16_t*)(ws + WS_WMIX), DM, nb * 32, 512 + kb * 64, scr, lane); continue; }
            r -= I_MX;
            if (r < I_O) { const int kb = r / 32, nb = r % 32; transpose_item(p.w_o, DM, nb * 32 + nl, kb * 64, nullptr, (bf16_t*)(ws + WS_WO), DM, nb * 32, kb * 64, scr, lane); continue; }
            r -= I_O;
            if (r < I_UP) { const int kb = r / 176, nb = r % 176, n = nb * 32 + nl; const int sc = ((n >> 7) & 1) * DFF + (n >> 8) * 128 + (n & 127);
                transpose_item(p.w_up, NUP, sc, kb * 64, p.ln2, (bf16_t*)(ws + WS_WUP), DM, nb * 32, kb * 64, scr, lane); continue; }
            r -= I_UP;
            { const int kb = r / 32, nb = r % 32; transpose_item(p.w_down, DM, nb * 32 + nl, kb * 64, nullptr, (bf16_t*)(ws + WS_WDN), DFF, nb * 32, kb * 64, scr, lane); }
        }
    }
}

template <int DK> DI unsigned img_off(int row, int ch) { return (unsigned)(row * (2 * DK) + 16 * (ch ^ ((((row & 3) << 2) | ((row >> 2) & 3)) & (DK / 8 - 1)))); }
template <int DK> DI unsigned tr_addr(int lane, int c, int ks, int t) {
    const int h = lane >> 5, blk = (lane >> 4) & 1, q = (lane & 15) >> 2, pp = lane & 3;
    return img_off<DK>(16 * ks + 8 * h + 4 * t + q, 4 * c + 2 * blk + (pp >> 1)) + 8 * (pp & 1);
}
DI bf16x8 tr_frag(LAS unsigned char* a0, LAS unsigned char* a1) {
    const s16x4 lo = __builtin_amdgcn_ds_read_tr16_b64_v4i16((LAS s16x4*)a0), hi = __builtin_amdgcn_ds_read_tr16_b64_v4i16((LAS s16x4*)a1);
    return __builtin_shufflevector(lo, hi, 0, 1, 2, 3, 4, 5, 6, 7);
}
DI bf16x8 pack8(const f32x16& x, int s) {
    u32x4 w; w.x = pk2(x[8 * s + 0], x[8 * s + 1]); w.y = pk2(x[8 * s + 2], x[8 * s + 3]); w.z = pk2(x[8 * s + 4], x[8 * s + 5]); w.w = pk2(x[8 * s + 6], x[8 * s + 7]);
    return __builtin_bit_cast(bf16x8, w);
}
#define MFMA32(a, b, c) __builtin_amdgcn_mfma_f32_32x32x16_bf16((a), (b), (c), 0, 0, 0)

constexpr int P2_BUF = 49152, P2_QO = 0, P2_KO = 16384, P2_VO = 32768, P2_P = 98304, P2_SSQ = P2_P + 64 * 144, P2_EBL = P2_SSQ + 1024;

template <int DK> DI void chain_prompt(const Params& p, LAS unsigned char* lds, const int branch, const int b, const int head) {
    constexpr int NDB = DK / 32, NCH = DK / 8, QLD = 4 * DK, NQI = (64 * NCH) / 512;
    int tid0 = threadIdx.x; asm volatile("" : "+v"(tid0));
    const int w = __builtin_amdgcn_readfirstlane(tid0 >> 6);
    int tid = tid0, lane = tid0 & 63, h = lane >> 5, r = lane & 31;
    unsigned char* ws = p.ws;
    const bf16_t* Q = (const bf16_t*)(ws + (branch == 0 ? PQ_R : PQ_G)) + head * DK;
    const bf16_t* K = (const bf16_t*)(ws + (branch == 0 ? PK_R : PK_G)) + head * DK;
    const bf16_t* V = (const bf16_t*)(ws + (branch == 0 ? PV_R : PV_G)) + head * 128;
    const bf16_t* G = (const bf16_t*)(ws + (branch == 0 ? PG_R : PG_G)) + head * 128;
    const float* ebl = (const float*)(ws + WS_EBL);
    bf16_t* arg = (bf16_t*)((unsigned char*)p.out + SEG1024) + branch * 512 + head * 128;
    const float* gain = (branch == 0 ? p.g_ret : p.g_gla) + head * 128;
    const int tok0 = b * 2048;
    const float lg2 = log2f(1.f - exp2f(-5.f - (float)head));
    const float ret_ebl = exp2f(64.f * lg2);
    f32x16 S[NDB];
#pragma unroll
    for (int d = 0; d < NDB; ++d)
#pragma unroll
        for (int i = 0; i < 16; ++i) S[d][i] = 0.f;
    u32x4 rq[NQI], rk[NQI], rv[2]; float rebl = 0.f;
#define P2_LOAD(c) do { const int tb = tok0 + 64 * (c); \
        _Pragma("unroll") for (int i = 0; i < NQI; ++i) { const int idx = tid + 512 * i, rr = idx / NCH, ch = idx % NCH; \
            rq[i] = *(const u32x4*)(Q + (size_t)(tb + rr) * QLD + ch * 8); rk[i] = *(const u32x4*)(K + (size_t)(tb + rr) * QLD + ch * 8); } \
        _Pragma("unroll") for (int i = 0; i < 2; ++i) { const int idx = tid + 512 * i, rr = idx >> 4, ch = idx & 15; rv[i] = *(const u32x4*)(V + (size_t)(tb + rr) * 512 + ch * 8); } \
        if (DK == 64 && tid < 64) rebl = ebl[(size_t)(b * 32 + (c)) * 256 + head * 64 + tid]; } while (0)
#define P2_STORE(buf) do { LAS unsigned char* bb = lds + (buf) * P2_BUF; \
        _Pragma("unroll") for (int i = 0; i < NQI; ++i) { const int idx = tid + 512 * i, rr = idx / NCH, ch = idx % NCH; \
            *(LAS u32x4*)(bb + P2_QO + img_off<DK>(rr, ch)) = rq[i]; *(LAS u32x4*)(bb + P2_KO + img_off<DK>(rr, ch)) = rk[i]; } \
        _Pragma("unroll") for (int i = 0; i < 2; ++i) { const int idx = tid + 512 * i, rr = idx >> 4, ch = idx & 15; *(LAS u32x4*)(bb + P2_VO + img_off<128>(rr, ch)) = rv[i]; } \
        if (DK == 64 && tid < 64) *(LAS float*)(lds + P2_EBL + (buf) * 256 + tid * 4) = rebl; } while (0)
    P2_LOAD(0); P2_STORE(0);
    __syncthreads();
    for (int c = 0; c < 32; ++c) {
        tid = tid0; asm volatile("" : "+v"(tid)); lane = tid & 63; h = lane >> 5; r = lane & 31;
        LAS unsigned char* bb = lds + (c & 1) * P2_BUF;
        LAS unsigned char* qi = bb + P2_QO; LAS unsigned char* ki = bb + P2_KO; LAS unsigned char* vi = bb + P2_VO;
        if (c + 1 < 32) P2_LOAD(c + 1);
        if (w < 4) {
            if (w < 3) {
                const int jb = (w == 2) ? 1 : 0, ib = (w == 0) ? 0 : 1;
                f32x16 pt;
#pragma unroll
                for (int i = 0; i < 16; ++i) pt[i] = 0.f;
#pragma unroll
                for (int s = 0; s < DK / 16; ++s) {
                    const bf16x8 a = *(const LAS bf16x8*)(ki + img_off<DK>(32 * jb + r, 2 * s + h)), bq = *(const LAS bf16x8*)(qi + img_off<DK>(32 * ib + r, 2 * s + h));
                    pt = MFMA32(a, bq, pt);
                }
                if (jb == ib) {
#pragma unroll
                    for (int i = 0; i < 16; ++i) { const int j = (i & 3) + 8 * (i >> 2) + 4 * h; pt[i] = (j <= r) ? pt[i] : 0.f; }
                }
#pragma unroll
                for (int g = 0; g < 4; ++g) { u32x2 o; o.x = pk2(pt[4 * g], pt[4 * g + 1]); o.y = pk2(pt[4 * g + 2], pt[4 * g + 3]);
                    *(LAS u32x2*)(lds + P2_P + (32 * ib + r) * 144 + (32 * jb + 8 * g + 4 * h) * 2) = o; }
            }
        }
        __syncthreads();
        f32x16 ot[2];
        if (w < 4) {
            bf16x8 vf[4];
#pragma unroll
            for (int s = 0; s < 4; ++s) vf[s] = tr_frag(vi + tr_addr<128>(lane, w, s, 0), vi + tr_addr<128>(lane, w, s, 1));
#pragma unroll
            for (int ib = 0; ib < 2; ++ib) {
#pragma unroll
                for (int i = 0; i < 16; ++i) ot[ib][i] = 0.f;
#pragma unroll
                for (int s = 0; s < (ib == 0 ? 2 : 4); ++s) {
                    const bf16x8 bp = *(const LAS bf16x8*)(lds + P2_P + (32 * ib + r) * 144 + (16 * s + 8 * h) * 2);
                    ot[ib] = MFMA32(vf[s], bp, ot[ib]);
                }
            }
#pragma unroll
            for (int d = 0; d < NDB; ++d)
#pragma unroll
                for (int s2 = 0; s2 < 2; ++s2) {
                    const bf16x8 sfr = pack8(S[d], s2);
#pragma unroll
                    for (int ib = 0; ib < 2; ++ib) {
                        const s16x4 lo = *(const LAS s16x4*)(qi + img_off<DK>(32 * ib + r, 4 * d + 2 * s2) + 8 * h), hi = *(const LAS s16x4*)(qi + img_off<DK>(32 * ib + r, 4 * d + 2 * s2 + 1) + 8 * h);
                        const bf16x8 bq = __builtin_shufflevector(lo, hi, 0, 1, 2, 3, 4, 5, 6, 7);
                        ot[ib] = MFMA32(sfr, bq, ot[ib]);
                    }
                }
#pragma unroll
            for (int d = 0; d < NDB; ++d) {
#pragma unroll
                for (int s = 0; s < 4; ++s) {
                    const bf16x8 a = tr_frag(ki + tr_addr<DK>(lane, d, s, 0), ki + tr_addr<DK>(lane, d, s, 1));
                    S[d] = MFMA32(a, vf[s], S[d]);
                }
                if (DK == 128) {
#pragma unroll
                    for (int i = 0; i < 16; ++i) S[d][i] *= ret_ebl;
                } else {
                    const LAS float* eb = (const LAS float*)(lds + P2_EBL + (c & 1) * 256) + 32 * d + 4 * h;
#pragma unroll
                    for (int g = 0; g < 4; ++g) { const f32x4 e4 = *(const LAS f32x4*)(eb + 8 * g);
#pragma unroll
                        for (int e = 0; e < 4; ++e) S[d][4 * g + e] *= e4[e]; }
                }
            }
#pragma unroll
            for (int ib = 0; ib < 2; ++ib) { float ss = 0.f;
#pragma unroll
                for (int i = 0; i < 16; ++i) ss += ot[ib][i] * ot[ib][i];
                ss += __shfl_xor(ss, 32);
                if (h == 0) *(LAS float*)(lds + P2_SSQ + (w * 64 + 32 * ib + r) * 4) = ss; }
        }
        if (c + 1 < 32) P2_STORE((c + 1) & 1);
        __syncthreads();
        if (w < 4) {
            asm volatile("" : "+v"(lane)); h = lane >> 5; r = lane & 31;
            const int tb = tok0 + 64 * c;
#pragma unroll
            for (int ib = 0; ib < 2; ++ib) {
                const LAS float* sq = (const LAS float*)(lds + P2_SSQ) + 32 * ib + r;
                const float tot = sq[0] + sq[64] + sq[128] + sq[192];
                const float rs = rsqrtf(tot * (1.f / 128.f) + EPS);
#pragma unroll
                for (int g = 0; g < 4; ++g) {
                    const u32x2 gg = *(const u32x2*)(G + (size_t)(tb + 32 * ib + r) * 512 + 32 * w + 8 * g + 4 * h);
                    const f32x4 gn = *(const f32x4*)(gain + 32 * w + 8 * g + 4 * h);
                    u32x2 o; o.x = pk2(ot[ib][4 * g] * rs * gn[0] * bflo(gg.x), ot[ib][4 * g + 1] * rs * gn[1] * bfhi(gg.x));
                    o.y = pk2(ot[ib][4 * g + 2] * rs * gn[2] * bflo(gg.y), ot[ib][4 * g + 3] * rs * gn[3] * bfhi(gg.y));
                    *(u32x2*)(arg + (size_t)(tb + 32 * ib + r) * 1024 + 32 * w + 8 * g + 4 * h) = o;
                }
            }
        }
    }
#undef P2_LOAD
#undef P2_STORE
    if (w < 4) {
        lane = tid0 & 63; h = lane >> 5; r = lane & 31;
        float* so = p.out + (branch == 0 ? OUT_RSP : OUT_GSP) + (size_t)(b * 4 + head) * DK * 128;
#pragma unroll
        for (int d = 0; d < NDB; ++d)
#pragma unroll
            for (int i = 0; i < 16; ++i) so[(size_t)(32 * d + (i & 3) + 8 * (i >> 2) + 4 * h) * 128 + 32 * w + r] = S[d][i];
    }
    __syncthreads();
}

template <int DK> DI void sample_unit(const Params& p, LAS unsigned char* lds, const int branch, const int b, const int head) {
    int tid = threadIdx.x; asm volatile("" : "+v"(tid));
    unsigned char* ws = p.ws;
    const bf16_t* Q = (const bf16_t*)(ws + (branch == 0 ? PQ_R : PQ_G)) + head * DK;
    const bf16_t* K = (const bf16_t*)(ws + (branch == 0 ? PK_R : PK_G)) + head * DK;
    const bf16_t* V = (const bf16_t*)(ws + (branch == 0 ? PV_R : PV_G)) + head * 128;
    const bf16_t* G = (const bf16_t*)(ws + (branch == 0 ? PG_R : PG_G)) + head * 128;
    bf16_t* arg = (bf16_t*)((unsigned char*)p.out + SEG1024) + branch * 512 + head * 128;
    const float* gain = (branch == 0 ? p.g_ret : p.g_gla) + head * 128;
    const float* sin_ = (branch == 0 ? p.state_ret : p.state_gla) + (size_t)(b * 4 + head) * DK * 128;
    float* sout = p.out + (branch == 0 ? OUT_RSS : OUT_GSS) + (size_t)(b * 4 + head) * DK * 128;
    const int tok0 = TP + 4 * b;
    LAS float* qs = (LAS float*)lds;
    LAS float* ks = qs + 4 * 128;
    LAS float* vs = ks + 4 * 128;
    LAS float* es = vs + 4 * 128;
    LAS float* Ps = es + 128;
    LAS float* ssq = Ps + 16;
    LAS float* op = ssq + 16;
    for (int i = tid; i < 4 * DK; i += 512) { const int t = i / DK, d = i % DK;
        qs[t * DK + d] = __uint_as_float((unsigned)Q[(size_t)(tok0 + t) * (4 * DK) + d] << 16); ks[t * DK + d] = __uint_as_float((unsigned)K[(size_t)(tok0 + t) * (4 * DK) + d] << 16); }
    { const int t = tid >> 7, v = tid & 127; vs[t * 128 + v] = __uint_as_float((unsigned)V[(size_t)(tok0 + t) * 512 + v] << 16); }
    if (tid < DK) {
        if (DK == 128) { const float lg2 = log2f(1.f - exp2f(-5.f - (float)head)); es[tid] = exp2f(4.f * lg2); }
        else es[tid] = ((const float*)(ws + WS_EBL))[(size_t)(256 + b) * 256 + head * 64 + tid];
    }
    __syncthreads();
    if (tid < 16) { const int i = tid >> 2, j = tid & 3; float s = 0.f; if (j <= i) { for (int d = 0; d < DK; ++d) s += qs[i * DK + d] * ks[j * DK + d]; } Ps[tid] = s; }
    {
        const int vq = tid & 31, dg = tid >> 5;
        f32x4 oa[4];
#pragma unroll
        for (int i = 0; i < 4; ++i) oa[i] = (f32x4){0.f, 0.f, 0.f, 0.f};
        f32x4 v4[4];
#pragma unroll
        for (int j = 0; j < 4; ++j) v4[j] = *(const LAS f32x4*)(vs + j * 128 + 4 * vq);
        f32x4 s0[DK / 16];
#pragma unroll
        for (int rr = 0; rr < DK / 16; ++rr) s0[rr] = *(const f32x4*)(sin_ + (size_t)(dg + 16 * rr) * 128 + 4 * vq);
#pragma unroll
        for (int rr = 0; rr < DK / 16; ++rr) {
            const int d = dg + 16 * rr;
            f32x4 sn = s0[rr];
#pragma unroll
            for (int i = 0; i < 4; ++i) { oa[i] += s0[rr] * qs[i * DK + d]; sn += v4[i] * ks[i * DK + d]; }
            sn *= es[d];
            *(f32x4*)(sout + (size_t)d * 128 + 4 * vq) = sn;
        }
#pragma unroll
        for (int i = 0; i < 4; ++i) *(LAS f32x4*)(op + (dg * 4 + i) * 128 + 4 * vq) = oa[i];
    }
    __syncthreads();
    {
        const int i = tid >> 7, v = tid & 127;
        float o = 0.f;
#pragma unroll
        for (int dg = 0; dg < 16; ++dg) o += op[(dg * 4 + i) * 128 + v];
#pragma unroll
        for (int j = 0; j < 4; ++j) o += Ps[i * 4 + j] * vs[j * 128 + v];
        const float s = wave_sum(o * o);
        if ((tid & 63) == 0) ssq[tid >> 6] = s;
        __syncthreads();
        const float rs = rsqrtf((ssq[2 * i] + ssq[2 * i + 1]) * (1.f / 128.f) + EPS);
        const float gate = __uint_as_float((unsigned)G[(size_t)(tok0 + i) * 512 + v] << 16);
        const unsigned wv = pk2(o * rs * gain[v] * gate, 0.f);
        arg[(size_t)(tok0 + i) * 1024 + v] = (bf16_t)(wv & 0xffffu);
    }
    __syncthreads();
}

DI void phase2(const Params& p, LAS unsigned char* lds) {
    const int G = gridDim.x, bx = blockIdx.x;
    const int nchb = G > 64 ? 64 : G;
    if (bx < nchb) {
        for (int c = bx; c < 64; c += nchb) {
            const int branch = c >> 5, bh = c & 31;
#ifndef NO_CH128
            if (branch == 0) chain_prompt<128>(p, lds, 0, bh >> 2, bh & 3);
#endif
#ifndef NO_CH64
            if (branch == 1) chain_prompt<64>(p, lds, 1, bh >> 2, bh & 3);
#endif
        }
    }
    const int nsb = G > 64 ? G - 64 : G, sb = G > 64 ? bx - 64 : bx;
    if (sb >= 0) {
        for (int u = sb; u < 1024; u += nsb) {
            const int branch = u >> 9, bh = u & 511;
#ifndef NO_SMP
            if (branch == 0) sample_unit<128>(p, lds, 0, bh >> 2, bh & 3); else sample_unit<64>(p, lds, 1, bh >> 2, bh & 3);
#endif
        }
    }
}

template <bool DRY> DI void phase_final(const Params& p) {
    const int lane = threadIdx.x & 63, gw = blockIdx.x * 8 + (threadIdx.x >> 6), ngw = gridDim.x * 8;
    for (int row = gw; row < T_TOK; row += ngw) {
        f32x4* hp = (f32x4*)(p.out + (size_t)row * DM) + lane;
        f32x4 v[4]; float s = 0.f;
#pragma unroll
        for (int j = 0; j < 4; ++j) { v[j] = hp[64 * j]; s += v[j][0] * v[j][0] + v[j][1] * v[j][1] + v[j][2] * v[j][2] + v[j][3] * v[j][3]; }
        const float rs = rsqrtf(wave_sum(s) * (1.f / DM) + EPS);
#pragma unroll
        for (int j = 0; j < 4; ++j) { const f32x4 g = *((const f32x4*)p.ln_f + lane + 64 * j); f32x4 o = v[j] * rs * g; if (DRY && p.out != nullptr) o = v[j]; hp[64 * j] = o; }
    }
}

__global__ void __launch_bounds__(512, 2) fwd_megakernel(Params p) {
    extern __shared__ __attribute__((aligned(16))) unsigned char shm[];
    LAS unsigned char* lds = (LAS unsigned char*)shm;
    cg::grid_group grid = cg::this_grid();
    if (p.ws == nullptr) grid.sync();
    if (threadIdx.x < 4) ((LAS unsigned*)(lds + 131072 + 4096))[threadIdx.x] = 0u;
    __syncthreads();
    const XcdBarrier xbar = xcd_barrier_post((unsigned*)(p.ws + WS_BAR), (volatile LAS unsigned*)(lds + 131072 + 4096));
    unsigned char* ws = p.ws;
    const int G = gridDim.x, bx = blockIdx.x;
    bf16_t* xb = (bf16_t*)p.out;
    bf16_t* arg = (bf16_t*)((unsigned char*)p.out + SEG1024);

#ifndef PHMASK
#define PHMASK 0x1ff
#endif
#define PH(n) if ((PHMASK >> (n)) & 1)
    PH(0) phase0(p, lds);
    xcd_barrier(xbar);
#if defined(DUP_PH) && DUP_PH == 0
    phase0(p, lds);
    xcd_barrier(xbar);
#endif
    PH(1) {
        pg8::Gemm g{xb, (const bf16_t*)(ws + WS_WIN), T_TOK, NPROJ, DM, DM, DM, 256}; pg8::StaticOrder S; S.init(T_TOK, NPROJ, G, bx);
        EpiProj E{ws, (const float*)(ws + WS_RSTD1), (const float*)(ws + WS_SH), (const float*)(ws + WS_ROPEC), (const float*)(ws + WS_ROPES)};
        pg8::gemm_phase<EpiProj>(lds, g, S, E);
#if defined(DUP_PH) && DUP_PH == 1
        xcd_barrier(xbar);
        pg8::gemm_phase<EpiProj>(lds, g, S, E);
#endif
    }
    xcd_barrier(xbar);
    PH(2) phase2(p, lds);
    xcd_barrier(xbar);
#if defined(DUP_PH) && DUP_PH == 2
    phase2(p, lds);
    xcd_barrier(xbar);
#endif
    PH(3) {
        pg8::Gemm g{arg, (const bf16_t*)(ws + WS_WMIX), T_TOK, DM, DM, DM, DM, 256}; pg8::StaticOrder S; S.init(T_TOK, DM, G, bx);
        EpiMix E{(const bf16_t*)(ws + PM_R), (const bf16_t*)(ws + PM_G), (bf16_t*)(ws + WS_MIX)};
        pg8::gemm_phase<EpiMix>(lds, g, S, E);
#if defined(DUP_PH) && DUP_PH == 3
        xcd_barrier(xbar);
        pg8::gemm_phase<EpiMix>(lds, g, S, E);
#endif
    }
    xcd_barrier(xbar);
    PH(4) {
        pg8::Gemm g{(const bf16_t*)(ws + WS_MIX), (const bf16_t*)(ws + WS_WO), T_TOK, DM, DM, DM, DM, 256}; pg8::StaticOrder S; S.init(T_TOK, DM, G, bx);
        EpiH E{p.x_prompt, p.x_sample, p.out, (bf16_t*)(ws + WS_SH), (float*)(ws + WS_SSQ2)};
        pg8::gemm_phase<EpiH>(lds, g, S, E);
    }
    xcd_barrier(xbar);
    PH(5) {
        pg8::Gemm g{(const bf16_t*)(ws + WS_SH) - 2 * DM, (const bf16_t*)(ws + WS_WUP), T_TOK, NUP, DM, DM, DM, 254}; pg8::StaticOrder S; S.init_tiles(67, 22, G, bx);
        EpiUpConv E{(const float*)(ws + WS_SSQ2), (bf16_t*)(ws + WS_ACT), p.conv_w, p.conv_b, p.cache_conv, p.out, (LAS float*)(lds + 131072)};
        pg8::gemm_phase<EpiUpConv>(lds, g, S, E);
    }
    xcd_barrier(xbar);
    PH(7) {
        pg8::Gemm g{(const bf16_t*)(ws + WS_ACT), (const bf16_t*)(ws + WS_WDN), T_TOK, DM, DFF, DFF, DFF, 256}; pg8::StaticOrder S; S.init(T_TOK, DM, G, bx);
#if defined(DUP_PH) && DUP_PH == 7
        { EpiDownT<true> E0{p.out}; pg8::gemm_phase<EpiDownT<true>>(lds, g, S, E0); xcd_barrier(xbar); }
#endif
        EpiDownT<false> E{p.out};
        pg8::gemm_phase<EpiDownT<false>>(lds, g, S, E);
    }
    xcd_barrier(xbar);
#if defined(DUP_PH) && DUP_PH == 8
    phase_final<true>(p);
    xcd_barrier(xbar);
#endif
    PH(8) phase_final<false>(p);
}

extern "C" void kernel_launch(void* const* d_in, const int* in_sizes, int n_in, void* d_out, int out_size, void* d_ws, size_t ws_size, hipStream_t stream) {
    static int grid = 0;
    if (grid == 0) {
        if (n_in != 20 || out_size != (int)OUT_END || ws_size < WS_END) { fprintf(stderr, "kernel_launch: unexpected shapes (n_in %d, out %d, ws %zu)\n", n_in, out_size, ws_size); grid = -1; return; }
        int dev = 0, cus = 0, per_cu = 0;
        hipGetDevice(&dev);
        hipDeviceGetAttribute(&cus, hipDeviceAttributeMultiprocessorCount, dev);
        if (hipFuncSetAttribute((const void*)fwd_megakernel, hipFuncAttributeMaxDynamicSharedMemorySize, LDS_BYTES) != hipSuccess) { fprintf(stderr, "kernel_launch: hipFuncSetAttribute failed\n"); grid = -1; return; }
        hipOccupancyMaxActiveBlocksPerMultiprocessor(&per_cu, (const void*)fwd_megakernel, 512, LDS_BYTES);
        if (per_cu < 1) { fprintf(stderr, "kernel_launch: occupancy query gave %d\n", per_cu); per_cu = 1; }
        grid = cus * 1;
        (void)hipGetLastError();
    }
    if (grid < 0) return;
    Params p{};
    const float** f = (const float**)&p;
    for (int i = 0; i < 20; ++i) f[i] = (const float*)d_in[i];
    p.out = (float*)d_out; p.ws = (unsigned char*)d_ws;
    if (hipMemsetAsync((unsigned char*)d_ws + WS_BAR, 0, 16384, stream) != hipSuccess) { fprintf(stderr, "kernel_launch: memset failed\n"); return; }
    void* args[] = {&p};
    hipError_t e = hipLaunchCooperativeKernel((const void*)fwd_megakernel, dim3(grid), dim3(512), args, LDS_BYTES, stream);
    if (e != hipSuccess) fprintf(stderr, "cooperative launch failed: %s (grid %d)\n", hipGetErrorString(e), grid);
}
```

```cpp
#include <hip/hip_runtime.h>
#include <hip/hip_cooperative_groups.h>
#include <cstdio>
namespace cg = cooperative_groups;

#define LAS __attribute__((address_space(3)))
#define DI __device__ __forceinline__
typedef unsigned short bf16_t;
typedef short bf16x8 __attribute__((ext_vector_type(8)));
typedef short s16x4 __attribute__((ext_vector_type(4)));
typedef float f32x4 __attribute__((ext_vector_type(4)));
typedef float f32x2 __attribute__((ext_vector_type(2)));
typedef float f32x16 __attribute__((ext_vector_type(16)));
typedef unsigned u32x4 __attribute__((ext_vector_type(4)));
typedef unsigned u32x2 __attribute__((ext_vector_type(2)));
typedef __bf16 bf16x2_t __attribute__((ext_vector_type(2)));

constexpr int T_TOK = 16896, TP = 16384, DM = 1024, DIN = 5648, NPROJ = 5632, DFF = 2816, NUP = 5632;
constexpr float EPS = 1e-6f;
constexpr size_t OUT_Y = 0, OUT_RSP = 17301504, OUT_RSS = OUT_RSP + 524288, OUT_GSP = OUT_RSS + 8388608, OUT_GSS = OUT_GSP + 262144,
                 OUT_CP = OUT_GSS + 4194304, OUT_CS = OUT_CP + 45056, OUT_END = OUT_CS + 720896;
constexpr size_t WS_WIN = 0, WS_WMIX = WS_WIN + (size_t)NPROJ * DM * 2, WS_WO = WS_WMIX + (size_t)DM * DM * 2, WS_WUP = WS_WO + (size_t)DM * DM * 2,
                 WS_WDN = WS_WUP + (size_t)NUP * DM * 2, WS_PROJ = WS_WDN + (size_t)DM * DFF * 2;
constexpr size_t SEG512 = (size_t)T_TOK * 512 * 2, SEG256 = (size_t)T_TOK * 256 * 2, SEG1024 = (size_t)T_TOK * 1024 * 2;
constexpr size_t PQ_R = WS_PROJ, PK_R = PQ_R + SEG512, PV_R = PK_R + SEG512, PG_R = PV_R + SEG512, PQ_G = PG_R + SEG512, PK_G = PQ_G + SEG256,
                 PV_G = PK_G + SEG256, PG_G = PV_G + SEG512, PM_R = PG_G + SEG512, PM_G = PM_R + SEG1024, WS_PROJ_END = PM_G + SEG1024;
constexpr size_t WS_MIX = PQ_R;
constexpr size_t WS_PART = WS_PROJ + (size_t)T_TOK * DFF * 2;
static_assert(WS_PART + (size_t)88 * 65536 * 4 <= WS_PROJ_END, "partials");
constexpr size_t WS_ACT = WS_PROJ;
constexpr size_t WS_SH = WS_PROJ_END;
constexpr size_t WS_RSTD1 = WS_SH + SEG1024, WS_SSQ2 = WS_RSTD1 + (size_t)T_TOK * 4, WS_EBL = WS_SSQ2 + (size_t)T_TOK * 4,
                 WS_ROPEC = WS_EBL + (size_t)384 * 256 * 4, WS_ROPES = WS_ROPEC + (size_t)2052 * 64 * 4, WS_BAR = WS_ROPES + (size_t)2052 * 64 * 4, WS_END = WS_BAR + 16384;
static_assert(WS_PROJ_END - WS_PROJ == (size_t)T_TOK * NPROJ * 2, "proj layout");
static_assert(WS_END <= (size_t)256 * 1024 * 1024, "workspace");
constexpr int LDS_BYTES = 131072 + 4096 + 16;

struct Params {
    const float *x_prompt, *x_sample, *state_ret, *state_gla, *cache_conv, *ln1, *w_in, *w_gate_up, *b_gate_up, *g_ret, *g_gla, *w_ret_out, *w_gla_out,
        *w_o, *ln2, *w_up, *conv_w, *conv_b, *w_down, *ln_f;
    float* out; unsigned char* ws;
};

DI unsigned pk2(float lo, float hi) { f32x2 v = {lo, hi}; bf16x2_t b = __builtin_convertvector(v, bf16x2_t); return __builtin_bit_cast(unsigned, b); }
DI float bflo(unsigned w) { return __uint_as_float(w << 16); }
DI float bfhi(unsigned w) { return __uint_as_float(w & 0xffff0000u); }
DI float wave_sum(float v) {
#pragma unroll
    for (int o = 1; o < 64; o <<= 1) v += __shfl_xor(v, o);
    return v;
}
DI float sigmoidf_(float x) { return 1.f / (1.f + __expf(-x)); }
DI const float* x_row(const Params& p, int tok) { return tok < TP ? p.x_prompt + (size_t)tok * DM : p.x_sample + (size_t)(tok - TP) * DM; }
#define LDS_WAIT() asm volatile("s_waitcnt lgkmcnt(0)" ::: "memory")

#define XB_TMO      128
#define XB_XCNT(j)  (256  + 64 * (j))
#define XB_XSUB(j)  (1280 + 64 * (j))
#define XB_XGEN(j)  (2304 + 64 * (j))
#define XB_TOP      3328
#define XB_TOPGEN   3392
#define XCD_BAR_WORDS 3456
#define XB_SPIN_CAP (1u << 22)
DI unsigned xb_ld(unsigned* p) { return __hip_atomic_load(p, __ATOMIC_RELAXED, __HIP_MEMORY_SCOPE_AGENT); }
DI unsigned xb_add(unsigned* p, unsigned v) { return __hip_atomic_fetch_add(p, v, __ATOMIC_RELAXED, __HIP_MEMORY_SCOPE_AGENT); }
DI unsigned xb_xcc_id() { return (unsigned)__builtin_amdgcn_s_getreg((3 << 11) | 20) & 0xFu; }
#define XB_SPIN(cond, bar) do { unsigned _sp = 0; while (cond) { __builtin_amdgcn_s_sleep(1); \
    if ((++_sp & 255u) == 0u) { if (xb_ld(&(bar)[XB_TMO])) break; if (_sp > XB_SPIN_CAP) { atomicAdd(&(bar)[XB_TMO], 1u); break; } } } } while (0)
struct XcdBarrier { unsigned* bar; unsigned x; volatile LAS unsigned* st; };
DI XcdBarrier xcd_barrier_post(unsigned* bar, volatile LAS unsigned* st) {
    XcdBarrier b; b.bar = bar; b.x = xb_xcc_id(); b.st = st;
    if (threadIdx.x == 0) (void)xb_add(&bar[XB_XCNT(b.x)], 1u);
    return b;
}
DI void xcd_barrier_complete(unsigned* bar, unsigned x, unsigned& nloc, unsigned& nx) {
    const unsigned G = gridDim.x * gridDim.y * gridDim.z;
    unsigned sum, cnt, mine, sp = 0u;
    for (;;) {
        sum = 0u; cnt = 0u; mine = 0u;
#pragma unroll
        for (unsigned j = 0; j < 16; ++j) { const unsigned c = xb_ld(&bar[XB_XCNT(j)]); sum += c; cnt += (c > 0u) ? 1u : 0u; mine = (j == x) ? c : mine; }
        if (sum == G) break;
        __builtin_amdgcn_s_sleep(1);
        if ((++sp & 255u) == 0u) { if (xb_ld(&bar[XB_TMO])) break; if (sp > XB_SPIN_CAP) { atomicAdd(&bar[XB_TMO], 1u); break; } }
    }
    nloc = mine > 0u ? mine : 1u; nx = cnt > 0u ? cnt : 1u;
}
DI void xcd_barrier(const XcdBarrier& b) {
    asm volatile("s_waitcnt vmcnt(0)" ::: "memory");
    __syncthreads();
    if (threadIdx.x == 0) {
        unsigned* bar = b.bar;
        __builtin_amdgcn_s_waitcnt(0);
        unsigned nloc = b.st[0], nx = b.st[1];
        if (nloc == 0u) { xcd_barrier_complete(bar, b.x, nloc, nx); b.st[0] = nloc; b.st[1] = nx; }
        const unsigned old = xb_add(&bar[XB_XSUB(b.x)], 1u);
        const unsigned gen = old / nloc;
        if (old + 1u == (gen + 1u) * nloc) {
            __builtin_amdgcn_fence(__ATOMIC_RELEASE, "agent");
            asm volatile("s_waitcnt vmcnt(0)" ::: "memory");
            const unsigned og = xb_add(&bar[XB_TOP], 1u);
            const unsigned tg = og / nx;
            if (og + 1u == (tg + 1u) * nx) xb_add(&bar[XB_TOPGEN], 1u);
            else XB_SPIN(xb_ld(&bar[XB_TOPGEN]) == tg, bar);
            __builtin_amdgcn_fence(__ATOMIC_ACQUIRE, "agent");
            xb_add(&bar[XB_XGEN(b.x)], 1u);
            asm volatile("s_waitcnt vmcnt(0)" ::: "memory");
        } else {
            XB_SPIN(xb_ld(&bar[XB_XGEN(b.x)]) == gen, bar);
            __builtin_amdgcn_fence(__ATOMIC_ACQUIRE, "agent");
            asm volatile("s_waitcnt vmcnt(0)" ::: "memory");
        }
    }
    __syncthreads();
}

namespace pg8 {
constexpr int BM = 256, BK = 64, HALF = 128, HTB = HALF * BK * 2, STAGE_BYTES = 8 * HTB, NXCD = 8, WGM = 8;
DI int lds_byte(int r, int c) { const int st = (r >> 4) * 2 + (c >> 5), rr = r & 15, cc = c & 31, ob = rr * 64 + cc * 2; return st * 1024 + (ob ^ (((ob >> 9) & 1) << 5)); }
DI void stage_rc(int b, int& R, int& C) { const int st = b / 1024, sb = b % 1024, swz = sb ^ (((sb >> 9) & 1) << 5); R = (st >> 1) * 16 + swz / 64; C = (st & 1) * 32 + (swz % 64) / 2; }
DI int perm32(int rho) { const int n = rho >> 4, i = rho & 15; return 8 * (i >> 2) + 4 * n + (i & 3); }
struct Unit { int pm, pn, kt0, id; };
struct Gemm { const bf16_t* A; const bf16_t* Bt; int M, N, K, lda, ldb, mstep; };
struct StaticOrder {
    int nM, nN, nwg, G, c;
    DI void init(int M, int N, int G_, int c_) { nM = M / BM; nN = N / BM; nwg = nM * nN; G = G_; c = c_; }
    DI void init_tiles(int nM_, int nN_, int G_, int c_) { nM = nM_; nN = nN_; nwg = nM * nN; G = G_; c = c_; }
    DI bool next(int i, Unit& u) const {
        u.kt0 = 0; u.id = 0; u.pm = 0; u.pn = 0;
        const long L = (long)i * G + c; if (L >= nwg) return false;
        int wgid = (int)L; { const int q = nwg / NXCD, r = nwg % NXCD, xcd = wgid % NXCD, off = wgid / NXCD; wgid = (xcd < r ? xcd * (q + 1) : r * (q + 1) + (xcd - r) * q) + off; }
        const int nig = WGM * nN, gid = wgid / nig, fm = gid * WGM, gsz = (nM - fm) < WGM ? (nM - fm) : WGM;
        u.pm = fm + ((wgid % nig) % gsz); u.pn = (wgid % nig) / gsz; return true;
    }
};
struct PieceOrder {
    int G, c;
    DI bool next(int i, Unit& u) const {
        const int pid = c + i * G; const int su = pid / 11;
        u.pm = 64 + (su >> 2); u.pn = su & 3; u.kt0 = (pid - su * 11) * 4; u.id = pid;
        return pid < 88;
    }
};
template <class Epi, class Sched, int NT>
DI void gemm_phase(LAS unsigned char* lds, const Gemm g, const Sched& S, const Epi& E) {
    int tid = threadIdx.x; asm volatile("" : "+v"(tid));
    const int wid = __builtin_amdgcn_readfirstlane(tid >> 6), lane = tid & 63, wr = wid >> 2, wc = wid & 3, fr = lane & 15, fq = lane >> 4;
    constexpr int nt = NT;
    unsigned voffA[2], voffB[2];
#pragma unroll
    for (int i = 0; i < 2; ++i) { int R, C; stage_rc(tid * 16 + i * 8192, R, C); const int Rb = Epi::PERM ? ((R & ~31) + perm32(R & 31)) : R;
        voffA[i] = (unsigned)(R * g.lda + C) * 2u; voffB[i] = (unsigned)(Rb * g.ldb + C) * 2u; }
    const size_t kstep = (size_t)(BK * 2);
    const size_t hstepA = (size_t)HALF * g.lda * 2, hstepB = (size_t)HALF * g.ldb * 2;
    const size_t tstepA = (size_t)g.mstep * g.lda * 2, tstepB = 2 * hstepB;
    const unsigned ldsw = (unsigned)wid * 1024u;
    const int aoff = lds_byte(wr * 64 + fr, fq * 8), boff = lds_byte(wc * 32 + fr, fq * 8);
#define PG8_SA(b, h) (((b) * 2 + (h)) * HTB)
#define PG8_SB(b, h) ((4 + (b) * 2 + (h)) * HTB)
#define PG8_STAGE(bufoff, gbase, voff) do { _Pragma("unroll") for (int _i = 0; _i < 2; ++_i) \
        __builtin_amdgcn_global_load_lds((const unsigned*)((const char*)(gbase) + (voff)[_i]), (LAS unsigned*)(lds + (bufoff) + ldsw + _i * 8192), 16, 0, 0); } while (0)
#define PG8_LDA(dst, b, h) do { _Pragma("unroll") for (int m = 0; m < 4; ++m) _Pragma("unroll") for (int k = 0; k < 2; ++k) dst[m][k] = *(const LAS bf16x8*)(lds + PG8_SA(b, h) + aoff + m * 2048 + k * 1024); } while (0)
#define PG8_LDB(dst, b, h) do { _Pragma("unroll") for (int n = 0; n < 2; ++n) _Pragma("unroll") for (int k = 0; k < 2; ++k) dst[n][k] = *(const LAS bf16x8*)(lds + PG8_SB(b, h) + boff + n * 2048 + k * 1024); } while (0)
#define PG8_MMA(ai, bj, At, Bt) do { __builtin_amdgcn_s_setprio(1); _Pragma("unroll") for (int m = 0; m < 4; ++m) _Pragma("unroll") for (int n = 0; n < 2; ++n) _Pragma("unroll") for (int k = 0; k < 2; ++k) \
        acc[ai][bj][m][n] = __builtin_amdgcn_mfma_f32_16x16x32_bf16(Bt[n][k], At[m][k], acc[ai][bj][m][n], 0, 0, 0); __builtin_amdgcn_s_setprio(0); } while (0)
#define PG8_WAIT_V(n) asm volatile("s_waitcnt vmcnt(" #n ")" ::: "memory")
#define PG8_WAIT_L(n) asm volatile("s_waitcnt lgkmcnt(" #n ")" ::: "memory")
#define PG8_BAR __builtin_amdgcn_s_barrier()
#define PG8_SCHED __builtin_amdgcn_sched_barrier(0)
    Unit cur, nxt; int ui = 0;
    if (!S.next(0, cur)) return;
    f32x4 acc[2][2][4][2];
#pragma unroll
    for (int a = 0; a < 2; ++a)
#pragma unroll
        for (int b = 0; b < 2; ++b)
#pragma unroll
            for (int m = 0; m < 4; ++m)
#pragma unroll
                for (int n = 0; n < 2; ++n) acc[a][b][m][n] = (f32x4){0.f, 0.f, 0.f, 0.f};
    bf16x8 At[4][2], B0[2][2], B1[2][2];
    const char* cA = (const char*)g.A + (size_t)cur.pm * tstepA + (size_t)cur.kt0 * kstep; const char* cB = (const char*)g.Bt + (size_t)cur.pn * tstepB + (size_t)cur.kt0 * kstep;
    PG8_STAGE(PG8_SB(0, 0), cB, voffB); PG8_STAGE(PG8_SA(0, 0), cA, voffA); PG8_STAGE(PG8_SB(0, 1), cB + hstepB, voffB); PG8_STAGE(PG8_SA(0, 1), cA + hstepA, voffA);
    if (wr == 1) PG8_BAR;
    PG8_WAIT_V(4); PG8_BAR;
    PG8_STAGE(PG8_SB(1, 0), cB + kstep, voffB); PG8_STAGE(PG8_SA(1, 0), cA + kstep, voffA); PG8_STAGE(PG8_SB(1, 1), cB + hstepB + kstep, voffB);
    PG8_WAIT_V(6); PG8_BAR;
    for (;;) {
        const bool has_next = S.next(ui + 1, nxt);
        const char* nA = has_next ? (const char*)g.A + (size_t)nxt.pm * tstepA + (size_t)nxt.kt0 * kstep : cA; const char* nB = has_next ? (const char*)g.Bt + (size_t)nxt.pn * tstepB + (size_t)nxt.kt0 * kstep : cB;
        for (int t = 0; t < nt; t += 2) {
            const bool last = (t == nt - 2);
            const char* a1 = cA + (size_t)(t + 1) * kstep;
            const char* a2 = last ? nA : cA + (size_t)(t + 2) * kstep; const char* b2 = last ? nB : cB + (size_t)(t + 2) * kstep;
            const char* a3 = a2 + kstep; const char* b3 = b2 + kstep;
            if constexpr (Epi::MIDK) { if (t == (nt >> 1)) E.mid(acc, cur, wr, wc, fr, fq); }
            PG8_LDB(B0, 0, 0); PG8_SCHED; PG8_LDA(At, 0, 0); PG8_STAGE(PG8_SA(1, 1), a1 + hstepA, voffA);
            PG8_WAIT_L(8); PG8_BAR; PG8_WAIT_L(0); PG8_MMA(0, 0, At, B0); PG8_BAR; PG8_SCHED;
            PG8_LDB(B1, 0, 1); PG8_STAGE(PG8_SB(0, 0), b2, voffB);
            PG8_BAR; PG8_WAIT_L(0); PG8_MMA(0, 1, At, B1); PG8_BAR;
            PG8_LDA(At, 0, 1); PG8_STAGE(PG8_SA(0, 0), a2, voffA);
            PG8_BAR; PG8_WAIT_L(0); PG8_MMA(1, 0, At, B0); PG8_BAR; PG8_SCHED;
            PG8_STAGE(PG8_SB(0, 1), b2 + hstepB, voffB);
            PG8_WAIT_V(6); PG8_BAR; PG8_MMA(1, 1, At, B1); PG8_BAR;
            PG8_LDB(B0, 1, 0); PG8_SCHED; PG8_LDA(At, 1, 0); PG8_STAGE(PG8_SA(0, 1), a2 + hstepA, voffA);
            PG8_WAIT_L(8); PG8_BAR; PG8_WAIT_L(0); PG8_MMA(0, 0, At, B0); PG8_BAR; PG8_SCHED;
            PG8_LDB(B1, 1, 1); PG8_STAGE(PG8_SB(1, 0), b3, voffB);
            PG8_BAR; PG8_WAIT_L(0); PG8_MMA(0, 1, At, B1); PG8_BAR;
            PG8_LDA(At, 1, 1); PG8_STAGE(PG8_SA(1, 0), a3, voffA);
            PG8_BAR; PG8_WAIT_L(0); PG8_MMA(1, 0, At, B0); PG8_BAR; PG8_SCHED;
            PG8_STAGE(PG8_SB(1, 1), b3 + hstepB, voffB);
            PG8_WAIT_V(6); PG8_BAR; PG8_MMA(1, 1, At, B1); PG8_BAR;
        }
        E(acc, cur, wr, wc, fr, fq);
        if (!has_next) break;
#pragma unroll
        for (int a = 0; a < 2; ++a)
#pragma unroll
            for (int b = 0; b < 2; ++b)
#pragma unroll
                for (int m = 0; m < 4; ++m)
#pragma unroll
                    for (int n = 0; n < 2; ++n) acc[a][b][m][n] = (f32x4){0.f, 0.f, 0.f, 0.f};
        cur = nxt; cA = nA; cB = nB; ++ui;
    }
    PG8_WAIT_V(0);
    if (wr == 0) PG8_BAR;
    PG8_BAR;
#undef PG8_SA
#undef PG8_SB
#undef PG8_STAGE
#undef PG8_LDA
#undef PG8_LDB
#undef PG8_MMA
#undef PG8_WAIT_V
#undef PG8_WAIT_L
#undef PG8_BAR
#undef PG8_SCHED
}
}
using pg8::Unit;
typedef f32x4 AccT[2][2][4][2];

struct EpiProj {
    static constexpr bool PERM = true, MIDK = false;
    unsigned char* ws; const float* rstd1; const float* bcum; const float* ropec; const float* ropes;
    DI void mid(AccT&, const Unit&, int, int, int, int) const {}
    DI void operator()(const AccT& acc, const Unit& u, int wr, int wc, int fr, int fq) const {
        const int pn = u.pn; int seg, pn0;
        if (pn < 8) { seg = pn >> 1; pn0 = seg * 2; } else if (pn == 8) { seg = 4; pn0 = 8; } else if (pn == 9) { seg = 5; pn0 = 9; }
        else if (pn < 12) { seg = 6; pn0 = 10; } else if (pn < 14) { seg = 7; pn0 = 12; } else if (pn < 18) { seg = 8; pn0 = 14; } else { seg = 9; pn0 = 18; }
        size_t segoff; int ld;
        switch (seg) { case 0: segoff = PQ_R; ld = 512; break; case 1: segoff = PK_R; ld = 512; break; case 2: segoff = PV_R; ld = 512; break; case 3: segoff = PG_R; ld = 512; break;
            case 4: segoff = PQ_G; ld = 256; break; case 5: segoff = PK_G; ld = 256; break; case 6: segoff = PV_G; ld = 512; break; case 7: segoff = PG_G; ld = 512; break;
            case 8: segoff = PM_R; ld = 1024; break; default: segoff = PM_G; ld = 1024; break; }
        bf16_t* base = (bf16_t*)(ws + segoff);
        const int lc0 = (pn - pn0) * 256 + wc * 32 + 8 * fq;
        const int row0 = u.pm * 256 + wr * 64 + fr;
        if (seg <= 1) {
            const int i0 = 16 * wc + 4 * fq;
#pragma unroll
            for (int ai = 0; ai < 2; ++ai)
#pragma unroll
                for (int m = 0; m < 4; ++m) {
                    const int row = row0 + ai * 128 + m * 16; const float rs = rstd1[row];
                    int posidx, ic; if (row < TP) { posidx = row & 2047; ic = row & 63; } else { const int s = row - TP; posidx = 2048 + (s & 3); ic = s & 3; }
                    const f32x4 c4 = *(const f32x4*)(ropec + posidx * 64 + i0), s4 = *(const f32x4*)(ropes + posidx * 64 + i0);
#pragma unroll
                    for (int bj = 0; bj < 2; ++bj) {
                        const int head = (pn - pn0) * 2 + bj;
                        const float lg2 = log2f(1.f - exp2f(-5.f - (float)head));
                        const float dec = (seg == 0) ? exp2f((float)(ic + 1) * lg2) : exp2f(-(float)(ic + 1) * lg2) * 0.08838834764831845f;
                        const f32x4 t1 = acc[ai][bj][m][0] * rs, t2 = acc[ai][bj][m][1] * rs;
                        const f32x4 o1 = (t1 * c4 - t2 * s4) * dec, o2 = (t1 * s4 + t2 * c4) * dec;
                        bf16_t* rp = base + (size_t)row * 512 + head * 128 + i0;
                        u32x2 w1, w2; w1.x = pk2(o1[0], o1[1]); w1.y = pk2(o1[2], o1[3]); w2.x = pk2(o2[0], o2[1]); w2.y = pk2(o2[2], o2[3]);
                        *(u32x2*)rp = w1; *(u32x2*)(rp + 64) = w2;
                    }
                }
            return;
        }
#pragma unroll
        for (int ai = 0; ai < 2; ++ai)
#pragma unroll
            for (int m = 0; m < 4; ++m) {
                const int row = row0 + ai * 128 + m * 16; const float rs = rstd1[row];
#pragma unroll
                for (int bj = 0; bj < 2; ++bj) {
                    const int lc = lc0 + bj * 128;
                    f32x4 v0 = acc[ai][bj][m][0] * rs, v1 = acc[ai][bj][m][1] * rs;
                    if (seg == 4 || seg == 5) {
                        const f32x4 b0 = *(const f32x4*)(bcum + (size_t)row * 256 + lc), b1 = *(const f32x4*)(bcum + (size_t)row * 256 + lc + 4);
                        if (seg == 4) {
#pragma unroll
                            for (int e = 0; e < 4; ++e) { v0[e] *= 0.125f * __expf(b0[e]); v1[e] *= 0.125f * __expf(b1[e]); }
                        } else {
#pragma unroll
                            for (int e = 0; e < 4; ++e) { v0[e] *= __expf(-b0[e]); v1[e] *= __expf(-b1[e]); }
                        }
                    } else if (seg == 3 || seg == 7) {
#pragma unroll
                        for (int e = 0; e < 4; ++e) { v0[e] = v0[e] * sigmoidf_(v0[e]); v1[e] = v1[e] * sigmoidf_(v1[e]); }
                    } else if (seg >= 8) {
#pragma unroll
                        for (int e = 0; e < 4; ++e) { v0[e] = sigmoidf_(v0[e]); v1[e] = sigmoidf_(v1[e]); }
                    }
                    u32x4 w; w.x = pk2(v0[0], v0[1]); w.y = pk2(v0[2], v0[3]); w.z = pk2(v1[0], v1[1]); w.w = pk2(v1[2], v1[3]);
                    *(u32x4*)(base + (size_t)row * ld + lc) = w;
                }
            }
    }
};
struct EpiMix {
    static constexpr bool PERM = true, MIDK = true;
    const bf16_t* mr; const bf16_t* mg; bf16_t* mix;
    DI void mid(AccT& acc, const Unit& u, int wr, int wc, int fr, int fq) const {
        int row0 = u.pm * 256 + wr * 64 + fr, c0 = u.pn * 256 + wc * 32 + 8 * fq;
        asm volatile("" : "+v"(row0), "+v"(c0));
#pragma unroll
        for (int ai = 0; ai < 2; ++ai)
#pragma unroll
            for (int m = 0; m < 4; ++m) {
                const int row = row0 + ai * 128 + m * 16;
#pragma unroll
                for (int bj = 0; bj < 2; ++bj) {
                    const u32x4 a = *(const u32x4*)(mr + (size_t)row * 1024 + c0 + bj * 128), b = *(const u32x4*)(mg + (size_t)row * 1024 + c0 + bj * 128);
                    f32x4 r0, r1;
                    r0[0] = bflo(a.x) / fmaxf(bflo(b.x), 1e-30f); r0[1] = bfhi(a.x) / fmaxf(bfhi(b.x), 1e-30f); r0[2] = bflo(a.y) / fmaxf(bflo(b.y), 1e-30f); r0[3] = bfhi(a.y) / fmaxf(bfhi(b.y), 1e-30f);
                    r1[0] = bflo(a.z) / fmaxf(bflo(b.z), 1e-30f); r1[1] = bfhi(a.z) / fmaxf(bfhi(b.z), 1e-30f); r1[2] = bflo(a.w) / fmaxf(bflo(b.w), 1e-30f); r1[3] = bfhi(a.w) / fmaxf(bfhi(b.w), 1e-30f);
                    acc[ai][bj][m][0] *= r0; acc[ai][bj][m][1] *= r1;
                }
                __builtin_amdgcn_sched_barrier(0);
            }
    }
    DI void operator()(const AccT& acc, const Unit& u, int wr, int wc, int fr, int fq) const {
        const int row0 = u.pm * 256 + wr * 64 + fr, c0 = u.pn * 256 + wc * 32 + 8 * fq;
#pragma unroll
        for (int ai = 0; ai < 2; ++ai)
#pragma unroll
            for (int m = 0; m < 4; ++m) {
                const int row = row0 + ai * 128 + m * 16;
#pragma unroll
                for (int bj = 0; bj < 2; ++bj) {
                    const u32x4 b = *(const u32x4*)(mg + (size_t)row * 1024 + c0 + bj * 128);
                    const f32x4 v0 = acc[ai][bj][m][0], v1 = acc[ai][bj][m][1];
                    u32x4 w; w.x = pk2(v0[0] * bflo(b.x), v0[1] * bfhi(b.x)); w.y = pk2(v0[2] * bflo(b.y), v0[3] * bfhi(b.y));
                    w.z = pk2(v1[0] * bflo(b.z), v1[1] * bfhi(b.z)); w.w = pk2(v1[2] * bflo(b.w), v1[3] * bfhi(b.w));
                    *(u32x4*)(mix + (size_t)row * 1024 + c0 + bj * 128) = w;
                }
            }
    }
};
struct EpiH {
    static constexpr bool PERM = true, MIDK = false;
    const float* xp; const float* xs; float* h; bf16_t* hb; float* ssq;
    DI void mid(AccT&, const Unit&, int, int, int, int) const {}
    DI void operator()(const AccT& acc, const Unit& u, int wr, int wc, int fr, int fq) const {
        const int row0 = u.pm * 256 + wr * 64 + fr, c0 = u.pn * 256 + wc * 32 + 8 * fq;
#pragma unroll
        for (int ai = 0; ai < 2; ++ai)
#pragma unroll
            for (int m = 0; m < 4; ++m) {
                const int row = row0 + ai * 128 + m * 16;
                const float* xr = row < TP ? xp + (size_t)row * DM : xs + (size_t)(row - TP) * DM;
                float ss = 0.f;
#pragma unroll
                for (int bj = 0; bj < 2; ++bj) {
                    const int c = c0 + bj * 128;
                    const f32x4 v0 = acc[ai][bj][m][0] + *(const f32x4*)(xr + c), v1 = acc[ai][bj][m][1] + *(const f32x4*)(xr + c + 4);
                    *(f32x4*)(h + (size_t)row * DM + c) = v0; *(f32x4*)(h + (size_t)row * DM + c + 4) = v1;
                    u32x4 w; w.x = pk2(v0[0], v0[1]); w.y = pk2(v0[2], v0[3]); w.z = pk2(v1[0], v1[1]); w.w = pk2(v1[2], v1[3]);
                    *(u32x4*)(hb + (size_t)row * DM + c) = w;
                    ss += v0[0] * v0[0] + v0[1] * v0[1] + v0[2] * v0[2] + v0[3] * v0[3] + v1[0] * v1[0] + v1[1] * v1[1] + v1[2] * v1[2] + v1[3] * v1[3];
                }
                ss += __shfl_xor(ss, 16); ss += __shfl_xor(ss, 32);
                if (fq == 0) unsafeAtomicAdd(ssq + row, ss);
            }
    }
};
DI f32x2 gelu_pk(f32x2 v) {
    const f32x2 av = __builtin_elementwise_abs(v), d = av * 0.2316418882f + 1.0f;
    f32x2 t; t.x = __builtin_amdgcn_rcpf(d.x); t.y = __builtin_amdgcn_rcpf(d.y);
    f32x2 q = t * 0.5307027145f + (-0.7265760135f); q = q * t + 0.7107068705f; q = q * t + (-0.142248368f); q = q * t + 0.127414796f; q = q * t;
    const f32x2 s = (v * v) * (-0.72134752044f);
    f32x2 e; e.x = __builtin_amdgcn_exp2f(s.x); e.y = __builtin_amdgcn_exp2f(s.y);
    const f32x2 m = v * (q * e), r = v - m;
    f32x2 o; o.x = v.x < 0.f ? m.x : r.x; o.y = v.y < 0.f ? m.y : r.y; return o;
}
#define DPPF(old_, src_, ctrl_) __int_as_float(__builtin_amdgcn_update_dpp(__float_as_int(old_), __float_as_int(src_), (ctrl_), 0xf, 0xf, false))
struct EpiUpConv {
    static constexpr bool PERM = true, MIDK = false;
    const float* ssq; bf16_t* act; const float* cw; const float* cb; const float* cache; float* out; LAS float* xch;
    DI void mid(AccT&, const Unit&, int, int, int, int) const {}
    DI void operator()(const AccT& acc, const Unit& u, int wr, int wc, int fr, int fq) const {
        const int tokbase = u.pm * 254 - 2, cl = wc * 32 + 8 * fq, f0 = u.pn * 128 + cl;
        float sq[2][4];
#pragma unroll
        for (int ai = 0; ai < 2; ++ai)
#pragma unroll
            for (int m = 0; m < 4; ++m) { const int tok = tokbase + ai * 128 + wr * 64 + m * 16 + fr; sq[ai][m] = (tok >= 0 && tok < T_TOK) ? ssq[tok] : -1.f; }
        f32x4 cb4[2], w04[2], w14[2], w24[2];
#pragma unroll
        for (int n = 0; n < 2; ++n) { cb4[n] = *(const f32x4*)(cb + f0 + 4 * n); w04[n] = *(const f32x4*)(cw + f0 + 4 * n); w14[n] = *(const f32x4*)(cw + DFF + f0 + 4 * n); w24[n] = *(const f32x4*)(cw + 2 * DFF + f0 + 4 * n); }
        float rs[2][4];
#pragma unroll
        for (int ai = 0; ai < 2; ++ai)
#pragma unroll
            for (int m = 0; m < 4; ++m) rs[ai][m] = sq[ai][m] >= 0.f ? rsqrtf(sq[ai][m] * (1.f / DM) + EPS) : 0.f;
        if (fr >= 14) {
#pragma unroll
            for (int ai = 0; ai < 2; ++ai) { LAS float* xp = xch + ((2 * ai + wr) * 2 + (fr - 14)) * 128 + cl;
                *(LAS f32x4*)xp = acc[ai][0][3][0] * rs[ai][3]; *(LAS f32x4*)(xp + 4) = acc[ai][0][3][1] * rs[ai][3]; }
        }
        asm volatile("s_waitcnt lgkmcnt(0)" ::: "memory"); __builtin_amdgcn_s_barrier(); __builtin_amdgcn_s_barrier(); asm volatile("" ::: "memory");
        const bool samp_tile = (tokbase + 255 >= TP);
#pragma unroll
        for (int ai = 0; ai < 2; ++ai) {
            const int g = 2 * ai + wr;
            f32x4 prev[2];
#pragma unroll
            for (int m = 0; m < 4; ++m) {
                const int i = ai * 128 + wr * 64 + m * 16 + fr, tok = tokbase + i;
                int l; const bool samp = tok >= TP;
                if (!samp) l = tok & 2047; else l = (tok - TP) & 3;
                u32x4 w; f32x4 curs[2];
#pragma unroll
                for (int n = 0; n < 2; ++n) {
                    const f32x4 cur = acc[ai][0][m][n] * rs[ai][m], vv = acc[ai][1][m][n] * rs[ai][m];
                    f32x4 x1, x2;
                    if (m == 0) {
                        f32x4 h1 = {0.f, 0.f, 0.f, 0.f}, h2 = {0.f, 0.f, 0.f, 0.f};
                        if (g >= 1) { h1 = *(const LAS f32x4*)(xch + ((g - 1) * 2 + 1) * 128 + cl + 4 * n); h2 = *(const LAS f32x4*)(xch + ((g - 1) * 2 + (fr == 0 ? 0 : 1)) * 128 + cl + 4 * n); }
#pragma unroll
                        for (int e = 0; e < 4; ++e) { x1[e] = DPPF(h1[e], cur[e], 0x111); x2[e] = DPPF(h2[e], cur[e], 0x112); }
                    } else {
#pragma unroll
                        for (int e = 0; e < 4; ++e) { const float o1 = DPPF(0.f, prev[n][e], 0x121), o2 = DPPF(0.f, prev[n][e], 0x122);
                            x1[e] = DPPF(o1, cur[e], 0x111); x2[e] = DPPF(o2, cur[e], 0x112); }
                    }
                    prev[n] = cur; curs[n] = cur;
                    if (l < 2) {
                        if (samp_tile && samp) {
                            const int bidx = (tok - TP) >> 2;
                            if (tok < T_TOK) { const f32x4 c1 = *(const f32x4*)(cache + ((size_t)bidx * 2 + 1) * DFF + f0 + 4 * n), c0 = *(const f32x4*)(cache + ((size_t)bidx * 2 + l) * DFF + f0 + 4 * n);
                                x2 = c0; if (l == 0) x1 = c1; }
                        } else { x2 = (f32x4){0.f, 0.f, 0.f, 0.f}; if (l == 0) x1 = x2; }
                    }
                    const f32x4 uc = cb4[n] + w04[n] * x2 + w14[n] * x1 + w24[n] * cur;
                    const f32x2 ga = gelu_pk((f32x2){uc[0], uc[1]}), gb = gelu_pk((f32x2){uc[2], uc[3]});
                    const unsigned p0 = pk2(ga.x * vv[0], ga.y * vv[1]), p1 = pk2(gb.x * vv[2], gb.y * vv[3]);
                    if (n == 0) { w.x = p0; w.y = p1; } else { w.z = p0; w.w = p1; }
                }
                if (i >= 2 && tok < T_TOK) {
                    *(u32x4*)(act + (size_t)tok * DFF + f0) = w;
                    if (!samp) { if (l >= 2046) { float* o = out + OUT_CP + ((size_t)(tok >> 11) * 2 + (l - 2046)) * DFF + f0; *(f32x4*)o = curs[0]; *(f32x4*)(o + 4) = curs[1]; } }
                    else if (l >= 2) { float* o = out + OUT_CS + ((size_t)((tok - TP) >> 2) * 2 + (l - 2)) * DFF + f0; *(f32x4*)o = curs[0]; *(f32x4*)(o + 4) = curs[1]; }
                }
            }
        }
    }
};
template <bool DRY> struct EpiDownT {
    static constexpr bool PERM = true, MIDK = false;
    float* h;
    DI void mid(AccT&, const Unit&, int, int, int, int) const {}
    DI void operator()(const AccT& acc, const Unit& u, int wr, int wc, int fr, int fq) const {
        const int row0 = u.pm * 256 + wr * 64 + fr, c0 = u.pn * 256 + wc * 32 + 8 * fq;
#pragma unroll
        for (int ai = 0; ai < 2; ++ai)
#pragma unroll
            for (int m = 0; m < 4; ++m) {
                const int row = row0 + ai * 128 + m * 16;
#pragma unroll
                for (int bj = 0; bj < 2; ++bj) {
                    float* hp = h + (size_t)row * DM + c0 + bj * 128;
                    const f32x4 h0 = *(const f32x4*)hp, h1 = *(const f32x4*)(hp + 4);
                    f32x4 v0 = acc[ai][bj][m][0] + h0, v1 = acc[ai][bj][m][1] + h1;
                    if (DRY && h != nullptr) { v0 = h0; v1 = h1; }
                    *(f32x4*)hp = v0; *(f32x4*)(hp + 4) = v1;
                }
            }
    }
};

struct EpiPart {
    static constexpr bool PERM = true, MIDK = false;
    float* part;
    DI void mid(AccT&, const Unit&, int, int, int, int) const {}
    DI void operator()(const AccT& acc, const Unit& u, int wr, int wc, int fr, int fq) const {
        float* base = part + (size_t)u.id * 65536 + (wr * 64 + fr) * 256 + wc * 32 + 8 * fq;
#pragma unroll
        for (int ai = 0; ai < 2; ++ai)
#pragma unroll
            for (int m = 0; m < 4; ++m)
#pragma unroll
                for (int bj = 0; bj < 2; ++bj) { float* q = base + (ai * 128 + m * 16) * 256 + bj * 128; *(f32x4*)q = acc[ai][bj][m][0]; *(f32x4*)(q + 4) = acc[ai][bj][m][1]; }
    }
};

DI void transpose_item(const float* __restrict__ src, int ldsrc, int srccol, int k0, const float* __restrict__ scale, bf16_t* dst, int lddst, int n0dst, int k0dst,
                       LAS float* scr, int lane) {
    float tv[32];
#pragma unroll
    for (int i = 0; i < 32; ++i) { const int kk = 2 * i + (lane >> 5); tv[i] = src[(size_t)(k0 + kk) * ldsrc + srccol]; }
    if (scale) {
#pragma unroll
        for (int i = 0; i < 32; ++i) tv[i] *= scale[k0 + 2 * i + (lane >> 5)];
    }
#pragma unroll
    for (int i = 0; i < 32; ++i) scr[(2 * i + (lane >> 5)) * 33 + (lane & 31)] = tv[i];
    LDS_WAIT();
    const int c = lane & 7;
#pragma unroll
    for (int j = 0; j < 4; ++j) { const int n = (lane >> 3) + 8 * j; const LAS float* s = scr + (8 * c) * 33 + n;
        u32x4 o; o.x = pk2(s[0 * 33], s[1 * 33]); o.y = pk2(s[2 * 33], s[3 * 33]); o.z = pk2(s[4 * 33], s[5 * 33]); o.w = pk2(s[6 * 33], s[7 * 33]);
        *(u32x4*)(dst + (size_t)(n0dst + n) * lddst + k0dst + 8 * c) = o; }
    LDS_WAIT();
}
DI float log_sigmoid(float z) { return fminf(z, 0.f) - log1pf(expf(-fabsf(z))); }

DI void phase0(const Params& p, LAS unsigned char* lds) {
    int tid = threadIdx.x; asm volatile("" : "+v"(tid));
    const int lane = tid & 63, wave = tid >> 6;
    unsigned char* ws = p.ws;
    LAS bf16_t* wga = (LAS bf16_t*)lds;
    LAS float* gas = (LAS float*)(lds + 33024);
    LAS float* scr = (LAS float*)(lds + 41216 + wave * 8448);
    bf16_t* xb = (bf16_t*)((unsigned char*)p.out + 0);
    float* rstd1 = (float*)(ws + WS_RSTD1); float* bcum = (float*)(ws + WS_SH); float* ebl = (float*)(ws + WS_EBL);
    { const int gt = blockIdx.x * 512 + tid, ng = gridDim.x * 512;
      float* ssq2 = (float*)(ws + WS_SSQ2);
      for (int i = gt; i < T_TOK; i += ng) ssq2[i] = 0.f;
      float* rc = (float*)(ws + WS_ROPEC); float* rsn = (float*)(ws + WS_ROPES);
      for (int i = gt; i < 2052 * 64; i += ng) { const int pi = i >> 6, fi = i & 63; const double pos = (double)(pi < 2048 ? pi : 16384 + (pi - 2048));
          const double inv = exp(-(double)fi * (9.210340371976184 / 64.0)); const double ang = pos * inv; const double kk = rint(ang * 0.15915494309189535);
          const float r = (float)(ang - kk * 6.283185307179586); rc[i] = cosf(r); rsn[i] = sinf(r); } }
    if (blockIdx.x < 132) {
        for (int k = tid; k < DM; k += 512) { const float g = p.ln1[k]; const float* s = p.w_in + (size_t)k * DIN + 3584;
#pragma unroll
            for (int r = 0; r < 16; r += 2) { const unsigned w = pk2(s[r] * g, s[r + 1] * g); wga[r * 1032 + k] = (bf16_t)(w & 0xffffu); wga[(r + 1) * 1032 + k] = (bf16_t)(w >> 16); } }
        __syncthreads();
        for (int u = blockIdx.x; u < 132; u += gridDim.x) {
            const int r16 = lane & 15, kq = lane >> 4, t0 = u * 128 + wave * 16, row = t0 + r16;
            const float* xr = x_row(p, row);
            f32x4 acc = {0.f, 0.f, 0.f, 0.f}; float ss = 0.f;
            for (int ks = 0; ks < 32; ks += 8) {
                f32x4 v[8][2];
#pragma unroll
                for (int q = 0; q < 8; ++q) { v[q][0] = *(const f32x4*)(xr + (ks + q) * 32 + kq * 8); v[q][1] = *(const f32x4*)(xr + (ks + q) * 32 + kq * 8 + 4); }
#pragma unroll
                for (int q = 0; q < 8; ++q) {
                    const f32x4 a0 = v[q][0], a1 = v[q][1];
                    ss += a0[0] * a0[0] + a0[1] * a0[1] + a0[2] * a0[2] + a0[3] * a0[3] + a1[0] * a1[0] + a1[1] * a1[1] + a1[2] * a1[2] + a1[3] * a1[3];
                    u32x4 w; w.x = pk2(a0[0], a0[1]); w.y = pk2(a0[2], a0[3]); w.z = pk2(a1[0], a1[1]); w.w = pk2(a1[2], a1[3]);
                    *(u32x4*)(xb + (size_t)row * DM + (ks + q) * 32 + kq * 8) = w;
                    const bf16x8 bfrag = *(const LAS bf16x8*)(wga + r16 * 1032 + (ks + q) * 32 + kq * 8);
                    acc = __builtin_amdgcn_mfma_f32_16x16x32_bf16(__builtin_bit_cast(bf16x8, w), bfrag, acc, 0, 0, 0);
                }
            }
            ss += __shfl_xor(ss, 16); ss += __shfl_xor(ss, 32);
            const float rs = rsqrtf(ss * (1.f / DM) + EPS);
            if (kq == 0) rstd1[row] = rs;
#pragma unroll
            for (int j = 0; j < 4; ++j) { const float rj = __shfl(rs, kq * 4 + j); gas[(wave * 16 + kq * 4 + j) * 16 + r16] = acc[j] * rj; }
            __syncthreads();
            {
                const int c = tid & 255, half = tid >> 8;
                float wg[16];
#pragma unroll
                for (int r = 0; r < 16; ++r) wg[r] = p.w_gate_up[r * 256 + c];
                const float bias = p.b_gate_up[c];
                const int tokb = u * 128 + half * 64; const bool samp = tokb >= TP;
                float cum = 0.f;
                for (int i = 0; i < 64; ++i) {
                    const LAS f32x4* gp = (const LAS f32x4*)(gas + (half * 64 + i) * 16);
                    const f32x4 g0 = gp[0], g1 = gp[1], g2 = gp[2], g3 = gp[3];
                    float z = bias;
                    z += g0[0] * wg[0] + g0[1] * wg[1] + g0[2] * wg[2] + g0[3] * wg[3] + g1[0] * wg[4] + g1[1] * wg[5] + g1[2] * wg[6] + g1[3] * wg[7];
                    z += g2[0] * wg[8] + g2[1] * wg[9] + g2[2] * wg[10] + g2[3] * wg[11] + g3[0] * wg[12] + g3[1] * wg[13] + g3[2] * wg[14] + g3[3] * wg[15];
                    const float ls = log_sigmoid(z) * (1.f / 16.f);
                    const bool reset = samp ? ((i & 3) == 0) : (i == 0);
                    cum = reset ? ls : cum + ls;
                    const int tok = tokb + i;
                    bcum[(size_t)tok * 256 + c] = cum;
                    if (samp) { if ((i & 3) == 3) ebl[(size_t)(256 + ((tok - TP) >> 2)) * 256 + c] = expf(cum); }
                    else if (i == 63) ebl[(size_t)(tok >> 6) * 256 + c] = expf(cum);
                }
            }
            __syncthreads();
        }
    }
    {
        const int gw = blockIdx.x * 8 + wave, ngw = gridDim.x * 8;
        constexpr int I_IN = 16 * 176, I_MX = 8 * 32, I_O = 16 * 32, I_UP = 16 * 176, I_DN = 44 * 32, NIT = I_IN + 2 * I_MX + I_O + I_UP + I_DN;
        for (int it = gw; it < NIT; it += ngw) {
            int r = it; const int nl = lane & 31;
            if (r < I_IN) { const int kb = r / 176, nb = r % 176, n = nb * 32 + nl; int sc;
                if (n < 1024) { const int pp = n & 127; sc = (n & ~127) + (((pp & 7) < 4) ? 4 * (pp >> 3) + (pp & 7) : 64 + 4 * (pp >> 3) + (pp & 7) - 4); }
                else sc = n < 3584 ? n : n + 16;
                transpose_item(p.w_in, DIN, sc, kb * 64, p.ln1, (bf16_t*)(ws + WS_WIN), DM, nb * 32, kb * 64, scr, lane); continue; }
            r -= I_IN;
            if (r < I_MX) { const int kb = r / 32, nb = r % 32; transpose_item(p.w_ret_out, DM, nb * 32 + nl, kb * 64, nullptr, (bf16_t*)(ws + WS_WMIX), DM, nb * 32, kb * 64, scr, lane); continue; }
            r -= I_MX;
            if (r < I_MX) { const int kb = r / 32, nb = r % 32; transpose_item(p.w_gla_out, DM, nb * 32 + nl, kb * 64, nullptr, (bf16_t*)(ws + WS_WMIX), DM, nb * 32, 512 + kb * 64, scr, lane); continue; }
            r -= I_MX;
            if (r < I_O) { const int kb = r / 32, nb = r % 32; transpose_item(p.w_o, DM, nb * 32 + nl, kb * 64, nullptr, (bf16_t*)(ws + WS_WO), DM, nb * 32, kb * 64, scr, lane); continue; }
            r -= I_O;
            if (r < I_UP) { const int kb = r / 176, nb = r % 176, n = nb * 32 + nl; const int sc = ((n >> 7) & 1) * DFF + (n >> 8) * 128 + (n & 127);
                transpose_item(p.w_up, NUP, sc, kb * 64, p.ln2, (bf16_t*)(ws + WS_WUP), DM, nb * 32, kb * 64, scr, lane); continue; }
            r -= I_UP;
            { const int kb = r / 32, nb = r % 32; transpose_item(p.w_down, DM, nb * 32 + nl, kb * 64, nullptr, (bf16_t*)(ws + WS_WDN), DFF, nb * 32, kb * 64, scr, lane); }
        }
    }
}

template <int DK> DI unsigned img_off(int row, int ch) { return (unsigned)(row * (2 * DK) + 16 * (ch ^ ((((row & 3) << 2) | ((row >> 2) & 3)) & (DK / 8 - 1)))); }
template <int DK> DI unsigned tr_addr(int lane, int c, int ks, int t) {
    const int h = lane >> 5, blk = (lane >> 4) & 1, q = (lane & 15) >> 2, pp = lane & 3;
    return img_off<DK>(16 * ks + 8 * h + 4 * t + q, 4 * c + 2 * blk + (pp >> 1)) + 8 * (pp & 1);
}
DI bf16x8 tr_frag(LAS unsigned char* a0, LAS unsigned char* a1) {
    const s16x4 lo = __builtin_amdgcn_ds_read_tr16_b64_v4i16((LAS s16x4*)a0), hi = __builtin_amdgcn_ds_read_tr16_b64_v4i16((LAS s16x4*)a1);
    return __builtin_shufflevector(lo, hi, 0, 1, 2, 3, 4, 5, 6, 7);
}
DI bf16x8 pack8(const f32x16& x, int s) {
    u32x4 w; w.x = pk2(x[8 * s + 0], x[8 * s + 1]); w.y = pk2(x[8 * s + 2], x[8 * s + 3]); w.z = pk2(x[8 * s + 4], x[8 * s + 5]); w.w = pk2(x[8 * s + 6], x[8 * s + 7]);
    return __builtin_bit_cast(bf16x8, w);
}
#define MFMA32(a, b, c) __builtin_amdgcn_mfma_f32_32x32x16_bf16((a), (b), (c), 0, 0, 0)

constexpr int P2_BUF = 49152, P2_QO = 0, P2_KO = 16384, P2_VO = 32768, P2_P = 98304, P2_SSQ = P2_P + 64 * 144, P2_EBL = P2_SSQ + 1024;

template <int DK> DI void chain_prompt(const Params& p, LAS unsigned char* lds, const int branch, const int b, const int head) {
    constexpr int NDB = DK / 32, NCH = DK / 8, QLD = 4 * DK, NQI = (64 * NCH) / 512;
    int tid0 = threadIdx.x; asm volatile("" : "+v"(tid0));
    const int w = __builtin_amdgcn_readfirstlane(tid0 >> 6);
    int tid = tid0, lane = tid0 & 63, h = lane >> 5, r = lane & 31;
    unsigned char* ws = p.ws;
    const bf16_t* Q = (const bf16_t*)(ws + (branch == 0 ? PQ_R : PQ_G)) + head * DK;
    const bf16_t* K = (const bf16_t*)(ws + (branch == 0 ? PK_R : PK_G)) + head * DK;
    const bf16_t* V = (const bf16_t*)(ws + (branch == 0 ? PV_R : PV_G)) + head * 128;
    const bf16_t* G = (const bf16_t*)(ws + (branch == 0 ? PG_R : PG_G)) + head * 128;
    const float* ebl = (const float*)(ws + WS_EBL);
    bf16_t* arg = (bf16_t*)((unsigned char*)p.out + SEG1024) + branch * 512 + head * 128;
    const float* gain = (branch == 0 ? p.g_ret : p.g_gla) + head * 128;
    const int tok0 = b * 2048;
    const float lg2 = log2f(1.f - exp2f(-5.f - (float)head));
    const float ret_ebl = exp2f(64.f * lg2);
    f32x16 S[NDB];
#pragma unroll
    for (int d = 0; d < NDB; ++d)
#pragma unroll
        for (int i = 0; i < 16; ++i) S[d][i] = 0.f;
    f32x4 gn[4];
    if (w < 4) {
#pragma unroll
        for (int g = 0; g < 4; ++g) gn[g] = *(const f32x4*)(gain + 32 * w + 8 * g + 4 * h);
    }
    u32x4 rq[NQI], rk[NQI], rv[2]; float rebl = 0.f;
#define P2_LOAD(c) do { const int tb = tok0 + 64 * (c); \
        _Pragma("unroll") for (int i = 0; i < NQI; ++i) { const int idx = tid + 512 * i, rr = idx / NCH, ch = idx % NCH; \
            rq[i] = *(const u32x4*)(Q + (size_t)(tb + rr) * QLD + ch * 8); rk[i] = *(const u32x4*)(K + (size_t)(tb + rr) * QLD + ch * 8); } \
        _Pragma("unroll") for (int i = 0; i < 2; ++i) { const int idx = tid + 512 * i, rr = idx >> 4, ch = idx & 15; rv[i] = *(const u32x4*)(V + (size_t)(tb + rr) * 512 + ch * 8); } \
        if (DK == 64 && tid < 64) rebl = ebl[(size_t)(b * 32 + (c)) * 256 + head * 64 + tid]; } while (0)
#define P2_STORE(buf) do { LAS unsigned char* bb = lds + (buf) * P2_BUF; \
        _Pragma("unroll") for (int i = 0; i < NQI; ++i) { const int idx = tid + 512 * i, rr = idx / NCH, ch = idx % NCH; \
            *(LAS u32x4*)(bb + P2_QO + img_off<DK>(rr, ch)) = rq[i]; *(LAS u32x4*)(bb + P2_KO + img_off<DK>(rr, ch)) = rk[i]; } \
        _Pragma("unroll") for (int i = 0; i < 2; ++i) { const int idx = tid + 512 * i, rr = idx >> 4, ch = idx & 15; *(LAS u32x4*)(bb + P2_VO + img_off<128>(rr, ch)) = rv[i]; } \
        if (DK == 64 && tid < 64) *(LAS float*)(lds + P2_EBL + (buf) * 256 + tid * 4) = rebl; } while (0)
    P2_LOAD(0); P2_STORE(0);
    __syncthreads();
    for (int c = 0; c < 32; ++c) {
        tid = tid0; asm volatile("" : "+v"(tid)); lane = tid & 63; h = lane >> 5; r = lane & 31;
        LAS unsigned char* bb = lds + (c & 1) * P2_BUF;
        LAS unsigned char* qi = bb + P2_QO; LAS unsigned char* ki = bb + P2_KO; LAS unsigned char* vi = bb + P2_VO;
        if (c + 1 < 32) P2_LOAD(c + 1);
        u32x2 gt[2][4];
        if (w < 4) {
            {   const int tbg = tok0 + 64 * c;
#pragma unroll
                for (int ib = 0; ib < 2; ++ib)
#pragma unroll
                    for (int g = 0; g < 4; ++g) gt[ib][g] = *(const u32x2*)(G + (size_t)(tbg + 32 * ib + r) * 512 + 32 * w + 8 * g + 4 * h); }
        }
        if (w >= 4 && w < 7) {
            const int ws_ = w - 4;
            const int jb = (ws_ == 2) ? 1 : 0, ib = (ws_ == 0) ? 0 : 1;
            f32x16 pt;
#pragma unroll
            for (int i = 0; i < 16; ++i) pt[i] = 0.f;
#pragma unroll
            for (int s = 0; s < DK / 16; ++s) {
                const bf16x8 a = *(const LAS bf16x8*)(ki + img_off<DK>(32 * jb + r, 2 * s + h)), bq = *(const LAS bf16x8*)(qi + img_off<DK>(32 * ib + r, 2 * s + h));
                pt = MFMA32(a, bq, pt);
            }
            if (jb == ib) {
#pragma unroll
                for (int i = 0; i < 16; ++i) { const int j = (i & 3) + 8 * (i >> 2) + 4 * h; pt[i] = (j <= r) ? pt[i] : 0.f; }
            }
#pragma unroll
            for (int g = 0; g < 4; ++g) { u32x2 o; o.x = pk2(pt[4 * g], pt[4 * g + 1]); o.y = pk2(pt[4 * g + 2], pt[4 * g + 3]);
                *(LAS u32x2*)(lds + P2_P + (32 * ib + r) * 144 + (32 * jb + 8 * g + 4 * h) * 2) = o; }
        }
        f32x16 ot[2];
        bf16x8 vf[4];
        if (w < 4) {
#pragma unroll
            for (int s = 0; s < 4; ++s) vf[s] = tr_frag(vi + tr_addr<128>(lane, w, s, 0), vi + tr_addr<128>(lane, w, s, 1));
#pragma unroll
            for (int ib = 0; ib < 2; ++ib)
#pragma unroll
                for (int i = 0; i < 16; ++i) ot[ib][i] = 0.f;
#pragma unroll
            for (int d = 0; d < NDB; ++d)
#pragma unroll
                for (int s2 = 0; s2 < 2; ++s2) {
                    const bf16x8 sfr = pack8(S[d], s2);
#pragma unroll
                    for (int ib = 0; ib < 2; ++ib) {
                        const s16x4 lo = *(const LAS s16x4*)(qi + img_off<DK>(32 * ib + r, 4 * d + 2 * s2) + 8 * h), hi = *(const LAS s16x4*)(qi + img_off<DK>(32 * ib + r, 4 * d + 2 * s2 + 1) + 8 * h);
                        const bf16x8 bq = __builtin_shufflevector(lo, hi, 0, 1, 2, 3, 4, 5, 6, 7);
                        ot[ib] = MFMA32(sfr, bq, ot[ib]);
                    }
                }
#pragma unroll
            for (int d = 0; d < NDB; ++d) {
#pragma unroll
                for (int s = 0; s < 4; ++s) {
                    const bf16x8 a = tr_frag(ki + tr_addr<DK>(lane, d, s, 0), ki + tr_addr<DK>(lane, d, s, 1));
                    S[d] = MFMA32(a, vf[s], S[d]);
                }
                if (DK == 128) {
#pragma unroll
                    for (int i = 0; i < 16; ++i) S[d][i] *= ret_ebl;
                } else {
                    const LAS float* eb = (const LAS float*)(lds + P2_EBL + (c & 1) * 256) + 32 * d + 4 * h;
#pragma unroll
                    for (int g = 0; g < 4; ++g) { const f32x4 e4 = *(const LAS f32x4*)(eb + 8 * g);
#pragma unroll
                        for (int e = 0; e < 4; ++e) S[d][4 * g + e] *= e4[e]; }
                }
            }
        }
        __syncthreads();
        if (w < 4) {
#pragma unroll
            for (int ib = 0; ib < 2; ++ib) {
#pragma unroll
                for (int s = 0; s < (ib == 0 ? 2 : 4); ++s) {
                    const bf16x8 bp = *(const LAS bf16x8*)(lds + P2_P + (32 * ib + r) * 144 + (16 * s + 8 * h) * 2);
                    ot[ib] = MFMA32(vf[s], bp, ot[ib]);
                }
            }
#pragma unroll
            for (int ib = 0; ib < 2; ++ib) { float ss = 0.f;
#pragma unroll
                for (int i = 0; i < 16; ++i) ss += ot[ib][i] * ot[ib][i];
                ss += __shfl_xor(ss, 32);
                if (h == 0) *(LAS float*)(lds + P2_SSQ + (w * 64 + 32 * ib + r) * 4) = ss; }
        }
        if (c + 1 < 32) P2_STORE((c + 1) & 1);
        __syncthreads();
        if (w < 4) {
            asm volatile("" : "+v"(lane)); h = lane >> 5; r = lane & 31;
            const int tb = tok0 + 64 * c;
#pragma unroll
            for (int ib = 0; ib < 2; ++ib) {
                const LAS float* sq = (const LAS float*)(lds + P2_SSQ) + 32 * ib + r;
                const float tot = sq[0] + sq[64] + sq[128] + sq[192];
                const float rs = rsqrtf(tot * (1.f / 128.f) + EPS);
#pragma unroll
                for (int g = 0; g < 4; ++g) {
                    const u32x2 gg = gt[ib][g];
                    u32x2 o; o.x = pk2(ot[ib][4 * g] * rs * gn[g][0] * bflo(gg.x), ot[ib][4 * g + 1] * rs * gn[g][1] * bfhi(gg.x));
                    o.y = pk2(ot[ib][4 * g + 2] * rs * gn[g][2] * bflo(gg.y), ot[ib][4 * g + 3] * rs * gn[g][3] * bfhi(gg.y));
                    *(u32x2*)(arg + (size_t)(tb + 32 * ib + r) * 1024 + 32 * w + 8 * g + 4 * h) = o;
                }
            }
        }
    }
#undef P2_LOAD
#undef P2_STORE
    if (w < 4) {
        lane = tid0 & 63; h = lane >> 5; r = lane & 31;
        float* so = p.out + (branch == 0 ? OUT_RSP : OUT_GSP) + (size_t)(b * 4 + head) * DK * 128;
#pragma unroll
        for (int d = 0; d < NDB; ++d)
#pragma unroll
            for (int i = 0; i < 16; ++i) so[(size_t)(32 * d + (i & 3) + 8 * (i >> 2) + 4 * h) * 128 + 32 * w + r] = S[d][i];
    }
    __syncthreads();
}

template <int DK> DI void sample_unit(const Params& p, LAS unsigned char* lds, const int branch, const int b, const int head) {
    int tid = threadIdx.x; asm volatile("" : "+v"(tid));
    unsigned char* ws = p.ws;
    const bf16_t* Q = (const bf16_t*)(ws + (branch == 0 ? PQ_R : PQ_G)) + head * DK;
    const bf16_t* K = (const bf16_t*)(ws + (branch == 0 ? PK_R : PK_G)) + head * DK;
    const bf16_t* V = (const bf16_t*)(ws + (branch == 0 ? PV_R : PV_G)) + head * 128;
    const bf16_t* G = (const bf16_t*)(ws + (branch == 0 ? PG_R : PG_G)) + head * 128;
    bf16_t* arg = (bf16_t*)((unsigned char*)p.out + SEG1024) + branch * 512 + head * 128;
    const float* gain = (branch == 0 ? p.g_ret : p.g_gla) + head * 128;
    const float* sin_ = (branch == 0 ? p.state_ret : p.state_gla) + (size_t)(b * 4 + head) * DK * 128;
    float* sout = p.out + (branch == 0 ? OUT_RSS : OUT_GSS) + (size_t)(b * 4 + head) * DK * 128;
    const int tok0 = TP + 4 * b;
    LAS float* qs = (LAS float*)lds;
    LAS float* ks = qs + 4 * 128;
    LAS float* vs = ks + 4 * 128;
    LAS float* es = vs + 4 * 128;
    LAS float* Ps = es + 128;
    LAS float* ssq = Ps + 16;
    LAS float* op = ssq + 16;
    for (int i = tid; i < 4 * DK; i += 512) { const int t = i / DK, d = i % DK;
        qs[t * DK + d] = __uint_as_float((unsigned)Q[(size_t)(tok0 + t) * (4 * DK) + d] << 16); ks[t * DK + d] = __uint_as_float((unsigned)K[(size_t)(tok0 + t) * (4 * DK) + d] << 16); }
    { const int t = tid >> 7, v = tid & 127; vs[t * 128 + v] = __uint_as_float((unsigned)V[(size_t)(tok0 + t) * 512 + v] << 16); }
    if (tid < DK) {
        if (DK == 128) { const float lg2 = log2f(1.f - exp2f(-5.f - (float)head)); es[tid] = exp2f(4.f * lg2); }
        else es[tid] = ((const float*)(ws + WS_EBL))[(size_t)(256 + b) * 256 + head * 64 + tid];
    }
    __syncthreads();
    if (tid < 16) { const int i = tid >> 2, j = tid & 3; float s = 0.f; if (j <= i) { for (int d = 0; d < DK; ++d) s += qs[i * DK + d] * ks[j * DK + d]; } Ps[tid] = s; }
    {
        const int vq = tid & 31, dg = tid >> 5;
        f32x4 oa[4];
#pragma unroll
        for (int i = 0; i < 4; ++i) oa[i] = (f32x4){0.f, 0.f, 0.f, 0.f};
        f32x4 v4[4];
#pragma unroll
        for (int j = 0; j < 4; ++j) v4[j] = *(const LAS f32x4*)(vs + j * 128 + 4 * vq);
        f32x4 s0[DK / 16];
#pragma unroll
        for (int rr = 0; rr < DK / 16; ++rr) s0[rr] = *(const f32x4*)(sin_ + (size_t)(dg + 16 * rr) * 128 + 4 * vq);
#pragma unroll
        for (int rr = 0; rr < DK / 16; ++rr) {
            const int d = dg + 16 * rr;
            f32x4 sn = s0[rr];
#pragma unroll
            for (int i = 0; i < 4; ++i) { oa[i] += s0[rr] * qs[i * DK + d]; sn += v4[i] * ks[i * DK + d]; }
            sn *= es[d];
            *(f32x4*)(sout + (size_t)d * 128 + 4 * vq) = sn;
        }
#pragma unroll
        for (int i = 0; i < 4; ++i) *(LAS f32x4*)(op + (dg * 4 + i) * 128 + 4 * vq) = oa[i];
    }
    __syncthreads();
    {
        const int i = tid >> 7, v = tid & 127;
        float o = 0.f;
#pragma unroll
        for (int dg = 0; dg < 16; ++dg) o += op[(dg * 4 + i) * 128 + v];
#pragma unroll
        for (int j = 0; j < 4; ++j) o += Ps[i * 4 + j] * vs[j * 128 + v];
        const float s = wave_sum(o * o);
        if ((tid & 63) == 0) ssq[tid >> 6] = s;
        __syncthreads();
        const float rs = rsqrtf((ssq[2 * i] + ssq[2 * i + 1]) * (1.f / 128.f) + EPS);
        const float gate = __uint_as_float((unsigned)G[(size_t)(tok0 + i) * 512 + v] << 16);
        const unsigned wv = pk2(o * rs * gain[v] * gate, 0.f);
        arg[(size_t)(tok0 + i) * 1024 + v] = (bf16_t)(wv & 0xffffu);
    }
    __syncthreads();
}

DI void phase2(const Params& p, LAS unsigned char* lds) {
    const int G = gridDim.x, bx = blockIdx.x;
    const int nchb = G > 64 ? 64 : G;
    if (bx < nchb) {
        for (int c = bx; c < 64; c += nchb) {
            const int branch = c >> 5, bh = c & 31;
#ifndef NO_CH128
            if (branch == 0) chain_prompt<128>(p, lds, 0, bh >> 2, bh & 3);
#endif
#ifndef NO_CH64
            if (branch == 1) chain_prompt<64>(p, lds, 1, bh >> 2, bh & 3);
#endif
        }
    }
    const int nsb = G > 64 ? G - 64 : G, sb = G > 64 ? bx - 64 : bx;
    if (sb >= 0) {
        for (int u = sb; u < 1024; u += nsb) {
            const int branch = u >> 9, bh = u & 511;
#ifndef NO_SMP
            if (branch == 0) sample_unit<128>(p, lds, 0, bh >> 2, bh & 3); else sample_unit<64>(p, lds, 1, bh >> 2, bh & 3);
#endif
        }
    }
}

template <bool DRY> DI void phase_final(const Params& p) {
    const int lane = threadIdx.x & 63, gw = blockIdx.x * 8 + (threadIdx.x >> 6), ngw = gridDim.x * 8;
    for (int row = gw; row < T_TOK; row += ngw) {
        f32x4* hp = (f32x4*)(p.out + (size_t)row * DM) + lane;
        f32x4 v[4]; float s = 0.f;
#pragma unroll
        for (int j = 0; j < 4; ++j) v[j] = hp[64 * j];
        if (row >= TP) {
            const float* part = (const float*)(p.ws + WS_PART) + (size_t)((row - TP) & 255) * 256 + 4 * lane;
#pragma unroll
            for (int j = 0; j < 4; ++j) { const int su = ((row - TP) >> 8) * 4 + j;
                for (int kp = 0; kp < 11; ++kp) v[j] += *(const f32x4*)(part + (size_t)(su * 11 + kp) * 65536); }
        }
#pragma unroll
        for (int j = 0; j < 4; ++j) s += v[j][0] * v[j][0] + v[j][1] * v[j][1] + v[j][2] * v[j][2] + v[j][3] * v[j][3];
        const float rs = rsqrtf(wave_sum(s) * (1.f / DM) + EPS);
#pragma unroll
        for (int j = 0; j < 4; ++j) { const f32x4 g = *((const f32x4*)p.ln_f + lane + 64 * j); f32x4 o = v[j] * rs * g; if (DRY && p.out != nullptr) o = v[j]; hp[64 * j] = o; }
    }
}

__global__ void __launch_bounds__(512, 2) fwd_megakernel(Params p) {
    extern __shared__ __attribute__((aligned(16))) unsigned char shm[];
    LAS unsigned char* lds = (LAS unsigned char*)shm;
    cg::grid_group grid = cg::this_grid();
    if (p.ws == nullptr) grid.sync();
    if (threadIdx.x < 4) ((LAS unsigned*)(lds + 131072 + 4096))[threadIdx.x] = 0u;
    __syncthreads();
    const XcdBarrier xbar = xcd_barrier_post((unsigned*)(p.ws + WS_BAR), (volatile LAS unsigned*)(lds + 131072 + 4096));
    unsigned char* ws = p.ws;
    const int G = gridDim.x, bx = blockIdx.x;
    bf16_t* xb = (bf16_t*)p.out;
    bf16_t* arg = (bf16_t*)((unsigned char*)p.out + SEG1024);

#ifndef PHMASK
#define PHMASK 0x1ff
#endif
#define PH(n) if ((PHMASK >> (n)) & 1)
    PH(0) phase0(p, lds);
    xcd_barrier(xbar);
#if defined(DUP_PH) && DUP_PH == 0
    phase0(p, lds);
    xcd_barrier(xbar);
#endif
    PH(1) {
        pg8::Gemm g{xb, (const bf16_t*)(ws + WS_WIN), T_TOK, NPROJ, DM, DM, DM, 256}; pg8::StaticOrder S; S.init(T_TOK, NPROJ, G, bx);
        EpiProj E{ws, (const float*)(ws + WS_RSTD1), (const float*)(ws + WS_SH), (const float*)(ws + WS_ROPEC), (const float*)(ws + WS_ROPES)};
        pg8::gemm_phase<EpiProj, pg8::StaticOrder, 16>(lds, g, S, E);
#if defined(DUP_PH) && DUP_PH == 1
        xcd_barrier(xbar);
        pg8::gemm_phase<EpiProj, pg8::StaticOrder, 16>(lds, g, S, E);
#endif
    }
    xcd_barrier(xbar);
    PH(2) phase2(p, lds);
    xcd_barrier(xbar);
#if defined(DUP_PH) && DUP_PH == 2
    phase2(p, lds);
    xcd_barrier(xbar);
#endif
    PH(3) {
        pg8::Gemm g{arg, (const bf16_t*)(ws + WS_WMIX), T_TOK, DM, DM, DM, DM, 256}; pg8::StaticOrder S; S.init(T_TOK, DM, G, bx);
        EpiMix E{(const bf16_t*)(ws + PM_R), (const bf16_t*)(ws + PM_G), (bf16_t*)(ws + WS_MIX)};
        pg8::gemm_phase<EpiMix, pg8::StaticOrder, 16>(lds, g, S, E);
#if defined(DUP_PH) && DUP_PH == 3
        xcd_barrier(xbar);
        pg8::gemm_phase<EpiMix, pg8::StaticOrder, 16>(lds, g, S, E);
#endif
    }
    xcd_barrier(xbar);
    PH(4) {
        pg8::Gemm g{(const bf16_t*)(ws + WS_MIX), (const bf16_t*)(ws + WS_WO), T_TOK, DM, DM, DM, DM, 256}; pg8::StaticOrder S; S.init(T_TOK, DM, G, bx);
        EpiH E{p.x_prompt, p.x_sample, p.out, (bf16_t*)(ws + WS_SH), (float*)(ws + WS_SSQ2)};
        pg8::gemm_phase<EpiH, pg8::StaticOrder, 16>(lds, g, S, E);
    }
    xcd_barrier(xbar);
    PH(5) {
        pg8::Gemm g{(const bf16_t*)(ws + WS_SH) - 2 * DM, (const bf16_t*)(ws + WS_WUP), T_TOK, NUP, DM, DM, DM, 254}; pg8::StaticOrder S; S.init_tiles(67, 22, G, bx);
        EpiUpConv E{(const float*)(ws + WS_SSQ2), (bf16_t*)(ws + WS_ACT), p.conv_w, p.conv_b, p.cache_conv, p.out, (LAS float*)(lds + 131072)};
        pg8::gemm_phase<EpiUpConv, pg8::StaticOrder, 16>(lds, g, S, E);
#if defined(DUP_PH) && DUP_PH == 5
        xcd_barrier(xbar);
        pg8::gemm_phase<EpiUpConv, pg8::StaticOrder, 16>(lds, g, S, E);
#endif
    }
    xcd_barrier(xbar);
    PH(7) {
        pg8::Gemm g{(const bf16_t*)(ws + WS_ACT), (const bf16_t*)(ws + WS_WDN), T_TOK, DM, DFF, DFF, DFF, 256}; pg8::StaticOrder S; S.init_tiles(64, 4, G, bx);
#if defined(DUP_PH) && DUP_PH == 7
        { EpiDownT<true> E0{p.out}; pg8::gemm_phase<EpiDownT<true>, pg8::StaticOrder, 44>(lds, g, S, E0); xcd_barrier(xbar); }
#endif
        EpiDownT<false> E{p.out};
        pg8::gemm_phase<EpiDownT<false>, pg8::StaticOrder, 44>(lds, g, S, E);
        {
            pg8::PieceOrder S2{G, bx}; EpiPart E2{(float*)(ws + WS_PART)};
            pg8::gemm_phase<EpiPart, pg8::PieceOrder, 4>(lds, g, S2, E2); }
    }
    xcd_barrier(xbar);
#if defined(DUP_PH) && DUP_PH == 8
    phase_final<true>(p);
    xcd_barrier(xbar);
#endif
    PH(8) phase_final<false>(p);
}

extern "C" void kernel_launch(void* const* d_in, const int* in_sizes, int n_in, void* d_out, int out_size, void* d_ws, size_t ws_size, hipStream_t stream) {
    static int grid = 0;
    if (grid == 0) {
        if (n_in != 20 || out_size != (int)OUT_END || ws_size < WS_END) { fprintf(stderr, "kernel_launch: unexpected shapes (n_in %d, out %d, ws %zu)\n", n_in, out_size, ws_size); grid = -1; return; }
        int dev = 0, cus = 0, per_cu = 0;
        hipGetDevice(&dev);
        hipDeviceGetAttribute(&cus, hipDeviceAttributeMultiprocessorCount, dev);
        if (hipFuncSetAttribute((const void*)fwd_megakernel, hipFuncAttributeMaxDynamicSharedMemorySize, LDS_BYTES) != hipSuccess) { fprintf(stderr, "kernel_launch: hipFuncSetAttribute failed\n"); grid = -1; return; }
        hipOccupancyMaxActiveBlocksPerMultiprocessor(&per_cu, (const void*)fwd_megakernel, 512, LDS_BYTES);
        if (per_cu < 1) { fprintf(stderr, "kernel_launch: occupancy query gave %d\n", per_cu); per_cu = 1; }
        grid = cus * 1;
        (void)hipGetLastError();
    }
    if (grid < 0) return;
    Params p{};
    const float** f = (const float**)&p;
    for (int i = 0; i < 20; ++i) f[i] = (const float*)d_in[i];
    p.out = (float*)d_out; p.ws = (unsigned char*)d_ws;
    if (hipMemsetAsync((unsigned char*)d_ws + WS_BAR, 0, 16384, stream) != hipSuccess) { fprintf(stderr, "kernel_launch: memset failed\n"); return; }
    void* args[] = {&p};
    hipError_t e = hipLaunchCooperativeKernel((const void*)fwd_megakernel, dim3(grid), dim3(512), args, LDS_BYTES, stream);
    if (e != hipSuccess) fprintf(stderr, "cooperative launch failed: %s (grid %d)\n", hipGetErrorString(e), grid);
}
```

```cpp
#include <hip/hip_runtime.h>
#include <hip/hip_cooperative_groups.h>
#include <cstdio>
namespace cg = cooperative_groups;

#define LAS __attribute__((address_space(3)))
#define DI __device__ __forceinline__
typedef unsigned short bf16_t;
typedef short bf16x8 __attribute__((ext_vector_type(8)));
typedef short s16x4 __attribute__((ext_vector_type(4)));
typedef float f32x4 __attribute__((ext_vector_type(4)));
typedef float f32x2 __attribute__((ext_vector_type(2)));
typedef float f32x16 __attribute__((ext_vector_type(16)));
typedef unsigned u32x4 __attribute__((ext_vector_type(4)));
typedef unsigned u32x2 __attribute__((ext_vector_type(2)));
typedef __bf16 bf16x2_t __attribute__((ext_vector_type(2)));

constexpr int T_TOK = 16896, TP = 16384, DM = 1024, DIN = 5648, NPROJ = 5632, DFF = 2816, NUP = 5632;
constexpr float EPS = 1e-6f;
constexpr size_t OUT_Y = 0, OUT_RSP = 17301504, OUT_RSS = OUT_RSP + 524288, OUT_GSP = OUT_RSS + 8388608, OUT_GSS = OUT_GSP + 262144,
                 OUT_CP = OUT_GSS + 4194304, OUT_CS = OUT_CP + 45056, OUT_END = OUT_CS + 720896;
constexpr size_t WS_WIN = 0, WS_WMIX = WS_WIN + (size_t)NPROJ * DM * 2, WS_WO = WS_WMIX + (size_t)DM * DM * 2, WS_WUP = WS_WO + (size_t)DM * DM * 2,
                 WS_WDN = WS_WUP + (size_t)NUP * DM * 2, WS_PROJ = WS_WDN + (size_t)DM * DFF * 2;
constexpr size_t SEG512 = (size_t)T_TOK * 512 * 2, SEG256 = (size_t)T_TOK * 256 * 2, SEG1024 = (size_t)T_TOK * 1024 * 2;
constexpr size_t PQ_R = WS_PROJ, PK_R = PQ_R + SEG512, PV_R = PK_R + SEG512, PG_R = PV_R + SEG512, PQ_G = PG_R + SEG512, PK_G = PQ_G + SEG256,
                 PV_G = PK_G + SEG256, PG_G = PV_G + SEG512, PM_R = PG_G + SEG512, PM_G = PM_R + SEG1024, WS_PROJ_END = PM_G + SEG1024;
constexpr size_t WS_MIX = PQ_R;
constexpr size_t WS_PART = WS_PROJ + (size_t)T_TOK * DFF * 2;
static_assert(WS_PART + (size_t)88 * 65536 * 4 <= WS_PROJ_END, "partials");
constexpr size_t WS_ACT = WS_PROJ;
constexpr size_t WS_SH = WS_PROJ_END;
constexpr size_t WS_RSTD1 = WS_SH + SEG1024, WS_SSQ2 = WS_RSTD1 + (size_t)T_TOK * 4, WS_EBL = WS_SSQ2 + (size_t)T_TOK * 4,
                 WS_ROPEC = WS_EBL + (size_t)384 * 256 * 4, WS_ROPES = WS_ROPEC + (size_t)2052 * 64 * 4, WS_BAR = WS_ROPES + (size_t)2052 * 64 * 4, WS_END = WS_BAR + 16384;
static_assert(WS_PROJ_END - WS_PROJ == (size_t)T_TOK * NPROJ * 2, "proj layout");
static_assert(WS_END <= (size_t)256 * 1024 * 1024, "workspace");
constexpr int LDS_BYTES = 131072 + 4096 + 16;

struct Params {
    const float *x_prompt, *x_sample, *state_ret, *state_gla, *cache_conv, *ln1, *w_in, *w_gate_up, *b_gate_up, *g_ret, *g_gla, *w_ret_out, *w_gla_out,
        *w_o, *ln2, *w_up, *conv_w, *conv_b, *w_down, *ln_f;
    float* out; unsigned char* ws;
};

DI unsigned pk2(float lo, float hi) { f32x2 v = {lo, hi}; bf16x2_t b = __builtin_convertvector(v, bf16x2_t); return __builtin_bit_cast(unsigned, b); }
DI float bflo(unsigned w) { return __uint_as_float(w << 16); }
DI float bfhi(unsigned w) { return __uint_as_float(w & 0xffff0000u); }
DI float wave_sum(float v) {
#pragma unroll
    for (int o = 1; o < 64; o <<= 1) v += __shfl_xor(v, o);
    return v;
}
DI float sigmoidf_(float x) { return __builtin_amdgcn_rcpf(1.f + __expf(-x)); }
DI const float* x_row(const Params& p, int tok) { return tok < TP ? p.x_prompt + (size_t)tok * DM : p.x_sample + (size_t)(tok - TP) * DM; }
#define LDS_WAIT() asm volatile("s_waitcnt lgkmcnt(0)" ::: "memory")

#define XB_TMO      128
#define XB_XCNT(j)  (256  + 64 * (j))
#define XB_XSUB(j)  (1280 + 64 * (j))
#define XB_XGEN(j)  (2304 + 64 * (j))
#define XB_TOP      3328
#define XB_TOPGEN   3392
#define XCD_BAR_WORDS 3456
#define XB_SPIN_CAP (1u << 22)
DI unsigned xb_ld(unsigned* p) { return __hip_atomic_load(p, __ATOMIC_RELAXED, __HIP_MEMORY_SCOPE_AGENT); }
DI unsigned xb_add(unsigned* p, unsigned v) { return __hip_atomic_fetch_add(p, v, __ATOMIC_RELAXED, __HIP_MEMORY_SCOPE_AGENT); }
DI unsigned xb_xcc_id() { return (unsigned)__builtin_amdgcn_s_getreg((3 << 11) | 20) & 0xFu; }
#define XB_SPIN(cond, bar) do { unsigned _sp = 0; while (cond) { __builtin_amdgcn_s_sleep(1); \
    if ((++_sp & 255u) == 0u) { if (xb_ld(&(bar)[XB_TMO])) break; if (_sp > XB_SPIN_CAP) { atomicAdd(&(bar)[XB_TMO], 1u); break; } } } } while (0)
struct XcdBarrier { unsigned* bar; unsigned x; volatile LAS unsigned* st; };
DI XcdBarrier xcd_barrier_post(unsigned* bar, volatile LAS unsigned* st) {
    XcdBarrier b; b.bar = bar; b.x = xb_xcc_id(); b.st = st;
    if (threadIdx.x == 0) (void)xb_add(&bar[XB_XCNT(b.x)], 1u);
    return b;
}
DI void xcd_barrier_complete(unsigned* bar, unsigned x, unsigned& nloc, unsigned& nx) {
    const unsigned G = gridDim.x * gridDim.y * gridDim.z;
    unsigned sum, cnt, mine, sp = 0u;
    for (;;) {
        sum = 0u; cnt = 0u; mine = 0u;
#pragma unroll
        for (unsigned j = 0; j < 16; ++j) { const unsigned c = xb_ld(&bar[XB_XCNT(j)]); sum += c; cnt += (c > 0u) ? 1u : 0u; mine = (j == x) ? c : mine; }
        if (sum == G) break;
        __builtin_amdgcn_s_sleep(1);
        if ((++sp & 255u) == 0u) { if (xb_ld(&bar[XB_TMO])) break; if (sp > XB_SPIN_CAP) { atomicAdd(&bar[XB_TMO], 1u); break; } }
    }
    nloc = mine > 0u ? mine : 1u; nx = cnt > 0u ? cnt : 1u;
}
DI void xcd_barrier(const XcdBarrier& b) {
    asm volatile("s_waitcnt vmcnt(0)" ::: "memory");
    __syncthreads();
    if (threadIdx.x == 0) {
        unsigned* bar = b.bar;
        __builtin_amdgcn_s_waitcnt(0);
        unsigned nloc = b.st[0], nx = b.st[1];
        if (nloc == 0u) { xcd_barrier_complete(bar, b.x, nloc, nx); b.st[0] = nloc; b.st[1] = nx; }
        const unsigned old = xb_add(&bar[XB_XSUB(b.x)], 1u);
        const unsigned gen = old / nloc;
        if (old + 1u == (gen + 1u) * nloc) {
            __builtin_amdgcn_fence(__ATOMIC_RELEASE, "agent");
            asm volatile("s_waitcnt vmcnt(0)" ::: "memory");
            const unsigned og = xb_add(&bar[XB_TOP], 1u);
            const unsigned tg = og / nx;
            if (og + 1u == (tg + 1u) * nx) xb_add(&bar[XB_TOPGEN], 1u);
            else XB_SPIN(xb_ld(&bar[XB_TOPGEN]) == tg, bar);
            __builtin_amdgcn_fence(__ATOMIC_ACQUIRE, "agent");
            xb_add(&bar[XB_XGEN(b.x)], 1u);
            asm volatile("s_waitcnt vmcnt(0)" ::: "memory");
        } else {
            XB_SPIN(xb_ld(&bar[XB_XGEN(b.x)]) == gen, bar);
            __builtin_amdgcn_fence(__ATOMIC_ACQUIRE, "agent");
            asm volatile("s_waitcnt vmcnt(0)" ::: "memory");
        }
    }
    __syncthreads();
}

namespace pg8 {
constexpr int BM = 256, BK = 64, HALF = 128, HTB = HALF * BK * 2, STAGE_BYTES = 8 * HTB, NXCD = 8, WGM = 8;
DI int lds_byte(int r, int c) { const int st = (r >> 4) * 2 + (c >> 5), rr = r & 15, cc = c & 31, ob = rr * 64 + cc * 2; return st * 1024 + (ob ^ (((ob >> 9) & 1) << 5)); }
DI void stage_rc(int b, int& R, int& C) { const int st = b / 1024, sb = b % 1024, swz = sb ^ (((sb >> 9) & 1) << 5); R = (st >> 1) * 16 + swz / 64; C = (st & 1) * 32 + (swz % 64) / 2; }
DI int perm32(int rho) { const int n = rho >> 4, i = rho & 15; return 8 * (i >> 2) + 4 * n + (i & 3); }
struct Unit { int pm, pn, kt0, id; };
struct Gemm { const bf16_t* A; const bf16_t* Bt; int M, N, K, lda, ldb, mstep; };
struct StaticOrder {
    int nM, nN, nwg, G, c;
    DI void init(int M, int N, int G_, int c_) { nM = M / BM; nN = N / BM; nwg = nM * nN; G = G_; c = c_; }
    DI void init_tiles(int nM_, int nN_, int G_, int c_) { nM = nM_; nN = nN_; nwg = nM * nN; G = G_; c = c_; }
    DI bool next(int i, Unit& u) const {
        u.kt0 = 0; u.id = 0; u.pm = 0; u.pn = 0;
        const long L = (long)i * G + c; if (L >= nwg) return false;
        int wgid = (int)L; { const int q = nwg / NXCD, r = nwg % NXCD, xcd = wgid % NXCD, off = wgid / NXCD; wgid = (xcd < r ? xcd * (q + 1) : r * (q + 1) + (xcd - r) * q) + off; }
        const int nig = WGM * nN, gid = wgid / nig, fm = gid * WGM, gsz = (nM - fm) < WGM ? (nM - fm) : WGM;
        u.pm = fm + ((wgid % nig) % gsz); u.pn = (wgid % nig) / gsz; return true;
    }
};
struct PieceOrder {
    int G, c;
    DI bool next(int i, Unit& u) const {
        const int pid = c + i * G; const int su = pid / 11;
        u.pm = 64 + (su >> 2); u.pn = su & 3; u.kt0 = (pid - su * 11) * 4; u.id = pid;
        return pid < 88;
    }
};
template <class Epi, class Sched, int NT>
DI void gemm_phase(LAS unsigned char* lds, const Gemm g, const Sched& S, const Epi& E) {
    int tid = threadIdx.x; asm volatile("" : "+v"(tid));
    const int wid = __builtin_amdgcn_readfirstlane(tid >> 6), lane = tid & 63, wr = wid >> 2, wc = wid & 3, fr = lane & 15, fq = lane >> 4;
    constexpr int nt = NT;
    unsigned voffA[2], voffB[2];
#pragma unroll
    for (int i = 0; i < 2; ++i) { int R, C; stage_rc(tid * 16 + i * 8192, R, C); const int Rb = Epi::PERM ? ((R & ~31) + perm32(R & 31)) : R;
        voffA[i] = (unsigned)(R * g.lda + C) * 2u; voffB[i] = (unsigned)(Rb * g.ldb + C) * 2u; }
    const size_t kstep = (size_t)(BK * 2);
    const size_t hstepA = (size_t)HALF * g.lda * 2, hstepB = (size_t)HALF * g.ldb * 2;
    const size_t tstepA = (size_t)g.mstep * g.lda * 2, tstepB = 2 * hstepB;
    const unsigned ldsw = (unsigned)wid * 1024u;
    const int aoff = lds_byte(wr * 64 + fr, fq * 8), boff = lds_byte(wc * 32 + fr, fq * 8);
#define PG8_SA(b, h) (((b) * 2 + (h)) * HTB)
#define PG8_SB(b, h) ((4 + (b) * 2 + (h)) * HTB)
#define PG8_STAGE(bufoff, gbase, voff) do { _Pragma("unroll") for (int _i = 0; _i < 2; ++_i) \
        __builtin_amdgcn_global_load_lds((const unsigned*)((const char*)(gbase) + (voff)[_i]), (LAS unsigned*)(lds + (bufoff) + ldsw + _i * 8192), 16, 0, 0); } while (0)
#define PG8_LDA(dst, b, h) do { _Pragma("unroll") for (int m = 0; m < 4; ++m) _Pragma("unroll") for (int k = 0; k < 2; ++k) dst[m][k] = *(const LAS bf16x8*)(lds + PG8_SA(b, h) + aoff + m * 2048 + k * 1024); } while (0)
#define PG8_LDB(dst, b, h) do { _Pragma("unroll") for (int n = 0; n < 2; ++n) _Pragma("unroll") for (int k = 0; k < 2; ++k) dst[n][k] = *(const LAS bf16x8*)(lds + PG8_SB(b, h) + boff + n * 2048 + k * 1024); } while (0)
#define PG8_MMA(ai, bj, At, Bt) do { __builtin_amdgcn_s_setprio(1); _Pragma("unroll") for (int m = 0; m < 4; ++m) _Pragma("unroll") for (int n = 0; n < 2; ++n) _Pragma("unroll") for (int k = 0; k < 2; ++k) \
        acc[ai][bj][m][n] = __builtin_amdgcn_mfma_f32_16x16x32_bf16(Bt[n][k], At[m][k], acc[ai][bj][m][n], 0, 0, 0); __builtin_amdgcn_s_setprio(0); } while (0)
#define PG8_WAIT_V(n) asm volatile("s_waitcnt vmcnt(" #n ")" ::: "memory")
#define PG8_WAIT_L(n) asm volatile("s_waitcnt lgkmcnt(" #n ")" ::: "memory")
#define PG8_BAR __builtin_amdgcn_s_barrier()
#define PG8_SCHED __builtin_amdgcn_sched_barrier(0)
    Unit cur, nxt; int ui = 0;
    if (!S.next(0, cur)) return;
    f32x4 acc[2][2][4][2];
#pragma unroll
    for (int a = 0; a < 2; ++a)
#pragma unroll
        for (int b = 0; b < 2; ++b)
#pragma unroll
            for (int m = 0; m < 4; ++m)
#pragma unroll
                for (int n = 0; n < 2; ++n) acc[a][b][m][n] = (f32x4){0.f, 0.f, 0.f, 0.f};
    bf16x8 At[4][2], B0[2][2], B1[2][2];
    const char* cA = (const char*)g.A + (size_t)cur.pm * tstepA + (size_t)cur.kt0 * kstep; const char* cB = (const char*)g.Bt + (size_t)cur.pn * tstepB + (size_t)cur.kt0 * kstep;
    PG8_STAGE(PG8_SB(0, 0), cB, voffB); PG8_STAGE(PG8_SA(0, 0), cA, voffA); PG8_STAGE(PG8_SB(0, 1), cB + hstepB, voffB); PG8_STAGE(PG8_SA(0, 1), cA + hstepA, voffA);
    if (wr == 1) PG8_BAR;
    PG8_WAIT_V(4); PG8_BAR;
    PG8_STAGE(PG8_SB(1, 0), cB + kstep, voffB); PG8_STAGE(PG8_SA(1, 0), cA + kstep, voffA); PG8_STAGE(PG8_SB(1, 1), cB + hstepB + kstep, voffB);
    PG8_WAIT_V(6); PG8_BAR;
    for (;;) {
        const bool has_next = S.next(ui + 1, nxt);
        const char* nA = has_next ? (const char*)g.A + (size_t)nxt.pm * tstepA + (size_t)nxt.kt0 * kstep : cA; const char* nB = has_next ? (const char*)g.Bt + (size_t)nxt.pn * tstepB + (size_t)nxt.kt0 * kstep : cB;
        for (int t = 0; t < nt; t += 2) {
            const bool last = (t == nt - 2);
            const char* a1 = cA + (size_t)(t + 1) * kstep;
            const char* a2 = last ? nA : cA + (size_t)(t + 2) * kstep; const char* b2 = last ? nB : cB + (size_t)(t + 2) * kstep;
            const char* a3 = a2 + kstep; const char* b3 = b2 + kstep;
            if constexpr (Epi::MIDK) { if (t == (nt >> 1)) E.mid(acc, cur, wr, wc, fr, fq); }
            PG8_LDB(B0, 0, 0); PG8_SCHED; PG8_LDA(At, 0, 0); PG8_STAGE(PG8_SA(1, 1), a1 + hstepA, voffA);
            PG8_WAIT_L(8); PG8_BAR; PG8_WAIT_L(0); PG8_MMA(0, 0, At, B0); PG8_BAR; PG8_SCHED;
            PG8_LDB(B1, 0, 1); PG8_STAGE(PG8_SB(0, 0), b2, voffB);
            PG8_BAR; PG8_WAIT_L(0); PG8_MMA(0, 1, At, B1); PG8_BAR;
            PG8_LDA(At, 0, 1); PG8_STAGE(PG8_SA(0, 0), a2, voffA);
            PG8_BAR; PG8_WAIT_L(0); PG8_MMA(1, 0, At, B0); PG8_BAR; PG8_SCHED;
            PG8_STAGE(PG8_SB(0, 1), b2 + hstepB, voffB);
            PG8_WAIT_V(6); PG8_BAR; PG8_MMA(1, 1, At, B1); PG8_BAR;
            PG8_LDB(B0, 1, 0); PG8_SCHED; PG8_LDA(At, 1, 0); PG8_STAGE(PG8_SA(0, 1), a2 + hstepA, voffA);
            PG8_WAIT_L(8); PG8_BAR; PG8_WAIT_L(0); PG8_MMA(0, 0, At, B0); PG8_BAR; PG8_SCHED;
            PG8_LDB(B1, 1, 1); PG8_STAGE(PG8_SB(1, 0), b3, voffB);
            PG8_BAR; PG8_WAIT_L(0); PG8_MMA(0, 1, At, B1); PG8_BAR;
            PG8_LDA(At, 1, 1); PG8_STAGE(PG8_SA(1, 0), a3, voffA);
            PG8_BAR; PG8_WAIT_L(0); PG8_MMA(1, 0, At, B0); PG8_BAR; PG8_SCHED;
            PG8_STAGE(PG8_SB(1, 1), b3 + hstepB, voffB);
            PG8_WAIT_V(6); PG8_BAR; PG8_MMA(1, 1, At, B1); PG8_BAR;
        }
        E(acc, cur, wr, wc, fr, fq);
        if (!has_next) break;
#pragma unroll
        for (int a = 0; a < 2; ++a)
#pragma unroll
            for (int b = 0; b < 2; ++b)
#pragma unroll
                for (int m = 0; m < 4; ++m)
#pragma unroll
                    for (int n = 0; n < 2; ++n) acc[a][b][m][n] = (f32x4){0.f, 0.f, 0.f, 0.f};
        cur = nxt; cA = nA; cB = nB; ++ui;
    }
    PG8_WAIT_V(0);
    if (wr == 0) PG8_BAR;
    PG8_BAR;
#undef PG8_SA
#undef PG8_SB
#undef PG8_STAGE
#undef PG8_LDA
#undef PG8_LDB
#undef PG8_MMA
#undef PG8_WAIT_V
#undef PG8_WAIT_L
#undef PG8_BAR
#undef PG8_SCHED
}
}
using pg8::Unit;
typedef f32x4 AccT[2][2][4][2];

struct EpiProj {
    static constexpr bool PERM = true, MIDK = false;
    unsigned char* ws; const float* rstd1; const float* bcum; const float* ropec; const float* ropes;
    DI void mid(AccT&, const Unit&, int, int, int, int) const {}
    DI void operator()(const AccT& acc, const Unit& u, int wr, int wc, int fr, int fq) const {
        const int pn = u.pn; int seg, pn0;
        if (pn < 8) { seg = pn >> 1; pn0 = seg * 2; } else if (pn == 8) { seg = 4; pn0 = 8; } else if (pn == 9) { seg = 5; pn0 = 9; }
        else if (pn < 12) { seg = 6; pn0 = 10; } else if (pn < 14) { seg = 7; pn0 = 12; } else if (pn < 18) { seg = 8; pn0 = 14; } else { seg = 9; pn0 = 18; }
        size_t segoff; int ld;
        switch (seg) { case 0: segoff = PQ_R; ld = 512; break; case 1: segoff = PK_R; ld = 512; break; case 2: segoff = PV_R; ld = 512; break; case 3: segoff = PG_R; ld = 512; break;
            case 4: segoff = PQ_G; ld = 256; break; case 5: segoff = PK_G; ld = 256; break; case 6: segoff = PV_G; ld = 512; break; case 7: segoff = PG_G; ld = 512; break;
            case 8: segoff = PM_R; ld = 1024; break; default: segoff = PM_G; ld = 1024; break; }
        bf16_t* base = (bf16_t*)(ws + segoff);
        const int lc0 = (pn - pn0) * 256 + wc * 32 + 8 * fq;
        const int row0 = u.pm * 256 + wr * 64 + fr;
        if (seg <= 1) {
            const int i0 = 16 * wc + 4 * fq;
            float lg2h[2];
#pragma unroll
            for (int bj = 0; bj < 2; ++bj) lg2h[bj] = log2f(1.f - exp2f(-5.f - (float)((pn - pn0) * 2 + bj)));
#pragma unroll
            for (int ai = 0; ai < 2; ++ai)
#pragma unroll
                for (int m = 0; m < 4; ++m) {
                    const int row = row0 + ai * 128 + m * 16; const float rs = rstd1[row];
                    int posidx, ic; if (row < TP) { posidx = row & 2047; ic = row & 63; } else { const int s = row - TP; posidx = 2048 + (s & 3); ic = s & 3; }
                    const f32x4 c4 = *(const f32x4*)(ropec + posidx * 64 + i0), s4 = *(const f32x4*)(ropes + posidx * 64 + i0);
#pragma unroll
                    for (int bj = 0; bj < 2; ++bj) {
                        const int head = (pn - pn0) * 2 + bj;
                        const float lg2 = lg2h[bj];
                        const float dec = (seg == 0) ? __builtin_amdgcn_exp2f((float)(ic + 1) * lg2) : __builtin_amdgcn_exp2f(-(float)(ic + 1) * lg2) * 0.08838834764831845f;
                        const f32x4 t1 = acc[ai][bj][m][0] * rs, t2 = acc[ai][bj][m][1] * rs;
                        const f32x4 o1 = (t1 * c4 - t2 * s4) * dec, o2 = (t1 * s4 + t2 * c4) * dec;
                        bf16_t* rp = base + (size_t)row * 512 + head * 128 + i0;
                        u32x2 w1, w2; w1.x = pk2(o1[0], o1[1]); w1.y = pk2(o1[2], o1[3]); w2.x = pk2(o2[0], o2[1]); w2.y = pk2(o2[2], o2[3]);
                        *(u32x2*)rp = w1; *(u32x2*)(rp + 64) = w2;
                    }
                }
            return;
        }
#pragma unroll
        for (int ai = 0; ai < 2; ++ai)
#pragma unroll
            for (int m = 0; m < 4; ++m) {
                const int row = row0 + ai * 128 + m * 16; const float rs = rstd1[row];
#pragma unroll
                for (int bj = 0; bj < 2; ++bj) {
                    const int lc = lc0 + bj * 128;
                    f32x4 v0 = acc[ai][bj][m][0] * rs, v1 = acc[ai][bj][m][1] * rs;
                    if (seg == 4 || seg == 5) {
                        const f32x4 b0 = *(const f32x4*)(bcum + (size_t)row * 256 + lc), b1 = *(const f32x4*)(bcum + (size_t)row * 256 + lc + 4);
                        if (seg == 4) {
#pragma unroll
                            for (int e = 0; e < 4; ++e) { v0[e] *= 0.125f * __expf(b0[e]); v1[e] *= 0.125f * __expf(b1[e]); }
                        } else {
#pragma unroll
                            for (int e = 0; e < 4; ++e) { v0[e] *= __expf(-b0[e]); v1[e] *= __expf(-b1[e]); }
                        }
                    } else if (seg == 3 || seg == 7) {
#pragma unroll
                        for (int e = 0; e < 4; ++e) { v0[e] = v0[e] * sigmoidf_(v0[e]); v1[e] = v1[e] * sigmoidf_(v1[e]); }
                    } else if (seg >= 8) {
#pragma unroll
                        for (int e = 0; e < 4; ++e) { v0[e] = sigmoidf_(v0[e]); v1[e] = sigmoidf_(v1[e]); }
                    }
                    u32x4 w; w.x = pk2(v0[0], v0[1]); w.y = pk2(v0[2], v0[3]); w.z = pk2(v1[0], v1[1]); w.w = pk2(v1[2], v1[3]);
                    __builtin_nontemporal_store(w, (u32x4*)(base + (size_t)row * ld + lc));
                }
            }
    }
};
struct EpiMix {
    static constexpr bool PERM = true, MIDK = true;
    const bf16_t* mr; const bf16_t* mg; bf16_t* mix;
    DI void mid(AccT& acc, const Unit& u, int wr, int wc, int fr, int fq) const {
        int row0 = u.pm * 256 + wr * 64 + fr, c0 = u.pn * 256 + wc * 32 + 8 * fq;
        asm volatile("" : "+v"(row0), "+v"(c0));
#pragma unroll
        for (int ai = 0; ai < 2; ++ai)
#pragma unroll
            for (int m = 0; m < 4; ++m) {
                const int row = row0 + ai * 128 + m * 16;
#pragma unroll
                for (int bj = 0; bj < 2; ++bj) {
                    const u32x4 a = *(const u32x4*)(mr + (size_t)row * 1024 + c0 + bj * 128), b = *(const u32x4*)(mg + (size_t)row * 1024 + c0 + bj * 128);
                    f32x4 r0, r1;
                    r0[0] = bflo(a.x) * __builtin_amdgcn_rcpf(fmaxf(bflo(b.x), 1e-30f)); r0[1] = bfhi(a.x) * __builtin_amdgcn_rcpf(fmaxf(bfhi(b.x), 1e-30f)); r0[2] = bflo(a.y) * __builtin_amdgcn_rcpf(fmaxf(bflo(b.y), 1e-30f)); r0[3] = bfhi(a.y) * __builtin_amdgcn_rcpf(fmaxf(bfhi(b.y), 1e-30f));
                    r1[0] = bflo(a.z) * __builtin_amdgcn_rcpf(fmaxf(bflo(b.z), 1e-30f)); r1[1] = bfhi(a.z) * __builtin_amdgcn_rcpf(fmaxf(bfhi(b.z), 1e-30f)); r1[2] = bflo(a.w) * __builtin_amdgcn_rcpf(fmaxf(bflo(b.w), 1e-30f)); r1[3] = bfhi(a.w) * __builtin_amdgcn_rcpf(fmaxf(bfhi(b.w), 1e-30f));
                    acc[ai][bj][m][0] *= r0; acc[ai][bj][m][1] *= r1;
                }
                __builtin_amdgcn_sched_barrier(0);
            }
    }
    DI void operator()(const AccT& acc, const Unit& u, int wr, int wc, int fr, int fq) const {
        const int row0 = u.pm * 256 + wr * 64 + fr, c0 = u.pn * 256 + wc * 32 + 8 * fq;
#pragma unroll
        for (int ai = 0; ai < 2; ++ai)
#pragma unroll
            for (int m = 0; m < 4; ++m) {
                const int row = row0 + ai * 128 + m * 16;
#pragma unroll
                for (int bj = 0; bj < 2; ++bj) {
                    const u32x4 b = *(const u32x4*)(mg + (size_t)row * 1024 + c0 + bj * 128);
                    const f32x4 v0 = acc[ai][bj][m][0], v1 = acc[ai][bj][m][1];
                    u32x4 w; w.x = pk2(v0[0] * bflo(b.x), v0[1] * bfhi(b.x)); w.y = pk2(v0[2] * bflo(b.y), v0[3] * bfhi(b.y));
                    w.z = pk2(v1[0] * bflo(b.z), v1[1] * bfhi(b.z)); w.w = pk2(v1[2] * bflo(b.w), v1[3] * bfhi(b.w));
                    *(u32x4*)(mix + (size_t)row * 1024 + c0 + bj * 128) = w;
                }
            }
    }
};
struct EpiH {
    static constexpr bool PERM = true, MIDK = false;
    const float* xp; const float* xs; float* h; bf16_t* hb; float* ssq;
    DI void mid(AccT&, const Unit&, int, int, int, int) const {}
    DI void operator()(const AccT& acc, const Unit& u, int wr, int wc, int fr, int fq) const {
        const int row0 = u.pm * 256 + wr * 64 + fr, c0 = u.pn * 256 + wc * 32 + 8 * fq;
#pragma unroll
        for (int ai = 0; ai < 2; ++ai)
#pragma unroll
            for (int m = 0; m < 4; ++m) {
                const int row = row0 + ai * 128 + m * 16;
                const float* xr = row < TP ? xp + (size_t)row * DM : xs + (size_t)(row - TP) * DM;
                float ss = 0.f;
#pragma unroll
                for (int bj = 0; bj < 2; ++bj) {
                    const int c = c0 + bj * 128;
                    const f32x4 v0 = acc[ai][bj][m][0] + *(const f32x4*)(xr + c), v1 = acc[ai][bj][m][1] + *(const f32x4*)(xr + c + 4);
                    *(f32x4*)(h + (size_t)row * DM + c) = v0; *(f32x4*)(h + (size_t)row * DM + c + 4) = v1;
                    u32x4 w; w.x = pk2(v0[0], v0[1]); w.y = pk2(v0[2], v0[3]); w.z = pk2(v1[0], v1[1]); w.w = pk2(v1[2], v1[3]);
                    *(u32x4*)(hb + (size_t)row * DM + c) = w;
                    ss += v0[0] * v0[0] + v0[1] * v0[1] + v0[2] * v0[2] + v0[3] * v0[3] + v1[0] * v1[0] + v1[1] * v1[1] + v1[2] * v1[2] + v1[3] * v1[3];
                }
                ss += __shfl_xor(ss, 16); ss += __shfl_xor(ss, 32);
                if (fq == 0) unsafeAtomicAdd(ssq + row, ss);
            }
    }
};
DI f32x2 gelu_pk(f32x2 v) {
    const f32x2 av = __builtin_elementwise_abs(v), d = av * 0.2316418882f + 1.0f;
    f32x2 t; t.x = __builtin_amdgcn_rcpf(d.x); t.y = __builtin_amdgcn_rcpf(d.y);
    f32x2 q = t * 0.5307027145f + (-0.7265760135f); q = q * t + 0.7107068705f; q = q * t + (-0.142248368f); q = q * t + 0.127414796f; q = q * t;
    const f32x2 s = (v * v) * (-0.72134752044f);
    f32x2 e; e.x = __builtin_amdgcn_exp2f(s.x); e.y = __builtin_amdgcn_exp2f(s.y);
    const f32x2 m = v * (q * e), r = v - m;
    f32x2 o; o.x = v.x < 0.f ? m.x : r.x; o.y = v.y < 0.f ? m.y : r.y; return o;
}
#define DPPF(old_, src_, ctrl_) __int_as_float(__builtin_amdgcn_update_dpp(__float_as_int(old_), __float_as_int(src_), (ctrl_), 0xf, 0xf, false))
struct EpiUpConv {
    static constexpr bool PERM = true, MIDK = false;
    const float* ssq; bf16_t* act; const float* cw; const float* cb; const float* cache; float* out; LAS float* xch;
    DI void mid(AccT&, const Unit&, int, int, int, int) const {}
    DI void operator()(const AccT& acc, const Unit& u, int wr, int wc, int fr, int fq) const {
        const int tokbase = u.pm * 254 - 2, cl = wc * 32 + 8 * fq, f0 = u.pn * 128 + cl;
        float sq[2][4];
#pragma unroll
        for (int ai = 0; ai < 2; ++ai)
#pragma unroll
            for (int m = 0; m < 4; ++m) { const int tok = tokbase + ai * 128 + wr * 64 + m * 16 + fr; sq[ai][m] = (tok >= 0 && tok < T_TOK) ? ssq[tok] : -1.f; }
        f32x4 cb4[2], w04[2], w14[2], w24[2];
#pragma unroll
        for (int n = 0; n < 2; ++n) { cb4[n] = *(const f32x4*)(cb + f0 + 4 * n); w04[n] = *(const f32x4*)(cw + f0 + 4 * n); w14[n] = *(const f32x4*)(cw + DFF + f0 + 4 * n); w24[n] = *(const f32x4*)(cw + 2 * DFF + f0 + 4 * n); }
        float rs[2][4];
#pragma unroll
        for (int ai = 0; ai < 2; ++ai)
#pragma unroll
            for (int m = 0; m < 4; ++m) rs[ai][m] = sq[ai][m] >= 0.f ? rsqrtf(sq[ai][m] * (1.f / DM) + EPS) : 0.f;
        if (fr >= 14) {
#pragma unroll
            for (int ai = 0; ai < 2; ++ai) { LAS float* xp = xch + ((2 * ai + wr) * 2 + (fr - 14)) * 128 + cl;
                *(LAS f32x4*)xp = acc[ai][0][3][0] * rs[ai][3]; *(LAS f32x4*)(xp + 4) = acc[ai][0][3][1] * rs[ai][3]; }
        }
        asm volatile("s_waitcnt lgkmcnt(0)" ::: "memory"); __builtin_amdgcn_s_barrier(); __builtin_amdgcn_s_barrier(); asm volatile("" ::: "memory");
        const bool samp_tile = (tokbase + 255 >= TP);
#pragma unroll
        for (int ai = 0; ai < 2; ++ai) {
            const int g = 2 * ai + wr;
            f32x4 prev[2];
#pragma unroll
            for (int m = 0; m < 4; ++m) {
                const int i = ai * 128 + wr * 64 + m * 16 + fr, tok = tokbase + i;
                int l; const bool samp = tok >= TP;
                if (!samp) l = tok & 2047; else l = (tok - TP) & 3;
                u32x4 w; f32x4 curs[2];
#pragma unroll
                for (int n = 0; n < 2; ++n) {
                    const f32x4 cur = acc[ai][0][m][n] * rs[ai][m], vv = acc[ai][1][m][n] * rs[ai][m];
                    f32x4 x1, x2;
                    if (m == 0) {
                        f32x4 h1 = {0.f, 0.f, 0.f, 0.f}, h2 = {0.f, 0.f, 0.f, 0.f};
                        if (g >= 1) { h1 = *(const LAS f32x4*)(xch + ((g - 1) * 2 + 1) * 128 + cl + 4 * n); h2 = *(const LAS f32x4*)(xch + ((g - 1) * 2 + (fr == 0 ? 0 : 1)) * 128 + cl + 4 * n); }
#pragma unroll
                        for (int e = 0; e < 4; ++e) { x1[e] = DPPF(h1[e], cur[e], 0x111); x2[e] = DPPF(h2[e], cur[e], 0x112); }
                    } else {
#pragma unroll
                        for (int e = 0; e < 4; ++e) { const float o1 = DPPF(0.f, prev[n][e], 0x121), o2 = DPPF(0.f, prev[n][e], 0x122);
                            x1[e] = DPPF(o1, cur[e], 0x111); x2[e] = DPPF(o2, cur[e], 0x112); }
                    }
                    prev[n] = cur; curs[n] = cur;
                    if (l < 2) {
                        if (samp_tile && samp) {
                            const int bidx = (tok - TP) >> 2;
                            if (tok < T_TOK) { const f32x4 c1 = *(const f32x4*)(cache + ((size_t)bidx * 2 + 1) * DFF + f0 + 4 * n), c0 = *(const f32x4*)(cache + ((size_t)bidx * 2 + l) * DFF + f0 + 4 * n);
                                x2 = c0; if (l == 0) x1 = c1; }
                        } else { x2 = (f32x4){0.f, 0.f, 0.f, 0.f}; if (l == 0) x1 = x2; }
                    }
                    const f32x4 uc = cb4[n] + w04[n] * x2 + w14[n] * x1 + w24[n] * cur;
                    const f32x2 ga = gelu_pk((f32x2){uc[0], uc[1]}), gb = gelu_pk((f32x2){uc[2], uc[3]});
                    const unsigned p0 = pk2(ga.x * vv[0], ga.y * vv[1]), p1 = pk2(gb.x * vv[2], gb.y * vv[3]);
                    if (n == 0) { w.x = p0; w.y = p1; } else { w.z = p0; w.w = p1; }
                }
                if (i >= 2 && tok < T_TOK) {
                    *(u32x4*)(act + (size_t)tok * DFF + f0) = w;
                    if (!samp) { if (l >= 2046) { float* o = out + OUT_CP + ((size_t)(tok >> 11) * 2 + (l - 2046)) * DFF + f0; *(f32x4*)o = curs[0]; *(f32x4*)(o + 4) = curs[1]; } }
                    else if (l >= 2) { float* o = out + OUT_CS + ((size_t)((tok - TP) >> 2) * 2 + (l - 2)) * DFF + f0; *(f32x4*)o = curs[0]; *(f32x4*)(o + 4) = curs[1]; }
                }
            }
        }
    }
};
template <bool DRY> struct EpiDownT {
    static constexpr bool PERM = true, MIDK = false;
    float* h;
    DI void mid(AccT&, const Unit&, int, int, int, int) const {}
    DI void operator()(const AccT& acc, const Unit& u, int wr, int wc, int fr, int fq) const {
        const int row0 = u.pm * 256 + wr * 64 + fr, c0 = u.pn * 256 + wc * 32 + 8 * fq;
#pragma unroll
        for (int ai = 0; ai < 2; ++ai)
#pragma unroll
            for (int m = 0; m < 4; ++m) {
                const int row = row0 + ai * 128 + m * 16;
#pragma unroll
                for (int bj = 0; bj < 2; ++bj) {
                    float* hp = h + (size_t)row * DM + c0 + bj * 128;
                    const f32x4 h0 = *(const f32x4*)hp, h1 = *(const f32x4*)(hp + 4);
                    f32x4 v0 = acc[ai][bj][m][0] + h0, v1 = acc[ai][bj][m][1] + h1;
                    if (DRY && h != nullptr) { v0 = h0; v1 = h1; }
                    *(f32x4*)hp = v0; *(f32x4*)(hp + 4) = v1;
                }
            }
    }
};

struct EpiPart {
    static constexpr bool PERM = true, MIDK = false;
    float* part;
    DI void mid(AccT&, const Unit&, int, int, int, int) const {}
    DI void operator()(const AccT& acc, const Unit& u, int wr, int wc, int fr, int fq) const {
        float* base = part + (size_t)u.id * 65536 + (wr * 64 + fr) * 256 + wc * 32 + 8 * fq;
#pragma unroll
        for (int ai = 0; ai < 2; ++ai)
#pragma unroll
            for (int m = 0; m < 4; ++m)
#pragma unroll
                for (int bj = 0; bj < 2; ++bj) { float* q = base + (ai * 128 + m * 16) * 256 + bj * 128; *(f32x4*)q = acc[ai][bj][m][0]; *(f32x4*)(q + 4) = acc[ai][bj][m][1]; }
    }
};

DI void transpose_item(const float* __restrict__ src, int ldsrc, int srccol, int k0, const float* __restrict__ scale, bf16_t* dst, int lddst, int n0dst, int k0dst,
                       LAS float* scr, int lane) {
    float tv[32];
#pragma unroll
    for (int i = 0; i < 32; ++i) { const int kk = 2 * i + (lane >> 5); tv[i] = src[(size_t)(k0 + kk) * ldsrc + srccol]; }
    if (scale) {
#pragma unroll
        for (int i = 0; i < 32; ++i) tv[i] *= scale[k0 + 2 * i + (lane >> 5)];
    }
#pragma unroll
    for (int i = 0; i < 32; ++i) scr[(2 * i + (lane >> 5)) * 33 + (lane & 31)] = tv[i];
    LDS_WAIT();
    const int c = lane & 7;
#pragma unroll
    for (int j = 0; j < 4; ++j) { const int n = (lane >> 3) + 8 * j; const LAS float* s = scr + (8 * c) * 33 + n;
        u32x4 o; o.x = pk2(s[0 * 33], s[1 * 33]); o.y = pk2(s[2 * 33], s[3 * 33]); o.z = pk2(s[4 * 33], s[5 * 33]); o.w = pk2(s[6 * 33], s[7 * 33]);
        *(u32x4*)(dst + (size_t)(n0dst + n) * lddst + k0dst + 8 * c) = o; }
    LDS_WAIT();
}
DI float log_sigmoid(float z) { return fminf(z, 0.f) - __logf(1.f + __expf(-fabsf(z))); }

DI void phase0(const Params& p, LAS unsigned char* lds) {
    int tid = threadIdx.x; asm volatile("" : "+v"(tid));
    const int lane = tid & 63, wave = tid >> 6;
    unsigned char* ws = p.ws;
    LAS bf16_t* wga = (LAS bf16_t*)lds;
    LAS float* gas = (LAS float*)(lds + 33024);
    LAS float* scr = (LAS float*)(lds + 41216 + wave * 8448);
    bf16_t* xb = (bf16_t*)((unsigned char*)p.out + 0);
    float* rstd1 = (float*)(ws + WS_RSTD1); float* bcum = (float*)(ws + WS_SH); float* ebl = (float*)(ws + WS_EBL);
    { const int gt = blockIdx.x * 512 + tid, ng = gridDim.x * 512;
      float* ssq2 = (float*)(ws + WS_SSQ2);
      for (int i = gt; i < T_TOK; i += ng) ssq2[i] = 0.f;
      float* rc = (float*)(ws + WS_ROPEC); float* rsn = (float*)(ws + WS_ROPES);
      for (int i = gt; i < 2052 * 64; i += ng) { const int pi = i >> 6, fi = i & 63; const double pos = (double)(pi < 2048 ? pi : 16384 + (pi - 2048));
          const double inv = exp(-(double)fi * (9.210340371976184 / 64.0)); const double ang = pos * inv; const double kk = rint(ang * 0.15915494309189535);
          const float r = (float)(ang - kk * 6.283185307179586); rc[i] = cosf(r); rsn[i] = sinf(r); } }
    {
        LAS float* accp = (LAS float*)(lds + 41216);
        LAS float* ssp = accp + 2048;
        LAS float* tot = ssp + 128;
        for (int k = tid; k < DM; k += 512) { const float g = p.ln1[k]; const float* s = p.w_in + (size_t)k * DIN + 3584;
            const f32x4 s0 = *(const f32x4*)s, s1 = *(const f32x4*)(s + 4), s2 = *(const f32x4*)(s + 8), s3 = *(const f32x4*)(s + 12);
            const float sv[16] = {s0[0], s0[1], s0[2], s0[3], s1[0], s1[1], s1[2], s1[3], s2[0], s2[1], s2[2], s2[3], s3[0], s3[1], s3[2], s3[3]};
#pragma unroll
            for (int r = 0; r < 16; r += 2) { const unsigned w = pk2(sv[r] * g, sv[r + 1] * g); wga[r * 1032 + k] = (bf16_t)(w & 0xffffu); wga[(r + 1) * 1032 + k] = (bf16_t)(w >> 16); } }
        __syncthreads();
        for (int u = blockIdx.x; u < 264; u += gridDim.x) {
            const int r16 = lane & 15, kq = lane >> 4, rg = wave & 3, kh = wave >> 2, row = u * 64 + rg * 16 + r16;
            const float* xr = x_row(p, row) + kh * 512;
            bf16_t* xbr = xb + (size_t)row * DM + kh * 512;
            const LAS bf16_t* wgr = wga + r16 * 1032 + kh * 512;
            f32x4 acc = {0.f, 0.f, 0.f, 0.f}; float ss = 0.f;
            for (int ks = 0; ks < 16; ks += 8) {
                f32x4 v[8][2];
#pragma unroll
                for (int q = 0; q < 8; ++q) { v[q][0] = *(const f32x4*)(xr + (ks + q) * 32 + kq * 8); v[q][1] = *(const f32x4*)(xr + (ks + q) * 32 + kq * 8 + 4); }
#pragma unroll
                for (int q = 0; q < 8; ++q) {
                    const f32x4 a0 = v[q][0], a1 = v[q][1];
                    ss += a0[0] * a0[0] + a0[1] * a0[1] + a0[2] * a0[2] + a0[3] * a0[3] + a1[0] * a1[0] + a1[1] * a1[1] + a1[2] * a1[2] + a1[3] * a1[3];
                    u32x4 w; w.x = pk2(a0[0], a0[1]); w.y = pk2(a0[2], a0[3]); w.z = pk2(a1[0], a1[1]); w.w = pk2(a1[2], a1[3]);
                    *(u32x4*)(xbr + (ks + q) * 32 + kq * 8) = w;
                    const bf16x8 bfrag = *(const LAS bf16x8*)(wgr + (ks + q) * 32 + kq * 8);
                    acc = __builtin_amdgcn_mfma_f32_16x16x32_bf16(__builtin_bit_cast(bf16x8, w), bfrag, acc, 0, 0, 0);
                }
            }
            ss += __shfl_xor(ss, 16); ss += __shfl_xor(ss, 32);
            if (kq == 0) ssp[kh * 64 + rg * 16 + r16] = ss;
#pragma unroll
            for (int j = 0; j < 4; ++j) accp[(kh * 64 + rg * 16 + kq * 4 + j) * 16 + r16] = acc[j];
            __syncthreads();
#pragma unroll
            for (int e = 0; e < 2; ++e) { const int idx = tid + 512 * e, lr = idx >> 4;
                const float rs = rsqrtf((ssp[lr] + ssp[64 + lr]) * (1.f / DM) + EPS);
                gas[idx] = (accp[idx] + accp[1024 + idx]) * rs;
                if ((idx & 15) == 0) rstd1[u * 64 + lr] = rs; }
            __syncthreads();
            {
                const int c = tid & 255, half = tid >> 8;
                float wg[16];
#pragma unroll
                for (int r = 0; r < 16; ++r) wg[r] = p.w_gate_up[r * 256 + c];
                const float bias = p.b_gate_up[c];
                const int tokb = u * 64 + half * 32; const bool samp = tokb >= TP;
                float ls[32]; float cum = 0.f;
#pragma unroll
                for (int i = 0; i < 32; ++i) {
                    const LAS f32x4* gp = (const LAS f32x4*)(gas + (half * 32 + i) * 16);
                    const f32x4 g0 = gp[0], g1 = gp[1], g2 = gp[2], g3 = gp[3];
                    float z = bias;
                    z += g0[0] * wg[0] + g0[1] * wg[1] + g0[2] * wg[2] + g0[3] * wg[3] + g1[0] * wg[4] + g1[1] * wg[5] + g1[2] * wg[6] + g1[3] * wg[7];
                    z += g2[0] * wg[8] + g2[1] * wg[9] + g2[2] * wg[10] + g2[3] * wg[11] + g3[0] * wg[12] + g3[1] * wg[13] + g3[2] * wg[14] + g3[3] * wg[15];
                    ls[i] = log_sigmoid(z) * (1.f / 16.f); cum += ls[i];
                }
                if (half == 0) tot[c] = cum;
                __syncthreads();
                cum = (half == 1 && !samp) ? tot[c] : 0.f;
#pragma unroll
                for (int i = 0; i < 32; ++i) {
                    cum = (samp && (i & 3) == 0) ? ls[i] : cum + ls[i];
                    const int tok = tokb + i;
                    bcum[(size_t)tok * 256 + c] = cum;
                    if (samp) { if ((i & 3) == 3) ebl[(size_t)(256 + ((tok - TP) >> 2)) * 256 + c] = expf(cum); }
                    else if (half == 1 && i == 31) ebl[(size_t)(tok >> 6) * 256 + c] = expf(cum);
                }
            }
            __syncthreads();
        }
    }
    {
        const int gw = blockIdx.x * 8 + wave, ngw = gridDim.x * 8;
        constexpr int I_IN = 16 * 176, I_MX = 8 * 32, I_O = 16 * 32, I_UP = 16 * 176, I_DN = 44 * 32, NIT = I_IN + 2 * I_MX + I_O + I_UP + I_DN;
        for (int it = gw; it < NIT; it += ngw) {
            int r = it; const int nl = lane & 31;
            if (r < I_IN) { const int kb = r / 176, nb = r % 176, n = nb * 32 + nl; int sc;
                if (n < 1024) { const int pp = n & 127; sc = (n & ~127) + (((pp & 7) < 4) ? 4 * (pp >> 3) + (pp & 7) : 64 + 4 * (pp >> 3) + (pp & 7) - 4); }
                else sc = n < 3584 ? n : n + 16;
                transpose_item(p.w_in, DIN, sc, kb * 64, p.ln1, (bf16_t*)(ws + WS_WIN), DM, nb * 32, kb * 64, scr, lane); continue; }
            r -= I_IN;
            if (r < I_MX) { const int kb = r / 32, nb = r % 32; transpose_item(p.w_ret_out, DM, nb * 32 + nl, kb * 64, nullptr, (bf16_t*)(ws + WS_WMIX), DM, nb * 32, kb * 64, scr, lane); continue; }
            r -= I_MX;
            if (r < I_MX) { const int kb = r / 32, nb = r % 32; transpose_item(p.w_gla_out, DM, nb * 32 + nl, kb * 64, nullptr, (bf16_t*)(ws + WS_WMIX), DM, nb * 32, 512 + kb * 64, scr, lane); continue; }
            r -= I_MX;
            if (r < I_O) { const int kb = r / 32, nb = r % 32; transpose_item(p.w_o, DM, nb * 32 + nl, kb * 64, nullptr, (bf16_t*)(ws + WS_WO), DM, nb * 32, kb * 64, scr, lane); continue; }
            r -= I_O;
            if (r < I_UP) { const int kb = r / 176, nb = r % 176, n = nb * 32 + nl; const int sc = ((n >> 7) & 1) * DFF + (n >> 8) * 128 + (n & 127);
                transpose_item(p.w_up, NUP, sc, kb * 64, p.ln2, (bf16_t*)(ws + WS_WUP), DM, nb * 32, kb * 64, scr, lane); continue; }
            r -= I_UP;
            { const int kb = r / 32, nb = r % 32; transpose_item(p.w_down, DM, nb * 32 + nl, kb * 64, nullptr, (bf16_t*)(ws + WS_WDN), DFF, nb * 32, kb * 64, scr, lane); }
        }
    }
}

template <int DK> DI unsigned img_off(int row, int ch) { return (unsigned)(row * (2 * DK) + 16 * (ch ^ ((((row & 3) << 2) | ((row >> 2) & 3)) & (DK / 8 - 1)))); }
template <int DK> DI unsigned tr_addr(int lane, int c, int ks, int t) {
    const int h = lane >> 5, blk = (lane >> 4) & 1, q = (lane & 15) >> 2, pp = lane & 3;
    return img_off<DK>(16 * ks + 8 * h + 4 * t + q, 4 * c + 2 * blk + (pp >> 1)) + 8 * (pp & 1);
}
DI bf16x8 tr_frag(LAS unsigned char* a0, LAS unsigned char* a1) {
    const s16x4 lo = __builtin_amdgcn_ds_read_tr16_b64_v4i16((LAS s16x4*)a0), hi = __builtin_amdgcn_ds_read_tr16_b64_v4i16((LAS s16x4*)a1);
    return __builtin_shufflevector(lo, hi, 0, 1, 2, 3, 4, 5, 6, 7);
}
DI bf16x8 pack8(const f32x16& x, int s) {
    u32x4 w; w.x = pk2(x[8 * s + 0], x[8 * s + 1]); w.y = pk2(x[8 * s + 2], x[8 * s + 3]); w.z = pk2(x[8 * s + 4], x[8 * s + 5]); w.w = pk2(x[8 * s + 6], x[8 * s + 7]);
    return __builtin_bit_cast(bf16x8, w);
}
#define MFMA32(a, b, c) __builtin_amdgcn_mfma_f32_32x32x16_bf16((a), (b), (c), 0, 0, 0)

constexpr int P2_BUF = 49152, P2_QO = 0, P2_KO = 16384, P2_VO = 32768, P2_P = 98304, P2_SSQ = P2_P + 64 * 144, P2_EBL = P2_SSQ + 1024;

template <int DK, bool FULL> DI void chain_prompt(const Params& p, LAS unsigned char* lds, const int branch, const int b, const int head, const int c0, const int nc, const int nprev, const bool write_final) {
    constexpr int NDB = DK / 32, NCH = DK / 8, QLD = 4 * DK, NQI = (64 * NCH) / 512;
    int tid0 = threadIdx.x; asm volatile("" : "+v"(tid0));
    const int w = __builtin_amdgcn_readfirstlane(tid0 >> 6);
    int tid = tid0, lane = tid0 & 63, h = lane >> 5, r = lane & 31;
    unsigned char* ws = p.ws;
    const bf16_t* Q = (const bf16_t*)(ws + (branch == 0 ? PQ_R : PQ_G)) + head * DK;
    const bf16_t* K = (const bf16_t*)(ws + (branch == 0 ? PK_R : PK_G)) + head * DK;
    const bf16_t* V = (const bf16_t*)(ws + (branch == 0 ? PV_R : PV_G)) + head * 128;
    const bf16_t* G = (const bf16_t*)(ws + (branch == 0 ? PG_R : PG_G)) + head * 128;
    const float* ebl = (const float*)(ws + WS_EBL);
    bf16_t* arg = (bf16_t*)((unsigned char*)p.out + SEG1024) + branch * 512 + head * 128;
    const float* gain = (branch == 0 ? p.g_ret : p.g_gla) + head * 128;
    const int tok0 = b * 2048;
    const float lg2 = log2f(1.f - exp2f(-5.f - (float)head));
    const float ret_ebl = exp2f(64.f * lg2);
    const int chain = branch * 32 + b * 4 + head;
    float* Lbuf = (float*)p.out + (size_t)chain * 3 * 16384;
    float* Dbuf = (float*)p.out + (size_t)64 * 3 * 16384 + (size_t)chain * 3 * 64;
    f32x16 S[NDB];
#pragma unroll
    for (int d = 0; d < NDB; ++d)
#pragma unroll
        for (int i = 0; i < 16; ++i) S[d][i] = 0.f;
    f32x4 gn[4];
    if (w < 4) {
#pragma unroll
        for (int g = 0; g < 4; ++g) gn[g] = *(const f32x4*)(gain + 32 * w + 8 * g + 4 * h);
        if (FULL) {
            for (int sg = 0; sg < nprev; ++sg) {
#pragma unroll
                for (int d = 0; d < NDB; ++d)
#pragma unroll
                    for (int i = 0; i < 16; ++i) {
                        const int dd = 32 * d + (i & 3) + 8 * (i >> 2) + 4 * h;
                        const float dec = (DK == 128) ? exp2f(64.f * (float)nc * lg2) : Dbuf[sg * 64 + dd];
                        S[d][i] = (sg == 0 ? 0.f : S[d][i] * dec) + Lbuf[(size_t)sg * 16384 + (size_t)dd * 128 + 32 * w + r];
                    }
            }
        }
    }
    float dprod = 1.f;
    u32x4 rq[NQI], rk[NQI], rv[2]; float rebl = 0.f;
#define P2_LOAD(c) do { const int tb = tok0 + 64 * (c); \
        _Pragma("unroll") for (int i = 0; i < NQI; ++i) { const int idx = tid + 512 * i, rr = idx / NCH, ch = idx % NCH; \
            rq[i] = *(const u32x4*)(Q + (size_t)(tb + rr) * QLD + ch * 8); rk[i] = *(const u32x4*)(K + (size_t)(tb + rr) * QLD + ch * 8); } \
        _Pragma("unroll") for (int i = 0; i < 2; ++i) { const int idx = tid + 512 * i, rr = idx >> 4, ch = idx & 15; rv[i] = *(const u32x4*)(V + (size_t)(tb + rr) * 512 + ch * 8); } \
        if (DK == 64 && tid < 64) rebl = ebl[(size_t)(b * 32 + (c)) * 256 + head * 64 + tid]; } while (0)
#define P2_STORE(buf) do { LAS unsigned char* bb = lds + (buf) * P2_BUF; \
        _Pragma("unroll") for (int i = 0; i < NQI; ++i) { const int idx = tid + 512 * i, rr = idx / NCH, ch = idx % NCH; \
            *(LAS u32x4*)(bb + P2_QO + img_off<DK>(rr, ch)) = rq[i]; *(LAS u32x4*)(bb + P2_KO + img_off<DK>(rr, ch)) = rk[i]; } \
        _Pragma("unroll") for (int i = 0; i < 2; ++i) { const int idx = tid + 512 * i, rr = idx >> 4, ch = idx & 15; *(LAS u32x4*)(bb + P2_VO + img_off<128>(rr, ch)) = rv[i]; } \
        if (DK == 64 && tid < 64) *(LAS float*)(lds + P2_EBL + (buf) * 256 + tid * 4) = rebl; } while (0)
    P2_LOAD(c0); P2_STORE(c0 & 1);
    dprod *= rebl;
    __syncthreads();
    const int cend = c0 + nc;
    for (int c = c0; c < cend; ++c) {
        tid = tid0; asm volatile("" : "+v"(tid)); lane = tid & 63; h = lane >> 5; r = lane & 31;
        LAS unsigned char* bb = lds + (c & 1) * P2_BUF;
        LAS unsigned char* qi = bb + P2_QO; LAS unsigned char* ki = bb + P2_KO; LAS unsigned char* vi = bb + P2_VO;
        if (c + 1 < cend) { P2_LOAD(c + 1); dprod *= rebl; }
        u32x2 gt[2][4];
        if (FULL && w < 4) {
            {   const int tbg = tok0 + 64 * c;
#pragma unroll
                for (int ib = 0; ib < 2; ++ib)
#pragma unroll
                    for (int g = 0; g < 4; ++g) gt[ib][g] = *(const u32x2*)(G + (size_t)(tbg + 32 * ib + r) * 512 + 32 * w + 8 * g + 4 * h); }
        }
        if (FULL && w >= 4 && w < 7) {
            const int ws_ = w - 4;
            const int jb = (ws_ == 2) ? 1 : 0, ib = (ws_ == 0) ? 0 : 1;
            f32x16 pt;
#pragma unroll
            for (int i = 0; i < 16; ++i) pt[i] = 0.f;
#pragma unroll
            for (int s = 0; s < DK / 16; ++s) {
                const bf16x8 a = *(const LAS bf16x8*)(ki + img_off<DK>(32 * jb + r, 2 * s + h)), bq = *(const LAS bf16x8*)(qi + img_off<DK>(32 * ib + r, 2 * s + h));
                pt = MFMA32(a, bq, pt);
            }
            if (jb == ib) {
#pragma unroll
                for (int i = 0; i < 16; ++i) { const int j = (i & 3) + 8 * (i >> 2) + 4 * h; pt[i] = (j <= r) ? pt[i] : 0.f; }
            }
#pragma unroll
            for (int g = 0; g < 4; ++g) { u32x2 o; o.x = pk2(pt[4 * g], pt[4 * g + 1]); o.y = pk2(pt[4 * g + 2], pt[4 * g + 3]);
                *(LAS u32x2*)(lds + P2_P + (32 * ib + r) * 144 + (32 * jb + 8 * g + 4 * h) * 2) = o; }
        }
        f32x16 ot[2];
        bf16x8 vf[4];
        if (w < 4) {
#pragma unroll
            for (int s = 0; s < 4; ++s) vf[s] = tr_frag(vi + tr_addr<128>(lane, w, s, 0), vi + tr_addr<128>(lane, w, s, 1));
#pragma unroll
            for (int ib = 0; ib < 2; ++ib)
#pragma unroll
                for (int i = 0; i < 16; ++i) ot[ib][i] = 0.f;
            if (FULL)
#pragma unroll
            for (int d = 0; d < NDB; ++d)
#pragma unroll
                for (int s2 = 0; s2 < 2; ++s2) {
                    const bf16x8 sfr = pack8(S[d], s2);
#pragma unroll
                    for (int ib = 0; ib < 2; ++ib) {
                        const s16x4 lo = *(const LAS s16x4*)(qi + img_off<DK>(32 * ib + r, 4 * d + 2 * s2) + 8 * h), hi = *(const LAS s16x4*)(qi + img_off<DK>(32 * ib + r, 4 * d + 2 * s2 + 1) + 8 * h);
                        const bf16x8 bq = __builtin_shufflevector(lo, hi, 0, 1, 2, 3, 4, 5, 6, 7);
                        ot[ib] = MFMA32(sfr, bq, ot[ib]);
                    }
                }
#pragma unroll
            for (int d = 0; d < NDB; ++d) {
#pragma unroll
                for (int s = 0; s < 4; ++s) {
                    const bf16x8 a = tr_frag(ki + tr_addr<DK>(lane, d, s, 0), ki + tr_addr<DK>(lane, d, s, 1));
                    S[d] = MFMA32(a, vf[s], S[d]);
                }
                if (DK == 128) {
#pragma unroll
                    for (int i = 0; i < 16; ++i) S[d][i] *= ret_ebl;
                } else {
                    const LAS float* eb = (const LAS float*)(lds + P2_EBL + (c & 1) * 256) + 32 * d + 4 * h;
#pragma unroll
                    for (int g = 0; g < 4; ++g) { const f32x4 e4 = *(const LAS f32x4*)(eb + 8 * g);
#pragma unroll
                        for (int e = 0; e < 4; ++e) S[d][4 * g + e] *= e4[e]; }
                }
            }
        }
        if (FULL) __syncthreads();
        if (FULL && w < 4) {
#pragma unroll
            for (int ib = 0; ib < 2; ++ib) {
#pragma unroll
                for (int s = 0; s < (ib == 0 ? 2 : 4); ++s) {
                    const bf16x8 bp = *(const LAS bf16x8*)(lds + P2_P + (32 * ib + r) * 144 + (16 * s + 8 * h) * 2);
                    ot[ib] = MFMA32(vf[s], bp, ot[ib]);
                }
            }
#pragma unroll
            for (int ib = 0; ib < 2; ++ib) { float ss = 0.f;
#pragma unroll
                for (int i = 0; i < 16; ++i) ss += ot[ib][i] * ot[ib][i];
                ss += __shfl_xor(ss, 32);
                if (h == 0) *(LAS float*)(lds + P2_SSQ + (w * 64 + 32 * ib + r) * 4) = ss; }
        }
        if (c + 1 < cend) P2_STORE((c + 1) & 1);
        __syncthreads();
        if (FULL && w < 4) {
            asm volatile("" : "+v"(lane)); h = lane >> 5; r = lane & 31;
            const int tb = tok0 + 64 * c;
#pragma unroll
            for (int ib = 0; ib < 2; ++ib) {
                const LAS float* sq = (const LAS float*)(lds + P2_SSQ) + 32 * ib + r;
                const float tot = sq[0] + sq[64] + sq[128] + sq[192];
                const float rs = rsqrtf(tot * (1.f / 128.f) + EPS);
#pragma unroll
                for (int g = 0; g < 4; ++g) {
                    const u32x2 gg = gt[ib][g];
                    u32x2 o; o.x = pk2(ot[ib][4 * g] * rs * gn[g][0] * bflo(gg.x), ot[ib][4 * g + 1] * rs * gn[g][1] * bfhi(gg.x));
                    o.y = pk2(ot[ib][4 * g + 2] * rs * gn[g][2] * bflo(gg.y), ot[ib][4 * g + 3] * rs * gn[g][3] * bfhi(gg.y));
                    *(u32x2*)(arg + (size_t)(tb + 32 * ib + r) * 1024 + 32 * w + 8 * g + 4 * h) = o;
                }
            }
        }
    }
#undef P2_LOAD
#undef P2_STORE
    if (!FULL && DK == 64 && tid0 < 64) Dbuf[nprev * 64 + tid0] = dprod;
    if (w < 4 && (write_final || !FULL)) {
        lane = tid0 & 63; h = lane >> 5; r = lane & 31;
        float* so = FULL ? p.out + (branch == 0 ? OUT_RSP : OUT_GSP) + (size_t)(b * 4 + head) * DK * 128 : Lbuf + (size_t)nprev * 16384;
#pragma unroll
        for (int d = 0; d < NDB; ++d)
#pragma unroll
            for (int i = 0; i < 16; ++i) so[(size_t)(32 * d + (i & 3) + 8 * (i >> 2) + 4 * h) * 128 + 32 * w + r] = S[d][i];
    }
    __syncthreads();
}

template <int DK> DI void sample_unit(const Params& p, LAS unsigned char* lds, const int branch, const int b, const int head) {
    int tid = threadIdx.x; asm volatile("" : "+v"(tid));
    unsigned char* ws = p.ws;
    const bf16_t* Q = (const bf16_t*)(ws + (branch == 0 ? PQ_R : PQ_G)) + head * DK;
    const bf16_t* K = (const bf16_t*)(ws + (branch == 0 ? PK_R : PK_G)) + head * DK;
    const bf16_t* V = (const bf16_t*)(ws + (branch == 0 ? PV_R : PV_G)) + head * 128;
    const bf16_t* G = (const bf16_t*)(ws + (branch == 0 ? PG_R : PG_G)) + head * 128;
    bf16_t* arg = (bf16_t*)((unsigned char*)p.out + SEG1024) + branch * 512 + head * 128;
    const float* gain = (branch == 0 ? p.g_ret : p.g_gla) + head * 128;
    const float* sin_ = (branch == 0 ? p.state_ret : p.state_gla) + (size_t)(b * 4 + head) * DK * 128;
    float* sout = p.out + (branch == 0 ? OUT_RSS : OUT_GSS) + (size_t)(b * 4 + head) * DK * 128;
    const int tok0 = TP + 4 * b;
    LAS float* qs = (LAS float*)lds;
    LAS float* ks = qs + 4 * 128;
    LAS float* vs = ks + 4 * 128;
    LAS float* es = vs + 4 * 128;
    LAS float* Ps = es + 128;
    LAS float* ssq = Ps + 16;
    LAS float* op = ssq + 16;
    for (int i = tid; i < 4 * DK; i += 512) { const int t = i / DK, d = i % DK;
        qs[t * DK + d] = __uint_as_float((unsigned)Q[(size_t)(tok0 + t) * (4 * DK) + d] << 16); ks[t * DK + d] = __uint_as_float((unsigned)K[(size_t)(tok0 + t) * (4 * DK) + d] << 16); }
    { const int t = tid >> 7, v = tid & 127; vs[t * 128 + v] = __uint_as_float((unsigned)V[(size_t)(tok0 + t) * 512 + v] << 16); }
    if (tid < DK) {
        if (DK == 128) { const float lg2 = log2f(1.f - exp2f(-5.f - (float)head)); es[tid] = exp2f(4.f * lg2); }
        else es[tid] = ((const float*)(ws + WS_EBL))[(size_t)(256 + b) * 256 + head * 64 + tid];
    }
    __syncthreads();
    if (tid < 16) { const int i = tid >> 2, j = tid & 3; float s = 0.f; if (j <= i) { for (int d = 0; d < DK; ++d) s += qs[i * DK + d] * ks[j * DK + d]; } Ps[tid] = s; }
    {
        const int vq = tid & 31, dg = tid >> 5;
        f32x4 oa[4];
#pragma unroll
        for (int i = 0; i < 4; ++i) oa[i] = (f32x4){0.f, 0.f, 0.f, 0.f};
        f32x4 v4[4];
#pragma unroll
        for (int j = 0; j < 4; ++j) v4[j] = *(const LAS f32x4*)(vs + j * 128 + 4 * vq);
        f32x4 s0[DK / 16];
#pragma unroll
        for (int rr = 0; rr < DK / 16; ++rr) s0[rr] = *(const f32x4*)(sin_ + (size_t)(dg + 16 * rr) * 128 + 4 * vq);
#pragma unroll
        for (int rr = 0; rr < DK / 16; ++rr) {
            const int d = dg + 16 * rr;
            f32x4 sn = s0[rr];
#pragma unroll
            for (int i = 0; i < 4; ++i) { oa[i] += s0[rr] * qs[i * DK + d]; sn += v4[i] * ks[i * DK + d]; }
            sn *= es[d];
            *(f32x4*)(sout + (size_t)d * 128 + 4 * vq) = sn;
        }
#pragma unroll
        for (int i = 0; i < 4; ++i) *(LAS f32x4*)(op + (dg * 4 + i) * 128 + 4 * vq) = oa[i];
    }
    __syncthreads();
    {
        const int i = tid >> 7, v = tid & 127;
        float o = 0.f;
#pragma unroll
        for (int dg = 0; dg < 16; ++dg) o += op[(dg * 4 + i) * 128 + v];
#pragma unroll
        for (int j = 0; j < 4; ++j) o += Ps[i * 4 + j] * vs[j * 128 + v];
        const float s = wave_sum(o * o);
        if ((tid & 63) == 0) ssq[tid >> 6] = s;
        __syncthreads();
        const float rs = rsqrtf((ssq[2 * i] + ssq[2 * i + 1]) * (1.f / 128.f) + EPS);
        const float gate = __uint_as_float((unsigned)G[(size_t)(tok0 + i) * 512 + v] << 16);
        const unsigned wv = pk2(o * rs * gain[v] * gate, 0.f);
        arg[(size_t)(tok0 + i) * 1024 + v] = (bf16_t)(wv & 0xffffu);
    }
    __syncthreads();
}

template <bool FULL> DI void chain_call(const Params& p, LAS unsigned char* lds, int chain, int c0, int nc, int nprev, bool wf) {
    const int branch = chain >> 5, bh = chain & 31;
    if (branch == 0) chain_prompt<128, FULL>(p, lds, 0, bh >> 2, bh & 3, c0, nc, nprev, wf); else chain_prompt<64, FULL>(p, lds, 1, bh >> 2, bh & 3, c0, nc, nprev, wf);
}
DI void sample_call(const Params& p, LAS unsigned char* lds, int u) {
    const int branch = u >> 9, bh = u & 511;
    if (branch == 0) sample_unit<128>(p, lds, 0, bh >> 2, bh & 3); else sample_unit<64>(p, lds, 1, bh >> 2, bh & 3);
}
DI void phase2(const Params& p, LAS unsigned char* lds, const XcdBarrier& xbar) {
    const int G = gridDim.x, bx = blockIdx.x;
    if (G == 256) {
        const int chain = bx & 63, seg = bx >> 6;
        if (seg < 3) chain_call<false>(p, lds, chain, 8 * seg, 8, seg, false);
        else { sample_call(p, lds, bx - 192); sample_call(p, lds, bx - 192 + 64); }
        xcd_barrier(xbar);
        chain_call<true>(p, lds, chain, 8 * seg, 8, seg, seg == 3);
        for (int u = 128 + bx; u < 1024; u += 256) sample_call(p, lds, u);
    } else {
        for (int c = bx; c < 64; c += G) chain_call<true>(p, lds, c, 0, 32, 0, true);
        for (int u = bx; u < 1024; u += G) sample_call(p, lds, u);
    }
}

template <bool DRY> DI void phase_final(const Params& p) {
    const int lane = threadIdx.x & 63, gw = blockIdx.x * 8 + (threadIdx.x >> 6), ngw = gridDim.x * 8;
    for (int row = gw; row < T_TOK; row += ngw) {
        f32x4* hp = (f32x4*)(p.out + (size_t)row * DM) + lane;
        f32x4 v[4]; float s = 0.f;
#pragma unroll
        for (int j = 0; j < 4; ++j) v[j] = hp[64 * j];
        if (row >= TP) {
            const float* part = (const float*)(p.ws + WS_PART) + (size_t)((row - TP) & 255) * 256 + 4 * lane;
#pragma unroll
            for (int j = 0; j < 4; ++j) { const int su = ((row - TP) >> 8) * 4 + j;
                for (int kp = 0; kp < 11; ++kp) v[j] += *(const f32x4*)(part + (size_t)(su * 11 + kp) * 65536); }
        }
#pragma unroll
        for (int j = 0; j < 4; ++j) s += v[j][0] * v[j][0] + v[j][1] * v[j][1] + v[j][2] * v[j][2] + v[j][3] * v[j][3];
        const float rs = rsqrtf(wave_sum(s) * (1.f / DM) + EPS);
#pragma unroll
        for (int j = 0; j < 4; ++j) { const f32x4 g = *((const f32x4*)p.ln_f + lane + 64 * j); f32x4 o = v[j] * rs * g; if (DRY && p.out != nullptr) o = v[j]; hp[64 * j] = o; }
    }
}

__global__ void __launch_bounds__(512, 2) fwd_megakernel(Params p) {
    extern __shared__ __attribute__((aligned(16))) unsigned char shm[];
    LAS unsigned char* lds = (LAS unsigned char*)shm;
    cg::grid_group grid = cg::this_grid();
    if (p.ws == nullptr) grid.sync();
    if (threadIdx.x < 4) ((LAS unsigned*)(lds + 131072 + 4096))[threadIdx.x] = 0u;
    __syncthreads();
    const XcdBarrier xbar = xcd_barrier_post((unsigned*)(p.ws + WS_BAR), (volatile LAS unsigned*)(lds + 131072 + 4096));
    unsigned char* ws = p.ws;
    const int G = gridDim.x, bx = blockIdx.x;
    bf16_t* xb = (bf16_t*)p.out;
    bf16_t* arg = (bf16_t*)((unsigned char*)p.out + SEG1024);

#ifndef PHMASK
#define PHMASK 0x1ff
#endif
#define PH(n) if ((PHMASK >> (n)) & 1)
    PH(0) phase0(p, lds);
    xcd_barrier(xbar);
#if defined(DUP_PH) && DUP_PH == 0
    phase0(p, lds);
    xcd_barrier(xbar);
#endif
    PH(1) {
        pg8::Gemm g{xb, (const bf16_t*)(ws + WS_WIN), T_TOK, NPROJ, DM, DM, DM, 256}; pg8::StaticOrder S; S.init(T_TOK, NPROJ, G, bx);
        EpiProj E{ws, (const float*)(ws + WS_RSTD1), (const float*)(ws + WS_SH), (const float*)(ws + WS_ROPEC), (const float*)(ws + WS_ROPES)};
        pg8::gemm_phase<EpiProj, pg8::StaticOrder, 16>(lds, g, S, E);
#if defined(DUP_PH) && DUP_PH == 1
        xcd_barrier(xbar);
        pg8::gemm_phase<EpiProj, pg8::StaticOrder, 16>(lds, g, S, E);
#endif
    }
    xcd_barrier(xbar);
    PH(2) phase2(p, lds, xbar);
    xcd_barrier(xbar);
#if defined(DUP_PH) && DUP_PH == 2
    phase2(p, lds, xbar);
    xcd_barrier(xbar);
#endif
    PH(3) {
        pg8::Gemm g{arg, (const bf16_t*)(ws + WS_WMIX), T_TOK, DM, DM, DM, DM, 256}; pg8::StaticOrder S; S.init(T_TOK, DM, G, bx);
        EpiMix E{(const bf16_t*)(ws + PM_R), (const bf16_t*)(ws + PM_G), (bf16_t*)(ws + WS_MIX)};
        pg8::gemm_phase<EpiMix, pg8::StaticOrder, 16>(lds, g, S, E);
#if defined(DUP_PH) && DUP_PH == 3
        xcd_barrier(xbar);
        pg8::gemm_phase<EpiMix, pg8::StaticOrder, 16>(lds, g, S, E);
#endif
    }
    xcd_barrier(xbar);
    PH(4) {
        pg8::Gemm g{(const bf16_t*)(ws + WS_MIX), (const bf16_t*)(ws + WS_WO), T_TOK, DM, DM, DM, DM, 256}; pg8::StaticOrder S; S.init(T_TOK, DM, G, bx);
        EpiH E{p.x_prompt, p.x_sample, p.out, (bf16_t*)(ws + WS_SH), (float*)(ws + WS_SSQ2)};
        pg8::gemm_phase<EpiH, pg8::StaticOrder, 16>(lds, g, S, E);
    }
    xcd_barrier(xbar);
    PH(5) {
        pg8::Gemm g{(const bf16_t*)(ws + WS_SH) - 2 * DM, (const bf16_t*)(ws + WS_WUP), T_TOK, NUP, DM, DM, DM, 254}; pg8::StaticOrder S; S.init_tiles(67, 22, G, bx);
        EpiUpConv E{(const float*)(ws + WS_SSQ2), (bf16_t*)(ws + WS_ACT), p.conv_w, p.conv_b, p.cache_conv, p.out, (LAS float*)(lds + 131072)};
        pg8::gemm_phase<EpiUpConv, pg8::StaticOrder, 16>(lds, g, S, E);
#if defined(DUP_PH) && DUP_PH == 5
        xcd_barrier(xbar);
        pg8::gemm_phase<EpiUpConv, pg8::StaticOrder, 16>(lds, g, S, E);
#endif
    }
    xcd_barrier(xbar);
    PH(7) {
        pg8::Gemm g{(const bf16_t*)(ws + WS_ACT), (const bf16_t*)(ws + WS_WDN), T_TOK, DM, DFF, DFF, DFF, 256}; pg8::StaticOrder S; S.init_tiles(64, 4, G, bx);
#if defined(DUP_PH) && DUP_PH == 7
        { EpiDownT<true> E0{p.out}; pg8::gemm_phase<EpiDownT<true>, pg8::StaticOrder, 44>(lds, g, S, E0); xcd_barrier(xbar); }
#endif
        EpiDownT<false> E{p.out};
        pg8::gemm_phase<EpiDownT<false>, pg8::StaticOrder, 44>(lds, g, S, E);
        {
            pg8::PieceOrder S2{G, bx}; EpiPart E2{(float*)(ws + WS_PART)};
            pg8::gemm_phase<EpiPart, pg8::PieceOrder, 4>(lds, g, S2, E2); }
    }
    xcd_barrier(xbar);
#if defined(DUP_PH) && DUP_PH == 8
    phase_final<true>(p);
    xcd_barrier(xbar);
#endif
    PH(8) phase_final<false>(p);
}

extern "C" void kernel_launch(void* const* d_in, const int* in_sizes, int n_in, void* d_out, int out_size, void* d_ws, size_t ws_size, hipStream_t stream) {
    static int grid = 0;
    if (grid == 0) {
        if (n_in != 20 || out_size != (int)OUT_END || ws_size < WS_END) { fprintf(stderr, "kernel_launch: unexpected shapes (n_in %d, out %d, ws %zu)\n", n_in, out_size, ws_size); grid = -1; return; }
        int dev = 0, cus = 0, per_cu = 0;
        hipGetDevice(&dev);
        hipDeviceGetAttribute(&cus, hipDeviceAttributeMultiprocessorCount, dev);
        if (hipFuncSetAttribute((const void*)fwd_megakernel, hipFuncAttributeMaxDynamicSharedMemorySize, LDS_BYTES) != hipSuccess) { fprintf(stderr, "kernel_launch: hipFuncSetAttribute failed\n"); grid = -1; return; }
        hipOccupancyMaxActiveBlocksPerMultiprocessor(&per_cu, (const void*)fwd_megakernel, 512, LDS_BYTES);
        if (per_cu < 1) { fprintf(stderr, "kernel_launch: occupancy query gave %d\n", per_cu); per_cu = 1; }
        grid = cus * 1;
        (void)hipGetLastError();
    }
    if (grid < 0) return;
    Params p{};
    const float** f = (const float**)&p;
    for (int i = 0; i < 20; ++i) f[i] = (const float*)d_in[i];
    p.out = (float*)d_out; p.ws = (unsigned char*)d_ws;
    if (hipMemsetAsync((unsigned char*)d_ws + WS_BAR, 0, 16384, stream) != hipSuccess) { fprintf(stderr, "kernel_launch: memset failed\n"); return; }
    void* args[] = {&p};
    hipError_t e = hipLaunchCooperativeKernel((const void*)fwd_megakernel, dim3(grid), dim3(512), args, LDS_BYTES, stream);
    if (e != hipSuccess) fprintf(stderr, "cooperative launch failed: %s (grid %d)\n", hipGetErrorString(e), grid);
}
```

```cpp
#include <hip/hip_runtime.h>
#include <hip/hip_cooperative_groups.h>
#include <cstdio>
namespace cg = cooperative_groups;

#define LAS __attribute__((address_space(3)))
#define DI __device__ __forceinline__
typedef unsigned short bf16_t;
typedef short bf16x8 __attribute__((ext_vector_type(8)));
typedef short s16x4 __attribute__((ext_vector_type(4)));
typedef float f32x4 __attribute__((ext_vector_type(4)));
typedef float f32x2 __attribute__((ext_vector_type(2)));
typedef float f32x16 __attribute__((ext_vector_type(16)));
typedef unsigned u32x4 __attribute__((ext_vector_type(4)));
typedef unsigned u32x2 __attribute__((ext_vector_type(2)));
typedef __bf16 bf16x2_t __attribute__((ext_vector_type(2)));

constexpr int T_TOK = 16896, TP = 16384, DM = 1024, DIN = 5648, NPROJ = 5632, DFF = 2816, NUP = 5632;
constexpr float EPS = 1e-6f;
constexpr size_t OUT_Y = 0, OUT_RSP = 17301504, OUT_RSS = OUT_RSP + 524288, OUT_GSP = OUT_RSS + 8388608, OUT_GSS = OUT_GSP + 262144,
                 OUT_CP = OUT_GSS + 4194304, OUT_CS = OUT_CP + 45056, OUT_END = OUT_CS + 720896;
constexpr size_t WS_WIN = 0, WS_WMIX = WS_WIN + (size_t)NPROJ * DM * 2, WS_WO = WS_WMIX + (size_t)DM * DM * 2, WS_WUP = WS_WO + (size_t)DM * DM * 2,
                 WS_WDN = WS_WUP + (size_t)NUP * DM * 2, WS_PROJ = WS_WDN + (size_t)DM * DFF * 2;
constexpr size_t SEG512 = (size_t)T_TOK * 512 * 2, SEG256 = (size_t)T_TOK * 256 * 2, SEG1024 = (size_t)T_TOK * 1024 * 2;
constexpr size_t PQ_R = WS_PROJ, PK_R = PQ_R + SEG512, PV_R = PK_R + SEG512, PG_R = PV_R + SEG512, PQ_G = PG_R + SEG512, PK_G = PQ_G + SEG256,
                 PV_G = PK_G + SEG256, PG_G = PV_G + SEG512, PM_R = PG_G + SEG512, PM_G = PM_R + SEG1024, WS_PROJ_END = PM_G + SEG1024;
constexpr size_t WS_MIX = PQ_R;
constexpr size_t WS_PART = WS_PROJ + (size_t)T_TOK * DFF * 2;
static_assert(WS_PART + (size_t)88 * 65536 * 4 <= WS_PROJ_END, "partials");
constexpr size_t WS_ACT = WS_PROJ;
constexpr size_t WS_SH = WS_PROJ_END;
constexpr size_t WS_RSTD1 = WS_SH + SEG1024, WS_SSQ2 = WS_RSTD1 + (size_t)T_TOK * 4, WS_EBL = WS_SSQ2 + (size_t)T_TOK * 4,
                 WS_ROPEC = WS_EBL + (size_t)384 * 256 * 4, WS_ROPES = WS_ROPEC + (size_t)2052 * 64 * 4, WS_BAR = WS_ROPES + (size_t)2052 * 64 * 4, WS_CNT = WS_BAR + 16384  ,
                 WS_EXCH = WS_CNT + 8192  , WS_END = WS_EXCH + (size_t)TP * 16;
static_assert(WS_PROJ_END - WS_PROJ == (size_t)T_TOK * NPROJ * 2, "proj layout");
static_assert(WS_END <= (size_t)256 * 1024 * 1024, "workspace");
constexpr int LDS_BYTES = 131072 + 4096 + 16;

struct Params {
    const float *x_prompt, *x_sample, *state_ret, *state_gla, *cache_conv, *ln1, *w_in, *w_gate_up, *b_gate_up, *g_ret, *g_gla, *w_ret_out, *w_gla_out,
        *w_o, *ln2, *w_up, *conv_w, *conv_b, *w_down, *ln_f;
    float* out; unsigned char* ws;
};

DI unsigned pk2(float lo, float hi) { f32x2 v = {lo, hi}; bf16x2_t b = __builtin_convertvector(v, bf16x2_t); return __builtin_bit_cast(unsigned, b); }
DI float bflo(unsigned w) { return __uint_as_float(w << 16); }
DI float bfhi(unsigned w) { return __uint_as_float(w & 0xffff0000u); }
DI float wave_sum(float v) {
#pragma unroll
    for (int o = 1; o < 64; o <<= 1) v += __shfl_xor(v, o);
    return v;
}
DI float sigmoidf_(float x) { return __builtin_amdgcn_rcpf(1.f + __expf(-x)); }
DI const float* x_row(const Params& p, int tok) { return tok < TP ? p.x_prompt + (size_t)tok * DM : p.x_sample + (size_t)(tok - TP) * DM; }
#define LDS_WAIT() asm volatile("s_waitcnt lgkmcnt(0)" ::: "memory")

#define XB_TMO      128
#define XB_XCNT(j)  (256  + 64 * (j))
#define XB_XSUB(j)  (1280 + 64 * (j))
#define XB_XGEN(j)  (2304 + 64 * (j))
#define XB_TOP      3328
#define XB_TOPGEN   3392
#define XCD_BAR_WORDS 3456
#define XB_SPIN_CAP (1u << 22)
DI unsigned xb_ld(unsigned* p) { return __hip_atomic_load(p, __ATOMIC_RELAXED, __HIP_MEMORY_SCOPE_AGENT); }
DI unsigned xb_add(unsigned* p, unsigned v) { return __hip_atomic_fetch_add(p, v, __ATOMIC_RELAXED, __HIP_MEMORY_SCOPE_AGENT); }
DI unsigned xb_xcc_id() { return (unsigned)__builtin_amdgcn_s_getreg((3 << 11) | 20) & 0xFu; }
#define XB_SPIN(cond, bar) do { unsigned _sp = 0; while (cond) { __builtin_amdgcn_s_sleep(1); \
    if ((++_sp & 255u) == 0u) { if (xb_ld(&(bar)[XB_TMO])) break; if (_sp > XB_SPIN_CAP) { atomicAdd(&(bar)[XB_TMO], 1u); break; } } } } while (0)
struct XcdBarrier { unsigned* bar; unsigned x; volatile LAS unsigned* st; };
DI XcdBarrier xcd_barrier_post(unsigned* bar, volatile LAS unsigned* st) {
    XcdBarrier b; b.bar = bar; b.x = xb_xcc_id(); b.st = st;
    if (threadIdx.x == 0) (void)xb_add(&bar[XB_XCNT(b.x)], 1u);
    return b;
}
DI void xcd_barrier_complete(unsigned* bar, unsigned x, unsigned& nloc, unsigned& nx) {
    const unsigned G = gridDim.x * gridDim.y * gridDim.z;
    unsigned sum, cnt, mine, sp = 0u;
    for (;;) {
        sum = 0u; cnt = 0u; mine = 0u;
#pragma unroll
        for (unsigned j = 0; j < 16; ++j) { const unsigned c = xb_ld(&bar[XB_XCNT(j)]); sum += c; cnt += (c > 0u) ? 1u : 0u; mine = (j == x) ? c : mine; }
        if (sum == G) break;
        __builtin_amdgcn_s_sleep(1);
        if ((++sp & 255u) == 0u) { if (xb_ld(&bar[XB_TMO])) break; if (sp > XB_SPIN_CAP) { atomicAdd(&bar[XB_TMO], 1u); break; } }
    }
    nloc = mine > 0u ? mine : 1u; nx = cnt > 0u ? cnt : 1u;
}
DI void xcd_barrier(const XcdBarrier& b) {
    asm volatile("s_waitcnt vmcnt(0)" ::: "memory");
    __syncthreads();
    if (threadIdx.x == 0) {
        unsigned* bar = b.bar;
        __builtin_amdgcn_s_waitcnt(0);
        unsigned nloc = b.st[0], nx = b.st[1];
        if (nloc == 0u) { xcd_barrier_complete(bar, b.x, nloc, nx); b.st[0] = nloc; b.st[1] = nx; }
        const unsigned old = xb_add(&bar[XB_XSUB(b.x)], 1u);
        const unsigned gen = old / nloc;
        if (old + 1u == (gen + 1u) * nloc) {
            __builtin_amdgcn_fence(__ATOMIC_RELEASE, "agent");
            asm volatile("s_waitcnt vmcnt(0)" ::: "memory");
            const unsigned og = xb_add(&bar[XB_TOP], 1u);
            const unsigned tg = og / nx;
            if (og + 1u == (tg + 1u) * nx) xb_add(&bar[XB_TOPGEN], 1u);
            else XB_SPIN(xb_ld(&bar[XB_TOPGEN]) == tg, bar);
            __builtin_amdgcn_fence(__ATOMIC_ACQUIRE, "agent");
            xb_add(&bar[XB_XGEN(b.x)], 1u);
            asm volatile("s_waitcnt vmcnt(0)" ::: "memory");
        } else {
            XB_SPIN(xb_ld(&bar[XB_XGEN(b.x)]) == gen, bar);
            __builtin_amdgcn_fence(__ATOMIC_ACQUIRE, "agent");
            asm volatile("s_waitcnt vmcnt(0)" ::: "memory");
        }
    }
    __syncthreads();
}

namespace pg8 {
constexpr int BM = 256, BK = 64, HALF = 128, HTB = HALF * BK * 2, STAGE_BYTES = 8 * HTB, NXCD = 8, WGM = 8;
DI int lds_byte(int r, int c) { const int st = (r >> 4) * 2 + (c >> 5), rr = r & 15, cc = c & 31, ob = rr * 64 + cc * 2; return st * 1024 + (ob ^ (((ob >> 9) & 1) << 5)); }
DI void stage_rc(int b, int& R, int& C) { const int st = b / 1024, sb = b % 1024, swz = sb ^ (((sb >> 9) & 1) << 5); R = (st >> 1) * 16 + swz / 64; C = (st & 1) * 32 + (swz % 64) / 2; }
DI int perm32(int rho) { const int n = rho >> 4, i = rho & 15; return 8 * (i >> 2) + 4 * n + (i & 3); }
struct Unit { int pm, pn, kt0, id; };
struct Gemm { const bf16_t* A; const bf16_t* Bt; int M, N, K, lda, ldb, mstep; };
struct StaticOrder {
    int nM, nN, nwg, G, c;
    DI void init(int M, int N, int G_, int c_) { nM = M / BM; nN = N / BM; nwg = nM * nN; G = G_; c = c_; }
    DI void init_tiles(int nM_, int nN_, int G_, int c_) { nM = nM_; nN = nN_; nwg = nM * nN; G = G_; c = c_; }
    DI bool next(int i, Unit& u) const {
        u.kt0 = 0; u.id = 0; u.pm = 0; u.pn = 0;
        const long L = (long)i * G + c; if (L >= nwg) return false;
        int wgid = (int)L; { const int q = nwg / NXCD, r = nwg % NXCD, xcd = wgid % NXCD, off = wgid / NXCD; wgid = (xcd < r ? xcd * (q + 1) : r * (q + 1) + (xcd - r) * q) + off; }
        const int nig = WGM * nN, gid = wgid / nig, fm = gid * WGM, gsz = (nM - fm) < WGM ? (nM - fm) : WGM;
        u.pm = fm + ((wgid % nig) % gsz); u.pn = (wgid % nig) / gsz; return true;
    }
};
struct PieceOrder {
    int G, c;
    DI bool next(int i, Unit& u) const {
        const int pid = c + i * G; const int su = pid / 11;
        u.pm = 64 + (su >> 2); u.pn = su & 3; u.kt0 = (pid - su * 11) * 4; u.id = pid;
        return pid < 88;
    }
};
template <class Epi, class Sched, int NT>
DI void gemm_phase(LAS unsigned char* lds, const Gemm g, const Sched& S, const Epi& E) {
    int tid = threadIdx.x; asm volatile("" : "+v"(tid));
    const int wid = __builtin_amdgcn_readfirstlane(tid >> 6), lane = tid & 63, wr = wid >> 2, wc = wid & 3, fr = lane & 15, fq = lane >> 4;
    constexpr int nt = NT;
    unsigned voffA[2], voffB[2];
#pragma unroll
    for (int i = 0; i < 2; ++i) { int R, C; stage_rc(tid * 16 + i * 8192, R, C); const int Rb = Epi::PERM ? ((R & ~31) + perm32(R & 31)) : R;
        voffA[i] = (unsigned)(R * g.lda + C) * 2u; voffB[i] = (unsigned)(Rb * g.ldb + C) * 2u; }
    const size_t kstep = (size_t)(BK * 2);
    const size_t hstepA = (size_t)HALF * g.lda * 2, hstepB = (size_t)HALF * g.ldb * 2;
    const size_t tstepA = (size_t)g.mstep * g.lda * 2, tstepB = 2 * hstepB;
    const unsigned ldsw = (unsigned)wid * 1024u;
    const int aoff = lds_byte(wr * 64 + fr, fq * 8), boff = lds_byte(wc * 32 + fr, fq * 8);
#define PG8_SA(b, h) (((b) * 2 + (h)) * HTB)
#define PG8_SB(b, h) ((4 + (b) * 2 + (h)) * HTB)
#define PG8_STAGE(bufoff, gbase, voff) do { _Pragma("unroll") for (int _i = 0; _i < 2; ++_i) \
        __builtin_amdgcn_global_load_lds((const unsigned*)((const char*)(gbase) + (voff)[_i]), (LAS unsigned*)(lds + (bufoff) + ldsw + _i * 8192), 16, 0, 0); } while (0)
#define PG8_LDA(dst, b, h) do { _Pragma("unroll") for (int m = 0; m < 4; ++m) _Pragma("unroll") for (int k = 0; k < 2; ++k) dst[m][k] = *(const LAS bf16x8*)(lds + PG8_SA(b, h) + aoff + m * 2048 + k * 1024); } while (0)
#define PG8_LDB(dst, b, h) do { _Pragma("unroll") for (int n = 0; n < 2; ++n) _Pragma("unroll") for (int k = 0; k < 2; ++k) dst[n][k] = *(const LAS bf16x8*)(lds + PG8_SB(b, h) + boff + n * 2048 + k * 1024); } while (0)
#define PG8_MMA(ai, bj, At, Bt) do { __builtin_amdgcn_s_setprio(1); _Pragma("unroll") for (int m = 0; m < 4; ++m) _Pragma("unroll") for (int n = 0; n < 2; ++n) _Pragma("unroll") for (int k = 0; k < 2; ++k) \
        acc[ai][bj][m][n] = __builtin_amdgcn_mfma_f32_16x16x32_bf16(Bt[n][k], At[m][k], acc[ai][bj][m][n], 0, 0, 0); __builtin_amdgcn_s_setprio(0); } while (0)
#define PG8_WAIT_V(n) asm volatile("s_waitcnt vmcnt(" #n ")" ::: "memory")
#define PG8_WAIT_L(n) asm volatile("s_waitcnt lgkmcnt(" #n ")" ::: "memory")
#define PG8_BAR __builtin_amdgcn_s_barrier()
#define PG8_SCHED __builtin_amdgcn_sched_barrier(0)
    Unit cur, nxt; int ui = 0;
    if (!S.next(0, cur)) return;
    f32x4 acc[2][2][4][2];
#pragma unroll
    for (int a = 0; a < 2; ++a)
#pragma unroll
        for (int b = 0; b < 2; ++b)
#pragma unroll
            for (int m = 0; m < 4; ++m)
#pragma unroll
                for (int n = 0; n < 2; ++n) acc[a][b][m][n] = (f32x4){0.f, 0.f, 0.f, 0.f};
    bf16x8 At[4][2], B0[2][2], B1[2][2];
    const char* cA = (const char*)g.A + (size_t)cur.pm * tstepA + (size_t)cur.kt0 * kstep; const char* cB = (const char*)g.Bt + (size_t)cur.pn * tstepB + (size_t)cur.kt0 * kstep;
    PG8_STAGE(PG8_SB(0, 0), cB, voffB); PG8_STAGE(PG8_SA(0, 0), cA, voffA); PG8_STAGE(PG8_SB(0, 1), cB + hstepB, voffB); PG8_STAGE(PG8_SA(0, 1), cA + hstepA, voffA);
    if (wr == 1) PG8_BAR;
    PG8_WAIT_V(4); PG8_BAR;
    PG8_STAGE(PG8_SB(1, 0), cB + kstep, voffB); PG8_STAGE(PG8_SA(1, 0), cA + kstep, voffA); PG8_STAGE(PG8_SB(1, 1), cB + hstepB + kstep, voffB);
    PG8_WAIT_V(6); PG8_BAR;
    for (;;) {
        const bool has_next = S.next(ui + 1, nxt);
        const char* nA = has_next ? (const char*)g.A + (size_t)nxt.pm * tstepA + (size_t)nxt.kt0 * kstep : cA; const char* nB = has_next ? (const char*)g.Bt + (size_t)nxt.pn * tstepB + (size_t)nxt.kt0 * kstep : cB;
        for (int t = 0; t < nt; t += 2) {
            const bool last = (t == nt - 2);
            const char* a1 = cA + (size_t)(t + 1) * kstep;
            const char* a2 = last ? nA : cA + (size_t)(t + 2) * kstep; const char* b2 = last ? nB : cB + (size_t)(t + 2) * kstep;
            const char* a3 = a2 + kstep; const char* b3 = b2 + kstep;
            if constexpr (Epi::MIDK) { if (t == (nt >> 1)) E.mid(acc, cur, wr, wc, fr, fq); }
            PG8_LDB(B0, 0, 0); PG8_SCHED; PG8_LDA(At, 0, 0); PG8_STAGE(PG8_SA(1, 1), a1 + hstepA, voffA);
            PG8_WAIT_L(8); PG8_BAR; PG8_WAIT_L(0); PG8_MMA(0, 0, At, B0); PG8_BAR; PG8_SCHED;
            PG8_LDB(B1, 0, 1); PG8_STAGE(PG8_SB(0, 0), b2, voffB);
            PG8_BAR; PG8_WAIT_L(0); PG8_MMA(0, 1, At, B1); PG8_BAR;
            PG8_LDA(At, 0, 1); PG8_STAGE(PG8_SA(0, 0), a2, voffA);
            PG8_BAR; PG8_WAIT_L(0); PG8_MMA(1, 0, At, B0); PG8_BAR; PG8_SCHED;
            PG8_STAGE(PG8_SB(0, 1), b2 + hstepB, voffB);
            PG8_WAIT_V(6); PG8_BAR; PG8_MMA(1, 1, At, B1); PG8_BAR;
            PG8_LDB(B0, 1, 0); PG8_SCHED; PG8_LDA(At, 1, 0); PG8_STAGE(PG8_SA(0, 1), a2 + hstepA, voffA);
            PG8_WAIT_L(8); PG8_BAR; PG8_WAIT_L(0); PG8_MMA(0, 0, At, B0); PG8_BAR; PG8_SCHED;
            PG8_LDB(B1, 1, 1); PG8_STAGE(PG8_SB(1, 0), b3, voffB);
            PG8_BAR; PG8_WAIT_L(0); PG8_MMA(0, 1, At, B1); PG8_BAR;
            PG8_LDA(At, 1, 1); PG8_STAGE(PG8_SA(1, 0), a3, voffA);
            PG8_BAR; PG8_WAIT_L(0); PG8_MMA(1, 0, At, B0); PG8_BAR; PG8_SCHED;
            PG8_STAGE(PG8_SB(1, 1), b3 + hstepB, voffB);
            PG8_WAIT_V(6); PG8_BAR; PG8_MMA(1, 1, At, B1); PG8_BAR;
        }
        E(acc, cur, wr, wc, fr, fq);
        if (!has_next) break;
#pragma unroll
        for (int a = 0; a < 2; ++a)
#pragma unroll
            for (int b = 0; b < 2; ++b)
#pragma unroll
                for (int m = 0; m < 4; ++m)
#pragma unroll
                    for (int n = 0; n < 2; ++n) acc[a][b][m][n] = (f32x4){0.f, 0.f, 0.f, 0.f};
        cur = nxt; cA = nA; cB = nB; ++ui;
    }
    PG8_WAIT_V(0);
    if (wr == 0) PG8_BAR;
    PG8_BAR;
#undef PG8_SA
#undef PG8_SB
#undef PG8_STAGE
#undef PG8_LDA
#undef PG8_LDB
#undef PG8_MMA
#undef PG8_WAIT_V
#undef PG8_WAIT_L
#undef PG8_BAR
#undef PG8_SCHED
}
}
using pg8::Unit;
typedef f32x4 AccT[2][2][4][2];

struct EpiProj {
    static constexpr bool PERM = true, MIDK = false;
    unsigned char* ws; const float* rstd1; const float* bcum; const float* ropec; const float* ropes;
    DI void mid(AccT&, const Unit&, int, int, int, int) const {}
    DI void operator()(const AccT& acc, const Unit& u, int wr, int wc, int fr, int fq) const {
        const int pn = u.pn; int seg, pn0;
        if (pn < 8) { seg = pn >> 1; pn0 = seg * 2; } else if (pn == 8) { seg = 4; pn0 = 8; } else if (pn == 9) { seg = 5; pn0 = 9; }
        else if (pn < 12) { seg = 6; pn0 = 10; } else if (pn < 14) { seg = 7; pn0 = 12; } else if (pn < 18) { seg = 8; pn0 = 14; } else { seg = 9; pn0 = 18; }
        size_t segoff; int ld;
        switch (seg) { case 0: segoff = PQ_R; ld = 512; break; case 1: segoff = PK_R; ld = 512; break; case 2: segoff = PV_R; ld = 512; break; case 3: segoff = PG_R; ld = 512; break;
            case 4: segoff = PQ_G; ld = 256; break; case 5: segoff = PK_G; ld = 256; break; case 6: segoff = PV_G; ld = 512; break; case 7: segoff = PG_G; ld = 512; break;
            case 8: segoff = PM_R; ld = 1024; break; default: segoff = PM_G; ld = 1024; break; }
        bf16_t* base = (bf16_t*)(ws + segoff);
        const int lc0 = (pn - pn0) * 256 + wc * 32 + 8 * fq;
        const int row0 = u.pm * 256 + wr * 64 + fr;
        if (seg <= 1) {
            const int i0 = 16 * wc + 4 * fq;
            float lg2h[2];
#pragma unroll
            for (int bj = 0; bj < 2; ++bj) lg2h[bj] = log2f(1.f - exp2f(-5.f - (float)((pn - pn0) * 2 + bj)));
#pragma unroll
            for (int ai = 0; ai < 2; ++ai)
#pragma unroll
                for (int m = 0; m < 4; ++m) {
                    const int row = row0 + ai * 128 + m * 16; const float rs = rstd1[row];
                    int posidx, ic; if (row < TP) { posidx = row & 2047; ic = row & 63; } else { const int s = row - TP; posidx = 2048 + (s & 3); ic = s & 3; }
                    const f32x4 c4 = *(const f32x4*)(ropec + posidx * 64 + i0), s4 = *(const f32x4*)(ropes + posidx * 64 + i0);
#pragma unroll
                    for (int bj = 0; bj < 2; ++bj) {
                        const int head = (pn - pn0) * 2 + bj;
                        const float lg2 = lg2h[bj];
                        const float dec = (seg == 0) ? __builtin_amdgcn_exp2f((float)(ic + 1) * lg2) : __builtin_amdgcn_exp2f(-(float)(ic + 1) * lg2) * 0.08838834764831845f;
                        const f32x4 t1 = acc[ai][bj][m][0] * rs, t2 = acc[ai][bj][m][1] * rs;
                        const f32x4 o1 = (t1 * c4 - t2 * s4) * dec, o2 = (t1 * s4 + t2 * c4) * dec;
                        bf16_t* rp = base + (size_t)row * 512 + head * 128 + i0;
                        u32x2 w1, w2; w1.x = pk2(o1[0], o1[1]); w1.y = pk2(o1[2], o1[3]); w2.x = pk2(o2[0], o2[1]); w2.y = pk2(o2[2], o2[3]);
                        *(u32x2*)rp = w1; *(u32x2*)(rp + 64) = w2;
                    }
                }
            return;
        }
#pragma unroll
        for (int ai = 0; ai < 2; ++ai)
#pragma unroll
            for (int m = 0; m < 4; ++m) {
                const int row = row0 + ai * 128 + m * 16; const float rs = rstd1[row];
#pragma unroll
                for (int bj = 0; bj < 2; ++bj) {
                    const int lc = lc0 + bj * 128;
                    f32x4 v0 = acc[ai][bj][m][0] * rs, v1 = acc[ai][bj][m][1] * rs;
                    if (seg == 4 || seg == 5) {
                        const f32x4 b0 = *(const f32x4*)(bcum + (size_t)row * 256 + lc), b1 = *(const f32x4*)(bcum + (size_t)row * 256 + lc + 4);
                        if (seg == 4) {
#pragma unroll
                            for (int e = 0; e < 4; ++e) { v0[e] *= 0.125f * __expf(b0[e]); v1[e] *= 0.125f * __expf(b1[e]); }
                        } else {
#pragma unroll
                            for (int e = 0; e < 4; ++e) { v0[e] *= __expf(-b0[e]); v1[e] *= __expf(-b1[e]); }
                        }
                    } else if (seg == 3 || seg == 7) {
#pragma unroll
                        for (int e = 0; e < 4; ++e) { v0[e] = v0[e] * sigmoidf_(v0[e]); v1[e] = v1[e] * sigmoidf_(v1[e]); }
                    } else if (seg >= 8) {
#pragma unroll
                        for (int e = 0; e < 4; ++e) { v0[e] = sigmoidf_(v0[e]); v1[e] = sigmoidf_(v1[e]); }
                    }
                    u32x4 w; w.x = pk2(v0[0], v0[1]); w.y = pk2(v0[2], v0[3]); w.z = pk2(v1[0], v1[1]); w.w = pk2(v1[2], v1[3]);
                    __builtin_nontemporal_store(w, (u32x4*)(base + (size_t)row * ld + lc));
                }
            }
    }
};
struct EpiMix {
    static constexpr bool PERM = true, MIDK = true;
    const bf16_t* mr; const bf16_t* mg; bf16_t* mix;
    DI void mid(AccT& acc, const Unit& u, int wr, int wc, int fr, int fq) const {
        int row0 = u.pm * 256 + wr * 64 + fr, c0 = u.pn * 256 + wc * 32 + 8 * fq;
        asm volatile("" : "+v"(row0), "+v"(c0));
#pragma unroll
        for (int ai = 0; ai < 2; ++ai)
#pragma unroll
            for (int m = 0; m < 4; ++m) {
                const int row = row0 + ai * 128 + m * 16;
#pragma unroll
                for (int bj = 0; bj < 2; ++bj) {
                    const u32x4 a = *(const u32x4*)(mr + (size_t)row * 1024 + c0 + bj * 128), b = *(const u32x4*)(mg + (size_t)row * 1024 + c0 + bj * 128);
                    f32x4 r0, r1;
                    r0[0] = bflo(a.x) * __builtin_amdgcn_rcpf(fmaxf(bflo(b.x), 1e-30f)); r0[1] = bfhi(a.x) * __builtin_amdgcn_rcpf(fmaxf(bfhi(b.x), 1e-30f)); r0[2] = bflo(a.y) * __builtin_amdgcn_rcpf(fmaxf(bflo(b.y), 1e-30f)); r0[3] = bfhi(a.y) * __builtin_amdgcn_rcpf(fmaxf(bfhi(b.y), 1e-30f));
                    r1[0] = bflo(a.z) * __builtin_amdgcn_rcpf(fmaxf(bflo(b.z), 1e-30f)); r1[1] = bfhi(a.z) * __builtin_amdgcn_rcpf(fmaxf(bfhi(b.z), 1e-30f)); r1[2] = bflo(a.w) * __builtin_amdgcn_rcpf(fmaxf(bflo(b.w), 1e-30f)); r1[3] = bfhi(a.w) * __builtin_amdgcn_rcpf(fmaxf(bfhi(b.w), 1e-30f));
                    acc[ai][bj][m][0] *= r0; acc[ai][bj][m][1] *= r1;
                }
                __builtin_amdgcn_sched_barrier(0);
            }
    }
    DI void operator()(const AccT& acc, const Unit& u, int wr, int wc, int fr, int fq) const {
        const int row0 = u.pm * 256 + wr * 64 + fr, c0 = u.pn * 256 + wc * 32 + 8 * fq;
#pragma unroll
        for (int ai = 0; ai < 2; ++ai)
#pragma unroll
            for (int m = 0; m < 4; ++m) {
                const int row = row0 + ai * 128 + m * 16;
#pragma unroll
                for (int bj = 0; bj < 2; ++bj) {
                    const u32x4 b = *(const u32x4*)(mg + (size_t)row * 1024 + c0 + bj * 128);
                    const f32x4 v0 = acc[ai][bj][m][0], v1 = acc[ai][bj][m][1];
                    u32x4 w; w.x = pk2(v0[0] * bflo(b.x), v0[1] * bfhi(b.x)); w.y = pk2(v0[2] * bflo(b.y), v0[3] * bfhi(b.y));
                    w.z = pk2(v1[0] * bflo(b.z), v1[1] * bfhi(b.z)); w.w = pk2(v1[2] * bflo(b.w), v1[3] * bfhi(b.w));
                    *(u32x4*)(mix + (size_t)row * 1024 + c0 + bj * 128) = w;
                }
            }
    }
};
struct EpiH {
    static constexpr bool PERM = true, MIDK = false;
    const float* xp; const float* xs; float* h; bf16_t* hb; float* ssq;
    DI void mid(AccT&, const Unit&, int, int, int, int) const {}
    DI void operator()(const AccT& acc, const Unit& u, int wr, int wc, int fr, int fq) const {
        const int row0 = u.pm * 256 + wr * 64 + fr, c0 = u.pn * 256 + wc * 32 + 8 * fq;
#pragma unroll
        for (int ai = 0; ai < 2; ++ai)
#pragma unroll
            for (int m = 0; m < 4; ++m) {
                const int row = row0 + ai * 128 + m * 16;
                const float* xr = row < TP ? xp + (size_t)row * DM : xs + (size_t)(row - TP) * DM;
                float ss = 0.f;
#pragma unroll
                for (int bj = 0; bj < 2; ++bj) {
                    const int c = c0 + bj * 128;
                    const f32x4 v0 = acc[ai][bj][m][0] + *(const f32x4*)(xr + c), v1 = acc[ai][bj][m][1] + *(const f32x4*)(xr + c + 4);
                    u32x4 w; w.x = pk2(v0[0], v0[1]); w.y = pk2(v0[2], v0[3]); w.z = pk2(v1[0], v1[1]); w.w = pk2(v1[2], v1[3]);
                    *(u32x4*)(hb + (size_t)row * DM + c) = w;
                    ss += v0[0] * v0[0] + v0[1] * v0[1] + v0[2] * v0[2] + v0[3] * v0[3] + v1[0] * v1[0] + v1[1] * v1[1] + v1[2] * v1[2] + v1[3] * v1[3];
                }
                ss += __shfl_xor(ss, 16); ss += __shfl_xor(ss, 32);
                if (fq == 0) unsafeAtomicAdd(ssq + row, ss);
            }
    }
};
DI f32x2 gelu_pk(f32x2 v) {
    const f32x2 av = __builtin_elementwise_abs(v), d = av * 0.2316418882f + 1.0f;
    f32x2 t; t.x = __builtin_amdgcn_rcpf(d.x); t.y = __builtin_amdgcn_rcpf(d.y);
    f32x2 q = t * 0.5307027145f + (-0.7265760135f); q = q * t + 0.7107068705f; q = q * t + (-0.142248368f); q = q * t + 0.127414796f; q = q * t;
    const f32x2 s = (v * v) * (-0.72134752044f);
    f32x2 e; e.x = __builtin_amdgcn_exp2f(s.x); e.y = __builtin_amdgcn_exp2f(s.y);
    const f32x2 m = v * (q * e), r = v - m;
    f32x2 o; o.x = v.x < 0.f ? m.x : r.x; o.y = v.y < 0.f ? m.y : r.y; return o;
}
#define DPPF(old_, src_, ctrl_) __int_as_float(__builtin_amdgcn_update_dpp(__float_as_int(old_), __float_as_int(src_), (ctrl_), 0xf, 0xf, false))
struct EpiUpConv {
    static constexpr bool PERM = true, MIDK = false;
    const float* ssq; bf16_t* act; const float* cw; const float* cb; const float* cache; float* out; LAS float* xch;
    DI void mid(AccT&, const Unit&, int, int, int, int) const {}
    DI void operator()(const AccT& acc, const Unit& u, int wr, int wc, int fr, int fq) const {
        const int tokbase = u.pm * 254 - 2, cl = wc * 32 + 8 * fq, f0 = u.pn * 128 + cl;
        float sq[2][4];
#pragma unroll
        for (int ai = 0; ai < 2; ++ai)
#pragma unroll
            for (int m = 0; m < 4; ++m) { const int tok = tokbase + ai * 128 + wr * 64 + m * 16 + fr; sq[ai][m] = (tok >= 0 && tok < T_TOK) ? ssq[tok] : -1.f; }
        f32x4 cb4[2], w04[2], w14[2], w24[2];
#pragma unroll
        for (int n = 0; n < 2; ++n) { cb4[n] = *(const f32x4*)(cb + f0 + 4 * n); w04[n] = *(const f32x4*)(cw + f0 + 4 * n); w14[n] = *(const f32x4*)(cw + DFF + f0 + 4 * n); w24[n] = *(const f32x4*)(cw + 2 * DFF + f0 + 4 * n); }
        float rs[2][4];
#pragma unroll
        for (int ai = 0; ai < 2; ++ai)
#pragma unroll
            for (int m = 0; m < 4; ++m) rs[ai][m] = sq[ai][m] >= 0.f ? rsqrtf(sq[ai][m] * (1.f / DM) + EPS) : 0.f;
        if (fr >= 14) {
#pragma unroll
            for (int ai = 0; ai < 2; ++ai) { LAS float* xp = xch + ((2 * ai + wr) * 2 + (fr - 14)) * 128 + cl;
                *(LAS f32x4*)xp = acc[ai][0][3][0] * rs[ai][3]; *(LAS f32x4*)(xp + 4) = acc[ai][0][3][1] * rs[ai][3]; }
        }
        asm volatile("s_waitcnt lgkmcnt(0)" ::: "memory"); __builtin_amdgcn_s_barrier(); __builtin_amdgcn_s_barrier(); asm volatile("" ::: "memory");
        const bool samp_tile = (tokbase + 255 >= TP);
#pragma unroll
        for (int ai = 0; ai < 2; ++ai) {
            const int g = 2 * ai + wr;
            f32x4 prev[2];
#pragma unroll
            for (int m = 0; m < 4; ++m) {
                const int i = ai * 128 + wr * 64 + m * 16 + fr, tok = tokbase + i;
                int l; const bool samp = tok >= TP;
                if (!samp) l = tok & 2047; else l = (tok - TP) & 3;
                u32x4 w; f32x4 curs[2];
#pragma unroll
                for (int n = 0; n < 2; ++n) {
                    const f32x4 cur = acc[ai][0][m][n] * rs[ai][m], vv = acc[ai][1][m][n] * rs[ai][m];
                    f32x4 x1, x2;
                    if (m == 0) {
                        f32x4 h1 = {0.f, 0.f, 0.f, 0.f}, h2 = {0.f, 0.f, 0.f, 0.f};
                        if (g >= 1) { h1 = *(const LAS f32x4*)(xch + ((g - 1) * 2 + 1) * 128 + cl + 4 * n); h2 = *(const LAS f32x4*)(xch + ((g - 1) * 2 + (fr == 0 ? 0 : 1)) * 128 + cl + 4 * n); }
#pragma unroll
                        for (int e = 0; e < 4; ++e) { x1[e] = DPPF(h1[e], cur[e], 0x111); x2[e] = DPPF(h2[e], cur[e], 0x112); }
                    } else {
#pragma unroll
                        for (int e = 0; e < 4; ++e) { const float o1 = DPPF(0.f, prev[n][e], 0x121), o2 = DPPF(0.f, prev[n][e], 0x122);
                            x1[e] = DPPF(o1, cur[e], 0x111); x2[e] = DPPF(o2, cur[e], 0x112); }
                    }
                    prev[n] = cur; curs[n] = cur;
                    if (l < 2) {
                        if (samp_tile && samp) {
                            const int bidx = (tok - TP) >> 2;
                            if (tok < T_TOK) { const f32x4 c1 = *(const f32x4*)(cache + ((size_t)bidx * 2 + 1) * DFF + f0 + 4 * n), c0 = *(const f32x4*)(cache + ((size_t)bidx * 2 + l) * DFF + f0 + 4 * n);
                                x2 = c0; if (l == 0) x1 = c1; }
                        } else { x2 = (f32x4){0.f, 0.f, 0.f, 0.f}; if (l == 0) x1 = x2; }
                    }
                    const f32x4 uc = cb4[n] + w04[n] * x2 + w14[n] * x1 + w24[n] * cur;
                    const f32x2 ga = gelu_pk((f32x2){uc[0], uc[1]}), gb = gelu_pk((f32x2){uc[2], uc[3]});
                    const unsigned p0 = pk2(ga.x * vv[0], ga.y * vv[1]), p1 = pk2(gb.x * vv[2], gb.y * vv[3]);
                    if (n == 0) { w.x = p0; w.y = p1; } else { w.z = p0; w.w = p1; }
                }
                if (i >= 2 && tok < T_TOK) {
                    *(u32x4*)(act + (size_t)tok * DFF + f0) = w;
                    if (!samp) { if (l >= 2046) { float* o = out + OUT_CP + ((size_t)(tok >> 11) * 2 + (l - 2046)) * DFF + f0; *(f32x4*)o = curs[0]; *(f32x4*)(o + 4) = curs[1]; } }
                    else if (l >= 2) { float* o = out + OUT_CS + ((size_t)((tok - TP) >> 2) * 2 + (l - 2)) * DFF + f0; *(f32x4*)o = curs[0]; *(f32x4*)(o + 4) = curs[1]; }
                }
            }
        }
    }
};
struct EpiDownNorm {
    static constexpr bool PERM = true, MIDK = false;
    const bf16_t* hb; float* y; const float* lnf; float* exch; unsigned* cnt; LAS float* xl;
    DI void mid(AccT&, const Unit&, int, int, int, int) const {}
    DI void operator()(const AccT& acc_, const Unit& u, int wr, int wc, int fr, int fq) const {
        AccT& acc = const_cast<AccT&>(acc_);
        const int lrow0 = wr * 64 + fr, row0 = u.pm * 256 + lrow0, c0 = u.pn * 256 + wc * 32 + 8 * fq;
#pragma unroll
        for (int ai = 0; ai < 2; ++ai)
#pragma unroll
            for (int m = 0; m < 4; ++m) {
                const int row = row0 + ai * 128 + m * 16;
                float ss = 0.f;
#pragma unroll
                for (int bj = 0; bj < 2; ++bj) {
                    const u32x4 hv = *(const u32x4*)(hb + (size_t)row * DM + c0 + bj * 128);
                    f32x4 v0 = acc[ai][bj][m][0], v1 = acc[ai][bj][m][1];
                    v0[0] += bflo(hv.x); v0[1] += bfhi(hv.x); v0[2] += bflo(hv.y); v0[3] += bfhi(hv.y); v1[0] += bflo(hv.z); v1[1] += bfhi(hv.z); v1[2] += bflo(hv.w); v1[3] += bfhi(hv.w);
                    acc[ai][bj][m][0] = v0; acc[ai][bj][m][1] = v1;
                    ss += v0[0] * v0[0] + v0[1] * v0[1] + v0[2] * v0[2] + v0[3] * v0[3] + v1[0] * v1[0] + v1[1] * v1[1] + v1[2] * v1[2] + v1[3] * v1[3];
                }
                ss += __shfl_xor(ss, 16); ss += __shfl_xor(ss, 32);
                if (fq == 0) xl[(lrow0 + ai * 128 + m * 16) * 4 + wc] = ss;
            }
        unsigned* pc = cnt + u.pm * 32;
#define G5_PUBLISH() do { if (wc == 0) { \
            if (fq == 0) { \
                _Pragma("unroll") for (int ai = 0; ai < 2; ++ai) _Pragma("unroll") for (int m = 0; m < 4; ++m) { const int lr = lrow0 + ai * 128 + m * 16; const f32x4 q = *(const LAS f32x4*)(xl + lr * 4); \
                    __hip_atomic_store(exch + (size_t)(u.pm * 256 + lr) * 4 + u.pn, (q[0] + q[1]) + (q[2] + q[3]), __ATOMIC_RELAXED, __HIP_MEMORY_SCOPE_AGENT); } } \
            asm volatile("s_waitcnt vmcnt(0)" ::: "memory"); \
            __builtin_amdgcn_fence(__ATOMIC_RELEASE, "agent"); \
            asm volatile("s_waitcnt vmcnt(0)" ::: "memory"); \
            if (fr == 0 && fq == 0) __hip_atomic_fetch_add(pc, 1u, __ATOMIC_RELAXED, __HIP_MEMORY_SCOPE_AGENT); } } while (0)
        asm volatile("s_waitcnt lgkmcnt(0)" ::: "memory"); __builtin_amdgcn_s_barrier(); asm volatile("" ::: "memory");
        if (wr == 1) G5_PUBLISH();
        asm volatile("s_waitcnt lgkmcnt(0)" ::: "memory"); __builtin_amdgcn_s_barrier(); asm volatile("" ::: "memory");
        if (wr == 0) G5_PUBLISH();
#undef G5_PUBLISH
        {
            unsigned spins = 0;
            while (__hip_atomic_load(pc, __ATOMIC_RELAXED, __HIP_MEMORY_SCOPE_AGENT) < 8u && ++spins < (1u << 18)) __builtin_amdgcn_s_sleep(16);
            __builtin_amdgcn_fence(__ATOMIC_ACQUIRE, "agent"); }
#pragma unroll
        for (int ai = 0; ai < 2; ++ai)
#pragma unroll
            for (int m = 0; m < 4; ++m) {
                const int row = row0 + ai * 128 + m * 16;
                f32x4 q;
                q[0] = __hip_atomic_load(exch + (size_t)row * 4 + 0, __ATOMIC_RELAXED, __HIP_MEMORY_SCOPE_AGENT); q[1] = __hip_atomic_load(exch + (size_t)row * 4 + 1, __ATOMIC_RELAXED, __HIP_MEMORY_SCOPE_AGENT);
                q[2] = __hip_atomic_load(exch + (size_t)row * 4 + 2, __ATOMIC_RELAXED, __HIP_MEMORY_SCOPE_AGENT); q[3] = __hip_atomic_load(exch + (size_t)row * 4 + 3, __ATOMIC_RELAXED, __HIP_MEMORY_SCOPE_AGENT);
                const float rs = rsqrtf(((q[0] + q[1]) + (q[2] + q[3])) * (1.f / DM) + EPS);
#pragma unroll
                for (int bj = 0; bj < 2; ++bj) {
                    const int c = c0 + bj * 128;
                    const f32x4 g0 = *(const f32x4*)(lnf + c), g1 = *(const f32x4*)(lnf + c + 4);
                    *(f32x4*)(y + (size_t)row * DM + c) = acc[ai][bj][m][0] * rs * g0; *(f32x4*)(y + (size_t)row * DM + c + 4) = acc[ai][bj][m][1] * rs * g1;
                }
            }
    }
};
struct EpiPart {
    static constexpr bool PERM = true, MIDK = false;
    float* part;
    DI void mid(AccT&, const Unit&, int, int, int, int) const {}
    DI void operator()(const AccT& acc, const Unit& u, int wr, int wc, int fr, int fq) const {
        float* base = part + (size_t)u.id * 65536 + (wr * 64 + fr) * 256 + wc * 32 + 8 * fq;
#pragma unroll
        for (int ai = 0; ai < 2; ++ai)
#pragma unroll
            for (int m = 0; m < 4; ++m)
#pragma unroll
                for (int bj = 0; bj < 2; ++bj) { float* q = base + (ai * 128 + m * 16) * 256 + bj * 128; *(f32x4*)q = acc[ai][bj][m][0]; *(f32x4*)(q + 4) = acc[ai][bj][m][1]; }
    }
};

DI void transpose_item(const float* __restrict__ src, int ldsrc, int srccol, int k0, const float* __restrict__ scale, bf16_t* dst, int lddst, int n0dst, int k0dst,
                       LAS float* scr, int lane) {
    float tv[32];
#pragma unroll
    for (int i = 0; i < 32; ++i) { const int kk = 2 * i + (lane >> 5); tv[i] = src[(size_t)(k0 + kk) * ldsrc + srccol]; }
    if (scale) {
#pragma unroll
        for (int i = 0; i < 32; ++i) tv[i] *= scale[k0 + 2 * i + (lane >> 5)];
    }
#pragma unroll
    for (int i = 0; i < 32; ++i) scr[(2 * i + (lane >> 5)) * 33 + (lane & 31)] = tv[i];
    LDS_WAIT();
    const int c = lane & 7;
#pragma unroll
    for (int j = 0; j < 4; ++j) { const int n = (lane >> 3) + 8 * j; const LAS float* s = scr + (8 * c) * 33 + n;
        u32x4 o; o.x = pk2(s[0 * 33], s[1 * 33]); o.y = pk2(s[2 * 33], s[3 * 33]); o.z = pk2(s[4 * 33], s[5 * 33]); o.w = pk2(s[6 * 33], s[7 * 33]);
        *(u32x4*)(dst + (size_t)(n0dst + n) * lddst + k0dst + 8 * c) = o; }
    LDS_WAIT();
}
DI float log_sigmoid(float z) { return fminf(z, 0.f) - __logf(1.f + __expf(-fabsf(z))); }

DI void phase0(const Params& p, LAS unsigned char* lds) {
    int tid = threadIdx.x; asm volatile("" : "+v"(tid));
    const int lane = tid & 63, wave = tid >> 6;
    unsigned char* ws = p.ws;
    LAS bf16_t* wga = (LAS bf16_t*)lds;
    LAS float* gas = (LAS float*)(lds + 33024);
    LAS float* scr = (LAS float*)(lds + 41216 + wave * 8448);
    bf16_t* xb = (bf16_t*)((unsigned char*)p.out + 0);
    float* rstd1 = (float*)(ws + WS_RSTD1); float* bcum = (float*)(ws + WS_SH); float* ebl = (float*)(ws + WS_EBL);
    { const int gt = blockIdx.x * 512 + tid, ng = gridDim.x * 512;
      float* ssq2 = (float*)(ws + WS_SSQ2);
      for (int i = gt; i < T_TOK; i += ng) ssq2[i] = 0.f;
      float* rc = (float*)(ws + WS_ROPEC); float* rsn = (float*)(ws + WS_ROPES);
      for (int i = gt; i < 2052 * 64; i += ng) { const int pi = i >> 6, fi = i & 63; const double pos = (double)(pi < 2048 ? pi : 16384 + (pi - 2048));
          const double inv = exp(-(double)fi * (9.210340371976184 / 64.0)); const double ang = pos * inv; const double kk = rint(ang * 0.15915494309189535);
          const float r = (float)(ang - kk * 6.283185307179586); rc[i] = cosf(r); rsn[i] = sinf(r); } }
    {
        LAS float* accp = (LAS float*)(lds + 41216);
        LAS float* ssp = accp + 2048;
        LAS float* tot = ssp + 128;
        for (int k = tid; k < DM; k += 512) { const float g = p.ln1[k]; const float* s = p.w_in + (size_t)k * DIN + 3584;
            const f32x4 s0 = *(const f32x4*)s, s1 = *(const f32x4*)(s + 4), s2 = *(const f32x4*)(s + 8), s3 = *(const f32x4*)(s + 12);
            const float sv[16] = {s0[0], s0[1], s0[2], s0[3], s1[0], s1[1], s1[2], s1[3], s2[0], s2[1], s2[2], s2[3], s3[0], s3[1], s3[2], s3[3]};
#pragma unroll
            for (int r = 0; r < 16; r += 2) { const unsigned w = pk2(sv[r] * g, sv[r + 1] * g); wga[r * 1032 + k] = (bf16_t)(w & 0xffffu); wga[(r + 1) * 1032 + k] = (bf16_t)(w >> 16); } }
        __syncthreads();
        for (int u = blockIdx.x; u < 264; u += gridDim.x) {
            const int r16 = lane & 15, kq = lane >> 4, rg = wave & 3, kh = wave >> 2, row = u * 64 + rg * 16 + r16;
            const float* xr = x_row(p, row) + kh * 512;
            bf16_t* xbr = xb + (size_t)row * DM + kh * 512;
            const LAS bf16_t* wgr = wga + r16 * 1032 + kh * 512;
            f32x4 acc = {0.f, 0.f, 0.f, 0.f}; float ss = 0.f;
            for (int ks = 0; ks < 16; ks += 8) {
                f32x4 v[8][2];
#pragma unroll
                for (int q = 0; q < 8; ++q) { v[q][0] = *(const f32x4*)(xr + (ks + q) * 32 + kq * 8); v[q][1] = *(const f32x4*)(xr + (ks + q) * 32 + kq * 8 + 4); }
#pragma unroll
                for (int q = 0; q < 8; ++q) {
                    const f32x4 a0 = v[q][0], a1 = v[q][1];
                    ss += a0[0] * a0[0] + a0[1] * a0[1] + a0[2] * a0[2] + a0[3] * a0[3] + a1[0] * a1[0] + a1[1] * a1[1] + a1[2] * a1[2] + a1[3] * a1[3];
                    u32x4 w; w.x = pk2(a0[0], a0[1]); w.y = pk2(a0[2], a0[3]); w.z = pk2(a1[0], a1[1]); w.w = pk2(a1[2], a1[3]);
                    *(u32x4*)(xbr + (ks + q) * 32 + kq * 8) = w;
                    const bf16x8 bfrag = *(const LAS bf16x8*)(wgr + (ks + q) * 32 + kq * 8);
                    acc = __builtin_amdgcn_mfma_f32_16x16x32_bf16(__builtin_bit_cast(bf16x8, w), bfrag, acc, 0, 0, 0);
                }
            }
            ss += __shfl_xor(ss, 16); ss += __shfl_xor(ss, 32);
            if (kq == 0) ssp[kh * 64 + rg * 16 + r16] = ss;
#pragma unroll
            for (int j = 0; j < 4; ++j) accp[(kh * 64 + rg * 16 + kq * 4 + j) * 16 + r16] = acc[j];
            __syncthreads();
#pragma unroll
            for (int e = 0; e < 2; ++e) { const int idx = tid + 512 * e, lr = idx >> 4;
                const float rs = rsqrtf((ssp[lr] + ssp[64 + lr]) * (1.f / DM) + EPS);
                gas[idx] = (accp[idx] + accp[1024 + idx]) * rs;
                if ((idx & 15) == 0) rstd1[u * 64 + lr] = rs; }
            __syncthreads();
            {
                const int c = tid & 255, half = tid >> 8;
                float wg[16];
#pragma unroll
                for (int r = 0; r < 16; ++r) wg[r] = p.w_gate_up[r * 256 + c];
                const float bias = p.b_gate_up[c];
                const int tokb = u * 64 + half * 32; const bool samp = tokb >= TP;
                float ls[32]; float cum = 0.f;
#pragma unroll
                for (int i = 0; i < 32; ++i) {
                    const LAS f32x4* gp = (const LAS f32x4*)(gas + (half * 32 + i) * 16);
                    const f32x4 g0 = gp[0], g1 = gp[1], g2 = gp[2], g3 = gp[3];
                    float z = bias;
                    z += g0[0] * wg[0] + g0[1] * wg[1] + g0[2] * wg[2] + g0[3] * wg[3] + g1[0] * wg[4] + g1[1] * wg[5] + g1[2] * wg[6] + g1[3] * wg[7];
                    z += g2[0] * wg[8] + g2[1] * wg[9] + g2[2] * wg[10] + g2[3] * wg[11] + g3[0] * wg[12] + g3[1] * wg[13] + g3[2] * wg[14] + g3[3] * wg[15];
                    ls[i] = log_sigmoid(z) * (1.f / 16.f); cum += ls[i];
                }
                if (half == 0) tot[c] = cum;
                __syncthreads();
                cum = (half == 1 && !samp) ? tot[c] : 0.f;
#pragma unroll
                for (int i = 0; i < 32; ++i) {
                    cum = (samp && (i & 3) == 0) ? ls[i] : cum + ls[i];
                    const int tok = tokb + i;
                    bcum[(size_t)tok * 256 + c] = cum;
                    if (samp) { if ((i & 3) == 3) ebl[(size_t)(256 + ((tok - TP) >> 2)) * 256 + c] = expf(cum); }
                    else if (half == 1 && i == 31) ebl[(size_t)(tok >> 6) * 256 + c] = expf(cum);
                }
            }
            __syncthreads();
        }
    }
    {
        const int gw = blockIdx.x * 8 + wave, ngw = gridDim.x * 8;
        constexpr int I_IN = 16 * 176, I_MX = 8 * 32, I_O = 16 * 32, I_UP = 16 * 176, I_DN = 44 * 32, NIT = I_IN + 2 * I_MX + I_O + I_UP + I_DN;
        for (int it = gw; it < NIT; it += ngw) {
            int r = it; const int nl = lane & 31;
            if (r < I_IN) { const int kb = r / 176, nb = r % 176, n = nb * 32 + nl; int sc;
                if (n < 1024) { const int pp = n & 127; sc = (n & ~127) + (((pp & 7) < 4) ? 4 * (pp >> 3) + (pp & 7) : 64 + 4 * (pp >> 3) + (pp & 7) - 4); }
                else sc = n < 3584 ? n : n + 16;
                transpose_item(p.w_in, DIN, sc, kb * 64, p.ln1, (bf16_t*)(ws + WS_WIN), DM, nb * 32, kb * 64, scr, lane); continue; }
            r -= I_IN;
            if (r < I_MX) { const int kb = r / 32, nb = r % 32; transpose_item(p.w_ret_out, DM, nb * 32 + nl, kb * 64, nullptr, (bf16_t*)(ws + WS_WMIX), DM, nb * 32, kb * 64, scr, lane); continue; }
            r -= I_MX;
            if (r < I_MX) { const int kb = r / 32, nb = r % 32; transpose_item(p.w_gla_out, DM, nb * 32 + nl, kb * 64, nullptr, (bf16_t*)(ws + WS_WMIX), DM, nb * 32, 512 + kb * 64, scr, lane); continue; }
            r -= I_MX;
            if (r < I_O) { const int kb = r / 32, nb = r % 32; transpose_item(p.w_o, DM, nb * 32 + nl, kb * 64, nullptr, (bf16_t*)(ws + WS_WO), DM, nb * 32, kb * 64, scr, lane); continue; }
            r -= I_O;
            if (r < I_UP) { const int kb = r / 176, nb = r % 176, n = nb * 32 + nl; const int sc = ((n >> 7) & 1) * DFF + (n >> 8) * 128 + (n & 127);
                transpose_item(p.w_up, NUP, sc, kb * 64, p.ln2, (bf16_t*)(ws + WS_WUP), DM, nb * 32, kb * 64, scr, lane); continue; }
            r -= I_UP;
            { const int kb = r / 32, nb = r % 32; transpose_item(p.w_down, DM, nb * 32 + nl, kb * 64, nullptr, (bf16_t*)(ws + WS_WDN), DFF, nb * 32, kb * 64, scr, lane); }
        }
    }
}

template <int DK> DI unsigned img_off(int row, int ch) { return (unsigned)(row * (2 * DK) + 16 * (ch ^ ((((row & 3) << 2) | ((row >> 2) & 3)) & (DK / 8 - 1)))); }
template <int DK> DI unsigned tr_addr(int lane, int c, int ks, int t) {
    const int h = lane >> 5, blk = (lane >> 4) & 1, q = (lane & 15) >> 2, pp = lane & 3;
    return img_off<DK>(16 * ks + 8 * h + 4 * t + q, 4 * c + 2 * blk + (pp >> 1)) + 8 * (pp & 1);
}
DI bf16x8 tr_frag(LAS unsigned char* a0, LAS unsigned char* a1) {
    const s16x4 lo = __builtin_amdgcn_ds_read_tr16_b64_v4i16((LAS s16x4*)a0), hi = __builtin_amdgcn_ds_read_tr16_b64_v4i16((LAS s16x4*)a1);
    return __builtin_shufflevector(lo, hi, 0, 1, 2, 3, 4, 5, 6, 7);
}
DI bf16x8 pack8(const f32x16& x, int s) {
    u32x4 w; w.x = pk2(x[8 * s + 0], x[8 * s + 1]); w.y = pk2(x[8 * s + 2], x[8 * s + 3]); w.z = pk2(x[8 * s + 4], x[8 * s + 5]); w.w = pk2(x[8 * s + 6], x[8 * s + 7]);
    return __builtin_bit_cast(bf16x8, w);
}
#define MFMA32(a, b, c) __builtin_amdgcn_mfma_f32_32x32x16_bf16((a), (b), (c), 0, 0, 0)

constexpr int P2_BUF = 49152, P2_QO = 0, P2_KO = 16384, P2_VO = 32768, P2_P = 98304, P2_SSQ = P2_P + 64 * 144, P2_EBL = P2_SSQ + 1024;

template <int DK, bool FULL> DI void chain_prompt(const Params& p, LAS unsigned char* lds, const int branch, const int b, const int head, const int c0, const int nc, const int nprev, const bool write_final) {
    constexpr int NDB = DK / 32, NCH = DK / 8, QLD = 4 * DK, NQI = (64 * NCH) / 512;
    int tid0 = threadIdx.x; asm volatile("" : "+v"(tid0));
    const int w = __builtin_amdgcn_readfirstlane(tid0 >> 6);
    int tid = tid0, lane = tid0 & 63, h = lane >> 5, r = lane & 31;
    unsigned char* ws = p.ws;
    const bf16_t* Q = (const bf16_t*)(ws + (branch == 0 ? PQ_R : PQ_G)) + head * DK;
    const bf16_t* K = (const bf16_t*)(ws + (branch == 0 ? PK_R : PK_G)) + head * DK;
    const bf16_t* V = (const bf16_t*)(ws + (branch == 0 ? PV_R : PV_G)) + head * 128;
    const bf16_t* G = (const bf16_t*)(ws + (branch == 0 ? PG_R : PG_G)) + head * 128;
    const float* ebl = (const float*)(ws + WS_EBL);
    bf16_t* arg = (bf16_t*)((unsigned char*)p.out + SEG1024) + branch * 512 + head * 128;
    const float* gain = (branch == 0 ? p.g_ret : p.g_gla) + head * 128;
    const int tok0 = b * 2048;
    const float lg2 = log2f(1.f - exp2f(-5.f - (float)head));
    const float ret_ebl = exp2f(64.f * lg2);
    const int chain = branch * 32 + b * 4 + head;
    float* Lbuf = (float*)p.out + (size_t)chain * 3 * 16384;
    float* Dbuf = (float*)p.out + (size_t)64 * 3 * 16384 + (size_t)chain * 3 * 64;
    f32x16 S[NDB];
#pragma unroll
    for (int d = 0; d < NDB; ++d)
#pragma unroll
        for (int i = 0; i < 16; ++i) S[d][i] = 0.f;
    f32x4 gn[4];
    if (w < 4) {
#pragma unroll
        for (int g = 0; g < 4; ++g) gn[g] = *(const f32x4*)(gain + 32 * w + 8 * g + 4 * h);
        if (FULL) {
            for (int sg = 0; sg < nprev; ++sg) {
#pragma unroll
                for (int d = 0; d < NDB; ++d)
#pragma unroll
                    for (int i = 0; i < 16; ++i) {
                        const int dd = 32 * d + (i & 3) + 8 * (i >> 2) + 4 * h;
                        const float dec = (DK == 128) ? exp2f(64.f * (float)nc * lg2) : Dbuf[sg * 64 + dd];
                        S[d][i] = (sg == 0 ? 0.f : S[d][i] * dec) + Lbuf[(size_t)sg * 16384 + (size_t)dd * 128 + 32 * w + r];
                    }
            }
        }
    }
    float dprod = 1.f;
    u32x4 rq[NQI], rk[NQI], rv[2]; float rebl = 0.f;
#define P2_LOAD(c) do { const int tb = tok0 + 64 * (c); \
        _Pragma("unroll") for (int i = 0; i < NQI; ++i) { const int idx = tid + 512 * i, rr = idx / NCH, ch = idx % NCH; \
            rq[i] = *(const u32x4*)(Q + (size_t)(tb + rr) * QLD + ch * 8); rk[i] = *(const u32x4*)(K + (size_t)(tb + rr) * QLD + ch * 8); } \
        _Pragma("unroll") for (int i = 0; i < 2; ++i) { const int idx = tid + 512 * i, rr = idx >> 4, ch = idx & 15; rv[i] = *(const u32x4*)(V + (size_t)(tb + rr) * 512 + ch * 8); } \
        if (DK == 64 && tid < 64) rebl = ebl[(size_t)(b * 32 + (c)) * 256 + head * 64 + tid]; } while (0)
#define P2_STORE(buf) do { LAS unsigned char* bb = lds + (buf) * P2_BUF; \
        _Pragma("unroll") for (int i = 0; i < NQI; ++i) { const int idx = tid + 512 * i, rr = idx / NCH, ch = idx % NCH; \
            *(LAS u32x4*)(bb + P2_QO + img_off<DK>(rr, ch)) = rq[i]; *(LAS u32x4*)(bb + P2_KO + img_off<DK>(rr, ch)) = rk[i]; } \
        _Pragma("unroll") for (int i = 0; i < 2; ++i) { const int idx = tid + 512 * i, rr = idx >> 4, ch = idx & 15; *(LAS u32x4*)(bb + P2_VO + img_off<128>(rr, ch)) = rv[i]; } \
        if (DK == 64 && tid < 64) *(LAS float*)(lds + P2_EBL + (buf) * 256 + tid * 4) = rebl; } while (0)
    P2_LOAD(c0); P2_STORE(c0 & 1);
    dprod *= rebl;
    __syncthreads();
    const int cend = c0 + nc;
    for (int c = c0; c < cend; ++c) {
        tid = tid0; asm volatile("" : "+v"(tid)); lane = tid & 63; h = lane >> 5; r = lane & 31;
        LAS unsigned char* bb = lds + (c & 1) * P2_BUF;
        LAS unsigned char* qi = bb + P2_QO; LAS unsigned char* ki = bb + P2_KO; LAS unsigned char* vi = bb + P2_VO;
        if (c + 1 < cend) { P2_LOAD(c + 1); dprod *= rebl; }
        u32x2 gt[2][4];
        if (FULL && w < 4) {
            {   const int tbg = tok0 + 64 * c;
#pragma unroll
                for (int ib = 0; ib < 2; ++ib)
#pragma unroll
                    for (int g = 0; g < 4; ++g) gt[ib][g] = *(const u32x2*)(G + (size_t)(tbg + 32 * ib + r) * 512 + 32 * w + 8 * g + 4 * h); }
        }
        if (FULL && w >= 4 && w < 7) {
            const int ws_ = w - 4;
            const int jb = (ws_ == 2) ? 1 : 0, ib = (ws_ == 0) ? 0 : 1;
            f32x16 pt;
#pragma unroll
            for (int i = 0; i < 16; ++i) pt[i] = 0.f;
#pragma unroll
            for (int s = 0; s < DK / 16; ++s) {
                const bf16x8 a = *(const LAS bf16x8*)(ki + img_off<DK>(32 * jb + r, 2 * s + h)), bq = *(const LAS bf16x8*)(qi + img_off<DK>(32 * ib + r, 2 * s + h));
                pt = MFMA32(a, bq, pt);
            }
            if (jb == ib) {
#pragma unroll
                for (int i = 0; i < 16; ++i) { const int j = (i & 3) + 8 * (i >> 2) + 4 * h; pt[i] = (j <= r) ? pt[i] : 0.f; }
            }
#pragma unroll
            for (int g = 0; g < 4; ++g) { u32x2 o; o.x = pk2(pt[4 * g], pt[4 * g + 1]); o.y = pk2(pt[4 * g + 2], pt[4 * g + 3]);
                *(LAS u32x2*)(lds + P2_P + (32 * ib + r) * 144 + (32 * jb + 8 * g + 4 * h) * 2) = o; }
        }
        f32x16 ot[2];
        bf16x8 vf[4];
        if (w < 4) {
#pragma unroll
            for (int s = 0; s < 4; ++s) vf[s] = tr_frag(vi + tr_addr<128>(lane, w, s, 0), vi + tr_addr<128>(lane, w, s, 1));
#pragma unroll
            for (int ib = 0; ib < 2; ++ib)
#pragma unroll
                for (int i = 0; i < 16; ++i) ot[ib][i] = 0.f;
            if (FULL)
#pragma unroll
            for (int d = 0; d < NDB; ++d)
#pragma unroll
                for (int s2 = 0; s2 < 2; ++s2) {
                    const bf16x8 sfr = pack8(S[d], s2);
#pragma unroll
                    for (int ib = 0; ib < 2; ++ib) {
                        const s16x4 lo = *(const LAS s16x4*)(qi + img_off<DK>(32 * ib + r, 4 * d + 2 * s2) + 8 * h), hi = *(const LAS s16x4*)(qi + img_off<DK>(32 * ib + r, 4 * d + 2 * s2 + 1) + 8 * h);
                        const bf16x8 bq = __builtin_shufflevector(lo, hi, 0, 1, 2, 3, 4, 5, 6, 7);
                        ot[ib] = MFMA32(sfr, bq, ot[ib]);
                    }
                }
#pragma unroll
            for (int d = 0; d < NDB; ++d) {
#pragma unroll
                for (int s = 0; s < 4; ++s) {
                    const bf16x8 a = tr_frag(ki + tr_addr<DK>(lane, d, s, 0), ki + tr_addr<DK>(lane, d, s, 1));
                    S[d] = MFMA32(a, vf[s], S[d]);
                }
                if (DK == 128) {
#pragma unroll
                    for (int i = 0; i < 16; ++i) S[d][i] *= ret_ebl;
                } else {
                    const LAS float* eb = (const LAS float*)(lds + P2_EBL + (c & 1) * 256) + 32 * d + 4 * h;
#pragma unroll
                    for (int g = 0; g < 4; ++g) { const f32x4 e4 = *(const LAS f32x4*)(eb + 8 * g);
#pragma unroll
                        for (int e = 0; e < 4; ++e) S[d][4 * g + e] *= e4[e]; }
                }
            }
        }
        if (FULL) __syncthreads();
        if (FULL && w < 4) {
#pragma unroll
            for (int ib = 0; ib < 2; ++ib) {
#pragma unroll
                for (int s = 0; s < (ib == 0 ? 2 : 4); ++s) {
                    const bf16x8 bp = *(const LAS bf16x8*)(lds + P2_P + (32 * ib + r) * 144 + (16 * s + 8 * h) * 2);
                    ot[ib] = MFMA32(vf[s], bp, ot[ib]);
                }
            }
#pragma unroll
            for (int ib = 0; ib < 2; ++ib) { float ss = 0.f;
#pragma unroll
                for (int i = 0; i < 16; ++i) ss += ot[ib][i] * ot[ib][i];
                ss += __shfl_xor(ss, 32);
                if (h == 0) *(LAS float*)(lds + P2_SSQ + (w * 64 + 32 * ib + r) * 4) = ss; }
        }
        if (c + 1 < cend) P2_STORE((c + 1) & 1);
        __syncthreads();
        if (FULL && w < 4) {
            asm volatile("" : "+v"(lane)); h = lane >> 5; r = lane & 31;
            const int tb = tok0 + 64 * c;
#pragma unroll
            for (int ib = 0; ib < 2; ++ib) {
                const LAS float* sq = (const LAS float*)(lds + P2_SSQ) + 32 * ib + r;
                const float tot = sq[0] + sq[64] + sq[128] + sq[192];
                const float rs = rsqrtf(tot * (1.f / 128.f) + EPS);
#pragma unroll
                for (int g = 0; g < 4; ++g) {
                    const u32x2 gg = gt[ib][g];
                    u32x2 o; o.x = pk2(ot[ib][4 * g] * rs * gn[g][0] * bflo(gg.x), ot[ib][4 * g + 1] * rs * gn[g][1] * bfhi(gg.x));
                    o.y = pk2(ot[ib][4 * g + 2] * rs * gn[g][2] * bflo(gg.y), ot[ib][4 * g + 3] * rs * gn[g][3] * bfhi(gg.y));
                    *(u32x2*)(arg + (size_t)(tb + 32 * ib + r) * 1024 + 32 * w + 8 * g + 4 * h) = o;
                }
            }
        }
    }
#undef P2_LOAD
#undef P2_STORE
    if (!FULL && DK == 64 && tid0 < 64) Dbuf[nprev * 64 + tid0] = dprod;
    if (w < 4 && (write_final || !FULL)) {
        lane = tid0 & 63; h = lane >> 5; r = lane & 31;
        float* so = FULL ? p.out + (branch == 0 ? OUT_RSP : OUT_GSP) + (size_t)(b * 4 + head) * DK * 128 : Lbuf + (size_t)nprev * 16384;
#pragma unroll
        for (int d = 0; d < NDB; ++d)
#pragma unroll
            for (int i = 0; i < 16; ++i) so[(size_t)(32 * d + (i & 3) + 8 * (i >> 2) + 4 * h) * 128 + 32 * w + r] = S[d][i];
    }
    __syncthreads();
}

template <int DK> DI void sample_unit(const Params& p, LAS unsigned char* lds, const int branch, const int b, const int head) {
    int tid = threadIdx.x; asm volatile("" : "+v"(tid));
    unsigned char* ws = p.ws;
    const bf16_t* Q = (const bf16_t*)(ws + (branch == 0 ? PQ_R : PQ_G)) + head * DK;
    const bf16_t* K = (const bf16_t*)(ws + (branch == 0 ? PK_R : PK_G)) + head * DK;
    const bf16_t* V = (const bf16_t*)(ws + (branch == 0 ? PV_R : PV_G)) + head * 128;
    const bf16_t* G = (const bf16_t*)(ws + (branch == 0 ? PG_R : PG_G)) + head * 128;
    bf16_t* arg = (bf16_t*)((unsigned char*)p.out + SEG1024) + branch * 512 + head * 128;
    const float* gain = (branch == 0 ? p.g_ret : p.g_gla) + head * 128;
    const float* sin_ = (branch == 0 ? p.state_ret : p.state_gla) + (size_t)(b * 4 + head) * DK * 128;
    float* sout = p.out + (branch == 0 ? OUT_RSS : OUT_GSS) + (size_t)(b * 4 + head) * DK * 128;
    const int tok0 = TP + 4 * b;
    LAS float* qs = (LAS float*)lds;
    LAS float* ks = qs + 4 * 128;
    LAS float* vs = ks + 4 * 128;
    LAS float* es = vs + 4 * 128;
    LAS float* Ps = es + 128;
    LAS float* ssq = Ps + 16;
    LAS float* op = ssq + 16;
    for (int i = tid; i < 4 * DK; i += 512) { const int t = i / DK, d = i % DK;
        qs[t * DK + d] = __uint_as_float((unsigned)Q[(size_t)(tok0 + t) * (4 * DK) + d] << 16); ks[t * DK + d] = __uint_as_float((unsigned)K[(size_t)(tok0 + t) * (4 * DK) + d] << 16); }
    { const int t = tid >> 7, v = tid & 127; vs[t * 128 + v] = __uint_as_float((unsigned)V[(size_t)(tok0 + t) * 512 + v] << 16); }
    if (tid < DK) {
        if (DK == 128) { const float lg2 = log2f(1.f - exp2f(-5.f - (float)head)); es[tid] = exp2f(4.f * lg2); }
        else es[tid] = ((const float*)(ws + WS_EBL))[(size_t)(256 + b) * 256 + head * 64 + tid];
    }
    __syncthreads();
    if (tid < 16) { const int i = tid >> 2, j = tid & 3; float s = 0.f; if (j <= i) { for (int d = 0; d < DK; ++d) s += qs[i * DK + d] * ks[j * DK + d]; } Ps[tid] = s; }
    {
        const int vq = tid & 31, dg = tid >> 5;
        f32x4 oa[4];
#pragma unroll
        for (int i = 0; i < 4; ++i) oa[i] = (f32x4){0.f, 0.f, 0.f, 0.f};
        f32x4 v4[4];
#pragma unroll
        for (int j = 0; j < 4; ++j) v4[j] = *(const LAS f32x4*)(vs + j * 128 + 4 * vq);
        f32x4 s0[DK / 16];
#pragma unroll
        for (int rr = 0; rr < DK / 16; ++rr) s0[rr] = *(const f32x4*)(sin_ + (size_t)(dg + 16 * rr) * 128 + 4 * vq);
#pragma unroll
        for (int rr = 0; rr < DK / 16; ++rr) {
            const int d = dg + 16 * rr;
            f32x4 sn = s0[rr];
#pragma unroll
            for (int i = 0; i < 4; ++i) { oa[i] += s0[rr] * qs[i * DK + d]; sn += v4[i] * ks[i * DK + d]; }
            sn *= es[d];
            *(f32x4*)(sout + (size_t)d * 128 + 4 * vq) = sn;
        }
#pragma unroll
        for (int i = 0; i < 4; ++i) *(LAS f32x4*)(op + (dg * 4 + i) * 128 + 4 * vq) = oa[i];
    }
    __syncthreads();
    {
        const int i = tid >> 7, v = tid & 127;
        float o = 0.f;
#pragma unroll
        for (int dg = 0; dg < 16; ++dg) o += op[(dg * 4 + i) * 128 + v];
#pragma unroll
        for (int j = 0; j < 4; ++j) o += Ps[i * 4 + j] * vs[j * 128 + v];
        const float s = wave_sum(o * o);
        if ((tid & 63) == 0) ssq[tid >> 6] = s;
        __syncthreads();
        const float rs = rsqrtf((ssq[2 * i] + ssq[2 * i + 1]) * (1.f / 128.f) + EPS);
        const float gate = __uint_as_float((unsigned)G[(size_t)(tok0 + i) * 512 + v] << 16);
        const unsigned wv = pk2(o * rs * gain[v] * gate, 0.f);
        arg[(size_t)(tok0 + i) * 1024 + v] = (bf16_t)(wv & 0xffffu);
    }
    __syncthreads();
}

template <bool FULL> DI void chain_call(const Params& p, LAS unsigned char* lds, int chain, int c0, int nc, int nprev, bool wf) {
    const int branch = chain >> 5, bh = chain & 31;
    if (branch == 0) chain_prompt<128, FULL>(p, lds, 0, bh >> 2, bh & 3, c0, nc, nprev, wf); else chain_prompt<64, FULL>(p, lds, 1, bh >> 2, bh & 3, c0, nc, nprev, wf);
}
DI void sample_call(const Params& p, LAS unsigned char* lds, int u) {
    const int branch = u >> 9, bh = u & 511;
    if (branch == 0) sample_unit<128>(p, lds, 0, bh >> 2, bh & 3); else sample_unit<64>(p, lds, 1, bh >> 2, bh & 3);
}
DI void phase2(const Params& p, LAS unsigned char* lds, const XcdBarrier& xbar) {
    const int G = gridDim.x, bx = blockIdx.x;
    if (G == 256) {
        const int chain = bx & 63, seg = bx >> 6;
        if (seg < 3) chain_call<false>(p, lds, chain, 8 * seg, 8, seg, false);
        else { sample_call(p, lds, bx - 192); sample_call(p, lds, bx - 192 + 64); }
        xcd_barrier(xbar);
        chain_call<true>(p, lds, chain, 8 * seg, 8, seg, seg == 3);
        for (int u = 128 + bx; u < 1024; u += 256) sample_call(p, lds, u);
    } else {
        for (int c = bx; c < 64; c += G) chain_call<true>(p, lds, c, 0, 32, 0, true);
        for (int u = bx; u < 1024; u += G) sample_call(p, lds, u);
    }
}

DI void phase_final(const Params& p) {
    const int lane = threadIdx.x & 63, gw = blockIdx.x * 8 + (threadIdx.x >> 6), ngw = gridDim.x * 8;
    const bf16_t* hb = (const bf16_t*)(p.ws + WS_SH);
    for (int row = TP + gw; row < T_TOK; row += ngw) {
        f32x4 v[4]; float s = 0.f;
        const float* part = (const float*)(p.ws + WS_PART) + (size_t)((row - TP) & 255) * 256 + 4 * lane;
#pragma unroll
        for (int j = 0; j < 4; ++j) {
            const u32x2 hv = *(const u32x2*)(hb + (size_t)row * DM + 256 * j + 4 * lane);
            v[j] = (f32x4){bflo(hv.x), bfhi(hv.x), bflo(hv.y), bfhi(hv.y)};
            const int su = ((row - TP) >> 8) * 4 + j;
            for (int kp = 0; kp < 11; ++kp) v[j] += *(const f32x4*)(part + (size_t)(su * 11 + kp) * 65536);
            s += v[j][0] * v[j][0] + v[j][1] * v[j][1] + v[j][2] * v[j][2] + v[j][3] * v[j][3];
        }
        const float rs = rsqrtf(wave_sum(s) * (1.f / DM) + EPS);
#pragma unroll
        for (int j = 0; j < 4; ++j) { const f32x4 g = *(const f32x4*)(p.ln_f + 256 * j + 4 * lane); *(f32x4*)(p.out + (size_t)row * DM + 256 * j + 4 * lane) = v[j] * rs * g; }
    }
}

__global__ void __launch_bounds__(512, 2) fwd_megakernel(Params p) {
    extern __shared__ __attribute__((aligned(16))) unsigned char shm[];
    LAS unsigned char* lds = (LAS unsigned char*)shm;
    cg::grid_group grid = cg::this_grid();
    if (p.ws == nullptr) grid.sync();
    if (threadIdx.x < 4) ((LAS unsigned*)(lds + 131072 + 4096))[threadIdx.x] = 0u;
    __syncthreads();
    const XcdBarrier xbar = xcd_barrier_post((unsigned*)(p.ws + WS_BAR), (volatile LAS unsigned*)(lds + 131072 + 4096));
    unsigned char* ws = p.ws;
    const int G = gridDim.x, bx = blockIdx.x;
    bf16_t* xb = (bf16_t*)p.out;
    bf16_t* arg = (bf16_t*)((unsigned char*)p.out + SEG1024);

#ifndef PHMASK
#define PHMASK 0x1ff
#endif
#define PH(n) if ((PHMASK >> (n)) & 1)
    PH(0) phase0(p, lds);
    xcd_barrier(xbar);
#if defined(DUP_PH) && DUP_PH == 0
    phase0(p, lds);
    xcd_barrier(xbar);
#endif
    PH(1) {
        pg8::Gemm g{xb, (const bf16_t*)(ws + WS_WIN), T_TOK, NPROJ, DM, DM, DM, 256}; pg8::StaticOrder S; S.init(T_TOK, NPROJ, G, bx);
        EpiProj E{ws, (const float*)(ws + WS_RSTD1), (const float*)(ws + WS_SH), (const float*)(ws + WS_ROPEC), (const float*)(ws + WS_ROPES)};
        pg8::gemm_phase<EpiProj, pg8::StaticOrder, 16>(lds, g, S, E);
#if defined(DUP_PH) && DUP_PH == 1
        xcd_barrier(xbar);
        pg8::gemm_phase<EpiProj, pg8::StaticOrder, 16>(lds, g, S, E);
#endif
    }
    xcd_barrier(xbar);
    PH(2) phase2(p, lds, xbar);
    xcd_barrier(xbar);
#if defined(DUP_PH) && DUP_PH == 2
    phase2(p, lds, xbar);
    xcd_barrier(xbar);
#endif
    PH(3) {
        pg8::Gemm g{arg, (const bf16_t*)(ws + WS_WMIX), T_TOK, DM, DM, DM, DM, 256}; pg8::StaticOrder S; S.init(T_TOK, DM, G, bx);
        EpiMix E{(const bf16_t*)(ws + PM_R), (const bf16_t*)(ws + PM_G), (bf16_t*)(ws + WS_MIX)};
        pg8::gemm_phase<EpiMix, pg8::StaticOrder, 16>(lds, g, S, E);
#if defined(DUP_PH) && DUP_PH == 3
        xcd_barrier(xbar);
        pg8::gemm_phase<EpiMix, pg8::StaticOrder, 16>(lds, g, S, E);
#endif
    }
    xcd_barrier(xbar);
    PH(4) {
        pg8::Gemm g{(const bf16_t*)(ws + WS_MIX), (const bf16_t*)(ws + WS_WO), T_TOK, DM, DM, DM, DM, 256}; pg8::StaticOrder S; S.init(T_TOK, DM, G, bx);
        EpiH E{p.x_prompt, p.x_sample, p.out, (bf16_t*)(ws + WS_SH), (float*)(ws + WS_SSQ2)};
        pg8::gemm_phase<EpiH, pg8::StaticOrder, 16>(lds, g, S, E);
    }
    xcd_barrier(xbar);
    PH(5) {
        pg8::Gemm g{(const bf16_t*)(ws + WS_SH) - 2 * DM, (const bf16_t*)(ws + WS_WUP), T_TOK, NUP, DM, DM, DM, 254}; pg8::StaticOrder S; S.init_tiles(67, 22, G, bx);
        EpiUpConv E{(const float*)(ws + WS_SSQ2), (bf16_t*)(ws + WS_ACT), p.conv_w, p.conv_b, p.cache_conv, p.out, (LAS float*)(lds + 131072)};
        pg8::gemm_phase<EpiUpConv, pg8::StaticOrder, 16>(lds, g, S, E);
#if defined(DUP_PH) && DUP_PH == 5
        xcd_barrier(xbar);
        pg8::gemm_phase<EpiUpConv, pg8::StaticOrder, 16>(lds, g, S, E);
#endif
    }
    xcd_barrier(xbar);
    PH(7) {
        pg8::Gemm g{(const bf16_t*)(ws + WS_ACT), (const bf16_t*)(ws + WS_WDN), T_TOK, DM, DFF, DFF, DFF, 256}; pg8::StaticOrder S; S.init_tiles(64, 4, G, bx);
        EpiDownNorm E{(const bf16_t*)(ws + WS_SH), p.out, p.ln_f, (float*)(ws + WS_EXCH), (unsigned*)(ws + WS_CNT), (LAS float*)(lds + 131072)};
        pg8::gemm_phase<EpiDownNorm, pg8::StaticOrder, 44>(lds, g, S, E);
        {   pg8::PieceOrder S2{G, bx}; EpiPart E2{(float*)(ws + WS_PART)};
            pg8::gemm_phase<EpiPart, pg8::PieceOrder, 4>(lds, g, S2, E2); }
    }
    xcd_barrier(xbar);
    PH(8) phase_final(p);
}

extern "C" void kernel_launch(void* const* d_in, const int* in_sizes, int n_in, void* d_out, int out_size, void* d_ws, size_t ws_size, hipStream_t stream) {
    static int grid = 0;
    if (grid == 0) {
        if (n_in != 20 || out_size != (int)OUT_END || ws_size < WS_END) { fprintf(stderr, "kernel_launch: unexpected shapes (n_in %d, out %d, ws %zu)\n", n_in, out_size, ws_size); grid = -1; return; }
        int dev = 0, cus = 0, per_cu = 0;
        hipGetDevice(&dev);
        hipDeviceGetAttribute(&cus, hipDeviceAttributeMultiprocessorCount, dev);
        if (hipFuncSetAttribute((const void*)fwd_megakernel, hipFuncAttributeMaxDynamicSharedMemorySize, LDS_BYTES) != hipSuccess) { fprintf(stderr, "kernel_launch: hipFuncSetAttribute failed\n"); grid = -1; return; }
        hipOccupancyMaxActiveBlocksPerMultiprocessor(&per_cu, (const void*)fwd_megakernel, 512, LDS_BYTES);
        if (per_cu < 1) { fprintf(stderr, "kernel_launch: occupancy query gave %d\n", per_cu); per_cu = 1; }
        grid = cus * 1;
        (void)hipGetLastError();
    }
    if (grid < 0) return;
    Params p{};
    const float** f = (const float**)&p;
    for (int i = 0; i < 20; ++i) f[i] = (const float*)d_in[i];
    p.out = (float*)d_out; p.ws = (unsigned char*)d_ws;
    if (hipMemsetAsync((unsigned char*)d_ws + WS_BAR, 0, 16384 + 8192, stream) != hipSuccess) { fprintf(stderr, "kernel_launch: memset failed\n"); return; }
    void* args[] = {&p};
    hipError_t e = hipLaunchCooperativeKernel((const void*)fwd_megakernel, dim3(grid), dim3(512), args, LDS_BYTES, stream);
    if (e != hipSuccess) fprintf(stderr, "cooperative launch failed: %s (grid %d)\n", hipGetErrorString(e), grid);
}
```

```cpp
#include <hip/hip_runtime.h>
#include <hip/hip_cooperative_groups.h>
#include <cstdio>
namespace cg = cooperative_groups;

#define LAS __attribute__((address_space(3)))
#define DI __device__ __forceinline__
typedef unsigned short bf16_t;
typedef short bf16x8 __attribute__((ext_vector_type(8)));
typedef short s16x4 __attribute__((ext_vector_type(4)));
typedef float f32x4 __attribute__((ext_vector_type(4)));
typedef float f32x2 __attribute__((ext_vector_type(2)));
typedef float f32x16 __attribute__((ext_vector_type(16)));
typedef unsigned u32x4 __attribute__((ext_vector_type(4)));
typedef unsigned u32x2 __attribute__((ext_vector_type(2)));
typedef __bf16 bf16x2_t __attribute__((ext_vector_type(2)));

constexpr int T_TOK = 16896, TP = 16384, DM = 1024, DIN = 5648, NPROJ = 5632, DFF = 2816, NUP = 5632;
constexpr float EPS = 1e-6f;
constexpr size_t OUT_Y = 0, OUT_RSP = 17301504, OUT_RSS = OUT_RSP + 524288, OUT_GSP = OUT_RSS + 8388608, OUT_GSS = OUT_GSP + 262144,
                 OUT_CP = OUT_GSS + 4194304, OUT_CS = OUT_CP + 45056, OUT_END = OUT_CS + 720896;
constexpr size_t WS_WIN = 0, WS_WMIX = WS_WIN + (size_t)NPROJ * DM * 2, WS_WO = WS_WMIX + (size_t)DM * DM * 2, WS_WUP = WS_WO + (size_t)DM * DM * 2,
                 WS_WDN = WS_WUP + (size_t)NUP * DM * 2, WS_PROJ = WS_WDN + (size_t)DM * DFF * 2;
constexpr size_t SEG512 = (size_t)T_TOK * 512 * 2, SEG256 = (size_t)T_TOK * 256 * 2, SEG1024 = (size_t)T_TOK * 1024 * 2;
constexpr size_t PQ_R = WS_PROJ, PK_R = PQ_R + SEG512, PV_R = PK_R + SEG512, PG_R = PV_R + SEG512, PQ_G = PG_R + SEG512, PK_G = PQ_G + SEG256,
                 PV_G = PK_G + SEG256, PG_G = PV_G + SEG512, PM_R = PG_G + SEG512, PM_G = PM_R + SEG1024, WS_PROJ_END = PM_G + SEG1024;
constexpr size_t WS_MIX = PQ_R;
constexpr size_t WS_PART = WS_PROJ + (size_t)T_TOK * DFF * 2;
static_assert(WS_PART + (size_t)88 * 65536 * 4 <= WS_PROJ_END, "partials");
constexpr size_t WS_ACT = WS_PROJ;
constexpr size_t WS_SH = WS_PROJ_END;
constexpr size_t WS_RSTD1 = WS_SH + SEG1024, WS_SSQ2 = WS_RSTD1 + (size_t)T_TOK * 4, WS_EBL = WS_SSQ2 + (size_t)T_TOK * 4,
                 WS_ROPEC = WS_EBL + (size_t)384 * 256 * 4, WS_ROPES = WS_ROPEC + (size_t)2052 * 64 * 4, WS_BAR = WS_ROPES + (size_t)2052 * 64 * 4, WS_CNT = WS_BAR + 16384  ,
                 WS_EXCH = WS_CNT + 8192  , WS_END = WS_EXCH + (size_t)TP * 16;
static_assert(WS_PROJ_END - WS_PROJ == (size_t)T_TOK * NPROJ * 2, "proj layout");
static_assert(WS_END <= (size_t)256 * 1024 * 1024, "workspace");
constexpr int LDS_BYTES = 131072 + 4096 + 16;

struct Params {
    const float *x_prompt, *x_sample, *state_ret, *state_gla, *cache_conv, *ln1, *w_in, *w_gate_up, *b_gate_up, *g_ret, *g_gla, *w_ret_out, *w_gla_out,
        *w_o, *ln2, *w_up, *conv_w, *conv_b, *w_down, *ln_f;
    float* out; unsigned char* ws;
};

DI unsigned pk2(float lo, float hi) { f32x2 v = {lo, hi}; bf16x2_t b = __builtin_convertvector(v, bf16x2_t); return __builtin_bit_cast(unsigned, b); }
DI float bflo(unsigned w) { return __uint_as_float(w << 16); }
DI float bfhi(unsigned w) { return __uint_as_float(w & 0xffff0000u); }
DI float wave_sum(float v) {
#pragma unroll
    for (int o = 1; o < 64; o <<= 1) v += __shfl_xor(v, o);
    return v;
}
DI float sigmoidf_(float x) { return __builtin_amdgcn_rcpf(1.f + __expf(-x)); }
DI const float* x_row(const Params& p, int tok) { return tok < TP ? p.x_prompt + (size_t)tok * DM : p.x_sample + (size_t)(tok - TP) * DM; }
#define LDS_WAIT() asm volatile("s_waitcnt lgkmcnt(0)" ::: "memory")

#define XB_TMO      128
#define XB_XCNT(j)  (256  + 64 * (j))
#define XB_XSUB(j)  (1280 + 64 * (j))
#define XB_XGEN(j)  (2304 + 64 * (j))
#define XB_TOP      3328
#define XB_TOPGEN   3392
#define XCD_BAR_WORDS 3456
#define XB_SPIN_CAP (1u << 22)
DI unsigned xb_ld(unsigned* p) { return __hip_atomic_load(p, __ATOMIC_RELAXED, __HIP_MEMORY_SCOPE_AGENT); }
DI unsigned xb_add(unsigned* p, unsigned v) { return __hip_atomic_fetch_add(p, v, __ATOMIC_RELAXED, __HIP_MEMORY_SCOPE_AGENT); }
DI unsigned xb_xcc_id() { return (unsigned)__builtin_amdgcn_s_getreg((3 << 11) | 20) & 0xFu; }
#define XB_SPIN(cond, bar) do { unsigned _sp = 0; while (cond) { __builtin_amdgcn_s_sleep(1); \
    if ((++_sp & 255u) == 0u) { if (xb_ld(&(bar)[XB_TMO])) break; if (_sp > XB_SPIN_CAP) { atomicAdd(&(bar)[XB_TMO], 1u); break; } } } } while (0)
struct XcdBarrier { unsigned* bar; unsigned x; volatile LAS unsigned* st; };
DI XcdBarrier xcd_barrier_post(unsigned* bar, volatile LAS unsigned* st) {
    XcdBarrier b; b.bar = bar; b.x = xb_xcc_id(); b.st = st;
    if (threadIdx.x == 0) (void)xb_add(&bar[XB_XCNT(b.x)], 1u);
    return b;
}
DI void xcd_barrier_complete(unsigned* bar, unsigned x, unsigned& nloc, unsigned& nx) {
    const unsigned G = gridDim.x * gridDim.y * gridDim.z;
    unsigned sum, cnt, mine, sp = 0u;
    for (;;) {
        sum = 0u; cnt = 0u; mine = 0u;
#pragma unroll
        for (unsigned j = 0; j < 16; ++j) { const unsigned c = xb_ld(&bar[XB_XCNT(j)]); sum += c; cnt += (c > 0u) ? 1u : 0u; mine = (j == x) ? c : mine; }
        if (sum == G) break;
        __builtin_amdgcn_s_sleep(1);
        if ((++sp & 255u) == 0u) { if (xb_ld(&bar[XB_TMO])) break; if (sp > XB_SPIN_CAP) { atomicAdd(&bar[XB_TMO], 1u); break; } }
    }
    nloc = mine > 0u ? mine : 1u; nx = cnt > 0u ? cnt : 1u;
}
DI void xcd_barrier(const XcdBarrier& b) {
    asm volatile("s_waitcnt vmcnt(0)" ::: "memory");
    __syncthreads();
    if (threadIdx.x == 0) {
        unsigned* bar = b.bar;
        __builtin_amdgcn_s_waitcnt(0);
        unsigned nloc = b.st[0], nx = b.st[1];
        if (nloc == 0u) { xcd_barrier_complete(bar, b.x, nloc, nx); b.st[0] = nloc; b.st[1] = nx; }
        const unsigned old = xb_add(&bar[XB_XSUB(b.x)], 1u);
        const unsigned gen = old / nloc;
        if (old + 1u == (gen + 1u) * nloc) {
            __builtin_amdgcn_fence(__ATOMIC_RELEASE, "agent");
            asm volatile("s_waitcnt vmcnt(0)" ::: "memory");
            const unsigned og = xb_add(&bar[XB_TOP], 1u);
            const unsigned tg = og / nx;
            if (og + 1u == (tg + 1u) * nx) xb_add(&bar[XB_TOPGEN], 1u);
            else XB_SPIN(xb_ld(&bar[XB_TOPGEN]) == tg, bar);
            __builtin_amdgcn_fence(__ATOMIC_ACQUIRE, "agent");
            xb_add(&bar[XB_XGEN(b.x)], 1u);
            asm volatile("s_waitcnt vmcnt(0)" ::: "memory");
        } else {
            XB_SPIN(xb_ld(&bar[XB_XGEN(b.x)]) == gen, bar);
            __builtin_amdgcn_fence(__ATOMIC_ACQUIRE, "agent");
            asm volatile("s_waitcnt vmcnt(0)" ::: "memory");
        }
    }
    __syncthreads();
}

namespace pg8 {
constexpr int BM = 256, BK = 64, HALF = 128, HTB = HALF * BK * 2, STAGE_BYTES = 8 * HTB, NXCD = 8, WGM = 8;
DI int lds_byte(int r, int c) { const int st = (r >> 4) * 2 + (c >> 5), rr = r & 15, cc = c & 31, ob = rr * 64 + cc * 2; return st * 1024 + (ob ^ (((ob >> 9) & 1) << 5)); }
DI void stage_rc(int b, int& R, int& C) { const int st = b / 1024, sb = b % 1024, swz = sb ^ (((sb >> 9) & 1) << 5); R = (st >> 1) * 16 + swz / 64; C = (st & 1) * 32 + (swz % 64) / 2; }
DI int perm32(int rho) { const int n = rho >> 4, i = rho & 15; return 8 * (i >> 2) + 4 * n + (i & 3); }
struct Unit { int pm, pn, kt0, id; };
struct Gemm { const bf16_t* A; const bf16_t* Bt; int M, N, K, lda, ldb, mstep; };
struct StaticOrder {
    int nM, nN, nwg, G, c;
    DI void init(int M, int N, int G_, int c_) { nM = M / BM; nN = N / BM; nwg = nM * nN; G = G_; c = c_; }
    DI void init_tiles(int nM_, int nN_, int G_, int c_) { nM = nM_; nN = nN_; nwg = nM * nN; G = G_; c = c_; }
    DI bool next(int i, Unit& u) const {
        u.kt0 = 0; u.id = 0; u.pm = 0; u.pn = 0;
        const long L = (long)i * G + c; if (L >= nwg) return false;
        int wgid = (int)L; { const int q = nwg / NXCD, r = nwg % NXCD, xcd = wgid % NXCD, off = wgid / NXCD; wgid = (xcd < r ? xcd * (q + 1) : r * (q + 1) + (xcd - r) * q) + off; }
        const int nig = WGM * nN, gid = wgid / nig, fm = gid * WGM, gsz = (nM - fm) < WGM ? (nM - fm) : WGM;
        u.pm = fm + ((wgid % nig) % gsz); u.pn = (wgid % nig) / gsz; return true;
    }
};
struct PieceOrder {
    int G, c;
    DI bool next(int i, Unit& u) const {
        const int pid = c + i * G; const int su = pid / 11;
        u.pm = 64 + (su >> 2); u.pn = su & 3; u.kt0 = (pid - su * 11) * 4; u.id = pid;
        return pid < 88;
    }
};
template <class Epi, class Sched, int NT>
DI void gemm_phase(LAS unsigned char* lds, const Gemm g, const Sched& S, const Epi& E) {
    int tid = threadIdx.x; asm volatile("" : "+v"(tid));
    const int wid = __builtin_amdgcn_readfirstlane(tid >> 6), lane = tid & 63, wr = wid >> 2, wc = wid & 3, fr = lane & 15, fq = lane >> 4;
    constexpr int nt = NT;
    unsigned voffA[2], voffB[2];
#pragma unroll
    for (int i = 0; i < 2; ++i) { int R, C; stage_rc(tid * 16 + i * 8192, R, C); const int Rb = Epi::PERM ? ((R & ~31) + perm32(R & 31)) : R;
        voffA[i] = (unsigned)(R * g.lda + C) * 2u; voffB[i] = (unsigned)(Rb * g.ldb + C) * 2u; }
    const size_t kstep = (size_t)(BK * 2);
    const size_t hstepA = (size_t)HALF * g.lda * 2, hstepB = (size_t)HALF * g.ldb * 2;
    const size_t tstepA = (size_t)g.mstep * g.lda * 2, tstepB = 2 * hstepB;
    const unsigned ldsw = (unsigned)wid * 1024u;
    const int aoff = lds_byte(wr * 64 + fr, fq * 8), boff = lds_byte(wc * 32 + fr, fq * 8);
#define PG8_SA(b, h) (((b) * 2 + (h)) * HTB)
#define PG8_SB(b, h) ((4 + (b) * 2 + (h)) * HTB)
#define PG8_STAGE(bufoff, gbase, voff) do { _Pragma("unroll") for (int _i = 0; _i < 2; ++_i) \
        __builtin_amdgcn_global_load_lds((const unsigned*)((const char*)(gbase) + (voff)[_i]), (LAS unsigned*)(lds + (bufoff) + ldsw + _i * 8192), 16, 0, 0); } while (0)
#define PG8_LDA(dst, b, h) do { _Pragma("unroll") for (int m = 0; m < 4; ++m) _Pragma("unroll") for (int k = 0; k < 2; ++k) dst[m][k] = *(const LAS bf16x8*)(lds + PG8_SA(b, h) + aoff + m * 2048 + k * 1024); } while (0)
#define PG8_LDB(dst, b, h) do { _Pragma("unroll") for (int n = 0; n < 2; ++n) _Pragma("unroll") for (int k = 0; k < 2; ++k) dst[n][k] = *(const LAS bf16x8*)(lds + PG8_SB(b, h) + boff + n * 2048 + k * 1024); } while (0)
#define PG8_MMA(ai, bj, At, Bt) do { __builtin_amdgcn_s_setprio(1); _Pragma("unroll") for (int m = 0; m < 4; ++m) _Pragma("unroll") for (int n = 0; n < 2; ++n) _Pragma("unroll") for (int k = 0; k < 2; ++k) \
        acc[ai][bj][m][n] = __builtin_amdgcn_mfma_f32_16x16x32_bf16(Bt[n][k], At[m][k], acc[ai][bj][m][n], 0, 0, 0); __builtin_amdgcn_s_setprio(0); } while (0)
#define PG8_WAIT_V(n) asm volatile("s_waitcnt vmcnt(" #n ")" ::: "memory")
#define PG8_WAIT_L(n) asm volatile("s_waitcnt lgkmcnt(" #n ")" ::: "memory")
#define PG8_BAR __builtin_amdgcn_s_barrier()
#define PG8_SCHED __builtin_amdgcn_sched_barrier(0)
    Unit cur, nxt; int ui = 0;
    if (!S.next(0, cur)) return;
    f32x4 acc[2][2][4][2];
#pragma unroll
    for (int a = 0; a < 2; ++a)
#pragma unroll
        for (int b = 0; b < 2; ++b)
#pragma unroll
            for (int m = 0; m < 4; ++m)
#pragma unroll
                for (int n = 0; n < 2; ++n) acc[a][b][m][n] = (f32x4){0.f, 0.f, 0.f, 0.f};
    bf16x8 At[4][2], B0[2][2], B1[2][2];
    const char* cA = (const char*)g.A + (size_t)cur.pm * tstepA + (size_t)cur.kt0 * kstep; const char* cB = (const char*)g.Bt + (size_t)cur.pn * tstepB + (size_t)cur.kt0 * kstep;
    PG8_STAGE(PG8_SB(0, 0), cB, voffB); PG8_STAGE(PG8_SA(0, 0), cA, voffA); PG8_STAGE(PG8_SB(0, 1), cB + hstepB, voffB); PG8_STAGE(PG8_SA(0, 1), cA + hstepA, voffA);
    if (wr == 1) PG8_BAR;
    PG8_WAIT_V(4); PG8_BAR;
    PG8_STAGE(PG8_SB(1, 0), cB + kstep, voffB); PG8_STAGE(PG8_SA(1, 0), cA + kstep, voffA); PG8_STAGE(PG8_SB(1, 1), cB + hstepB + kstep, voffB);
    PG8_WAIT_V(6); PG8_BAR;
    for (;;) {
        const bool has_next = S.next(ui + 1, nxt);
        const char* nA = has_next ? (const char*)g.A + (size_t)nxt.pm * tstepA + (size_t)nxt.kt0 * kstep : cA; const char* nB = has_next ? (const char*)g.Bt + (size_t)nxt.pn * tstepB + (size_t)nxt.kt0 * kstep : cB;
        for (int t = 0; t < nt; t += 2) {
            const bool last = (t == nt - 2);
            const char* a1 = cA + (size_t)(t + 1) * kstep;
            const char* a2 = last ? nA : cA + (size_t)(t + 2) * kstep; const char* b2 = last ? nB : cB + (size_t)(t + 2) * kstep;
            const char* a3 = a2 + kstep; const char* b3 = b2 + kstep;
            if constexpr (Epi::MIDK) { if (t == (nt >> 1)) E.mid(acc, cur, wr, wc, fr, fq); }
            PG8_LDB(B0, 0, 0); PG8_SCHED; PG8_LDA(At, 0, 0); PG8_STAGE(PG8_SA(1, 1), a1 + hstepA, voffA);
            PG8_WAIT_L(8); PG8_BAR; PG8_WAIT_L(0); PG8_MMA(0, 0, At, B0); PG8_BAR; PG8_SCHED;
            PG8_LDB(B1, 0, 1); PG8_STAGE(PG8_SB(0, 0), b2, voffB);
            PG8_BAR; PG8_WAIT_L(0); PG8_MMA(0, 1, At, B1); PG8_BAR;
            PG8_LDA(At, 0, 1); PG8_STAGE(PG8_SA(0, 0), a2, voffA);
            PG8_BAR; PG8_WAIT_L(0); PG8_MMA(1, 0, At, B0); PG8_BAR; PG8_SCHED;
            PG8_STAGE(PG8_SB(0, 1), b2 + hstepB, voffB);
            PG8_WAIT_V(6); PG8_BAR; PG8_MMA(1, 1, At, B1); PG8_BAR;
            PG8_LDB(B0, 1, 0); PG8_SCHED; PG8_LDA(At, 1, 0); PG8_STAGE(PG8_SA(0, 1), a2 + hstepA, voffA);
            PG8_WAIT_L(8); PG8_BAR; PG8_WAIT_L(0); PG8_MMA(0, 0, At, B0); PG8_BAR; PG8_SCHED;
            PG8_LDB(B1, 1, 1); PG8_STAGE(PG8_SB(1, 0), b3, voffB);
            PG8_BAR; PG8_WAIT_L(0); PG8_MMA(0, 1, At, B1); PG8_BAR;
            PG8_LDA(At, 1, 1); PG8_STAGE(PG8_SA(1, 0), a3, voffA);
            PG8_BAR; PG8_WAIT_L(0); PG8_MMA(1, 0, At, B0); PG8_BAR; PG8_SCHED;
            PG8_STAGE(PG8_SB(1, 1), b3 + hstepB, voffB);
            PG8_WAIT_V(6); PG8_BAR; PG8_MMA(1, 1, At, B1); PG8_BAR;
        }
        E(acc, cur, wr, wc, fr, fq);
        if (!has_next) break;
#pragma unroll
        for (int a = 0; a < 2; ++a)
#pragma unroll
            for (int b = 0; b < 2; ++b)
#pragma unroll
                for (int m = 0; m < 4; ++m)
#pragma unroll
                    for (int n = 0; n < 2; ++n) acc[a][b][m][n] = (f32x4){0.f, 0.f, 0.f, 0.f};
        cur = nxt; cA = nA; cB = nB; ++ui;
    }
    PG8_WAIT_V(0);
    if (wr == 0) PG8_BAR;
    PG8_BAR;
#undef PG8_SA
#undef PG8_SB
#undef PG8_STAGE
#undef PG8_LDA
#undef PG8_LDB
#undef PG8_MMA
#undef PG8_WAIT_V
#undef PG8_WAIT_L
#undef PG8_BAR
#undef PG8_SCHED
}
}
using pg8::Unit;
typedef f32x4 AccT[2][2][4][2];

struct EpiProj {
    static constexpr bool PERM = true, MIDK = false;
    unsigned char* ws; const float* rstd1; const float* bcum; const float* ropec; const float* ropes;
    DI void mid(AccT&, const Unit&, int, int, int, int) const {}
    DI void operator()(const AccT& acc, const Unit& u, int wr, int wc, int fr, int fq) const {
        const int pn = u.pn; int seg, pn0;
        if (pn < 8) { seg = pn >> 1; pn0 = seg * 2; } else if (pn == 8) { seg = 4; pn0 = 8; } else if (pn == 9) { seg = 5; pn0 = 9; }
        else if (pn < 12) { seg = 6; pn0 = 10; } else if (pn < 14) { seg = 7; pn0 = 12; } else if (pn < 18) { seg = 8; pn0 = 14; } else { seg = 9; pn0 = 18; }
        size_t segoff; int ld;
        switch (seg) { case 0: segoff = PQ_R; ld = 512; break; case 1: segoff = PK_R; ld = 512; break; case 2: segoff = PV_R; ld = 512; break; case 3: segoff = PG_R; ld = 512; break;
            case 4: segoff = PQ_G; ld = 256; break; case 5: segoff = PK_G; ld = 256; break; case 6: segoff = PV_G; ld = 512; break; case 7: segoff = PG_G; ld = 512; break;
            case 8: segoff = PM_R; ld = 1024; break; default: segoff = PM_G; ld = 1024; break; }
        bf16_t* base = (bf16_t*)(ws + segoff);
        const int lc0 = (pn - pn0) * 256 + wc * 32 + 8 * fq;
        const int row0 = u.pm * 256 + wr * 64 + fr;
        if (seg <= 1) {
            const int i0 = 16 * wc + 4 * fq;
            float lg2h[2];
#pragma unroll
            for (int bj = 0; bj < 2; ++bj) lg2h[bj] = log2f(1.f - exp2f(-5.f - (float)((pn - pn0) * 2 + bj)));
#pragma unroll
            for (int ai = 0; ai < 2; ++ai)
#pragma unroll
                for (int m = 0; m < 4; ++m) {
                    const int row = row0 + ai * 128 + m * 16; const float rs = rstd1[row];
                    int posidx, ic; if (row < TP) { posidx = row & 2047; ic = row & 63; } else { const int s = row - TP; posidx = 2048 + (s & 3); ic = s & 3; }
                    const f32x4 c4 = *(const f32x4*)(ropec + posidx * 64 + i0), s4 = *(const f32x4*)(ropes + posidx * 64 + i0);
#pragma unroll
                    for (int bj = 0; bj < 2; ++bj) {
                        const int head = (pn - pn0) * 2 + bj;
                        const float lg2 = lg2h[bj];
                        const float dec = (seg == 0) ? __builtin_amdgcn_exp2f((float)(ic + 1) * lg2) : __builtin_amdgcn_exp2f(-(float)(ic + 1) * lg2) * 0.08838834764831845f;
                        const f32x4 t1 = acc[ai][bj][m][0] * rs, t2 = acc[ai][bj][m][1] * rs;
                        const f32x4 o1 = (t1 * c4 - t2 * s4) * dec, o2 = (t1 * s4 + t2 * c4) * dec;
                        bf16_t* rp = base + (size_t)row * 512 + head * 128 + i0;
                        u32x2 w1, w2; w1.x = pk2(o1[0], o1[1]); w1.y = pk2(o1[2], o1[3]); w2.x = pk2(o2[0], o2[1]); w2.y = pk2(o2[2], o2[3]);
                        *(u32x2*)rp = w1; *(u32x2*)(rp + 64) = w2;
                    }
                }
            return;
        }
#pragma unroll
        for (int ai = 0; ai < 2; ++ai)
#pragma unroll
            for (int m = 0; m < 4; ++m) {
                const int row = row0 + ai * 128 + m * 16; const float rs = rstd1[row];
#pragma unroll
                for (int bj = 0; bj < 2; ++bj) {
                    const int lc = lc0 + bj * 128;
                    f32x4 v0 = acc[ai][bj][m][0] * rs, v1 = acc[ai][bj][m][1] * rs;
                    if (seg == 4 || seg == 5) {
                        const f32x4 b0 = *(const f32x4*)(bcum + (size_t)row * 256 + lc), b1 = *(const f32x4*)(bcum + (size_t)row * 256 + lc + 4);
                        if (seg == 4) {
#pragma unroll
                            for (int e = 0; e < 4; ++e) { v0[e] *= 0.125f * __expf(b0[e]); v1[e] *= 0.125f * __expf(b1[e]); }
                        } else {
#pragma unroll
                            for (int e = 0; e < 4; ++e) { v0[e] *= __expf(-b0[e]); v1[e] *= __expf(-b1[e]); }
                        }
                    } else if (seg == 3 || seg == 7) {
#pragma unroll
                        for (int e = 0; e < 4; ++e) { v0[e] = v0[e] * sigmoidf_(v0[e]); v1[e] = v1[e] * sigmoidf_(v1[e]); }
                    } else if (seg >= 8) {
#pragma unroll
                        for (int e = 0; e < 4; ++e) { v0[e] = sigmoidf_(v0[e]); v1[e] = sigmoidf_(v1[e]); }
                    }
                    u32x4 w; w.x = pk2(v0[0], v0[1]); w.y = pk2(v0[2], v0[3]); w.z = pk2(v1[0], v1[1]); w.w = pk2(v1[2], v1[3]);
                    __builtin_nontemporal_store(w, (u32x4*)(base + (size_t)row * ld + lc));
                }
            }
    }
};
struct EpiMix {
    static constexpr bool PERM = true, MIDK = true;
    const bf16_t* mr; const bf16_t* mg; bf16_t* mix;
    DI void mid(AccT& acc, const Unit& u, int wr, int wc, int fr, int fq) const {
        int row0 = u.pm * 256 + wr * 64 + fr, c0 = u.pn * 256 + wc * 32 + 8 * fq;
        asm volatile("" : "+v"(row0), "+v"(c0));
#pragma unroll
        for (int ai = 0; ai < 2; ++ai)
#pragma unroll
            for (int m = 0; m < 4; ++m) {
                const int row = row0 + ai * 128 + m * 16;
#pragma unroll
                for (int bj = 0; bj < 2; ++bj) {
                    const u32x4 a = *(const u32x4*)(mr + (size_t)row * 1024 + c0 + bj * 128), b = *(const u32x4*)(mg + (size_t)row * 1024 + c0 + bj * 128);
                    f32x4 r0, r1;
                    r0[0] = bflo(a.x) * __builtin_amdgcn_rcpf(fmaxf(bflo(b.x), 1e-30f)); r0[1] = bfhi(a.x) * __builtin_amdgcn_rcpf(fmaxf(bfhi(b.x), 1e-30f)); r0[2] = bflo(a.y) * __builtin_amdgcn_rcpf(fmaxf(bflo(b.y), 1e-30f)); r0[3] = bfhi(a.y) * __builtin_amdgcn_rcpf(fmaxf(bfhi(b.y), 1e-30f));
                    r1[0] = bflo(a.z) * __builtin_amdgcn_rcpf(fmaxf(bflo(b.z), 1e-30f)); r1[1] = bfhi(a.z) * __builtin_amdgcn_rcpf(fmaxf(bfhi(b.z), 1e-30f)); r1[2] = bflo(a.w) * __builtin_amdgcn_rcpf(fmaxf(bflo(b.w), 1e-30f)); r1[3] = bfhi(a.w) * __builtin_amdgcn_rcpf(fmaxf(bfhi(b.w), 1e-30f));
                    acc[ai][bj][m][0] *= r0; acc[ai][bj][m][1] *= r1;
                }
                __builtin_amdgcn_sched_barrier(0);
            }
    }
    DI void operator()(const AccT& acc, const Unit& u, int wr, int wc, int fr, int fq) const {
        const int row0 = u.pm * 256 + wr * 64 + fr, c0 = u.pn * 256 + wc * 32 + 8 * fq;
#pragma unroll
        for (int ai = 0; ai < 2; ++ai)
#pragma unroll
            for (int m = 0; m < 4; ++m) {
                const int row = row0 + ai * 128 + m * 16;
#pragma unroll
                for (int bj = 0; bj < 2; ++bj) {
                    const u32x4 b = *(const u32x4*)(mg + (size_t)row * 1024 + c0 + bj * 128);
                    const f32x4 v0 = acc[ai][bj][m][0], v1 = acc[ai][bj][m][1];
                    u32x4 w; w.x = pk2(v0[0] * bflo(b.x), v0[1] * bfhi(b.x)); w.y = pk2(v0[2] * bflo(b.y), v0[3] * bfhi(b.y));
                    w.z = pk2(v1[0] * bflo(b.z), v1[1] * bfhi(b.z)); w.w = pk2(v1[2] * bflo(b.w), v1[3] * bfhi(b.w));
                    *(u32x4*)(mix + (size_t)row * 1024 + c0 + bj * 128) = w;
                }
            }
    }
};
struct EpiH {
    static constexpr bool PERM = true, MIDK = false;
    const float* xp; const float* xs; float* h; bf16_t* hb; float* ssq;
    DI void mid(AccT&, const Unit&, int, int, int, int) const {}
    DI void operator()(const AccT& acc, const Unit& u, int wr, int wc, int fr, int fq) const {
        const int row0 = u.pm * 256 + wr * 64 + fr, c0 = u.pn * 256 + wc * 32 + 8 * fq;
#pragma unroll
        for (int ai = 0; ai < 2; ++ai)
#pragma unroll
            for (int m = 0; m < 4; ++m) {
                const int row = row0 + ai * 128 + m * 16;
                const float* xr = row < TP ? xp + (size_t)row * DM : xs + (size_t)(row - TP) * DM;
                float ss = 0.f;
#pragma unroll
                for (int bj = 0; bj < 2; ++bj) {
                    const int c = c0 + bj * 128;
                    const f32x4 v0 = acc[ai][bj][m][0] + *(const f32x4*)(xr + c), v1 = acc[ai][bj][m][1] + *(const f32x4*)(xr + c + 4);
                    u32x4 w; w.x = pk2(v0[0], v0[1]); w.y = pk2(v0[2], v0[3]); w.z = pk2(v1[0], v1[1]); w.w = pk2(v1[2], v1[3]);
                    *(u32x4*)(hb + (size_t)row * DM + c) = w;
                    ss += v0[0] * v0[0] + v0[1] * v0[1] + v0[2] * v0[2] + v0[3] * v0[3] + v1[0] * v1[0] + v1[1] * v1[1] + v1[2] * v1[2] + v1[3] * v1[3];
                }
                ss += __shfl_xor(ss, 16); ss += __shfl_xor(ss, 32);
                if (fq == 0) unsafeAtomicAdd(ssq + row, ss);
            }
    }
};
DI f32x2 gelu_pk(f32x2 v) {
    const f32x2 av = __builtin_elementwise_abs(v), d = av * 0.2316418882f + 1.0f;
    f32x2 t; t.x = __builtin_amdgcn_rcpf(d.x); t.y = __builtin_amdgcn_rcpf(d.y);
    f32x2 q = t * 0.5307027145f + (-0.7265760135f); q = q * t + 0.7107068705f; q = q * t + (-0.142248368f); q = q * t + 0.127414796f; q = q * t;
    const f32x2 s = (v * v) * (-0.72134752044f);
    f32x2 e; e.x = __builtin_amdgcn_exp2f(s.x); e.y = __builtin_amdgcn_exp2f(s.y);
    const f32x2 m = v * (q * e), r = v - m;
    f32x2 o; o.x = v.x < 0.f ? m.x : r.x; o.y = v.y < 0.f ? m.y : r.y; return o;
}
#define DPPF(old_, src_, ctrl_) __int_as_float(__builtin_amdgcn_update_dpp(__float_as_int(old_), __float_as_int(src_), (ctrl_), 0xf, 0xf, false))
struct EpiUpConv {
    static constexpr bool PERM = true, MIDK = false;
    const float* ssq; bf16_t* act; const float* cw; const float* cb; const float* cache; float* out; LAS float* xch;
    DI void mid(AccT&, const Unit&, int, int, int, int) const {}
    DI void operator()(const AccT& acc, const Unit& u, int wr, int wc, int fr, int fq) const {
        const int tokbase = u.pm * 254 - 2, cl = wc * 32 + 8 * fq, f0 = u.pn * 128 + cl;
        float sq[2][4];
#pragma unroll
        for (int ai = 0; ai < 2; ++ai)
#pragma unroll
            for (int m = 0; m < 4; ++m) { const int tok = tokbase + ai * 128 + wr * 64 + m * 16 + fr; sq[ai][m] = (tok >= 0 && tok < T_TOK) ? ssq[tok] : -1.f; }
        f32x4 cb4[2], w04[2], w14[2], w24[2];
#pragma unroll
        for (int n = 0; n < 2; ++n) { cb4[n] = *(const f32x4*)(cb + f0 + 4 * n); w04[n] = *(const f32x4*)(cw + f0 + 4 * n); w14[n] = *(const f32x4*)(cw + DFF + f0 + 4 * n); w24[n] = *(const f32x4*)(cw + 2 * DFF + f0 + 4 * n); }
        float rs[2][4];
#pragma unroll
        for (int ai = 0; ai < 2; ++ai)
#pragma unroll
            for (int m = 0; m < 4; ++m) rs[ai][m] = sq[ai][m] >= 0.f ? rsqrtf(sq[ai][m] * (1.f / DM) + EPS) : 0.f;
        if (fr >= 14) {
#pragma unroll
            for (int ai = 0; ai < 2; ++ai) { LAS float* xp = xch + ((2 * ai + wr) * 2 + (fr - 14)) * 128 + cl;
                *(LAS f32x4*)xp = acc[ai][0][3][0] * rs[ai][3]; *(LAS f32x4*)(xp + 4) = acc[ai][0][3][1] * rs[ai][3]; }
        }
        asm volatile("s_waitcnt lgkmcnt(0)" ::: "memory"); __builtin_amdgcn_s_barrier(); __builtin_amdgcn_s_barrier(); asm volatile("" ::: "memory");
        const bool samp_tile = (tokbase + 255 >= TP);
#pragma unroll
        for (int ai = 0; ai < 2; ++ai) {
            const int g = 2 * ai + wr;
            f32x4 prev[2];
#pragma unroll
            for (int m = 0; m < 4; ++m) {
                const int i = ai * 128 + wr * 64 + m * 16 + fr, tok = tokbase + i;
                int l; const bool samp = tok >= TP;
                if (!samp) l = tok & 2047; else l = (tok - TP) & 3;
                u32x4 w; f32x4 curs[2];
#pragma unroll
                for (int n = 0; n < 2; ++n) {
                    const f32x4 cur = acc[ai][0][m][n] * rs[ai][m], vv = acc[ai][1][m][n] * rs[ai][m];
                    f32x4 x1, x2;
                    if (m == 0) {
                        f32x4 h1 = {0.f, 0.f, 0.f, 0.f}, h2 = {0.f, 0.f, 0.f, 0.f};
                        if (g >= 1) { h1 = *(const LAS f32x4*)(xch + ((g - 1) * 2 + 1) * 128 + cl + 4 * n); h2 = *(const LAS f32x4*)(xch + ((g - 1) * 2 + (fr == 0 ? 0 : 1)) * 128 + cl + 4 * n); }
#pragma unroll
                        for (int e = 0; e < 4; ++e) { x1[e] = DPPF(h1[e], cur[e], 0x111); x2[e] = DPPF(h2[e], cur[e], 0x112); }
                    } else {
#pragma unroll
                        for (int e = 0; e < 4; ++e) { const float o1 = DPPF(0.f, prev[n][e], 0x121), o2 = DPPF(0.f, prev[n][e], 0x122);
                            x1[e] = DPPF(o1, cur[e], 0x111); x2[e] = DPPF(o2, cur[e], 0x112); }
                    }
                    prev[n] = cur; curs[n] = cur;
                    if (l < 2) {
                        if (samp_tile && samp) {
                            const int bidx = (tok - TP) >> 2;
                            if (tok < T_TOK) { const f32x4 c1 = *(const f32x4*)(cache + ((size_t)bidx * 2 + 1) * DFF + f0 + 4 * n), c0 = *(const f32x4*)(cache + ((size_t)bidx * 2 + l) * DFF + f0 + 4 * n);
                                x2 = c0; if (l == 0) x1 = c1; }
                        } else { x2 = (f32x4){0.f, 0.f, 0.f, 0.f}; if (l == 0) x1 = x2; }
                    }
                    const f32x4 uc = cb4[n] + w04[n] * x2 + w14[n] * x1 + w24[n] * cur;
                    const f32x2 ga = gelu_pk((f32x2){uc[0], uc[1]}), gb = gelu_pk((f32x2){uc[2], uc[3]});
                    const unsigned p0 = pk2(ga.x * vv[0], ga.y * vv[1]), p1 = pk2(gb.x * vv[2], gb.y * vv[3]);
                    if (n == 0) { w.x = p0; w.y = p1; } else { w.z = p0; w.w = p1; }
                }
                if (i >= 2 && tok < T_TOK) {
                    *(u32x4*)(act + (size_t)tok * DFF + f0) = w;
                    if (!samp) { if (l >= 2046) { float* o = out + OUT_CP + ((size_t)(tok >> 11) * 2 + (l - 2046)) * DFF + f0; *(f32x4*)o = curs[0]; *(f32x4*)(o + 4) = curs[1]; } }
                    else if (l >= 2) { float* o = out + OUT_CS + ((size_t)((tok - TP) >> 2) * 2 + (l - 2)) * DFF + f0; *(f32x4*)o = curs[0]; *(f32x4*)(o + 4) = curs[1]; }
                }
            }
        }
    }
};
struct EpiDownNorm {
    static constexpr bool PERM = true, MIDK = false;
    const bf16_t* hb; float* y; const float* lnf; float* exch; unsigned* cnt; LAS float* xl;
    DI void mid(AccT&, const Unit&, int, int, int, int) const {}
    DI void operator()(const AccT& acc_, const Unit& u, int wr, int wc, int fr, int fq) const {
        AccT& acc = const_cast<AccT&>(acc_);
        const int lrow0 = wr * 64 + fr, row0 = u.pm * 256 + lrow0, c0 = u.pn * 256 + wc * 32 + 8 * fq;
#pragma unroll
        for (int ai = 0; ai < 2; ++ai)
#pragma unroll
            for (int m = 0; m < 4; ++m) {
                const int row = row0 + ai * 128 + m * 16;
                float ss = 0.f;
#pragma unroll
                for (int bj = 0; bj < 2; ++bj) {
                    const u32x4 hv = *(const u32x4*)(hb + (size_t)row * DM + c0 + bj * 128);
                    f32x4 v0 = acc[ai][bj][m][0], v1 = acc[ai][bj][m][1];
                    v0[0] += bflo(hv.x); v0[1] += bfhi(hv.x); v0[2] += bflo(hv.y); v0[3] += bfhi(hv.y); v1[0] += bflo(hv.z); v1[1] += bfhi(hv.z); v1[2] += bflo(hv.w); v1[3] += bfhi(hv.w);
                    acc[ai][bj][m][0] = v0; acc[ai][bj][m][1] = v1;
                    ss += v0[0] * v0[0] + v0[1] * v0[1] + v0[2] * v0[2] + v0[3] * v0[3] + v1[0] * v1[0] + v1[1] * v1[1] + v1[2] * v1[2] + v1[3] * v1[3];
                }
                ss += __shfl_xor(ss, 16); ss += __shfl_xor(ss, 32);
                if (fq == 0) xl[(lrow0 + ai * 128 + m * 16) * 4 + wc] = ss;
            }
        unsigned* pc = cnt + u.pm * 32;
#define G5_PUBLISH() do { if (wc == 0) { \
            if (fq == 0) { \
                _Pragma("unroll") for (int ai = 0; ai < 2; ++ai) _Pragma("unroll") for (int m = 0; m < 4; ++m) { const int lr = lrow0 + ai * 128 + m * 16; const f32x4 q = *(const LAS f32x4*)(xl + lr * 4); \
                    __hip_atomic_store(exch + (size_t)(u.pm * 256 + lr) * 4 + u.pn, (q[0] + q[1]) + (q[2] + q[3]), __ATOMIC_RELAXED, __HIP_MEMORY_SCOPE_AGENT); } } \
            asm volatile("s_waitcnt vmcnt(0)" ::: "memory"); \
            __builtin_amdgcn_fence(__ATOMIC_RELEASE, "agent"); \
            asm volatile("s_waitcnt vmcnt(0)" ::: "memory"); \
            if (fr == 0 && fq == 0) __hip_atomic_fetch_add(pc, 1u, __ATOMIC_RELAXED, __HIP_MEMORY_SCOPE_AGENT); } } while (0)
        asm volatile("s_waitcnt lgkmcnt(0)" ::: "memory"); __builtin_amdgcn_s_barrier(); asm volatile("" ::: "memory");
        if (wr == 1) G5_PUBLISH();
        asm volatile("s_waitcnt lgkmcnt(0)" ::: "memory"); __builtin_amdgcn_s_barrier(); asm volatile("" ::: "memory");
        if (wr == 0) G5_PUBLISH();
#undef G5_PUBLISH
        {
            unsigned spins = 0;
            while (__hip_atomic_load(pc, __ATOMIC_RELAXED, __HIP_MEMORY_SCOPE_AGENT) < 8u && ++spins < (1u << 18)) __builtin_amdgcn_s_sleep(16);
            __builtin_amdgcn_fence(__ATOMIC_ACQUIRE, "agent"); }
#pragma unroll
        for (int ai = 0; ai < 2; ++ai)
#pragma unroll
            for (int m = 0; m < 4; ++m) {
                const int row = row0 + ai * 128 + m * 16;
                f32x4 q;
                q[0] = __hip_atomic_load(exch + (size_t)row * 4 + 0, __ATOMIC_RELAXED, __HIP_MEMORY_SCOPE_AGENT); q[1] = __hip_atomic_load(exch + (size_t)row * 4 + 1, __ATOMIC_RELAXED, __HIP_MEMORY_SCOPE_AGENT);
                q[2] = __hip_atomic_load(exch + (size_t)row * 4 + 2, __ATOMIC_RELAXED, __HIP_MEMORY_SCOPE_AGENT); q[3] = __hip_atomic_load(exch + (size_t)row * 4 + 3, __ATOMIC_RELAXED, __HIP_MEMORY_SCOPE_AGENT);
                const float rs = rsqrtf(((q[0] + q[1]) + (q[2] + q[3])) * (1.f / DM) + EPS);
#pragma unroll
                for (int bj = 0; bj < 2; ++bj) {
                    const int c = c0 + bj * 128;
                    const f32x4 g0 = *(const f32x4*)(lnf + c), g1 = *(const f32x4*)(lnf + c + 4);
                    *(f32x4*)(y + (size_t)row * DM + c) = acc[ai][bj][m][0] * rs * g0; *(f32x4*)(y + (size_t)row * DM + c + 4) = acc[ai][bj][m][1] * rs * g1;
                }
            }
    }
};
struct EpiPart {
    static constexpr bool PERM = true, MIDK = false;
    bf16_t* part;
    DI void mid(AccT&, const Unit&, int, int, int, int) const {}
    DI void operator()(const AccT& acc, const Unit& u, int wr, int wc, int fr, int fq) const {
        bf16_t* base = part + (size_t)u.id * 65536 + (wr * 64 + fr) * 256 + wc * 32 + 8 * fq;
#pragma unroll
        for (int ai = 0; ai < 2; ++ai)
#pragma unroll
            for (int m = 0; m < 4; ++m)
#pragma unroll
                for (int bj = 0; bj < 2; ++bj) { const f32x4 v0 = acc[ai][bj][m][0], v1 = acc[ai][bj][m][1];
                    u32x4 w; w.x = pk2(v0[0], v0[1]); w.y = pk2(v0[2], v0[3]); w.z = pk2(v1[0], v1[1]); w.w = pk2(v1[2], v1[3]);
                    *(u32x4*)(base + (ai * 128 + m * 16) * 256 + bj * 128) = w; }
    }
};

DI void transpose_item(const float* __restrict__ src, int ldsrc, int srccol, int k0, const float* __restrict__ scale, bf16_t* dst, int lddst, int n0dst, int k0dst,
                       LAS float* scr, int lane) {
    float tv[32];
#pragma unroll
    for (int i = 0; i < 32; ++i) { const int kk = 2 * i + (lane >> 5); tv[i] = src[(size_t)(k0 + kk) * ldsrc + srccol]; }
    if (scale) {
#pragma unroll
        for (int i = 0; i < 32; ++i) tv[i] *= scale[k0 + 2 * i + (lane >> 5)];
    }
#pragma unroll
    for (int i = 0; i < 32; ++i) scr[(2 * i + (lane >> 5)) * 33 + (lane & 31)] = tv[i];
    LDS_WAIT();
    const int c = lane & 7;
#pragma unroll
    for (int j = 0; j < 4; ++j) { const int n = (lane >> 3) + 8 * j; const LAS float* s = scr + (8 * c) * 33 + n;
        u32x4 o; o.x = pk2(s[0 * 33], s[1 * 33]); o.y = pk2(s[2 * 33], s[3 * 33]); o.z = pk2(s[4 * 33], s[5 * 33]); o.w = pk2(s[6 * 33], s[7 * 33]);
        *(u32x4*)(dst + (size_t)(n0dst + n) * lddst + k0dst + 8 * c) = o; }
    LDS_WAIT();
}
DI float log_sigmoid(float z) { return fminf(z, 0.f) - __logf(1.f + __expf(-fabsf(z))); }

DI void phase0(const Params& p, LAS unsigned char* lds) {
    int tid = threadIdx.x; asm volatile("" : "+v"(tid));
    const int lane = tid & 63, wave = tid >> 6;
    unsigned char* ws = p.ws;
    LAS bf16_t* wga = (LAS bf16_t*)lds;
    LAS float* gas = (LAS float*)(lds + 33024);
    LAS float* scr = (LAS float*)(lds + 41216 + wave * 8448);
    bf16_t* xb = (bf16_t*)((unsigned char*)p.out + 0);
    float* rstd1 = (float*)(ws + WS_RSTD1); float* bcum = (float*)(ws + WS_SH); float* ebl = (float*)(ws + WS_EBL);
    { const int gt = blockIdx.x * 512 + tid, ng = gridDim.x * 512;
      float* ssq2 = (float*)(ws + WS_SSQ2);
      for (int i = gt; i < T_TOK; i += ng) ssq2[i] = 0.f;
      float* rc = (float*)(ws + WS_ROPEC); float* rsn = (float*)(ws + WS_ROPES);
      for (int i = gt; i < 2052 * 64; i += ng) { const int pi = i >> 6, fi = i & 63; const double pos = (double)(pi < 2048 ? pi : 16384 + (pi - 2048));
          const double inv = exp(-(double)fi * (9.210340371976184 / 64.0)); const double ang = pos * inv; const double kk = rint(ang * 0.15915494309189535);
          const float r = (float)(ang - kk * 6.283185307179586); rc[i] = cosf(r); rsn[i] = sinf(r); } }
    {
        LAS float* accp = (LAS float*)(lds + 41216);
        LAS float* ssp = accp + 2048;
        LAS float* tot = ssp + 128;
        for (int k = tid; k < DM; k += 512) { const float g = p.ln1[k]; const float* s = p.w_in + (size_t)k * DIN + 3584;
            const f32x4 s0 = *(const f32x4*)s, s1 = *(const f32x4*)(s + 4), s2 = *(const f32x4*)(s + 8), s3 = *(const f32x4*)(s + 12);
            const float sv[16] = {s0[0], s0[1], s0[2], s0[3], s1[0], s1[1], s1[2], s1[3], s2[0], s2[1], s2[2], s2[3], s3[0], s3[1], s3[2], s3[3]};
#pragma unroll
            for (int r = 0; r < 16; r += 2) { const unsigned w = pk2(sv[r] * g, sv[r + 1] * g); wga[r * 1032 + k] = (bf16_t)(w & 0xffffu); wga[(r + 1) * 1032 + k] = (bf16_t)(w >> 16); } }
        __syncthreads();
        for (int u = blockIdx.x; u < 264; u += gridDim.x) {
            const int r16 = lane & 15, kq = lane >> 4, rg = wave & 3, kh = wave >> 2, row = u * 64 + rg * 16 + r16;
            const float* xr = x_row(p, row) + kh * 512;
            bf16_t* xbr = xb + (size_t)row * DM + kh * 512;
            const LAS bf16_t* wgr = wga + r16 * 1032 + kh * 512;
            f32x4 acc = {0.f, 0.f, 0.f, 0.f}; float ss = 0.f;
            for (int ks = 0; ks < 16; ks += 8) {
                f32x4 v[8][2];
#pragma unroll
                for (int q = 0; q < 8; ++q) { v[q][0] = *(const f32x4*)(xr + (ks + q) * 32 + kq * 8); v[q][1] = *(const f32x4*)(xr + (ks + q) * 32 + kq * 8 + 4); }
#pragma unroll
                for (int q = 0; q < 8; ++q) {
                    const f32x4 a0 = v[q][0], a1 = v[q][1];
                    ss += a0[0] * a0[0] + a0[1] * a0[1] + a0[2] * a0[2] + a0[3] * a0[3] + a1[0] * a1[0] + a1[1] * a1[1] + a1[2] * a1[2] + a1[3] * a1[3];
                    u32x4 w; w.x = pk2(a0[0], a0[1]); w.y = pk2(a0[2], a0[3]); w.z = pk2(a1[0], a1[1]); w.w = pk2(a1[2], a1[3]);
                    *(u32x4*)(xbr + (ks + q) * 32 + kq * 8) = w;
                    const bf16x8 bfrag = *(const LAS bf16x8*)(wgr + (ks + q) * 32 + kq * 8);
                    acc = __builtin_amdgcn_mfma_f32_16x16x32_bf16(__builtin_bit_cast(bf16x8, w), bfrag, acc, 0, 0, 0);
                }
            }
            ss += __shfl_xor(ss, 16); ss += __shfl_xor(ss, 32);
            if (kq == 0) ssp[kh * 64 + rg * 16 + r16] = ss;
#pragma unroll
            for (int j = 0; j < 4; ++j) accp[(kh * 64 + rg * 16 + kq * 4 + j) * 16 + r16] = acc[j];
            __syncthreads();
#pragma unroll
            for (int e = 0; e < 2; ++e) { const int idx = tid + 512 * e, lr = idx >> 4;
                const float rs = rsqrtf((ssp[lr] + ssp[64 + lr]) * (1.f / DM) + EPS);
                gas[idx] = (accp[idx] + accp[1024 + idx]) * rs;
                if ((idx & 15) == 0) rstd1[u * 64 + lr] = rs; }
            __syncthreads();
            {
                const int c = tid & 255, half = tid >> 8;
                float wg[16];
#pragma unroll
                for (int r = 0; r < 16; ++r) wg[r] = p.w_gate_up[r * 256 + c];
                const float bias = p.b_gate_up[c];
                const int tokb = u * 64 + half * 32; const bool samp = tokb >= TP;
                float ls[32]; float cum = 0.f;
#pragma unroll
                for (int i = 0; i < 32; ++i) {
                    const LAS f32x4* gp = (const LAS f32x4*)(gas + (half * 32 + i) * 16);
                    const f32x4 g0 = gp[0], g1 = gp[1], g2 = gp[2], g3 = gp[3];
                    float z = bias;
                    z += g0[0] * wg[0] + g0[1] * wg[1] + g0[2] * wg[2] + g0[3] * wg[3] + g1[0] * wg[4] + g1[1] * wg[5] + g1[2] * wg[6] + g1[3] * wg[7];
                    z += g2[0] * wg[8] + g2[1] * wg[9] + g2[2] * wg[10] + g2[3] * wg[11] + g3[0] * wg[12] + g3[1] * wg[13] + g3[2] * wg[14] + g3[3] * wg[15];
                    ls[i] = log_sigmoid(z) * (1.f / 16.f); cum += ls[i];
                }
                if (half == 0) tot[c] = cum;
                __syncthreads();
                cum = (half == 1 && !samp) ? tot[c] : 0.f;
#pragma unroll
                for (int i = 0; i < 32; ++i) {
                    cum = (samp && (i & 3) == 0) ? ls[i] : cum + ls[i];
                    const int tok = tokb + i;
                    bcum[(size_t)tok * 256 + c] = cum;
                    if (samp) { if ((i & 3) == 3) ebl[(size_t)(256 + ((tok - TP) >> 2)) * 256 + c] = expf(cum); }
                    else if (half == 1 && i == 31) ebl[(size_t)(tok >> 6) * 256 + c] = expf(cum);
                }
            }
            __syncthreads();
        }
    }
    {
        const int gw = blockIdx.x * 8 + wave, ngw = gridDim.x * 8;
        constexpr int I_IN = 16 * 176, I_MX = 8 * 32, I_O = 16 * 32, I_UP = 16 * 176, I_DN = 44 * 32, NIT = I_IN + 2 * I_MX + I_O + I_UP + I_DN;
        for (int it = gw; it < NIT; it += ngw) {
            int r = it; const int nl = lane & 31;
            if (r < I_IN) { const int kb = r / 176, nb = r % 176, n = nb * 32 + nl; int sc;
                if (n < 1024) { const int pp = n & 127; sc = (n & ~127) + (((pp & 7) < 4) ? 4 * (pp >> 3) + (pp & 7) : 64 + 4 * (pp >> 3) + (pp & 7) - 4); }
                else sc = n < 3584 ? n : n + 16;
                transpose_item(p.w_in, DIN, sc, kb * 64, p.ln1, (bf16_t*)(ws + WS_WIN), DM, nb * 32, kb * 64, scr, lane); continue; }
            r -= I_IN;
            if (r < I_MX) { const int kb = r / 32, nb = r % 32; transpose_item(p.w_ret_out, DM, nb * 32 + nl, kb * 64, nullptr, (bf16_t*)(ws + WS_WMIX), DM, nb * 32, kb * 64, scr, lane); continue; }
            r -= I_MX;
            if (r < I_MX) { const int kb = r / 32, nb = r % 32; transpose_item(p.w_gla_out, DM, nb * 32 + nl, kb * 64, nullptr, (bf16_t*)(ws + WS_WMIX), DM, nb * 32, 512 + kb * 64, scr, lane); continue; }
            r -= I_MX;
            if (r < I_O) { const int kb = r / 32, nb = r % 32; transpose_item(p.w_o, DM, nb * 32 + nl, kb * 64, nullptr, (bf16_t*)(ws + WS_WO), DM, nb * 32, kb * 64, scr, lane); continue; }
            r -= I_O;
            if (r < I_UP) { const int kb = r / 176, nb = r % 176, n = nb * 32 + nl; const int sc = ((n >> 7) & 1) * DFF + (n >> 8) * 128 + (n & 127);
                transpose_item(p.w_up, NUP, sc, kb * 64, p.ln2, (bf16_t*)(ws + WS_WUP), DM, nb * 32, kb * 64, scr, lane); continue; }
            r -= I_UP;
            { const int kb = r / 32, nb = r % 32; transpose_item(p.w_down, DM, nb * 32 + nl, kb * 64, nullptr, (bf16_t*)(ws + WS_WDN), DFF, nb * 32, kb * 64, scr, lane); }
        }
    }
}

template <int DK> DI unsigned img_off(int row, int ch) { return (unsigned)(row * (2 * DK) + 16 * (ch ^ ((((row & 3) << 2) | ((row >> 2) & 3)) & (DK / 8 - 1)))); }
template <int DK> DI unsigned tr_addr(int lane, int c, int ks, int t) {
    const int h = lane >> 5, blk = (lane >> 4) & 1, q = (lane & 15) >> 2, pp = lane & 3;
    return img_off<DK>(16 * ks + 8 * h + 4 * t + q, 4 * c + 2 * blk + (pp >> 1)) + 8 * (pp & 1);
}
DI bf16x8 tr_frag(LAS unsigned char* a0, LAS unsigned char* a1) {
    const s16x4 lo = __builtin_amdgcn_ds_read_tr16_b64_v4i16((LAS s16x4*)a0), hi = __builtin_amdgcn_ds_read_tr16_b64_v4i16((LAS s16x4*)a1);
    return __builtin_shufflevector(lo, hi, 0, 1, 2, 3, 4, 5, 6, 7);
}
DI bf16x8 pack8(const f32x16& x, int s) {
    u32x4 w; w.x = pk2(x[8 * s + 0], x[8 * s + 1]); w.y = pk2(x[8 * s + 2], x[8 * s + 3]); w.z = pk2(x[8 * s + 4], x[8 * s + 5]); w.w = pk2(x[8 * s + 6], x[8 * s + 7]);
    return __builtin_bit_cast(bf16x8, w);
}
#define MFMA32(a, b, c) __builtin_amdgcn_mfma_f32_32x32x16_bf16((a), (b), (c), 0, 0, 0)

constexpr int P2_BUF = 49152, P2_QO = 0, P2_KO = 16384, P2_VO = 32768, P2_P = 98304, P2_SSQ = P2_P + 64 * 144, P2_EBL = P2_SSQ + 1024;

template <int DK, bool FULL> DI void chain_prompt(const Params& p, LAS unsigned char* lds, const int branch, const int b, const int head, const int c0, const int nc, const int nprev, const bool write_final) {
    constexpr int NDB = DK / 32, NCH = DK / 8, QLD = 4 * DK, NQI = (64 * NCH) / 512;
    int tid0 = threadIdx.x; asm volatile("" : "+v"(tid0));
    const int w = __builtin_amdgcn_readfirstlane(tid0 >> 6);
    int tid = tid0, lane = tid0 & 63, h = lane >> 5, r = lane & 31;
    unsigned char* ws = p.ws;
    const bf16_t* Q = (const bf16_t*)(ws + (branch == 0 ? PQ_R : PQ_G)) + head * DK;
    const bf16_t* K = (const bf16_t*)(ws + (branch == 0 ? PK_R : PK_G)) + head * DK;
    const bf16_t* V = (const bf16_t*)(ws + (branch == 0 ? PV_R : PV_G)) + head * 128;
    const bf16_t* G = (const bf16_t*)(ws + (branch == 0 ? PG_R : PG_G)) + head * 128;
    const float* ebl = (const float*)(ws + WS_EBL);
    bf16_t* arg = (bf16_t*)((unsigned char*)p.out + SEG1024) + branch * 512 + head * 128;
    const float* gain = (branch == 0 ? p.g_ret : p.g_gla) + head * 128;
    const int tok0 = b * 2048;
    const float lg2 = log2f(1.f - exp2f(-5.f - (float)head));
    const float ret_ebl = exp2f(64.f * lg2);
    const int chain = branch * 32 + b * 4 + head;
    float* Lbuf = (float*)p.out + (size_t)chain * 3 * 16384;
    float* Dbuf = (float*)p.out + (size_t)64 * 3 * 16384 + (size_t)chain * 3 * 64;
    f32x16 S[NDB];
#pragma unroll
    for (int d = 0; d < NDB; ++d)
#pragma unroll
        for (int i = 0; i < 16; ++i) S[d][i] = 0.f;
    f32x4 gn[4];
    if (w < 4) {
#pragma unroll
        for (int g = 0; g < 4; ++g) gn[g] = *(const f32x4*)(gain + 32 * w + 8 * g + 4 * h);
        if (FULL) {
            for (int sg = 0; sg < nprev; ++sg) {
#pragma unroll
                for (int d = 0; d < NDB; ++d)
#pragma unroll
                    for (int i = 0; i < 16; ++i) {
                        const int dd = 32 * d + (i & 3) + 8 * (i >> 2) + 4 * h;
                        const float dec = (DK == 128) ? exp2f(64.f * (float)nc * lg2) : Dbuf[sg * 64 + dd];
                        S[d][i] = (sg == 0 ? 0.f : S[d][i] * dec) + Lbuf[(size_t)sg * 16384 + (size_t)dd * 128 + 32 * w + r];
                    }
            }
        }
    }
    float dprod = 1.f;
    u32x4 rq[NQI], rk[NQI], rv[2]; float rebl = 0.f;
#define P2_LOAD(c) do { const int tb = tok0 + 64 * (c); \
        _Pragma("unroll") for (int i = 0; i < NQI; ++i) { const int idx = tid + 512 * i, rr = idx / NCH, ch = idx % NCH; \
            rq[i] = *(const u32x4*)(Q + (size_t)(tb + rr) * QLD + ch * 8); rk[i] = *(const u32x4*)(K + (size_t)(tb + rr) * QLD + ch * 8); } \
        _Pragma("unroll") for (int i = 0; i < 2; ++i) { const int idx = tid + 512 * i, rr = idx >> 4, ch = idx & 15; rv[i] = *(const u32x4*)(V + (size_t)(tb + rr) * 512 + ch * 8); } \
        if (DK == 64 && tid < 64) rebl = ebl[(size_t)(b * 32 + (c)) * 256 + head * 64 + tid]; } while (0)
#define P2_STORE(buf) do { LAS unsigned char* bb = lds + (buf) * P2_BUF; \
        _Pragma("unroll") for (int i = 0; i < NQI; ++i) { const int idx = tid + 512 * i, rr = idx / NCH, ch = idx % NCH; \
            *(LAS u32x4*)(bb + P2_QO + img_off<DK>(rr, ch)) = rq[i]; *(LAS u32x4*)(bb + P2_KO + img_off<DK>(rr, ch)) = rk[i]; } \
        _Pragma("unroll") for (int i = 0; i < 2; ++i) { const int idx = tid + 512 * i, rr = idx >> 4, ch = idx & 15; *(LAS u32x4*)(bb + P2_VO + img_off<128>(rr, ch)) = rv[i]; } \
        if (DK == 64 && tid < 64) *(LAS float*)(lds + P2_EBL + (buf) * 256 + tid * 4) = rebl; } while (0)
    P2_LOAD(c0); P2_STORE(c0 & 1);
    dprod *= rebl;
    __syncthreads();
    const int cend = c0 + nc;
    for (int c = c0; c < cend; ++c) {
        tid = tid0; asm volatile("" : "+v"(tid)); lane = tid & 63; h = lane >> 5; r = lane & 31;
        LAS unsigned char* bb = lds + (c & 1) * P2_BUF;
        LAS unsigned char* qi = bb + P2_QO; LAS unsigned char* ki = bb + P2_KO; LAS unsigned char* vi = bb + P2_VO;
        if (c + 1 < cend) { P2_LOAD(c + 1); dprod *= rebl; }
        u32x2 gt[2][4];
        if (FULL && w < 4) {
            {   const int tbg = tok0 + 64 * c;
#pragma unroll
                for (int ib = 0; ib < 2; ++ib)
#pragma unroll
                    for (int g = 0; g < 4; ++g) gt[ib][g] = *(const u32x2*)(G + (size_t)(tbg + 32 * ib + r) * 512 + 32 * w + 8 * g + 4 * h); }
        }
        if (FULL && w >= 4 && w < 7) {
            const int ws_ = w - 4;
            const int jb = (ws_ == 2) ? 1 : 0, ib = (ws_ == 0) ? 0 : 1;
            f32x16 pt;
#pragma unroll
            for (int i = 0; i < 16; ++i) pt[i] = 0.f;
#pragma unroll
            for (int s = 0; s < DK / 16; ++s) {
                const bf16x8 a = *(const LAS bf16x8*)(ki + img_off<DK>(32 * jb + r, 2 * s + h)), bq = *(const LAS bf16x8*)(qi + img_off<DK>(32 * ib + r, 2 * s + h));
                pt = MFMA32(a, bq, pt);
            }
            if (jb == ib) {
#pragma unroll
                for (int i = 0; i < 16; ++i) { const int j = (i & 3) + 8 * (i >> 2) + 4 * h; pt[i] = (j <= r) ? pt[i] : 0.f; }
            }
#pragma unroll
            for (int g = 0; g < 4; ++g) { u32x2 o; o.x = pk2(pt[4 * g], pt[4 * g + 1]); o.y = pk2(pt[4 * g + 2], pt[4 * g + 3]);
                *(LAS u32x2*)(lds + P2_P + (32 * ib + r) * 144 + (32 * jb + 8 * g + 4 * h) * 2) = o; }
        }
        f32x16 ot[2];
        bf16x8 vf[4];
        if (w < 4) {
#pragma unroll
            for (int s = 0; s < 4; ++s) vf[s] = tr_frag(vi + tr_addr<128>(lane, w, s, 0), vi + tr_addr<128>(lane, w, s, 1));
#pragma unroll
            for (int ib = 0; ib < 2; ++ib)
#pragma unroll
                for (int i = 0; i < 16; ++i) ot[ib][i] = 0.f;
            if (FULL)
#pragma unroll
            for (int d = 0; d < NDB; ++d)
#pragma unroll
                for (int s2 = 0; s2 < 2; ++s2) {
                    const bf16x8 sfr = pack8(S[d], s2);
#pragma unroll
                    for (int ib = 0; ib < 2; ++ib) {
                        const s16x4 lo = *(const LAS s16x4*)(qi + img_off<DK>(32 * ib + r, 4 * d + 2 * s2) + 8 * h), hi = *(const LAS s16x4*)(qi + img_off<DK>(32 * ib + r, 4 * d + 2 * s2 + 1) + 8 * h);
                        const bf16x8 bq = __builtin_shufflevector(lo, hi, 0, 1, 2, 3, 4, 5, 6, 7);
                        ot[ib] = MFMA32(sfr, bq, ot[ib]);
                    }
                }
#pragma unroll
            for (int d = 0; d < NDB; ++d) {
#pragma unroll
                for (int s = 0; s < 4; ++s) {
                    const bf16x8 a = tr_frag(ki + tr_addr<DK>(lane, d, s, 0), ki + tr_addr<DK>(lane, d, s, 1));
                    S[d] = MFMA32(a, vf[s], S[d]);
                }
                if (DK == 128) {
#pragma unroll
                    for (int i = 0; i < 16; ++i) S[d][i] *= ret_ebl;
                } else {
                    const LAS float* eb = (const LAS float*)(lds + P2_EBL + (c & 1) * 256) + 32 * d + 4 * h;
#pragma unroll
                    for (int g = 0; g < 4; ++g) { const f32x4 e4 = *(const LAS f32x4*)(eb + 8 * g);
#pragma unroll
                        for (int e = 0; e < 4; ++e) S[d][4 * g + e] *= e4[e]; }
                }
            }
        }
        if (FULL) __syncthreads();
        if (FULL && w < 4) {
#pragma unroll
            for (int ib = 0; ib < 2; ++ib) {
#pragma unroll
                for (int s = 0; s < (ib == 0 ? 2 : 4); ++s) {
                    const bf16x8 bp = *(const LAS bf16x8*)(lds + P2_P + (32 * ib + r) * 144 + (16 * s + 8 * h) * 2);
                    ot[ib] = MFMA32(vf[s], bp, ot[ib]);
                }
            }
#pragma unroll
            for (int ib = 0; ib < 2; ++ib) { float ss = 0.f;
#pragma unroll
                for (int i = 0; i < 16; ++i) ss += ot[ib][i] * ot[ib][i];
                ss += __shfl_xor(ss, 32);
                if (h == 0) *(LAS float*)(lds + P2_SSQ + (w * 64 + 32 * ib + r) * 4) = ss; }
        }
        if (c + 1 < cend) P2_STORE((c + 1) & 1);
        __syncthreads();
        if (FULL && w < 4) {
            asm volatile("" : "+v"(lane)); h = lane >> 5; r = lane & 31;
            const int tb = tok0 + 64 * c;
#pragma unroll
            for (int ib = 0; ib < 2; ++ib) {
                const LAS float* sq = (const LAS float*)(lds + P2_SSQ) + 32 * ib + r;
                const float tot = sq[0] + sq[64] + sq[128] + sq[192];
                const float rs = rsqrtf(tot * (1.f / 128.f) + EPS);
#pragma unroll
                for (int g = 0; g < 4; ++g) {
                    const u32x2 gg = gt[ib][g];
                    u32x2 o; o.x = pk2(ot[ib][4 * g] * rs * gn[g][0] * bflo(gg.x), ot[ib][4 * g + 1] * rs * gn[g][1] * bfhi(gg.x));
                    o.y = pk2(ot[ib][4 * g + 2] * rs * gn[g][2] * bflo(gg.y), ot[ib][4 * g + 3] * rs * gn[g][3] * bfhi(gg.y));
                    *(u32x2*)(arg + (size_t)(tb + 32 * ib + r) * 1024 + 32 * w + 8 * g + 4 * h) = o;
                }
            }
        }
    }
#undef P2_LOAD
#undef P2_STORE
    if (!FULL && DK == 64 && tid0 < 64) Dbuf[nprev * 64 + tid0] = dprod;
    if (w < 4 && (write_final || !FULL)) {
        lane = tid0 & 63; h = lane >> 5; r = lane & 31;
        float* so = FULL ? p.out + (branch == 0 ? OUT_RSP : OUT_GSP) + (size_t)(b * 4 + head) * DK * 128 : Lbuf + (size_t)nprev * 16384;
#pragma unroll
        for (int d = 0; d < NDB; ++d)
#pragma unroll
            for (int i = 0; i < 16; ++i) so[(size_t)(32 * d + (i & 3) + 8 * (i >> 2) + 4 * h) * 128 + 32 * w + r] = S[d][i];
    }
    __syncthreads();
}

template <int DK> DI void sample_unit(const Params& p, LAS unsigned char* lds, const int branch, const int b, const int head) {
    int tid = threadIdx.x; asm volatile("" : "+v"(tid));
    unsigned char* ws = p.ws;
    const bf16_t* Q = (const bf16_t*)(ws + (branch == 0 ? PQ_R : PQ_G)) + head * DK;
    const bf16_t* K = (const bf16_t*)(ws + (branch == 0 ? PK_R : PK_G)) + head * DK;
    const bf16_t* V = (const bf16_t*)(ws + (branch == 0 ? PV_R : PV_G)) + head * 128;
    const bf16_t* G = (const bf16_t*)(ws + (branch == 0 ? PG_R : PG_G)) + head * 128;
    bf16_t* arg = (bf16_t*)((unsigned char*)p.out + SEG1024) + branch * 512 + head * 128;
    const float* gain = (branch == 0 ? p.g_ret : p.g_gla) + head * 128;
    const float* sin_ = (branch == 0 ? p.state_ret : p.state_gla) + (size_t)(b * 4 + head) * DK * 128;
    float* sout = p.out + (branch == 0 ? OUT_RSS : OUT_GSS) + (size_t)(b * 4 + head) * DK * 128;
    const int tok0 = TP + 4 * b;
    LAS float* qs = (LAS float*)lds;
    LAS float* ks = qs + 4 * 128;
    LAS float* vs = ks + 4 * 128;
    LAS float* es = vs + 4 * 128;
    LAS float* Ps = es + 128;
    LAS float* ssq = Ps + 16;
    LAS float* op = ssq + 16;
    for (int i = tid; i < 4 * DK; i += 512) { const int t = i / DK, d = i % DK;
        qs[t * DK + d] = __uint_as_float((unsigned)Q[(size_t)(tok0 + t) * (4 * DK) + d] << 16); ks[t * DK + d] = __uint_as_float((unsigned)K[(size_t)(tok0 + t) * (4 * DK) + d] << 16); }
    { const int t = tid >> 7, v = tid & 127; vs[t * 128 + v] = __uint_as_float((unsigned)V[(size_t)(tok0 + t) * 512 + v] << 16); }
    if (tid < DK) {
        if (DK == 128) { const float lg2 = log2f(1.f - exp2f(-5.f - (float)head)); es[tid] = exp2f(4.f * lg2); }
        else es[tid] = ((const float*)(ws + WS_EBL))[(size_t)(256 + b) * 256 + head * 64 + tid];
    }
    __syncthreads();
    if (tid < 16) { const int i = tid >> 2, j = tid & 3; float s = 0.f; if (j <= i) { for (int d = 0; d < DK; ++d) s += qs[i * DK + d] * ks[j * DK + d]; } Ps[tid] = s; }
    {
        const int vq = tid & 31, dg = tid >> 5;
        f32x4 oa[4];
#pragma unroll
        for (int i = 0; i < 4; ++i) oa[i] = (f32x4){0.f, 0.f, 0.f, 0.f};
        f32x4 v4[4];
#pragma unroll
        for (int j = 0; j < 4; ++j) v4[j] = *(const LAS f32x4*)(vs + j * 128 + 4 * vq);
        f32x4 s0[DK / 16];
#pragma unroll
        for (int rr = 0; rr < DK / 16; ++rr) s0[rr] = *(const f32x4*)(sin_ + (size_t)(dg + 16 * rr) * 128 + 4 * vq);
#pragma unroll
        for (int rr = 0; rr < DK / 16; ++rr) {
            const int d = dg + 16 * rr;
            f32x4 sn = s0[rr];
#pragma unroll
            for (int i = 0; i < 4; ++i) { oa[i] += s0[rr] * qs[i * DK + d]; sn += v4[i] * ks[i * DK + d]; }
            sn *= es[d];
            *(f32x4*)(sout + (size_t)d * 128 + 4 * vq) = sn;
        }
#pragma unroll
        for (int i = 0; i < 4; ++i) *(LAS f32x4*)(op + (dg * 4 + i) * 128 + 4 * vq) = oa[i];
    }
    __syncthreads();
    {
        const int i = tid >> 7, v = tid & 127;
        float o = 0.f;
#pragma unroll
        for (int dg = 0; dg < 16; ++dg) o += op[(dg * 4 + i) * 128 + v];
#pragma unroll
        for (int j = 0; j < 4; ++j) o += Ps[i * 4 + j] * vs[j * 128 + v];
        const float s = wave_sum(o * o);
        if ((tid & 63) == 0) ssq[tid >> 6] = s;
        __syncthreads();
        const float rs = rsqrtf((ssq[2 * i] + ssq[2 * i + 1]) * (1.f / 128.f) + EPS);
        const float gate = __uint_as_float((unsigned)G[(size_t)(tok0 + i) * 512 + v] << 16);
        const unsigned wv = pk2(o * rs * gain[v] * gate, 0.f);
        arg[(size_t)(tok0 + i) * 1024 + v] = (bf16_t)(wv & 0xffffu);
    }
    __syncthreads();
}

template <bool FULL> DI void chain_call(const Params& p, LAS unsigned char* lds, int chain, int c0, int nc, int nprev, bool wf) {
    const int branch = chain >> 5, bh = chain & 31;
    if (branch == 0) chain_prompt<128, FULL>(p, lds, 0, bh >> 2, bh & 3, c0, nc, nprev, wf); else chain_prompt<64, FULL>(p, lds, 1, bh >> 2, bh & 3, c0, nc, nprev, wf);
}
DI void sample_call(const Params& p, LAS unsigned char* lds, int u) {
    const int branch = u >> 9, bh = u & 511;
    if (branch == 0) sample_unit<128>(p, lds, 0, bh >> 2, bh & 3); else sample_unit<64>(p, lds, 1, bh >> 2, bh & 3);
}
DI void phase2(const Params& p, LAS unsigned char* lds, const XcdBarrier& xbar) {
    const int G = gridDim.x, bx = blockIdx.x;
    if (G == 256) {
        const int chain = bx & 63, seg = bx >> 6;
        if (seg < 3) chain_call<false>(p, lds, chain, 8 * seg, 8, seg, false);
        else { sample_call(p, lds, bx - 192); sample_call(p, lds, bx - 192 + 64); }
        xcd_barrier(xbar);
        chain_call<true>(p, lds, chain, 8 * seg, 8, seg, seg == 3);
        for (int u = 128 + bx; u < 1024; u += 256) sample_call(p, lds, u);
    } else {
        for (int c = bx; c < 64; c += G) chain_call<true>(p, lds, c, 0, 32, 0, true);
        for (int u = bx; u < 1024; u += G) sample_call(p, lds, u);
    }
}

DI void phase_final(const Params& p) {
    const int lane = threadIdx.x & 63, gw = blockIdx.x * 8 + (threadIdx.x >> 6), ngw = gridDim.x * 8;
    const bf16_t* hb = (const bf16_t*)(p.ws + WS_SH);
    for (int row = TP + gw; row < T_TOK; row += ngw) {
        f32x4 v[4]; float s = 0.f;
        const bf16_t* part = (const bf16_t*)(p.ws + WS_PART) + (size_t)((row - TP) & 255) * 256 + 4 * lane;
#pragma unroll
        for (int j = 0; j < 4; ++j) {
            const u32x2 hv = *(const u32x2*)(hb + (size_t)row * DM + 256 * j + 4 * lane);
            v[j] = (f32x4){bflo(hv.x), bfhi(hv.x), bflo(hv.y), bfhi(hv.y)};
            const int su = ((row - TP) >> 8) * 4 + j;
            for (int kp = 0; kp < 11; ++kp) { const u32x2 pv = *(const u32x2*)(part + (size_t)(su * 11 + kp) * 65536); v[j] += (f32x4){bflo(pv.x), bfhi(pv.x), bflo(pv.y), bfhi(pv.y)}; }
            s += v[j][0] * v[j][0] + v[j][1] * v[j][1] + v[j][2] * v[j][2] + v[j][3] * v[j][3];
        }
        const float rs = rsqrtf(wave_sum(s) * (1.f / DM) + EPS);
#pragma unroll
        for (int j = 0; j < 4; ++j) { const f32x4 g = *(const f32x4*)(p.ln_f + 256 * j + 4 * lane); *(f32x4*)(p.out + (size_t)row * DM + 256 * j + 4 * lane) = v[j] * rs * g; }
    }
}

__global__ void __launch_bounds__(512, 2) fwd_megakernel(Params p) {
    extern __shared__ __attribute__((aligned(16))) unsigned char shm[];
    LAS unsigned char* lds = (LAS unsigned char*)shm;
    cg::grid_group grid = cg::this_grid();
    if (p.ws == nullptr) grid.sync();
    if (threadIdx.x < 4) ((LAS unsigned*)(lds + 131072 + 4096))[threadIdx.x] = 0u;
    __syncthreads();
    const XcdBarrier xbar = xcd_barrier_post((unsigned*)(p.ws + WS_BAR), (volatile LAS unsigned*)(lds + 131072 + 4096));
    unsigned char* ws = p.ws;
    const int G = gridDim.x, bx = blockIdx.x;
    bf16_t* xb = (bf16_t*)p.out;
    bf16_t* arg = (bf16_t*)((unsigned char*)p.out + SEG1024);

#ifndef PHMASK
#define PHMASK 0x1ff
#endif
#define PH(n) if ((PHMASK >> (n)) & 1)
    PH(0) phase0(p, lds);
    xcd_barrier(xbar);
#if defined(DUP_PH) && DUP_PH == 0
    phase0(p, lds);
    xcd_barrier(xbar);
#endif
    PH(1) {
        pg8::Gemm g{xb, (const bf16_t*)(ws + WS_WIN), T_TOK, NPROJ, DM, DM, DM, 256}; pg8::StaticOrder S; S.init(T_TOK, NPROJ, G, bx);
        EpiProj E{ws, (const float*)(ws + WS_RSTD1), (const float*)(ws + WS_SH), (const float*)(ws + WS_ROPEC), (const float*)(ws + WS_ROPES)};
        pg8::gemm_phase<EpiProj, pg8::StaticOrder, 16>(lds, g, S, E);
#if defined(DUP_PH) && DUP_PH == 1
        xcd_barrier(xbar);
        pg8::gemm_phase<EpiProj, pg8::StaticOrder, 16>(lds, g, S, E);
#endif
    }
    xcd_barrier(xbar);
    PH(2) phase2(p, lds, xbar);
    xcd_barrier(xbar);
#if defined(DUP_PH) && DUP_PH == 2
    phase2(p, lds, xbar);
    xcd_barrier(xbar);
#endif
    PH(3) {
        pg8::Gemm g{arg, (const bf16_t*)(ws + WS_WMIX), T_TOK, DM, DM, DM, DM, 256}; pg8::StaticOrder S; S.init(T_TOK, DM, G, bx);
        EpiMix E{(const bf16_t*)(ws + PM_R), (const bf16_t*)(ws + PM_G), (bf16_t*)(ws + WS_MIX)};
        pg8::gemm_phase<EpiMix, pg8::StaticOrder, 16>(lds, g, S, E);
#if defined(DUP_PH) && DUP_PH == 3
        xcd_barrier(xbar);
        pg8::gemm_phase<EpiMix, pg8::StaticOrder, 16>(lds, g, S, E);
#endif
    }
    xcd_barrier(xbar);
    PH(4) {
        pg8::Gemm g{(const bf16_t*)(ws + WS_MIX), (const bf16_t*)(ws + WS_WO), T_TOK, DM, DM, DM, DM, 256}; pg8::StaticOrder S; S.init(T_TOK, DM, G, bx);
        EpiH E{p.x_prompt, p.x_sample, p.out, (bf16_t*)(ws + WS_SH), (float*)(ws + WS_SSQ2)};
        pg8::gemm_phase<EpiH, pg8::StaticOrder, 16>(lds, g, S, E);
    }
    xcd_barrier(xbar);
    PH(5) {
        pg8::Gemm g{(const bf16_t*)(ws + WS_SH) - 2 * DM, (const bf16_t*)(ws + WS_WUP), T_TOK, NUP, DM, DM, DM, 254}; pg8::StaticOrder S; S.init_tiles(67, 22, G, bx);
        EpiUpConv E{(const float*)(ws + WS_SSQ2), (bf16_t*)(ws + WS_ACT), p.conv_w, p.conv_b, p.cache_conv, p.out, (LAS float*)(lds + 131072)};
        pg8::gemm_phase<EpiUpConv, pg8::StaticOrder, 16>(lds, g, S, E);
#if defined(DUP_PH) && DUP_PH == 5
        xcd_barrier(xbar);
        pg8::gemm_phase<EpiUpConv, pg8::StaticOrder, 16>(lds, g, S, E);
#endif
    }
    xcd_barrier(xbar);
    PH(7) {
        pg8::Gemm g{(const bf16_t*)(ws + WS_ACT), (const bf16_t*)(ws + WS_WDN), T_TOK, DM, DFF, DFF, DFF, 256}; pg8::StaticOrder S; S.init_tiles(64, 4, G, bx);
        EpiDownNorm E{(const bf16_t*)(ws + WS_SH), p.out, p.ln_f, (float*)(ws + WS_EXCH), (unsigned*)(ws + WS_CNT), (LAS float*)(lds + 131072)};
        pg8::gemm_phase<EpiDownNorm, pg8::StaticOrder, 44>(lds, g, S, E);
        {   pg8::PieceOrder S2{G, bx}; EpiPart E2{(bf16_t*)(ws + WS_PART)};
            pg8::gemm_phase<EpiPart, pg8::PieceOrder, 4>(lds, g, S2, E2); }
    }
    xcd_barrier(xbar);
    PH(8) phase_final(p);
}

extern "C" void kernel_launch(void* const* d_in, const int* in_sizes, int n_in, void* d_out, int out_size, void* d_ws, size_t ws_size, hipStream_t stream) {
    static int grid = 0;
    if (grid == 0) {
        if (n_in != 20 || out_size != (int)OUT_END || ws_size < WS_END) { fprintf(stderr, "kernel_launch: unexpected shapes (n_in %d, out %d, ws %zu)\n", n_in, out_size, ws_size); grid = -1; return; }
        int dev = 0, cus = 0, per_cu = 0;
        hipGetDevice(&dev);
        hipDeviceGetAttribute(&cus, hipDeviceAttributeMultiprocessorCount, dev);
        if (hipFuncSetAttribute((const void*)fwd_megakernel, hipFuncAttributeMaxDynamicSharedMemorySize, LDS_BYTES) != hipSuccess) { fprintf(stderr, "kernel_launch: hipFuncSetAttribute failed\n"); grid = -1; return; }
        hipOccupancyMaxActiveBlocksPerMultiprocessor(&per_cu, (const void*)fwd_megakernel, 512, LDS_BYTES);
        if (per_cu < 1) { fprintf(stderr, "kernel_launch: occupancy query gave %d\n", per_cu); per_cu = 1; }
        grid = cus * 1;
        (void)hipGetLastError();
    }
    if (grid < 0) return;
    Params p{};
    const float** f = (const float**)&p;
    for (int i = 0; i < 20; ++i) f[i] = (const float*)d_in[i];
    p.out = (float*)d_out; p.ws = (unsigned char*)d_ws;
    if (hipMemsetAsync((unsigned char*)d_ws + WS_BAR, 0, 16384 + 8192, stream) != hipSuccess) { fprintf(stderr, "kernel_launch: memset failed\n"); return; }
    void* args[] = {&p};
    hipError_t e = hipLaunchCooperativeKernel((const void*)fwd_megakernel, dim3(grid), dim3(512), args, LDS_BYTES, stream);
    if (e != hipSuccess) fprintf(stderr, "cooperative launch failed: %s (grid %d)\n", hipGetErrorString(e), grid);
}
```

```cpp
#include <hip/hip_runtime.h>
#include <hip/hip_cooperative_groups.h>
#include <cstdio>
namespace cg = cooperative_groups;

#define LAS __attribute__((address_space(3)))
#define DI __device__ __forceinline__
typedef unsigned short bf16_t;
typedef short bf16x8 __attribute__((ext_vector_type(8)));
typedef short s16x4 __attribute__((ext_vector_type(4)));
typedef float f32x4 __attribute__((ext_vector_type(4)));
typedef float f32x2 __attribute__((ext_vector_type(2)));
typedef float f32x16 __attribute__((ext_vector_type(16)));
typedef unsigned u32x4 __attribute__((ext_vector_type(4)));
typedef unsigned u32x2 __attribute__((ext_vector_type(2)));
typedef __bf16 bf16x2_t __attribute__((ext_vector_type(2)));

constexpr int T_TOK = 16896, TP = 16384, DM = 1024, DIN = 5648, NPROJ = 5632, DFF = 2816, NUP = 5632;
constexpr float EPS = 1e-6f;
constexpr size_t OUT_Y = 0, OUT_RSP = 17301504, OUT_RSS = OUT_RSP + 524288, OUT_GSP = OUT_RSS + 8388608, OUT_GSS = OUT_GSP + 262144,
                 OUT_CP = OUT_GSS + 4194304, OUT_CS = OUT_CP + 45056, OUT_END = OUT_CS + 720896;
constexpr size_t WS_WIN = 0, WS_WMIX = WS_WIN + (size_t)NPROJ * DM * 2, WS_WO = WS_WMIX + (size_t)DM * DM * 2, WS_WUP = WS_WO + (size_t)DM * DM * 2,
                 WS_WDN = WS_WUP + (size_t)NUP * DM * 2, WS_PROJ = WS_WDN + (size_t)DM * DFF * 2;
constexpr size_t SEG512 = (size_t)T_TOK * 512 * 2, SEG256 = (size_t)T_TOK * 256 * 2, SEG1024 = (size_t)T_TOK * 1024 * 2;
constexpr size_t PQ_R = WS_PROJ, PK_R = PQ_R + SEG512, PV_R = PK_R + SEG512, PG_R = PV_R + SEG512, PQ_G = PG_R + SEG512, PK_G = PQ_G + SEG256,
                 PV_G = PK_G + SEG256, PG_G = PV_G + SEG512, PM_R = PG_G + SEG512, PM_G = PM_R + SEG1024, WS_PROJ_END = PM_G + SEG1024;
constexpr size_t WS_MIX = PQ_R;
constexpr size_t WS_PART = WS_PROJ + (size_t)T_TOK * DFF * 2;
static_assert(WS_PART + (size_t)88 * 65536 * 4 <= WS_PROJ_END, "partials");
constexpr size_t WS_ACT = WS_PROJ;
constexpr size_t WS_SH = WS_PROJ_END;
constexpr size_t WS_RSTD1 = WS_SH + SEG1024, WS_SSQ2 = WS_RSTD1 + (size_t)T_TOK * 4, WS_EBL = WS_SSQ2 + (size_t)T_TOK * 4,
                 WS_ROPEC = WS_EBL + (size_t)384 * 256 * 4, WS_ROPES = WS_ROPEC + (size_t)2052 * 64 * 4, WS_BAR = WS_ROPES + (size_t)2052 * 64 * 4, WS_CNT = WS_BAR + 16384  ,
                 WS_EXCH = WS_CNT + 8192  , WS_END = WS_EXCH + (size_t)TP * 16;
static_assert(WS_PROJ_END - WS_PROJ == (size_t)T_TOK * NPROJ * 2, "proj layout");
static_assert(WS_END <= (size_t)256 * 1024 * 1024, "workspace");
constexpr int LDS_BYTES = 131072 + 4096 + 16;

struct Params {
    const float *x_prompt, *x_sample, *state_ret, *state_gla, *cache_conv, *ln1, *w_in, *w_gate_up, *b_gate_up, *g_ret, *g_gla, *w_ret_out, *w_gla_out,
        *w_o, *ln2, *w_up, *conv_w, *conv_b, *w_down, *ln_f;
    float* out; unsigned char* ws;
};

DI unsigned pk2(float lo, float hi) { f32x2 v = {lo, hi}; bf16x2_t b = __builtin_convertvector(v, bf16x2_t); return __builtin_bit_cast(unsigned, b); }
DI float bflo(unsigned w) { return __uint_as_float(w << 16); }
DI float bfhi(unsigned w) { return __uint_as_float(w & 0xffff0000u); }
DI float wave_sum(float v) {
#pragma unroll
    for (int o = 1; o < 64; o <<= 1) v += __shfl_xor(v, o);
    return v;
}
DI float sigmoidf_(float x) { return __builtin_amdgcn_rcpf(1.f + __expf(-x)); }
DI const float* x_row(const Params& p, int tok) { return tok < TP ? p.x_prompt + (size_t)tok * DM : p.x_sample + (size_t)(tok - TP) * DM; }
#define LDS_WAIT() asm volatile("s_waitcnt lgkmcnt(0)" ::: "memory")

#define XB_TMO      128
#define XB_XCNT(j)  (256  + 64 * (j))
#define XB_XSUB(j)  (1280 + 64 * (j))
#define XB_XGEN(j)  (2304 + 64 * (j))
#define XB_TOP      3328
#define XB_TOPGEN   3392
#define XCD_BAR_WORDS 3456
#define XB_SPIN_CAP (1u << 22)
DI unsigned xb_ld(unsigned* p) { return __hip_atomic_load(p, __ATOMIC_RELAXED, __HIP_MEMORY_SCOPE_AGENT); }
DI unsigned xb_add(unsigned* p, unsigned v) { return __hip_atomic_fetch_add(p, v, __ATOMIC_RELAXED, __HIP_MEMORY_SCOPE_AGENT); }
DI unsigned xb_xcc_id() { return (unsigned)__builtin_amdgcn_s_getreg((3 << 11) | 20) & 0xFu; }
#define XB_SPIN(cond, bar) do { unsigned _sp = 0; while (cond) { __builtin_amdgcn_s_sleep(1); \
    if ((++_sp & 255u) == 0u) { if (xb_ld(&(bar)[XB_TMO])) break; if (_sp > XB_SPIN_CAP) { atomicAdd(&(bar)[XB_TMO], 1u); break; } } } } while (0)
struct XcdBarrier { unsigned* bar; unsigned x; volatile LAS unsigned* st; };
DI XcdBarrier xcd_barrier_post(unsigned* bar, volatile LAS unsigned* st) {
    XcdBarrier b; b.bar = bar; b.x = xb_xcc_id(); b.st = st;
    if (threadIdx.x == 0) (void)xb_add(&bar[XB_XCNT(b.x)], 1u);
    return b;
}
DI void xcd_barrier_complete(unsigned* bar, unsigned x, unsigned& nloc, unsigned& nx) {
    const unsigned G = gridDim.x * gridDim.y * gridDim.z;
    unsigned sum, cnt, mine, sp = 0u;
    for (;;) {
        sum = 0u; cnt = 0u; mine = 0u;
#pragma unroll
        for (unsigned j = 0; j < 16; ++j) { const unsigned c = xb_ld(&bar[XB_XCNT(j)]); sum += c; cnt += (c > 0u) ? 1u : 0u; mine = (j == x) ? c : mine; }
        if (sum == G) break;
        __builtin_amdgcn_s_sleep(1);
        if ((++sp & 255u) == 0u) { if (xb_ld(&bar[XB_TMO])) break; if (sp > XB_SPIN_CAP) { atomicAdd(&bar[XB_TMO], 1u); break; } }
    }
    nloc = mine > 0u ? mine : 1u; nx = cnt > 0u ? cnt : 1u;
}
DI void xcd_barrier(const XcdBarrier& b) {
    asm volatile("s_waitcnt vmcnt(0)" ::: "memory");
    __syncthreads();
    if (threadIdx.x == 0) {
        unsigned* bar = b.bar;
        __builtin_amdgcn_s_waitcnt(0);
        unsigned nloc = b.st[0], nx = b.st[1];
        if (nloc == 0u) { xcd_barrier_complete(bar, b.x, nloc, nx); b.st[0] = nloc; b.st[1] = nx; }
        const unsigned old = xb_add(&bar[XB_XSUB(b.x)], 1u);
        const unsigned gen = old / nloc;
        if (old + 1u == (gen + 1u) * nloc) {
            __builtin_amdgcn_fence(__ATOMIC_RELEASE, "agent");
            asm volatile("s_waitcnt vmcnt(0)" ::: "memory");
            const unsigned og = xb_add(&bar[XB_TOP], 1u);
            const unsigned tg = og / nx;
            if (og + 1u == (tg + 1u) * nx) xb_add(&bar[XB_TOPGEN], 1u);
            else XB_SPIN(xb_ld(&bar[XB_TOPGEN]) == tg, bar);
            __builtin_amdgcn_fence(__ATOMIC_ACQUIRE, "agent");
            xb_add(&bar[XB_XGEN(b.x)], 1u);
            asm volatile("s_waitcnt vmcnt(0)" ::: "memory");
        } else {
            XB_SPIN(xb_ld(&bar[XB_XGEN(b.x)]) == gen, bar);
            __builtin_amdgcn_fence(__ATOMIC_ACQUIRE, "agent");
            asm volatile("s_waitcnt vmcnt(0)" ::: "memory");
        }
    }
    __syncthreads();
}

namespace pg8 {
constexpr int BM = 256, BK = 64, HALF = 128, HTB = HALF * BK * 2, STAGE_BYTES = 8 * HTB, NXCD = 8, WGM = 8;
DI int lds_byte(int r, int c) { const int st = (r >> 4) * 2 + (c >> 5), rr = r & 15, cc = c & 31, ob = rr * 64 + cc * 2; return st * 1024 + (ob ^ (((ob >> 9) & 1) << 5)); }
DI void stage_rc(int b, int& R, int& C) { const int st = b / 1024, sb = b % 1024, swz = sb ^ (((sb >> 9) & 1) << 5); R = (st >> 1) * 16 + swz / 64; C = (st & 1) * 32 + (swz % 64) / 2; }
DI int perm32(int rho) { const int n = rho >> 4, i = rho & 15; return 8 * (i >> 2) + 4 * n + (i & 3); }
struct Unit { int pm, pn, kt0, id; };
struct Gemm { const bf16_t* A; const bf16_t* Bt; int M, N, K, lda, ldb, mstep; };
struct StaticOrder {
    int nM, nN, nwg, G, c;
    DI void init(int M, int N, int G_, int c_) { nM = M / BM; nN = N / BM; nwg = nM * nN; G = G_; c = c_; }
    DI void init_tiles(int nM_, int nN_, int G_, int c_) { nM = nM_; nN = nN_; nwg = nM * nN; G = G_; c = c_; }
    DI bool next(int i, Unit& u) const {
        u.kt0 = 0; u.id = 0; u.pm = 0; u.pn = 0;
        const long L = (long)i * G + c; if (L >= nwg) return false;
        int wgid = (int)L; { const int q = nwg / NXCD, r = nwg % NXCD, xcd = wgid % NXCD, off = wgid / NXCD; wgid = (xcd < r ? xcd * (q + 1) : r * (q + 1) + (xcd - r) * q) + off; }
        const int nig = WGM * nN, gid = wgid / nig, fm = gid * WGM, gsz = (nM - fm) < WGM ? (nM - fm) : WGM;
        u.pm = fm + ((wgid % nig) % gsz); u.pn = (wgid % nig) / gsz; return true;
    }
};
struct PieceOrder {
    int G, c;
    DI bool next(int i, Unit& u) const {
        const int pid = c + i * G; const int su = pid / 11;
        u.pm = 64 + (su >> 2); u.pn = su & 3; u.kt0 = (pid - su * 11) * 4; u.id = pid;
        return pid < 88;
    }
};
template <class Epi, class Sched, int NT>
DI void gemm_phase(LAS unsigned char* lds, const Gemm g, const Sched& S, const Epi& E) {
    int tid = threadIdx.x; asm volatile("" : "+v"(tid));
    const int wid = __builtin_amdgcn_readfirstlane(tid >> 6), lane = tid & 63, wr = wid >> 2, wc = wid & 3, fr = lane & 15, fq = lane >> 4;
    constexpr int nt = NT;
    unsigned voffA[2], voffB[2];
#pragma unroll
    for (int i = 0; i < 2; ++i) { int R, C; stage_rc(tid * 16 + i * 8192, R, C); const int Rb = Epi::PERM ? ((R & ~31) + perm32(R & 31)) : R;
        voffA[i] = (unsigned)(R * g.lda + C) * 2u; voffB[i] = (unsigned)(Rb * g.ldb + C) * 2u; }
    const size_t kstep = (size_t)(BK * 2);
    const size_t hstepA = (size_t)HALF * g.lda * 2, hstepB = (size_t)HALF * g.ldb * 2;
    const size_t tstepA = (size_t)g.mstep * g.lda * 2, tstepB = 2 * hstepB;
    const unsigned ldsw = (unsigned)wid * 1024u;
    const int aoff = lds_byte(wr * 64 + fr, fq * 8), boff = lds_byte(wc * 32 + fr, fq * 8);
#define PG8_SA(b, h) (((b) * 2 + (h)) * HTB)
#define PG8_SB(b, h) ((4 + (b) * 2 + (h)) * HTB)
#define PG8_STAGE(bufoff, gbase, voff) do { _Pragma("unroll") for (int _i = 0; _i < 2; ++_i) \
        __builtin_amdgcn_global_load_lds((const unsigned*)((const char*)(gbase) + (voff)[_i]), (LAS unsigned*)(lds + (bufoff) + ldsw + _i * 8192), 16, 0, 0); } while (0)
#define PG8_LDA(dst, b, h) do { _Pragma("unroll") for (int m = 0; m < 4; ++m) _Pragma("unroll") for (int k = 0; k < 2; ++k) dst[m][k] = *(const LAS bf16x8*)(lds + PG8_SA(b, h) + aoff + m * 2048 + k * 1024); } while (0)
#define PG8_LDB(dst, b, h) do { _Pragma("unroll") for (int n = 0; n < 2; ++n) _Pragma("unroll") for (int k = 0; k < 2; ++k) dst[n][k] = *(const LAS bf16x8*)(lds + PG8_SB(b, h) + boff + n * 2048 + k * 1024); } while (0)
#define PG8_MMA(ai, bj, At, Bt) do { __builtin_amdgcn_s_setprio(1); _Pragma("unroll") for (int m = 0; m < 4; ++m) _Pragma("unroll") for (int n = 0; n < 2; ++n) _Pragma("unroll") for (int k = 0; k < 2; ++k) \
        acc[ai][bj][m][n] = __builtin_amdgcn_mfma_f32_16x16x32_bf16(Bt[n][k], At[m][k], acc[ai][bj][m][n], 0, 0, 0); __builtin_amdgcn_s_setprio(0); } while (0)
#define PG8_WAIT_V(n) asm volatile("s_waitcnt vmcnt(" #n ")" ::: "memory")
#define PG8_WAIT_L(n) asm volatile("s_waitcnt lgkmcnt(" #n ")" ::: "memory")
#define PG8_BAR __builtin_amdgcn_s_barrier()
#define PG8_SCHED __builtin_amdgcn_sched_barrier(0)
    Unit cur, nxt; int ui = 0;
    if (!S.next(0, cur)) return;
    f32x4 acc[2][2][4][2];
#pragma unroll
    for (int a = 0; a < 2; ++a)
#pragma unroll
        for (int b = 0; b < 2; ++b)
#pragma unroll
            for (int m = 0; m < 4; ++m)
#pragma unroll
                for (int n = 0; n < 2; ++n) acc[a][b][m][n] = (f32x4){0.f, 0.f, 0.f, 0.f};
    bf16x8 At[4][2], B0[2][2], B1[2][2];
    const char* cA = (const char*)g.A + (size_t)cur.pm * tstepA + (size_t)cur.kt0 * kstep; const char* cB = (const char*)g.Bt + (size_t)cur.pn * tstepB + (size_t)cur.kt0 * kstep;
    PG8_STAGE(PG8_SB(0, 0), cB, voffB); PG8_STAGE(PG8_SA(0, 0), cA, voffA); PG8_STAGE(PG8_SB(0, 1), cB + hstepB, voffB); PG8_STAGE(PG8_SA(0, 1), cA + hstepA, voffA);
    if (wr == 1) PG8_BAR;
    PG8_WAIT_V(4); PG8_BAR;
    PG8_STAGE(PG8_SB(1, 0), cB + kstep, voffB); PG8_STAGE(PG8_SA(1, 0), cA + kstep, voffA); PG8_STAGE(PG8_SB(1, 1), cB + hstepB + kstep, voffB);
    PG8_WAIT_V(6); PG8_BAR;
    for (;;) {
        const bool has_next = S.next(ui + 1, nxt);
        const char* nA = has_next ? (const char*)g.A + (size_t)nxt.pm * tstepA + (size_t)nxt.kt0 * kstep : cA; const char* nB = has_next ? (const char*)g.Bt + (size_t)nxt.pn * tstepB + (size_t)nxt.kt0 * kstep : cB;
        for (int t = 0; t < nt; t += 2) {
            const bool last = (t == nt - 2);
            const char* a1 = cA + (size_t)(t + 1) * kstep;
            const char* a2 = last ? nA : cA + (size_t)(t + 2) * kstep; const char* b2 = last ? nB : cB + (size_t)(t + 2) * kstep;
            const char* a3 = a2 + kstep; const char* b3 = b2 + kstep;
            if constexpr (Epi::MIDK) { if (t == (nt >> 1)) E.mid(acc, cur, wr, wc, fr, fq); }
            PG8_LDB(B0, 0, 0); PG8_SCHED; PG8_LDA(At, 0, 0); PG8_STAGE(PG8_SA(1, 1), a1 + hstepA, voffA);
            PG8_WAIT_L(8); PG8_BAR; PG8_WAIT_L(0); PG8_MMA(0, 0, At, B0); PG8_BAR; PG8_SCHED;
            PG8_LDB(B1, 0, 1); PG8_STAGE(PG8_SB(0, 0), b2, voffB);
            PG8_BAR; PG8_WAIT_L(0); PG8_MMA(0, 1, At, B1); PG8_BAR;
            PG8_LDA(At, 0, 1); PG8_STAGE(PG8_SA(0, 0), a2, voffA);
            PG8_BAR; PG8_WAIT_L(0); PG8_MMA(1, 0, At, B0); PG8_BAR; PG8_SCHED;
            PG8_STAGE(PG8_SB(0, 1), b2 + hstepB, voffB);
            PG8_WAIT_V(6); PG8_BAR; PG8_MMA(1, 1, At, B1); PG8_BAR;
            PG8_LDB(B0, 1, 0); PG8_SCHED; PG8_LDA(At, 1, 0); PG8_STAGE(PG8_SA(0, 1), a2 + hstepA, voffA);
            PG8_WAIT_L(8); PG8_BAR; PG8_WAIT_L(0); PG8_MMA(0, 0, At, B0); PG8_BAR; PG8_SCHED;
            PG8_LDB(B1, 1, 1); PG8_STAGE(PG8_SB(1, 0), b3, voffB);
            PG8_BAR; PG8_WAIT_L(0); PG8_MMA(0, 1, At, B1); PG8_BAR;
            PG8_LDA(At, 1, 1); PG8_STAGE(PG8_SA(1, 0), a3, voffA);
            PG8_BAR; PG8_WAIT_L(0); PG8_MMA(1, 0, At, B0); PG8_BAR; PG8_SCHED;
            PG8_STAGE(PG8_SB(1, 1), b3 + hstepB, voffB);
            PG8_WAIT_V(6); PG8_BAR; PG8_MMA(1, 1, At, B1); PG8_BAR;
        }
        E(acc, cur, wr, wc, fr, fq);
        if (!has_next) break;
#pragma unroll
        for (int a = 0; a < 2; ++a)
#pragma unroll
            for (int b = 0; b < 2; ++b)
#pragma unroll
                for (int m = 0; m < 4; ++m)
#pragma unroll
                    for (int n = 0; n < 2; ++n) acc[a][b][m][n] = (f32x4){0.f, 0.f, 0.f, 0.f};
        cur = nxt; cA = nA; cB = nB; ++ui;
    }
    PG8_WAIT_V(0);
    if (wr == 0) PG8_BAR;
    PG8_BAR;
#undef PG8_SA
#undef PG8_SB
#undef PG8_STAGE
#undef PG8_LDA
#undef PG8_LDB
#undef PG8_MMA
#undef PG8_WAIT_V
#undef PG8_WAIT_L
#undef PG8_BAR
#undef PG8_SCHED
}
}
using pg8::Unit;
typedef f32x4 AccT[2][2][4][2];

struct EpiProj {
    static constexpr bool PERM = true, MIDK = false;
    unsigned char* ws; const float* rstd1; const float* bcum; const float* ropec; const float* ropes;
    DI void mid(AccT&, const Unit&, int, int, int, int) const {}
    DI void operator()(const AccT& acc, const Unit& u, int wr, int wc, int fr, int fq) const {
        const int pn = u.pn; int seg, pn0;
        if (pn < 8) { seg = pn >> 1; pn0 = seg * 2; } else if (pn == 8) { seg = 4; pn0 = 8; } else if (pn == 9) { seg = 5; pn0 = 9; }
        else if (pn < 12) { seg = 6; pn0 = 10; } else if (pn < 14) { seg = 7; pn0 = 12; } else if (pn < 18) { seg = 8; pn0 = 14; } else { seg = 9; pn0 = 18; }
        size_t segoff; int ld;
        switch (seg) { case 0: segoff = PQ_R; ld = 512; break; case 1: segoff = PK_R; ld = 512; break; case 2: segoff = PV_R; ld = 512; break; case 3: segoff = PG_R; ld = 512; break;
            case 4: segoff = PQ_G; ld = 256; break; case 5: segoff = PK_G; ld = 256; break; case 6: segoff = PV_G; ld = 512; break; case 7: segoff = PG_G; ld = 512; break;
            case 8: segoff = PM_R; ld = 1024; break; default: segoff = PM_G; ld = 1024; break; }
        bf16_t* base = (bf16_t*)(ws + segoff);
        const int lc0 = (pn - pn0) * 256 + wc * 32 + 8 * fq;
        const int row0 = u.pm * 256 + wr * 64 + fr;
        if (seg <= 1) {
            const int i0 = 16 * wc + 4 * fq;
            float lg2h[2];
#pragma unroll
            for (int bj = 0; bj < 2; ++bj) lg2h[bj] = log2f(1.f - exp2f(-5.f - (float)((pn - pn0) * 2 + bj)));
#pragma unroll
            for (int ai = 0; ai < 2; ++ai)
#pragma unroll
                for (int m = 0; m < 4; ++m) {
                    const int row = row0 + ai * 128 + m * 16; const float rs = rstd1[row];
                    int posidx, ic; if (row < TP) { posidx = row & 2047; ic = row & 63; } else { const int s = row - TP; posidx = 2048 + (s & 3); ic = s & 3; }
                    const f32x4 c4 = *(const f32x4*)(ropec + posidx * 64 + i0), s4 = *(const f32x4*)(ropes + posidx * 64 + i0);
#pragma unroll
                    for (int bj = 0; bj < 2; ++bj) {
                        const int head = (pn - pn0) * 2 + bj;
                        const float lg2 = lg2h[bj];
                        const float dec = (seg == 0) ? __builtin_amdgcn_exp2f((float)(ic + 1) * lg2) : __builtin_amdgcn_exp2f(-(float)(ic + 1) * lg2) * 0.08838834764831845f;
                        const f32x4 t1 = acc[ai][bj][m][0] * rs, t2 = acc[ai][bj][m][1] * rs;
                        const f32x4 o1 = (t1 * c4 - t2 * s4) * dec, o2 = (t1 * s4 + t2 * c4) * dec;
                        bf16_t* rp = base + (size_t)row * 512 + head * 128 + i0;
                        u32x2 w1, w2; w1.x = pk2(o1[0], o1[1]); w1.y = pk2(o1[2], o1[3]); w2.x = pk2(o2[0], o2[1]); w2.y = pk2(o2[2], o2[3]);
                        *(u32x2*)rp = w1; *(u32x2*)(rp + 64) = w2;
                    }
                }
            return;
        }
#pragma unroll
        for (int ai = 0; ai < 2; ++ai)
#pragma unroll
            for (int m = 0; m < 4; ++m) {
                const int row = row0 + ai * 128 + m * 16; const float rs = rstd1[row];
#pragma unroll
                for (int bj = 0; bj < 2; ++bj) {
                    const int lc = lc0 + bj * 128;
                    f32x4 v0 = acc[ai][bj][m][0] * rs, v1 = acc[ai][bj][m][1] * rs;
                    if (seg == 4 || seg == 5) {
                        const f32x4 b0 = *(const f32x4*)(bcum + (size_t)row * 256 + lc), b1 = *(const f32x4*)(bcum + (size_t)row * 256 + lc + 4);
                        if (seg == 4) {
#pragma unroll
                            for (int e = 0; e < 4; ++e) { v0[e] *= 0.125f * __expf(b0[e]); v1[e] *= 0.125f * __expf(b1[e]); }
                        } else {
#pragma unroll
                            for (int e = 0; e < 4; ++e) { v0[e] *= __expf(-b0[e]); v1[e] *= __expf(-b1[e]); }
                        }
                    } else if (seg == 3 || seg == 7) {
#pragma unroll
                        for (int e = 0; e < 4; ++e) { v0[e] = v0[e] * sigmoidf_(v0[e]); v1[e] = v1[e] * sigmoidf_(v1[e]); }
                    } else if (seg >= 8) {
#pragma unroll
                        for (int e = 0; e < 4; ++e) { v0[e] = sigmoidf_(v0[e]); v1[e] = sigmoidf_(v1[e]); }
                    }
                    u32x4 w; w.x = pk2(v0[0], v0[1]); w.y = pk2(v0[2], v0[3]); w.z = pk2(v1[0], v1[1]); w.w = pk2(v1[2], v1[3]);
                    __builtin_nontemporal_store(w, (u32x4*)(base + (size_t)row * ld + lc));
                }
            }
    }
};
struct EpiMix {
    static constexpr bool PERM = true, MIDK = true;
    const bf16_t* mr; const bf16_t* mg; bf16_t* mix;
    DI void mid(AccT& acc, const Unit& u, int wr, int wc, int fr, int fq) const {
        int row0 = u.pm * 256 + wr * 64 + fr, c0 = u.pn * 256 + wc * 32 + 8 * fq;
        asm volatile("" : "+v"(row0), "+v"(c0));
#pragma unroll
        for (int ai = 0; ai < 2; ++ai)
#pragma unroll
            for (int m = 0; m < 4; ++m) {
                const int row = row0 + ai * 128 + m * 16;
#pragma unroll
                for (int bj = 0; bj < 2; ++bj) {
                    const u32x4 a = *(const u32x4*)(mr + (size_t)row * 1024 + c0 + bj * 128), b = *(const u32x4*)(mg + (size_t)row * 1024 + c0 + bj * 128);
                    f32x4 r0, r1;
                    r0[0] = bflo(a.x) * __builtin_amdgcn_rcpf(fmaxf(bflo(b.x), 1e-30f)); r0[1] = bfhi(a.x) * __builtin_amdgcn_rcpf(fmaxf(bfhi(b.x), 1e-30f)); r0[2] = bflo(a.y) * __builtin_amdgcn_rcpf(fmaxf(bflo(b.y), 1e-30f)); r0[3] = bfhi(a.y) * __builtin_amdgcn_rcpf(fmaxf(bfhi(b.y), 1e-30f));
                    r1[0] = bflo(a.z) * __builtin_amdgcn_rcpf(fmaxf(bflo(b.z), 1e-30f)); r1[1] = bfhi(a.z) * __builtin_amdgcn_rcpf(fmaxf(bfhi(b.z), 1e-30f)); r1[2] = bflo(a.w) * __builtin_amdgcn_rcpf(fmaxf(bflo(b.w), 1e-30f)); r1[3] = bfhi(a.w) * __builtin_amdgcn_rcpf(fmaxf(bfhi(b.w), 1e-30f));
                    acc[ai][bj][m][0] *= r0; acc[ai][bj][m][1] *= r1;
                }
                __builtin_amdgcn_sched_barrier(0);
            }
    }
    DI void operator()(const AccT& acc, const Unit& u, int wr, int wc, int fr, int fq) const {
        const int row0 = u.pm * 256 + wr * 64 + fr, c0 = u.pn * 256 + wc * 32 + 8 * fq;
#pragma unroll
        for (int ai = 0; ai < 2; ++ai)
#pragma unroll
            for (int m = 0; m < 4; ++m) {
                const int row = row0 + ai * 128 + m * 16;
#pragma unroll
                for (int bj = 0; bj < 2; ++bj) {
                    const u32x4 b = *(const u32x4*)(mg + (size_t)row * 1024 + c0 + bj * 128);
                    const f32x4 v0 = acc[ai][bj][m][0], v1 = acc[ai][bj][m][1];
                    u32x4 w; w.x = pk2(v0[0] * bflo(b.x), v0[1] * bfhi(b.x)); w.y = pk2(v0[2] * bflo(b.y), v0[3] * bfhi(b.y));
                    w.z = pk2(v1[0] * bflo(b.z), v1[1] * bfhi(b.z)); w.w = pk2(v1[2] * bflo(b.w), v1[3] * bfhi(b.w));
                    *(u32x4*)(mix + (size_t)row * 1024 + c0 + bj * 128) = w;
                }
            }
    }
};
struct EpiH {
    static constexpr bool PERM = true, MIDK = false;
    const float* xp; const float* xs; float* h; bf16_t* hb; float* ssq;
    DI void mid(AccT&, const Unit&, int, int, int, int) const {}
    DI void operator()(const AccT& acc, const Unit& u, int wr, int wc, int fr, int fq) const {
        const int row0 = u.pm * 256 + wr * 64 + fr, c0 = u.pn * 256 + wc * 32 + 8 * fq;
#pragma unroll
        for (int ai = 0; ai < 2; ++ai)
#pragma unroll
            for (int m = 0; m < 4; ++m) {
                const int row = row0 + ai * 128 + m * 16;
                const float* xr = row < TP ? xp + (size_t)row * DM : xs + (size_t)(row - TP) * DM;
                float ss = 0.f;
#pragma unroll
                for (int bj = 0; bj < 2; ++bj) {
                    const int c = c0 + bj * 128;
                    const f32x4 v0 = acc[ai][bj][m][0] + *(const f32x4*)(xr + c), v1 = acc[ai][bj][m][1] + *(const f32x4*)(xr + c + 4);
                    u32x4 w; w.x = pk2(v0[0], v0[1]); w.y = pk2(v0[2], v0[3]); w.z = pk2(v1[0], v1[1]); w.w = pk2(v1[2], v1[3]);
                    *(u32x4*)(hb + (size_t)row * DM + c) = w;
                    ss += v0[0] * v0[0] + v0[1] * v0[1] + v0[2] * v0[2] + v0[3] * v0[3] + v1[0] * v1[0] + v1[1] * v1[1] + v1[2] * v1[2] + v1[3] * v1[3];
                }
                ss += __shfl_xor(ss, 16); ss += __shfl_xor(ss, 32);
                if (fq == 0) unsafeAtomicAdd(ssq + row, ss);
            }
    }
};
DI f32x2 gelu_pk(f32x2 v) {
    const f32x2 av = __builtin_elementwise_abs(v), d = av * 0.2316418882f + 1.0f;
    f32x2 t; t.x = __builtin_amdgcn_rcpf(d.x); t.y = __builtin_amdgcn_rcpf(d.y);
    f32x2 q = t * 0.5307027145f + (-0.7265760135f); q = q * t + 0.7107068705f; q = q * t + (-0.142248368f); q = q * t + 0.127414796f; q = q * t;
    const f32x2 s = (v * v) * (-0.72134752044f);
    f32x2 e; e.x = __builtin_amdgcn_exp2f(s.x); e.y = __builtin_amdgcn_exp2f(s.y);
    const f32x2 m = v * (q * e), r = v - m;
    f32x2 o; o.x = v.x < 0.f ? m.x : r.x; o.y = v.y < 0.f ? m.y : r.y; return o;
}
#define DPPF(old_, src_, ctrl_) __int_as_float(__builtin_amdgcn_update_dpp(__float_as_int(old_), __float_as_int(src_), (ctrl_), 0xf, 0xf, false))
struct EpiUpConv {
    static constexpr bool PERM = true, MIDK = false;
    const float* ssq; bf16_t* act; const float* cw; const float* cb; const float* cache; float* out; LAS float* xch;
    DI void mid(AccT&, const Unit&, int, int, int, int) const {}
    DI void operator()(const AccT& acc, const Unit& u, int wr, int wc, int fr, int fq) const {
        const int tokbase = u.pm * 254 - 2, cl = wc * 32 + 8 * fq, f0 = u.pn * 128 + cl;
        float sq[2][4];
#pragma unroll
        for (int ai = 0; ai < 2; ++ai)
#pragma unroll
            for (int m = 0; m < 4; ++m) { const int tok = tokbase + ai * 128 + wr * 64 + m * 16 + fr; sq[ai][m] = (tok >= 0 && tok < T_TOK) ? ssq[tok] : -1.f; }
        f32x4 cb4[2], w04[2], w14[2], w24[2];
#pragma unroll
        for (int n = 0; n < 2; ++n) { cb4[n] = *(const f32x4*)(cb + f0 + 4 * n); w04[n] = *(const f32x4*)(cw + f0 + 4 * n); w14[n] = *(const f32x4*)(cw + DFF + f0 + 4 * n); w24[n] = *(const f32x4*)(cw + 2 * DFF + f0 + 4 * n); }
        float rs[2][4];
#pragma unroll
        for (int ai = 0; ai < 2; ++ai)
#pragma unroll
            for (int m = 0; m < 4; ++m) rs[ai][m] = sq[ai][m] >= 0.f ? rsqrtf(sq[ai][m] * (1.f / DM) + EPS) : 0.f;
        if (fr >= 14) {
#pragma unroll
            for (int ai = 0; ai < 2; ++ai) { LAS float* xp = xch + ((2 * ai + wr) * 2 + (fr - 14)) * 128 + cl;
                *(LAS f32x4*)xp = acc[ai][0][3][0] * rs[ai][3]; *(LAS f32x4*)(xp + 4) = acc[ai][0][3][1] * rs[ai][3]; }
        }
        asm volatile("s_waitcnt lgkmcnt(0)" ::: "memory"); __builtin_amdgcn_s_barrier(); __builtin_amdgcn_s_barrier(); asm volatile("" ::: "memory");
        const bool samp_tile = (tokbase + 255 >= TP);
#pragma unroll
        for (int ai = 0; ai < 2; ++ai) {
            const int g = 2 * ai + wr;
            f32x4 prev[2];
#pragma unroll
            for (int m = 0; m < 4; ++m) {
                const int i = ai * 128 + wr * 64 + m * 16 + fr, tok = tokbase + i;
                int l; const bool samp = tok >= TP;
                if (!samp) l = tok & 2047; else l = (tok - TP) & 3;
                u32x4 w; f32x4 curs[2];
#pragma unroll
                for (int n = 0; n < 2; ++n) {
                    const f32x4 cur = acc[ai][0][m][n] * rs[ai][m], vv = acc[ai][1][m][n] * rs[ai][m];
                    f32x4 x1, x2;
                    if (m == 0) {
                        f32x4 h1 = {0.f, 0.f, 0.f, 0.f}, h2 = {0.f, 0.f, 0.f, 0.f};
                        if (g >= 1) { h1 = *(const LAS f32x4*)(xch + ((g - 1) * 2 + 1) * 128 + cl + 4 * n); h2 = *(const LAS f32x4*)(xch + ((g - 1) * 2 + (fr == 0 ? 0 : 1)) * 128 + cl + 4 * n); }
#pragma unroll
                        for (int e = 0; e < 4; ++e) { x1[e] = DPPF(h1[e], cur[e], 0x111); x2[e] = DPPF(h2[e], cur[e], 0x112); }
                    } else {
#pragma unroll
                        for (int e = 0; e < 4; ++e) { const float o1 = DPPF(0.f, prev[n][e], 0x121), o2 = DPPF(0.f, prev[n][e], 0x122);
                            x1[e] = DPPF(o1, cur[e], 0x111); x2[e] = DPPF(o2, cur[e], 0x112); }
                    }
                    prev[n] = cur; curs[n] = cur;
                    if (l < 2) {
                        if (samp_tile && samp) {
                            const int bidx = (tok - TP) >> 2;
                            if (tok < T_TOK) { const f32x4 c1 = *(const f32x4*)(cache + ((size_t)bidx * 2 + 1) * DFF + f0 + 4 * n), c0 = *(const f32x4*)(cache + ((size_t)bidx * 2 + l) * DFF + f0 + 4 * n);
                                x2 = c0; if (l == 0) x1 = c1; }
                        } else { x2 = (f32x4){0.f, 0.f, 0.f, 0.f}; if (l == 0) x1 = x2; }
                    }
                    const f32x4 uc = cb4[n] + w04[n] * x2 + w14[n] * x1 + w24[n] * cur;
                    const f32x2 ga = gelu_pk((f32x2){uc[0], uc[1]}), gb = gelu_pk((f32x2){uc[2], uc[3]});
                    const unsigned p0 = pk2(ga.x * vv[0], ga.y * vv[1]), p1 = pk2(gb.x * vv[2], gb.y * vv[3]);
                    if (n == 0) { w.x = p0; w.y = p1; } else { w.z = p0; w.w = p1; }
                }
                if (i >= 2 && tok < T_TOK) {
                    *(u32x4*)(act + (size_t)tok * DFF + f0) = w;
                    if (!samp) { if (l >= 2046) { float* o = out + OUT_CP + ((size_t)(tok >> 11) * 2 + (l - 2046)) * DFF + f0; *(f32x4*)o = curs[0]; *(f32x4*)(o + 4) = curs[1]; } }
                    else if (l >= 2) { float* o = out + OUT_CS + ((size_t)((tok - TP) >> 2) * 2 + (l - 2)) * DFF + f0; *(f32x4*)o = curs[0]; *(f32x4*)(o + 4) = curs[1]; }
                }
            }
        }
    }
};
struct EpiDownNorm {
    static constexpr bool PERM = true, MIDK = false;
    const bf16_t* hb; float* y; const float* lnf; float* exch; unsigned* cnt; LAS float* xl;
    DI void mid(AccT&, const Unit&, int, int, int, int) const {}
    DI void operator()(const AccT& acc_, const Unit& u, int wr, int wc, int fr, int fq) const {
        AccT& acc = const_cast<AccT&>(acc_);
        const int lrow0 = wr * 64 + fr; int row0 = u.pm * 256 + lrow0, c0 = u.pn * 256 + wc * 32 + 8 * fq;
        asm volatile("" : "+v"(row0), "+v"(c0));
#pragma unroll
        for (int ai = 0; ai < 2; ++ai)
#pragma unroll
            for (int m = 0; m < 4; ++m) {
                const int row = row0 + ai * 128 + m * 16;
                float ss = 0.f;
#pragma unroll
                for (int bj = 0; bj < 2; ++bj) {
                    const u32x4 hv = *(const u32x4*)(hb + (size_t)row * DM + c0 + bj * 128);
                    f32x4 v0 = acc[ai][bj][m][0], v1 = acc[ai][bj][m][1];
                    v0[0] += bflo(hv.x); v0[1] += bfhi(hv.x); v0[2] += bflo(hv.y); v0[3] += bfhi(hv.y); v1[0] += bflo(hv.z); v1[1] += bfhi(hv.z); v1[2] += bflo(hv.w); v1[3] += bfhi(hv.w);
                    acc[ai][bj][m][0] = v0; acc[ai][bj][m][1] = v1;
                    ss += v0[0] * v0[0] + v0[1] * v0[1] + v0[2] * v0[2] + v0[3] * v0[3] + v1[0] * v1[0] + v1[1] * v1[1] + v1[2] * v1[2] + v1[3] * v1[3];
                }
                ss += __shfl_xor(ss, 16); ss += __shfl_xor(ss, 32);
                if (fq == 0) xl[(lrow0 + ai * 128 + m * 16) * 4 + wc] = ss;
            }
        unsigned* pc = cnt + u.pm * 32;
#define G5_PUBLISH() do { if (wc == 0) { \
            if (fq == 0) { \
                _Pragma("unroll") for (int ai = 0; ai < 2; ++ai) _Pragma("unroll") for (int m = 0; m < 4; ++m) { const int lr = lrow0 + ai * 128 + m * 16; const f32x4 q = *(const LAS f32x4*)(xl + lr * 4); \
                    __hip_atomic_store(exch + (size_t)(u.pm * 256 + lr) * 4 + u.pn, (q[0] + q[1]) + (q[2] + q[3]), __ATOMIC_RELAXED, __HIP_MEMORY_SCOPE_AGENT); } } \
            asm volatile("s_waitcnt vmcnt(0)" ::: "memory"); \
            __builtin_amdgcn_fence(__ATOMIC_RELEASE, "agent"); \
            asm volatile("s_waitcnt vmcnt(0)" ::: "memory"); \
            if (fr == 0 && fq == 0) __hip_atomic_fetch_add(pc, 1u, __ATOMIC_RELAXED, __HIP_MEMORY_SCOPE_AGENT); } } while (0)
        asm volatile("s_waitcnt lgkmcnt(0)" ::: "memory"); __builtin_amdgcn_s_barrier(); asm volatile("" ::: "memory");
        if (wr == 1) G5_PUBLISH();
        asm volatile("s_waitcnt lgkmcnt(0)" ::: "memory"); __builtin_amdgcn_s_barrier(); asm volatile("" ::: "memory");
        if (wr == 0) G5_PUBLISH();
#undef G5_PUBLISH
        {
            unsigned spins = 0;
            while (__hip_atomic_load(pc, __ATOMIC_RELAXED, __HIP_MEMORY_SCOPE_AGENT) < 8u && ++spins < (1u << 18)) __builtin_amdgcn_s_sleep(16);
            __builtin_amdgcn_fence(__ATOMIC_ACQUIRE, "agent"); }
        asm volatile("" : "+v"(row0), "+v"(c0));
#pragma unroll
        for (int ai = 0; ai < 2; ++ai)
#pragma unroll
            for (int m = 0; m < 4; ++m) {
                const int row = row0 + ai * 128 + m * 16;
                f32x4 q;
                q[0] = __hip_atomic_load(exch + (size_t)row * 4 + 0, __ATOMIC_RELAXED, __HIP_MEMORY_SCOPE_AGENT); q[1] = __hip_atomic_load(exch + (size_t)row * 4 + 1, __ATOMIC_RELAXED, __HIP_MEMORY_SCOPE_AGENT);
                q[2] = __hip_atomic_load(exch + (size_t)row * 4 + 2, __ATOMIC_RELAXED, __HIP_MEMORY_SCOPE_AGENT); q[3] = __hip_atomic_load(exch + (size_t)row * 4 + 3, __ATOMIC_RELAXED, __HIP_MEMORY_SCOPE_AGENT);
                const float rs = rsqrtf(((q[0] + q[1]) + (q[2] + q[3])) * (1.f / DM) + EPS);
#pragma unroll
                for (int bj = 0; bj < 2; ++bj) {
                    const int c = c0 + bj * 128;
                    const f32x4 g0 = *(const f32x4*)(lnf + c), g1 = *(const f32x4*)(lnf + c + 4);
                    *(f32x4*)(y + (size_t)row * DM + c) = acc[ai][bj][m][0] * rs * g0; *(f32x4*)(y + (size_t)row * DM + c + 4) = acc[ai][bj][m][1] * rs * g1;
                }
            }
    }
};
struct EpiPart {
    static constexpr bool PERM = true, MIDK = false;
    bf16_t* part;
    DI void mid(AccT&, const Unit&, int, int, int, int) const {}
    DI void operator()(const AccT& acc, const Unit& u, int wr, int wc, int fr, int fq) const {
        bf16_t* base = part + (size_t)u.id * 65536 + (wr * 64 + fr) * 256 + wc * 32 + 8 * fq;
#pragma unroll
        for (int ai = 0; ai < 2; ++ai)
#pragma unroll
            for (int m = 0; m < 4; ++m)
#pragma unroll
                for (int bj = 0; bj < 2; ++bj) { const f32x4 v0 = acc[ai][bj][m][0], v1 = acc[ai][bj][m][1];
                    u32x4 w; w.x = pk2(v0[0], v0[1]); w.y = pk2(v0[2], v0[3]); w.z = pk2(v1[0], v1[1]); w.w = pk2(v1[2], v1[3]);
                    *(u32x4*)(base + (ai * 128 + m * 16) * 256 + bj * 128) = w; }
    }
};

DI void transpose_item(const float* __restrict__ src, int ldsrc, int srccol, int k0, const float* __restrict__ scale, bf16_t* dst, int lddst, int n0dst, int k0dst,
                       LAS float* scr, int lane) {
    float tv[32];
#pragma unroll
    for (int i = 0; i < 32; ++i) { const int kk = 2 * i + (lane >> 5); tv[i] = src[(size_t)(k0 + kk) * ldsrc + srccol]; }
    if (scale) {
#pragma unroll
        for (int i = 0; i < 32; ++i) tv[i] *= scale[k0 + 2 * i + (lane >> 5)];
    }
#pragma unroll
    for (int i = 0; i < 32; ++i) scr[(2 * i + (lane >> 5)) * 33 + (lane & 31)] = tv[i];
    LDS_WAIT();
    const int c = lane & 7;
#pragma unroll
    for (int j = 0; j < 4; ++j) { const int n = (lane >> 3) + 8 * j; const LAS float* s = scr + (8 * c) * 33 + n;
        u32x4 o; o.x = pk2(s[0 * 33], s[1 * 33]); o.y = pk2(s[2 * 33], s[3 * 33]); o.z = pk2(s[4 * 33], s[5 * 33]); o.w = pk2(s[6 * 33], s[7 * 33]);
        *(u32x4*)(dst + (size_t)(n0dst + n) * lddst + k0dst + 8 * c) = o; }
    LDS_WAIT();
}
DI float log_sigmoid(float z) { return fminf(z, 0.f) - __logf(1.f + __expf(-fabsf(z))); }


template <int RG> DI void xpass_unit(const Params& p, LAS unsigned char* lds, const int tok0, const int tid_, bf16_t* xb, float* rstd1, float* bcum, float* ebl) {
    constexpr int KS = 8 / RG, TU = 16 * RG, NKS = 32 / KS, HT = TU / 2;
    int tid = tid_; asm volatile("" : "+v"(tid));
    const int lane = tid & 63, wave = tid >> 6;
    LAS bf16_t* wga = (LAS bf16_t*)lds;
    LAS float* gas = (LAS float*)(lds + 33024);
    LAS float* accp = (LAS float*)(lds + 41216);
    LAS float* ssp = accp + 2048;
    LAS float* tot = ssp + 128;
    const int r16 = lane & 15, kq = lane >> 4, rg = wave % RG, kh = wave / RG, row = tok0 + rg * 16 + r16;
    const float* xr = x_row(p, row) + kh * (32 * NKS);
    bf16_t* xbr = xb + (size_t)row * DM + kh * (32 * NKS);
    const LAS bf16_t* wgr = wga + r16 * 1032 + kh * (32 * NKS);
    f32x4 acc = {0.f, 0.f, 0.f, 0.f}; float ss = 0.f;
    constexpr int BQ = NKS < 8 ? NKS : 8;
    for (int ks = 0; ks < NKS; ks += BQ) {
        f32x4 v[BQ][2];
#pragma unroll
        for (int q = 0; q < BQ; ++q) { v[q][0] = *(const f32x4*)(xr + (ks + q) * 32 + kq * 8); v[q][1] = *(const f32x4*)(xr + (ks + q) * 32 + kq * 8 + 4); }
#pragma unroll
        for (int q = 0; q < BQ; ++q) {
            const f32x4 a0 = v[q][0], a1 = v[q][1];
            ss += a0[0] * a0[0] + a0[1] * a0[1] + a0[2] * a0[2] + a0[3] * a0[3] + a1[0] * a1[0] + a1[1] * a1[1] + a1[2] * a1[2] + a1[3] * a1[3];
            u32x4 w; w.x = pk2(a0[0], a0[1]); w.y = pk2(a0[2], a0[3]); w.z = pk2(a1[0], a1[1]); w.w = pk2(a1[2], a1[3]);
            *(u32x4*)(xbr + (ks + q) * 32 + kq * 8) = w;
            const bf16x8 bfrag = *(const LAS bf16x8*)(wgr + (ks + q) * 32 + kq * 8);
            acc = __builtin_amdgcn_mfma_f32_16x16x32_bf16(__builtin_bit_cast(bf16x8, w), bfrag, acc, 0, 0, 0);
        }
    }
    ss += __shfl_xor(ss, 16); ss += __shfl_xor(ss, 32);
    if (kq == 0) ssp[kh * TU + rg * 16 + r16] = ss;
#pragma unroll
    for (int j = 0; j < 4; ++j) accp[(kh * TU + rg * 16 + kq * 4 + j) * 16 + r16] = acc[j];
    __syncthreads();
    for (int idx = tid; idx < TU * 16; idx += 512) { const int lr = idx >> 4;
        float sq = 0.f, a = 0.f;
#pragma unroll
        for (int k = 0; k < KS; ++k) { sq += ssp[k * TU + lr]; a += accp[k * TU * 16 + idx]; }
        const float rs = rsqrtf(sq * (1.f / DM) + EPS);
        gas[idx] = a * rs;
        if ((idx & 15) == 0) rstd1[tok0 + lr] = rs; }
    __syncthreads();
    {
        const int c = tid & 255, half = tid >> 8;
        float wg[16];
#pragma unroll
        for (int r = 0; r < 16; ++r) wg[r] = p.w_gate_up[r * 256 + c];
        const float bias = p.b_gate_up[c];
        const int tokb = tok0 + half * HT; const bool samp = tokb >= TP;
        float ls[HT]; float cum = 0.f;
#pragma unroll
        for (int i = 0; i < HT; ++i) {
            const LAS f32x4* gp = (const LAS f32x4*)(gas + (half * HT + i) * 16);
            const f32x4 g0 = gp[0], g1 = gp[1], g2 = gp[2], g3 = gp[3];
            float z = bias;
            z += g0[0] * wg[0] + g0[1] * wg[1] + g0[2] * wg[2] + g0[3] * wg[3] + g1[0] * wg[4] + g1[1] * wg[5] + g1[2] * wg[6] + g1[3] * wg[7];
            z += g2[0] * wg[8] + g2[1] * wg[9] + g2[2] * wg[10] + g2[3] * wg[11] + g3[0] * wg[12] + g3[1] * wg[13] + g3[2] * wg[14] + g3[3] * wg[15];
            ls[i] = log_sigmoid(z) * (1.f / 16.f); cum += ls[i];
        }
        if (half == 0) tot[c] = cum;
        __syncthreads();
        cum = (half == 1 && !samp) ? tot[c] : 0.f;
#pragma unroll
        for (int i = 0; i < HT; ++i) {
            cum = (samp && (i & 3) == 0) ? ls[i] : cum + ls[i];
            const int tok = tokb + i;
            bcum[(size_t)tok * 256 + c] = cum;
            if (samp) { if ((i & 3) == 3) ebl[(size_t)(256 + ((tok - TP) >> 2)) * 256 + c] = expf(cum); }
            else if (half == 1 && i == HT - 1) ebl[(size_t)(tok >> 6) * 256 + c] = expf(cum);
        }
    }
    __syncthreads();
}

DI void phase0(const Params& p, LAS unsigned char* lds) {
    int tid = threadIdx.x; asm volatile("" : "+v"(tid));
    const int lane = tid & 63, wave = tid >> 6;
    unsigned char* ws = p.ws;
    LAS bf16_t* wga = (LAS bf16_t*)lds;
    LAS float* gas = (LAS float*)(lds + 33024);
    LAS float* scr = (LAS float*)(lds + 41216 + wave * 8448);
    bf16_t* xb = (bf16_t*)((unsigned char*)p.out + 0);
    float* rstd1 = (float*)(ws + WS_RSTD1); float* bcum = (float*)(ws + WS_SH); float* ebl = (float*)(ws + WS_EBL);
    { const int gt = blockIdx.x * 512 + tid, ng = gridDim.x * 512;
      float* ssq2 = (float*)(ws + WS_SSQ2);
      for (int i = gt; i < T_TOK; i += ng) ssq2[i] = 0.f;
      float* rc = (float*)(ws + WS_ROPEC); float* rsn = (float*)(ws + WS_ROPES);
      for (int i = gt; i < 2052 * 64; i += ng) { const int pi = i >> 6, fi = i & 63; const double pos = (double)(pi < 2048 ? pi : 16384 + (pi - 2048));
          const double inv = exp(-(double)fi * (9.210340371976184 / 64.0)); const double ang = pos * inv; const double kk = rint(ang * 0.15915494309189535);
          const float r = (float)(ang - kk * 6.283185307179586); rc[i] = cosf(r); rsn[i] = sinf(r); } }
    {
        LAS float* accp = (LAS float*)(lds + 41216);
        LAS float* ssp = accp + 2048;
        LAS float* tot = ssp + 128;
        for (int k = tid; k < DM; k += 512) { const float g = p.ln1[k]; const float* s = p.w_in + (size_t)k * DIN + 3584;
            const f32x4 s0 = *(const f32x4*)s, s1 = *(const f32x4*)(s + 4), s2 = *(const f32x4*)(s + 8), s3 = *(const f32x4*)(s + 12);
            const float sv[16] = {s0[0], s0[1], s0[2], s0[3], s1[0], s1[1], s1[2], s1[3], s2[0], s2[1], s2[2], s2[3], s3[0], s3[1], s3[2], s3[3]};
#pragma unroll
            for (int r = 0; r < 16; r += 2) { const unsigned w = pk2(sv[r] * g, sv[r + 1] * g); wga[r * 1032 + k] = (bf16_t)(w & 0xffffu); wga[(r + 1) * 1032 + k] = (bf16_t)(w >> 16); } }
        __syncthreads();
        for (int u = blockIdx.x; u < 256; u += gridDim.x) xpass_unit<4>(p, lds, u * 64, tid, xb, rstd1, bcum, ebl);
        for (int u = blockIdx.x; u < 32; u += gridDim.x) xpass_unit<1>(p, lds, TP + u * 16, tid, xb, rstd1, bcum, ebl);
    }
    {
        const int gw = blockIdx.x * 8 + wave, ngw = gridDim.x * 8;
        constexpr int I_IN = 16 * 176, I_MX = 8 * 32, I_O = 16 * 32, I_UP = 16 * 176, I_DN = 44 * 32, NIT = I_IN + 2 * I_MX + I_O + I_UP + I_DN;
        for (int it = gw; it < NIT; it += ngw) {
            int r = it; const int nl = lane & 31;
            if (r < I_IN) { const int kb = r / 176, nb = r % 176, n = nb * 32 + nl; int sc;
                if (n < 1024) { const int pp = n & 127; sc = (n & ~127) + (((pp & 7) < 4) ? 4 * (pp >> 3) + (pp & 7) : 64 + 4 * (pp >> 3) + (pp & 7) - 4); }
                else sc = n < 3584 ? n : n + 16;
                transpose_item(p.w_in, DIN, sc, kb * 64, p.ln1, (bf16_t*)(ws + WS_WIN), DM, nb * 32, kb * 64, scr, lane); continue; }
            r -= I_IN;
            if (r < I_MX) { const int kb = r / 32, nb = r % 32; transpose_item(p.w_ret_out, DM, nb * 32 + nl, kb * 64, nullptr, (bf16_t*)(ws + WS_WMIX), DM, nb * 32, kb * 64, scr, lane); continue; }
            r -= I_MX;
            if (r < I_MX) { const int kb = r / 32, nb = r % 32; transpose_item(p.w_gla_out, DM, nb * 32 + nl, kb * 64, nullptr, (bf16_t*)(ws + WS_WMIX), DM, nb * 32, 512 + kb * 64, scr, lane); continue; }
            r -= I_MX;
            if (r < I_O) { const int kb = r / 32, nb = r % 32; transpose_item(p.w_o, DM, nb * 32 + nl, kb * 64, nullptr, (bf16_t*)(ws + WS_WO), DM, nb * 32, kb * 64, scr, lane); continue; }
            r -= I_O;
            if (r < I_UP) { const int kb = r / 176, nb = r % 176, n = nb * 32 + nl; const int sc = ((n >> 7) & 1) * DFF + (n >> 8) * 128 + (n & 127);
                transpose_item(p.w_up, NUP, sc, kb * 64, p.ln2, (bf16_t*)(ws + WS_WUP), DM, nb * 32, kb * 64, scr, lane); continue; }
            r -= I_UP;
            { const int kb = r / 32, nb = r % 32; transpose_item(p.w_down, DM, nb * 32 + nl, kb * 64, nullptr, (bf16_t*)(ws + WS_WDN), DFF, nb * 32, kb * 64, scr, lane); }
        }
    }
}

template <int DK> DI unsigned img_off(int row, int ch) { return (unsigned)(row * (2 * DK) + 16 * (ch ^ ((((row & 3) << 2) | ((row >> 2) & 3)) & (DK / 8 - 1)))); }
template <int DK> DI unsigned tr_addr(int lane, int c, int ks, int t) {
    const int h = lane >> 5, blk = (lane >> 4) & 1, q = (lane & 15) >> 2, pp = lane & 3;
    return img_off<DK>(16 * ks + 8 * h + 4 * t + q, 4 * c + 2 * blk + (pp >> 1)) + 8 * (pp & 1);
}
DI bf16x8 tr_frag(LAS unsigned char* a0, LAS unsigned char* a1) {
    const s16x4 lo = __builtin_amdgcn_ds_read_tr16_b64_v4i16((LAS s16x4*)a0), hi = __builtin_amdgcn_ds_read_tr16_b64_v4i16((LAS s16x4*)a1);
    return __builtin_shufflevector(lo, hi, 0, 1, 2, 3, 4, 5, 6, 7);
}
DI bf16x8 pack8(const f32x16& x, int s) {
    u32x4 w; w.x = pk2(x[8 * s + 0], x[8 * s + 1]); w.y = pk2(x[8 * s + 2], x[8 * s + 3]); w.z = pk2(x[8 * s + 4], x[8 * s + 5]); w.w = pk2(x[8 * s + 6], x[8 * s + 7]);
    return __builtin_bit_cast(bf16x8, w);
}
#define MFMA32(a, b, c) __builtin_amdgcn_mfma_f32_32x32x16_bf16((a), (b), (c), 0, 0, 0)

constexpr int P2_BUF = 49152, P2_QO = 0, P2_KO = 16384, P2_VO = 32768, P2_P = 98304, P2_SSQ = P2_P + 64 * 144, P2_EBL = P2_SSQ + 1024;

template <int DK, bool FULL> DI void chain_prompt(const Params& p, LAS unsigned char* lds, const int branch, const int b, const int head, const int c0, const int nc, const int nprev, const bool write_final) {
    constexpr int NDB = DK / 32, NCH = DK / 8, QLD = 4 * DK, NQI = (64 * NCH) / 512;
    int tid0 = threadIdx.x; asm volatile("" : "+v"(tid0));
    const int w = __builtin_amdgcn_readfirstlane(tid0 >> 6);
    int tid = tid0, lane = tid0 & 63, h = lane >> 5, r = lane & 31;
    unsigned char* ws = p.ws;
    const bf16_t* Q = (const bf16_t*)(ws + (branch == 0 ? PQ_R : PQ_G)) + head * DK;
    const bf16_t* K = (const bf16_t*)(ws + (branch == 0 ? PK_R : PK_G)) + head * DK;
    const bf16_t* V = (const bf16_t*)(ws + (branch == 0 ? PV_R : PV_G)) + head * 128;
    const bf16_t* G = (const bf16_t*)(ws + (branch == 0 ? PG_R : PG_G)) + head * 128;
    const float* ebl = (const float*)(ws + WS_EBL);
    bf16_t* arg = (bf16_t*)((unsigned char*)p.out + SEG1024) + branch * 512 + head * 128;
    const float* gain = (branch == 0 ? p.g_ret : p.g_gla) + head * 128;
    const int tok0 = b * 2048;
    const float lg2 = log2f(1.f - exp2f(-5.f - (float)head));
    const float ret_ebl = exp2f(64.f * lg2);
    const int chain = branch * 32 + b * 4 + head;
    float* Lbuf = (float*)p.out + (size_t)chain * 3 * 16384;
    float* Dbuf = (float*)p.out + (size_t)64 * 3 * 16384 + (size_t)chain * 3 * 64;
    f32x16 S[NDB];
#pragma unroll
    for (int d = 0; d < NDB; ++d)
#pragma unroll
        for (int i = 0; i < 16; ++i) S[d][i] = 0.f;
    f32x4 gn[4];
    if (w < 4) {
#pragma unroll
        for (int g = 0; g < 4; ++g) gn[g] = *(const f32x4*)(gain + 32 * w + 8 * g + 4 * h);
        if (FULL) {
            for (int sg = 0; sg < nprev; ++sg) {
#pragma unroll
                for (int d = 0; d < NDB; ++d)
#pragma unroll
                    for (int i = 0; i < 16; ++i) {
                        const int dd = 32 * d + (i & 3) + 8 * (i >> 2) + 4 * h;
                        const float dec = (DK == 128) ? exp2f(64.f * (float)nc * lg2) : Dbuf[sg * 64 + dd];
                        S[d][i] = (sg == 0 ? 0.f : S[d][i] * dec) + Lbuf[(size_t)sg * 16384 + (size_t)dd * 128 + 32 * w + r];
                    }
            }
        }
    }
    float dprod = 1.f;
    u32x4 rq[NQI], rk[NQI], rv[2]; float rebl = 0.f;
#define P2_LOAD(c) do { const int tb = tok0 + 64 * (c); \
        _Pragma("unroll") for (int i = 0; i < NQI; ++i) { const int idx = tid + 512 * i, rr = idx / NCH, ch = idx % NCH; \
            rq[i] = *(const u32x4*)(Q + (size_t)(tb + rr) * QLD + ch * 8); rk[i] = *(const u32x4*)(K + (size_t)(tb + rr) * QLD + ch * 8); } \
        _Pragma("unroll") for (int i = 0; i < 2; ++i) { const int idx = tid + 512 * i, rr = idx >> 4, ch = idx & 15; rv[i] = *(const u32x4*)(V + (size_t)(tb + rr) * 512 + ch * 8); } \
        if (DK == 64 && tid < 64) rebl = ebl[(size_t)(b * 32 + (c)) * 256 + head * 64 + tid]; } while (0)
#define P2_STORE(buf) do { LAS unsigned char* bb = lds + (buf) * P2_BUF; \
        _Pragma("unroll") for (int i = 0; i < NQI; ++i) { const int idx = tid + 512 * i, rr = idx / NCH, ch = idx % NCH; \
            *(LAS u32x4*)(bb + P2_QO + img_off<DK>(rr, ch)) = rq[i]; *(LAS u32x4*)(bb + P2_KO + img_off<DK>(rr, ch)) = rk[i]; } \
        _Pragma("unroll") for (int i = 0; i < 2; ++i) { const int idx = tid + 512 * i, rr = idx >> 4, ch = idx & 15; *(LAS u32x4*)(bb + P2_VO + img_off<128>(rr, ch)) = rv[i]; } \
        if (DK == 64 && tid < 64) *(LAS float*)(lds + P2_EBL + (buf) * 256 + tid * 4) = rebl; } while (0)
    P2_LOAD(c0); P2_STORE(c0 & 1);
    dprod *= rebl;
    __syncthreads();
    const int cend = c0 + nc;
    for (int c = c0; c < cend; ++c) {
        tid = tid0; asm volatile("" : "+v"(tid)); lane = tid & 63; h = lane >> 5; r = lane & 31;
        LAS unsigned char* bb = lds + (c & 1) * P2_BUF;
        LAS unsigned char* qi = bb + P2_QO; LAS unsigned char* ki = bb + P2_KO; LAS unsigned char* vi = bb + P2_VO;
        if (c + 1 < cend) { P2_LOAD(c + 1); dprod *= rebl; }
        u32x2 gt[2][4];
        if (FULL && w < 4) {
            {   const int tbg = tok0 + 64 * c;
#pragma unroll
                for (int ib = 0; ib < 2; ++ib)
#pragma unroll
                    for (int g = 0; g < 4; ++g) gt[ib][g] = *(const u32x2*)(G + (size_t)(tbg + 32 * ib + r) * 512 + 32 * w + 8 * g + 4 * h); }
        }
        if (FULL && w >= 4 && w < 7) {
            const int ws_ = w - 4;
            const int jb = (ws_ == 2) ? 1 : 0, ib = (ws_ == 0) ? 0 : 1;
            f32x16 pt;
#pragma unroll
            for (int i = 0; i < 16; ++i) pt[i] = 0.f;
#pragma unroll
            for (int s = 0; s < DK / 16; ++s) {
                const bf16x8 a = *(const LAS bf16x8*)(ki + img_off<DK>(32 * jb + r, 2 * s + h)), bq = *(const LAS bf16x8*)(qi + img_off<DK>(32 * ib + r, 2 * s + h));
                pt = MFMA32(a, bq, pt);
            }
            if (jb == ib) {
#pragma unroll
                for (int i = 0; i < 16; ++i) { const int j = (i & 3) + 8 * (i >> 2) + 4 * h; pt[i] = (j <= r) ? pt[i] : 0.f; }
            }
#pragma unroll
            for (int g = 0; g < 4; ++g) { u32x2 o; o.x = pk2(pt[4 * g], pt[4 * g + 1]); o.y = pk2(pt[4 * g + 2], pt[4 * g + 3]);
                *(LAS u32x2*)(lds + P2_P + (32 * ib + r) * 144 + (32 * jb + 8 * g + 4 * h) * 2) = o; }
        }
        f32x16 ot[2];
        bf16x8 vf[4];
        if (w < 4) {
#pragma unroll
            for (int s = 0; s < 4; ++s) vf[s] = tr_frag(vi + tr_addr<128>(lane, w, s, 0), vi + tr_addr<128>(lane, w, s, 1));
#pragma unroll
            for (int ib = 0; ib < 2; ++ib)
#pragma unroll
                for (int i = 0; i < 16; ++i) ot[ib][i] = 0.f;
            if (FULL)
#pragma unroll
            for (int d = 0; d < NDB; ++d)
#pragma unroll
                for (int s2 = 0; s2 < 2; ++s2) {
                    const bf16x8 sfr = pack8(S[d], s2);
#pragma unroll
                    for (int ib = 0; ib < 2; ++ib) {
                        const s16x4 lo = *(const LAS s16x4*)(qi + img_off<DK>(32 * ib + r, 4 * d + 2 * s2) + 8 * h), hi = *(const LAS s16x4*)(qi + img_off<DK>(32 * ib + r, 4 * d + 2 * s2 + 1) + 8 * h);
                        const bf16x8 bq = __builtin_shufflevector(lo, hi, 0, 1, 2, 3, 4, 5, 6, 7);
                        ot[ib] = MFMA32(sfr, bq, ot[ib]);
                    }
                }
#pragma unroll
            for (int d = 0; d < NDB; ++d) {
#pragma unroll
                for (int s = 0; s < 4; ++s) {
                    const bf16x8 a = tr_frag(ki + tr_addr<DK>(lane, d, s, 0), ki + tr_addr<DK>(lane, d, s, 1));
                    S[d] = MFMA32(a, vf[s], S[d]);
                }
                if (DK == 128) {
#pragma unroll
                    for (int i = 0; i < 16; ++i) S[d][i] *= ret_ebl;
                } else {
                    const LAS float* eb = (const LAS float*)(lds + P2_EBL + (c & 1) * 256) + 32 * d + 4 * h;
#pragma unroll
                    for (int g = 0; g < 4; ++g) { const f32x4 e4 = *(const LAS f32x4*)(eb + 8 * g);
#pragma unroll
                        for (int e = 0; e < 4; ++e) S[d][4 * g + e] *= e4[e]; }
                }
            }
        }
        if (FULL) __syncthreads();
        if (FULL && w < 4) {
#pragma unroll
            for (int ib = 0; ib < 2; ++ib) {
#pragma unroll
                for (int s = 0; s < (ib == 0 ? 2 : 4); ++s) {
                    const bf16x8 bp = *(const LAS bf16x8*)(lds + P2_P + (32 * ib + r) * 144 + (16 * s + 8 * h) * 2);
                    ot[ib] = MFMA32(vf[s], bp, ot[ib]);
                }
            }
#pragma unroll
            for (int ib = 0; ib < 2; ++ib) { float ss = 0.f;
#pragma unroll
                for (int i = 0; i < 16; ++i) ss += ot[ib][i] * ot[ib][i];
                ss += __shfl_xor(ss, 32);
                if (h == 0) *(LAS float*)(lds + P2_SSQ + (w * 64 + 32 * ib + r) * 4) = ss; }
        }
        if (c + 1 < cend) P2_STORE((c + 1) & 1);
        __syncthreads();
        if (FULL && w < 4) {
            asm volatile("" : "+v"(lane)); h = lane >> 5; r = lane & 31;
            const int tb = tok0 + 64 * c;
#pragma unroll
            for (int ib = 0; ib < 2; ++ib) {
                const LAS float* sq = (const LAS float*)(lds + P2_SSQ) + 32 * ib + r;
                const float tot = sq[0] + sq[64] + sq[128] + sq[192];
                const float rs = rsqrtf(tot * (1.f / 128.f) + EPS);
#pragma unroll
                for (int g = 0; g < 4; ++g) {
                    const u32x2 gg = gt[ib][g];
                    u32x2 o; o.x = pk2(ot[ib][4 * g] * rs * gn[g][0] * bflo(gg.x), ot[ib][4 * g + 1] * rs * gn[g][1] * bfhi(gg.x));
                    o.y = pk2(ot[ib][4 * g + 2] * rs * gn[g][2] * bflo(gg.y), ot[ib][4 * g + 3] * rs * gn[g][3] * bfhi(gg.y));
                    *(u32x2*)(arg + (size_t)(tb + 32 * ib + r) * 1024 + 32 * w + 8 * g + 4 * h) = o;
                }
            }
        }
    }
#undef P2_LOAD
#undef P2_STORE
    if (!FULL && DK == 64 && tid0 < 64) Dbuf[nprev * 64 + tid0] = dprod;
    if (w < 4 && (write_final || !FULL)) {
        lane = tid0 & 63; h = lane >> 5; r = lane & 31;
        float* so = FULL ? p.out + (branch == 0 ? OUT_RSP : OUT_GSP) + (size_t)(b * 4 + head) * DK * 128 : Lbuf + (size_t)nprev * 16384;
#pragma unroll
        for (int d = 0; d < NDB; ++d)
#pragma unroll
            for (int i = 0; i < 16; ++i) so[(size_t)(32 * d + (i & 3) + 8 * (i >> 2) + 4 * h) * 128 + 32 * w + r] = S[d][i];
    }
    __syncthreads();
}

template <int DK> DI void sample_unit(const Params& p, LAS unsigned char* lds, const int branch, const int b, const int head) {
    int tid = threadIdx.x; asm volatile("" : "+v"(tid));
    unsigned char* ws = p.ws;
    const bf16_t* Q = (const bf16_t*)(ws + (branch == 0 ? PQ_R : PQ_G)) + head * DK;
    const bf16_t* K = (const bf16_t*)(ws + (branch == 0 ? PK_R : PK_G)) + head * DK;
    const bf16_t* V = (const bf16_t*)(ws + (branch == 0 ? PV_R : PV_G)) + head * 128;
    const bf16_t* G = (const bf16_t*)(ws + (branch == 0 ? PG_R : PG_G)) + head * 128;
    bf16_t* arg = (bf16_t*)((unsigned char*)p.out + SEG1024) + branch * 512 + head * 128;
    const float* gain = (branch == 0 ? p.g_ret : p.g_gla) + head * 128;
    const float* sin_ = (branch == 0 ? p.state_ret : p.state_gla) + (size_t)(b * 4 + head) * DK * 128;
    float* sout = p.out + (branch == 0 ? OUT_RSS : OUT_GSS) + (size_t)(b * 4 + head) * DK * 128;
    const int tok0 = TP + 4 * b;
    LAS float* qs = (LAS float*)lds;
    LAS float* ks = qs + 4 * 128;
    LAS float* vs = ks + 4 * 128;
    LAS float* es = vs + 4 * 128;
    LAS float* Ps = es + 128;
    LAS float* ssq = Ps + 16;
    LAS float* op = ssq + 16;
    for (int i = tid; i < 4 * DK; i += 512) { const int t = i / DK, d = i % DK;
        qs[t * DK + d] = __uint_as_float((unsigned)Q[(size_t)(tok0 + t) * (4 * DK) + d] << 16); ks[t * DK + d] = __uint_as_float((unsigned)K[(size_t)(tok0 + t) * (4 * DK) + d] << 16); }
    { const int t = tid >> 7, v = tid & 127; vs[t * 128 + v] = __uint_as_float((unsigned)V[(size_t)(tok0 + t) * 512 + v] << 16); }
    if (tid < DK) {
        if (DK == 128) { const float lg2 = log2f(1.f - exp2f(-5.f - (float)head)); es[tid] = exp2f(4.f * lg2); }
        else es[tid] = ((const float*)(ws + WS_EBL))[(size_t)(256 + b) * 256 + head * 64 + tid];
    }
    __syncthreads();
    if (tid < 16) { const int i = tid >> 2, j = tid & 3; float s = 0.f; if (j <= i) { for (int d = 0; d < DK; ++d) s += qs[i * DK + d] * ks[j * DK + d]; } Ps[tid] = s; }
    {
        const int vq = tid & 31, dg = tid >> 5;
        f32x4 oa[4];
#pragma unroll
        for (int i = 0; i < 4; ++i) oa[i] = (f32x4){0.f, 0.f, 0.f, 0.f};
        f32x4 v4[4];
#pragma unroll
        for (int j = 0; j < 4; ++j) v4[j] = *(const LAS f32x4*)(vs + j * 128 + 4 * vq);
        f32x4 s0[DK / 16];
#pragma unroll
        for (int rr = 0; rr < DK / 16; ++rr) s0[rr] = *(const f32x4*)(sin_ + (size_t)(dg + 16 * rr) * 128 + 4 * vq);
#pragma unroll
        for (int rr = 0; rr < DK / 16; ++rr) {
            const int d = dg + 16 * rr;
            f32x4 sn = s0[rr];
#pragma unroll
            for (int i = 0; i < 4; ++i) { oa[i] += s0[rr] * qs[i * DK + d]; sn += v4[i] * ks[i * DK + d]; }
            sn *= es[d];
            *(f32x4*)(sout + (size_t)d * 128 + 4 * vq) = sn;
        }
#pragma unroll
        for (int i = 0; i < 4; ++i) *(LAS f32x4*)(op + (dg * 4 + i) * 128 + 4 * vq) = oa[i];
    }
    __syncthreads();
    {
        const int i = tid >> 7, v = tid & 127;
        float o = 0.f;
#pragma unroll
        for (int dg = 0; dg < 16; ++dg) o += op[(dg * 4 + i) * 128 + v];
#pragma unroll
        for (int j = 0; j < 4; ++j) o += Ps[i * 4 + j] * vs[j * 128 + v];
        const float s = wave_sum(o * o);
        if ((tid & 63) == 0) ssq[tid >> 6] = s;
        __syncthreads();
        const float rs = rsqrtf((ssq[2 * i] + ssq[2 * i + 1]) * (1.f / 128.f) + EPS);
        const float gate = __uint_as_float((unsigned)G[(size_t)(tok0 + i) * 512 + v] << 16);
        const unsigned wv = pk2(o * rs * gain[v] * gate, 0.f);
        arg[(size_t)(tok0 + i) * 1024 + v] = (bf16_t)(wv & 0xffffu);
    }
    __syncthreads();
}

template <bool FULL> DI void chain_call(const Params& p, LAS unsigned char* lds, int chain, int c0, int nc, int nprev, bool wf) {
    const int branch = chain >> 5, bh = chain & 31;
    if (branch == 0) chain_prompt<128, FULL>(p, lds, 0, bh >> 2, bh & 3, c0, nc, nprev, wf); else chain_prompt<64, FULL>(p, lds, 1, bh >> 2, bh & 3, c0, nc, nprev, wf);
}
DI void sample_call(const Params& p, LAS unsigned char* lds, int u) {
    const int branch = u >> 9, bh = u & 511;
    if (branch == 0) sample_unit<128>(p, lds, 0, bh >> 2, bh & 3); else sample_unit<64>(p, lds, 1, bh >> 2, bh & 3);
}
DI void phase2(const Params& p, LAS unsigned char* lds, const XcdBarrier& xbar) {
    const int G = gridDim.x, bx = blockIdx.x;
    if (G == 256) {
        const int chain = bx & 63, seg = bx >> 6;
        if (seg < 3) chain_call<false>(p, lds, chain, 8 * seg, 8, seg, false);
        else { sample_call(p, lds, bx - 192); sample_call(p, lds, bx - 192 + 64); }
        xcd_barrier(xbar);
        chain_call<true>(p, lds, chain, 8 * seg, 8, seg, seg == 3);
        for (int u = 128 + bx; u < 1024; u += 256) sample_call(p, lds, u);
    } else {
        for (int c = bx; c < 64; c += G) chain_call<true>(p, lds, c, 0, 32, 0, true);
        for (int u = bx; u < 1024; u += G) sample_call(p, lds, u);
    }
}

DI void phase_final(const Params& p) {
    const int lane = threadIdx.x & 63, gw = blockIdx.x * 8 + (threadIdx.x >> 6), ngw = gridDim.x * 8;
    const bf16_t* hb = (const bf16_t*)(p.ws + WS_SH);
    for (int row = TP + gw; row < T_TOK; row += ngw) {
        f32x4 v[4]; float s = 0.f;
        const bf16_t* part = (const bf16_t*)(p.ws + WS_PART) + (size_t)((row - TP) & 255) * 256 + 4 * lane;
#pragma unroll
        for (int j = 0; j < 4; ++j) {
            const u32x2 hv = *(const u32x2*)(hb + (size_t)row * DM + 256 * j + 4 * lane);
            v[j] = (f32x4){bflo(hv.x), bfhi(hv.x), bflo(hv.y), bfhi(hv.y)};
            const int su = ((row - TP) >> 8) * 4 + j;
            for (int kp = 0; kp < 11; ++kp) { const u32x2 pv = *(const u32x2*)(part + (size_t)(su * 11 + kp) * 65536); v[j] += (f32x4){bflo(pv.x), bfhi(pv.x), bflo(pv.y), bfhi(pv.y)}; }
            s += v[j][0] * v[j][0] + v[j][1] * v[j][1] + v[j][2] * v[j][2] + v[j][3] * v[j][3];
        }
        const float rs = rsqrtf(wave_sum(s) * (1.f / DM) + EPS);
#pragma unroll
        for (int j = 0; j < 4; ++j) { const f32x4 g = *(const f32x4*)(p.ln_f + 256 * j + 4 * lane); *(f32x4*)(p.out + (size_t)row * DM + 256 * j + 4 * lane) = v[j] * rs * g; }
    }
}

__global__ void __launch_bounds__(512, 2) fwd_megakernel(Params p) {
    extern __shared__ __attribute__((aligned(16))) unsigned char shm[];
    LAS unsigned char* lds = (LAS unsigned char*)shm;
    cg::grid_group grid = cg::this_grid();
    if (p.ws == nullptr) grid.sync();
    if (threadIdx.x < 4) ((LAS unsigned*)(lds + 131072 + 4096))[threadIdx.x] = 0u;
    __syncthreads();
    const XcdBarrier xbar = xcd_barrier_post((unsigned*)(p.ws + WS_BAR), (volatile LAS unsigned*)(lds + 131072 + 4096));
    unsigned char* ws = p.ws;
    const int G = gridDim.x, bx = blockIdx.x;
    bf16_t* xb = (bf16_t*)p.out;
    bf16_t* arg = (bf16_t*)((unsigned char*)p.out + SEG1024);

#ifndef PHMASK
#define PHMASK 0x1ff
#endif
#define PH(n) if ((PHMASK >> (n)) & 1)
    PH(0) phase0(p, lds);
    xcd_barrier(xbar);
#if defined(DUP_PH) && DUP_PH == 0
    phase0(p, lds);
    xcd_barrier(xbar);
#endif
    PH(1) {
        pg8::Gemm g{xb, (const bf16_t*)(ws + WS_WIN), T_TOK, NPROJ, DM, DM, DM, 256}; pg8::StaticOrder S; S.init(T_TOK, NPROJ, G, bx);
        EpiProj E{ws, (const float*)(ws + WS_RSTD1), (const float*)(ws + WS_SH), (const float*)(ws + WS_ROPEC), (const float*)(ws + WS_ROPES)};
        pg8::gemm_phase<EpiProj, pg8::StaticOrder, 16>(lds, g, S, E);
#if defined(DUP_PH) && DUP_PH == 1
        xcd_barrier(xbar);
        pg8::gemm_phase<EpiProj, pg8::StaticOrder, 16>(lds, g, S, E);
#endif
    }
    xcd_barrier(xbar);
    PH(2) phase2(p, lds, xbar);
    xcd_barrier(xbar);
#if defined(DUP_PH) && DUP_PH == 2
    phase2(p, lds, xbar);
    xcd_barrier(xbar);
#endif
    PH(3) {
        pg8::Gemm g{arg, (const bf16_t*)(ws + WS_WMIX), T_TOK, DM, DM, DM, DM, 256}; pg8::StaticOrder S; S.init(T_TOK, DM, G, bx);
        EpiMix E{(const bf16_t*)(ws + PM_R), (const bf16_t*)(ws + PM_G), (bf16_t*)(ws + WS_MIX)};
        pg8::gemm_phase<EpiMix, pg8::StaticOrder, 16>(lds, g, S, E);
#if defined(DUP_PH) && DUP_PH == 3
        xcd_barrier(xbar);
        pg8::gemm_phase<EpiMix, pg8::StaticOrder, 16>(lds, g, S, E);
#endif
    }
    xcd_barrier(xbar);
    PH(4) {
        pg8::Gemm g{(const bf16_t*)(ws + WS_MIX), (const bf16_t*)(ws + WS_WO), T_TOK, DM, DM, DM, DM, 256}; pg8::StaticOrder S; S.init(T_TOK, DM, G, bx);
        EpiH E{p.x_prompt, p.x_sample, p.out, (bf16_t*)(ws + WS_SH), (float*)(ws + WS_SSQ2)};
        pg8::gemm_phase<EpiH, pg8::StaticOrder, 16>(lds, g, S, E);
    }
    xcd_barrier(xbar);
    PH(5) {
        pg8::Gemm g{(const bf16_t*)(ws + WS_SH) - 2 * DM, (const bf16_t*)(ws + WS_WUP), T_TOK, NUP, DM, DM, DM, 254}; pg8::StaticOrder S; S.init_tiles(67, 22, G, bx);
        EpiUpConv E{(const float*)(ws + WS_SSQ2), (bf16_t*)(ws + WS_ACT), p.conv_w, p.conv_b, p.cache_conv, p.out, (LAS float*)(lds + 131072)};
        pg8::gemm_phase<EpiUpConv, pg8::StaticOrder, 16>(lds, g, S, E);
#if defined(DUP_PH) && DUP_PH == 5
        xcd_barrier(xbar);
        pg8::gemm_phase<EpiUpConv, pg8::StaticOrder, 16>(lds, g, S, E);
#endif
    }
    xcd_barrier(xbar);
    PH(7) {
        pg8::Gemm g{(const bf16_t*)(ws + WS_ACT), (const bf16_t*)(ws + WS_WDN), T_TOK, DM, DFF, DFF, DFF, 256}; pg8::StaticOrder S; S.init_tiles(64, 4, G, bx);
        EpiDownNorm E{(const bf16_t*)(ws + WS_SH), p.out, p.ln_f, (float*)(ws + WS_EXCH), (unsigned*)(ws + WS_CNT), (LAS float*)(lds + 131072)};
        pg8::gemm_phase<EpiDownNorm, pg8::StaticOrder, 44>(lds, g, S, E);
        {   pg8::PieceOrder S2{G, bx}; EpiPart E2{(bf16_t*)(ws + WS_PART)};
            pg8::gemm_phase<EpiPart, pg8::PieceOrder, 4>(lds, g, S2, E2); }
    }
    xcd_barrier(xbar);
    PH(8) phase_final(p);
}

extern "C" void kernel_launch(void* const* d_in, const int* in_sizes, int n_in, void* d_out, int out_size, void* d_ws, size_t ws_size, hipStream_t stream) {
    static int grid = 0;
    if (grid == 0) {
        if (n_in != 20 || out_size != (int)OUT_END || ws_size < WS_END) { fprintf(stderr, "kernel_launch: unexpected shapes (n_in %d, out %d, ws %zu)\n", n_in, out_size, ws_size); grid = -1; return; }
        int dev = 0, cus = 0, per_cu = 0;
        hipGetDevice(&dev);
        hipDeviceGetAttribute(&cus, hipDeviceAttributeMultiprocessorCount, dev);
        if (hipFuncSetAttribute((const void*)fwd_megakernel, hipFuncAttributeMaxDynamicSharedMemorySize, LDS_BYTES) != hipSuccess) { fprintf(stderr, "kernel_launch: hipFuncSetAttribute failed\n"); grid = -1; return; }
        hipOccupancyMaxActiveBlocksPerMultiprocessor(&per_cu, (const void*)fwd_megakernel, 512, LDS_BYTES);
        if (per_cu < 1) { fprintf(stderr, "kernel_launch: occupancy query gave %d\n", per_cu); per_cu = 1; }
        grid = cus * 1;
        (void)hipGetLastError();
    }
    if (grid < 0) return;
    Params p{};
    const float** f = (const float**)&p;
    for (int i = 0; i < 20; ++i) f[i] = (const float*)d_in[i];
    p.out = (float*)d_out; p.ws = (unsigned char*)d_ws;
    if (hipMemsetAsync((unsigned char*)d_ws + WS_BAR, 0, 16384 + 8192, stream) != hipSuccess) { fprintf(stderr, "kernel_launch: memset failed\n"); return; }
    void* args[] = {&p};
    hipError_t e = hipLaunchCooperativeKernel((const void*)fwd_megakernel, dim3(grid), dim3(512), args, LDS_BYTES, stream);
    if (e != hipSuccess) fprintf(stderr, "cooperative launch failed: %s (grid %d)\n", hipGetErrorString(e), grid);
}
```

```cpp
#include <hip/hip_runtime.h>
#include <hip/hip_cooperative_groups.h>
#include <cstdio>
namespace cg = cooperative_groups;

#define LAS __attribute__((address_space(3)))
#define DI __device__ __forceinline__
typedef unsigned short bf16_t;
typedef short bf16x8 __attribute__((ext_vector_type(8)));
typedef short s16x4 __attribute__((ext_vector_type(4)));
typedef float f32x4 __attribute__((ext_vector_type(4)));
typedef float f32x2 __attribute__((ext_vector_type(2)));
typedef float f32x16 __attribute__((ext_vector_type(16)));
typedef unsigned u32x4 __attribute__((ext_vector_type(4)));
typedef unsigned u32x2 __attribute__((ext_vector_type(2)));
typedef __bf16 bf16x2_t __attribute__((ext_vector_type(2)));

constexpr int T_TOK = 16896, TP = 16384, DM = 1024, DIN = 5648, NPROJ = 5632, DFF = 2816, NUP = 5632;
constexpr float EPS = 1e-6f;
constexpr size_t OUT_Y = 0, OUT_RSP = 17301504, OUT_RSS = OUT_RSP + 524288, OUT_GSP = OUT_RSS + 8388608, OUT_GSS = OUT_GSP + 262144,
                 OUT_CP = OUT_GSS + 4194304, OUT_CS = OUT_CP + 45056, OUT_END = OUT_CS + 720896;
constexpr size_t WS_WIN = 0, WS_WMIX = WS_WIN + (size_t)NPROJ * DM * 2, WS_WO = WS_WMIX + (size_t)DM * DM * 2, WS_WUP = WS_WO + (size_t)DM * DM * 2,
                 WS_WDN = WS_WUP + (size_t)NUP * DM * 2, WS_PROJ = WS_WDN + (size_t)DM * DFF * 2;
constexpr size_t SEG512 = (size_t)T_TOK * 512 * 2, SEG256 = (size_t)T_TOK * 256 * 2, SEG1024 = (size_t)T_TOK * 1024 * 2;
constexpr size_t PQ_R = WS_PROJ, PK_R = PQ_R + SEG512, PV_R = PK_R + SEG512, PG_R = PV_R + SEG512, PQ_G = PG_R + SEG512, PK_G = PQ_G + SEG256,
                 PV_G = PK_G + SEG256, PG_G = PV_G + SEG512, PM_R = PG_G + SEG512, PM_G = PM_R + SEG1024, WS_PROJ_END = PM_G + SEG1024;
constexpr size_t WS_MIX = PQ_R;
constexpr size_t WS_PART = WS_PROJ + (size_t)T_TOK * DFF * 2;
static_assert(WS_PART + (size_t)88 * 65536 * 4 <= WS_PROJ_END, "partials");
constexpr size_t WS_ACT = WS_PROJ;
constexpr size_t WS_SH = WS_PROJ_END;
constexpr size_t WS_RSTD1 = WS_SH + SEG1024, WS_SSQ2 = WS_RSTD1 + (size_t)T_TOK * 4, WS_EBL = WS_SSQ2 + (size_t)T_TOK * 4,
                 WS_ROPEC = WS_EBL + (size_t)384 * 256 * 4, WS_ROPES = WS_ROPEC + (size_t)2052 * 64 * 4, WS_BAR = WS_ROPES + (size_t)2052 * 64 * 4, WS_CNT = WS_BAR + 16384  ,
                 WS_EXCH = WS_CNT + 8192  , WS_END = WS_EXCH + (size_t)TP * 16;
static_assert(WS_PROJ_END - WS_PROJ == (size_t)T_TOK * NPROJ * 2, "proj layout");
static_assert(WS_END <= (size_t)256 * 1024 * 1024, "workspace");
constexpr int LDS_BYTES = 131072 + 4096 + 16;

struct Params {
    const float *x_prompt, *x_sample, *state_ret, *state_gla, *cache_conv, *ln1, *w_in, *w_gate_up, *b_gate_up, *g_ret, *g_gla, *w_ret_out, *w_gla_out,
        *w_o, *ln2, *w_up, *conv_w, *conv_b, *w_down, *ln_f;
    float* out; unsigned char* ws;
};

DI unsigned pk2(float lo, float hi) { f32x2 v = {lo, hi}; bf16x2_t b = __builtin_convertvector(v, bf16x2_t); return __builtin_bit_cast(unsigned, b); }
DI float bflo(unsigned w) { return __uint_as_float(w << 16); }
DI float bfhi(unsigned w) { return __uint_as_float(w & 0xffff0000u); }
DI float wave_sum(float v) {
#pragma unroll
    for (int o = 1; o < 64; o <<= 1) v += __shfl_xor(v, o);
    return v;
}
DI float sigmoidf_(float x) { return __builtin_amdgcn_rcpf(1.f + __expf(-x)); }
DI const float* x_row(const Params& p, int tok) { return tok < TP ? p.x_prompt + (size_t)tok * DM : p.x_sample + (size_t)(tok - TP) * DM; }
#define LDS_WAIT() asm volatile("s_waitcnt lgkmcnt(0)" ::: "memory")

#define XB_TMO      128
#define XB_XCNT(j)  (256  + 64 * (j))
#define XB_XSUB(j)  (1280 + 64 * (j))
#define XB_XGEN(j)  (2304 + 64 * (j))
#define XB_TOP      3328
#define XB_TOPGEN   3392
#define XCD_BAR_WORDS 3456
#define XB_SPIN_CAP (1u << 22)
DI unsigned xb_ld(unsigned* p) { return __hip_atomic_load(p, __ATOMIC_RELAXED, __HIP_MEMORY_SCOPE_AGENT); }
DI unsigned xb_add(unsigned* p, unsigned v) { return __hip_atomic_fetch_add(p, v, __ATOMIC_RELAXED, __HIP_MEMORY_SCOPE_AGENT); }
DI unsigned xb_xcc_id() { return (unsigned)__builtin_amdgcn_s_getreg((3 << 11) | 20) & 0xFu; }
#define XB_SPIN(cond, bar) do { unsigned _sp = 0; while (cond) { __builtin_amdgcn_s_sleep(1); \
    if ((++_sp & 255u) == 0u) { if (xb_ld(&(bar)[XB_TMO])) break; if (_sp > XB_SPIN_CAP) { atomicAdd(&(bar)[XB_TMO], 1u); break; } } } } while (0)
struct XcdBarrier { unsigned* bar; unsigned x; volatile LAS unsigned* st; };
DI XcdBarrier xcd_barrier_post(unsigned* bar, volatile LAS unsigned* st) {
    XcdBarrier b; b.bar = bar; b.x = xb_xcc_id(); b.st = st;
    if (threadIdx.x == 0) (void)xb_add(&bar[XB_XCNT(b.x)], 1u);
    return b;
}
DI void xcd_barrier_complete(unsigned* bar, unsigned x, unsigned& nloc, unsigned& nx) {
    const unsigned G = gridDim.x * gridDim.y * gridDim.z;
    unsigned sum, cnt, mine, sp = 0u;
    for (;;) {
        sum = 0u; cnt = 0u; mine = 0u;
#pragma unroll
        for (unsigned j = 0; j < 16; ++j) { const unsigned c = xb_ld(&bar[XB_XCNT(j)]); sum += c; cnt += (c > 0u) ? 1u : 0u; mine = (j == x) ? c : mine; }
        if (sum == G) break;
        __builtin_amdgcn_s_sleep(1);
        if ((++sp & 255u) == 0u) { if (xb_ld(&bar[XB_TMO])) break; if (sp > XB_SPIN_CAP) { atomicAdd(&bar[XB_TMO], 1u); break; } }
    }
    nloc = mine > 0u ? mine : 1u; nx = cnt > 0u ? cnt : 1u;
}
DI void xcd_barrier(const XcdBarrier& b) {
    asm volatile("s_waitcnt vmcnt(0)" ::: "memory");
    __syncthreads();
    if (threadIdx.x == 0) {
        unsigned* bar = b.bar;
        __builtin_amdgcn_s_waitcnt(0);
        unsigned nloc = b.st[0], nx = b.st[1];
        if (nloc == 0u) { xcd_barrier_complete(bar, b.x, nloc, nx); b.st[0] = nloc; b.st[1] = nx; }
        const unsigned old = xb_add(&bar[XB_XSUB(b.x)], 1u);
        const unsigned gen = old / nloc;
        if (old + 1u == (gen + 1u) * nloc) {
            __builtin_amdgcn_fence(__ATOMIC_RELEASE, "agent");
            asm volatile("s_waitcnt vmcnt(0)" ::: "memory");
            const unsigned og = xb_add(&bar[XB_TOP], 1u);
            const unsigned tg = og / nx;
            if (og + 1u == (tg + 1u) * nx) xb_add(&bar[XB_TOPGEN], 1u);
            else XB_SPIN(xb_ld(&bar[XB_TOPGEN]) == tg, bar);
            __builtin_amdgcn_fence(__ATOMIC_ACQUIRE, "agent");
            xb_add(&bar[XB_XGEN(b.x)], 1u);
            asm volatile("s_waitcnt vmcnt(0)" ::: "memory");
        } else {
            XB_SPIN(xb_ld(&bar[XB_XGEN(b.x)]) == gen, bar);
            __builtin_amdgcn_fence(__ATOMIC_ACQUIRE, "agent");
            asm volatile("s_waitcnt vmcnt(0)" ::: "memory");
        }
    }
    __syncthreads();
}

namespace pg8 {
constexpr int BM = 256, BK = 64, HALF = 128, HTB = HALF * BK * 2, STAGE_BYTES = 8 * HTB, NXCD = 8, WGM = 8;
DI int lds_byte(int r, int c) { const int st = (r >> 4) * 2 + (c >> 5), rr = r & 15, cc = c & 31, ob = rr * 64 + cc * 2; return st * 1024 + (ob ^ (((ob >> 9) & 1) << 5)); }
DI void stage_rc(int b, int& R, int& C) { const int st = b / 1024, sb = b % 1024, swz = sb ^ (((sb >> 9) & 1) << 5); R = (st >> 1) * 16 + swz / 64; C = (st & 1) * 32 + (swz % 64) / 2; }
DI int perm32(int rho) { const int n = rho >> 4, i = rho & 15; return 8 * (i >> 2) + 4 * n + (i & 3); }
struct Unit { int pm, pn, kt0, id; };
struct Gemm { const bf16_t* A; const bf16_t* Bt; int M, N, K, lda, ldb, mstep; };
struct StaticOrder {
    int nM, nN, nwg, G, c;
    DI void init(int M, int N, int G_, int c_) { nM = M / BM; nN = N / BM; nwg = nM * nN; G = G_; c = c_; }
    DI void init_tiles(int nM_, int nN_, int G_, int c_) { nM = nM_; nN = nN_; nwg = nM * nN; G = G_; c = c_; }
    DI bool next(int i, Unit& u) const {
        u.kt0 = 0; u.id = 0; u.pm = 0; u.pn = 0;
        const long L = (long)i * G + c; if (L >= nwg) return false;
        int wgid = (int)L; { const int q = nwg / NXCD, r = nwg % NXCD, xcd = wgid % NXCD, off = wgid / NXCD; wgid = (xcd < r ? xcd * (q + 1) : r * (q + 1) + (xcd - r) * q) + off; }
        const int nig = WGM * nN, gid = wgid / nig, fm = gid * WGM, gsz = (nM - fm) < WGM ? (nM - fm) : WGM;
        u.pm = fm + ((wgid % nig) % gsz); u.pn = (wgid % nig) / gsz; return true;
    }
};
struct PieceOrder {
    int G, c;
    DI bool next(int i, Unit& u) const {
        const int pid = c + i * G; const int su = pid / 11;
        u.pm = 64 + (su >> 2); u.pn = su & 3; u.kt0 = (pid - su * 11) * 4; u.id = pid;
        return pid < 88;
    }
};
template <class Epi, class Sched, int NT>
DI void gemm_phase(LAS unsigned char* lds, const Gemm g, const Sched& S, const Epi& E) {
    int tid = threadIdx.x; asm volatile("" : "+v"(tid));
    const int wid = __builtin_amdgcn_readfirstlane(tid >> 6), lane = tid & 63, wr = wid >> 2, wc = wid & 3, fr = lane & 15, fq = lane >> 4;
    constexpr int nt = NT;
    unsigned voffA[2], voffB[2];
#pragma unroll
    for (int i = 0; i < 2; ++i) { int R, C; stage_rc(tid * 16 + i * 8192, R, C); const int Rb = Epi::PERM ? ((R & ~31) + perm32(R & 31)) : R;
        voffA[i] = (unsigned)(R * g.lda + C) * 2u; voffB[i] = (unsigned)(Rb * g.ldb + C) * 2u; }
    const size_t kstep = (size_t)(BK * 2);
    const size_t hstepA = (size_t)HALF * g.lda * 2, hstepB = (size_t)HALF * g.ldb * 2;
    const size_t tstepA = (size_t)g.mstep * g.lda * 2, tstepB = 2 * hstepB;
    const unsigned ldsw = (unsigned)wid * 1024u;
    const int aoff = lds_byte(wr * 64 + fr, fq * 8), boff = lds_byte(wc * 32 + fr, fq * 8);
#define PG8_SA(b, h) (((b) * 2 + (h)) * HTB)
#define PG8_SB(b, h) ((4 + (b) * 2 + (h)) * HTB)
#define PG8_STAGE(bufoff, gbase, voff) do { _Pragma("unroll") for (int _i = 0; _i < 2; ++_i) \
        __builtin_amdgcn_global_load_lds((const unsigned*)((const char*)(gbase) + (voff)[_i]), (LAS unsigned*)(lds + (bufoff) + ldsw + _i * 8192), 16, 0, 0); } while (0)
#define PG8_LDA(dst, b, h) do { _Pragma("unroll") for (int m = 0; m < 4; ++m) _Pragma("unroll") for (int k = 0; k < 2; ++k) dst[m][k] = *(const LAS bf16x8*)(lds + PG8_SA(b, h) + aoff + m * 2048 + k * 1024); } while (0)
#define PG8_LDB(dst, b, h) do { _Pragma("unroll") for (int n = 0; n < 2; ++n) _Pragma("unroll") for (int k = 0; k < 2; ++k) dst[n][k] = *(const LAS bf16x8*)(lds + PG8_SB(b, h) + boff + n * 2048 + k * 1024); } while (0)
#define PG8_MMA(ai, bj, At, Bt) do { __builtin_amdgcn_s_setprio(1); _Pragma("unroll") for (int m = 0; m < 4; ++m) _Pragma("unroll") for (int n = 0; n < 2; ++n) _Pragma("unroll") for (int k = 0; k < 2; ++k) \
        acc[ai][bj][m][n] = __builtin_amdgcn_mfma_f32_16x16x32_bf16(Bt[n][k], At[m][k], acc[ai][bj][m][n], 0, 0, 0); __builtin_amdgcn_s_setprio(0); } while (0)
#define PG8_WAIT_V(n) asm volatile("s_waitcnt vmcnt(" #n ")" ::: "memory")
#define PG8_WAIT_L(n) asm volatile("s_waitcnt lgkmcnt(" #n ")" ::: "memory")
#define PG8_BAR __builtin_amdgcn_s_barrier()
#define PG8_SCHED __builtin_amdgcn_sched_barrier(0)
    Unit cur, nxt; int ui = 0;
    if (!S.next(0, cur)) return;
    f32x4 acc[2][2][4][2];
#pragma unroll
    for (int a = 0; a < 2; ++a)
#pragma unroll
        for (int b = 0; b < 2; ++b)
#pragma unroll
            for (int m = 0; m < 4; ++m)
#pragma unroll
                for (int n = 0; n < 2; ++n) acc[a][b][m][n] = (f32x4){0.f, 0.f, 0.f, 0.f};
    bf16x8 At[4][2], B0[2][2], B1[2][2];
    const char* cA = (const char*)g.A + (size_t)cur.pm * tstepA + (size_t)cur.kt0 * kstep; const char* cB = (const char*)g.Bt + (size_t)cur.pn * tstepB + (size_t)cur.kt0 * kstep;
    PG8_STAGE(PG8_SB(0, 0), cB, voffB); PG8_STAGE(PG8_SA(0, 0), cA, voffA); PG8_STAGE(PG8_SB(0, 1), cB + hstepB, voffB); PG8_STAGE(PG8_SA(0, 1), cA + hstepA, voffA);
    if (wr == 1) PG8_BAR;
    PG8_WAIT_V(4); PG8_BAR;
    PG8_STAGE(PG8_SB(1, 0), cB + kstep, voffB); PG8_STAGE(PG8_SA(1, 0), cA + kstep, voffA); PG8_STAGE(PG8_SB(1, 1), cB + hstepB + kstep, voffB);
    PG8_WAIT_V(6); PG8_BAR;
    for (;;) {
        const bool has_next = S.next(ui + 1, nxt);
        const char* nA = has_next ? (const char*)g.A + (size_t)nxt.pm * tstepA + (size_t)nxt.kt0 * kstep : cA; const char* nB = has_next ? (const char*)g.Bt + (size_t)nxt.pn * tstepB + (size_t)nxt.kt0 * kstep : cB;
        for (int t = 0; t < nt; t += 2) {
            const bool last = (t == nt - 2);
            const char* a1 = cA + (size_t)(t + 1) * kstep;
            const char* a2 = last ? nA : cA + (size_t)(t + 2) * kstep; const char* b2 = last ? nB : cB + (size_t)(t + 2) * kstep;
            const char* a3 = a2 + kstep; const char* b3 = b2 + kstep;
            if constexpr (Epi::MIDK) { if (t == (nt >> 1)) E.mid(acc, cur, wr, wc, fr, fq); }
            PG8_LDB(B0, 0, 0); PG8_SCHED; PG8_LDA(At, 0, 0); PG8_STAGE(PG8_SA(1, 1), a1 + hstepA, voffA);
            PG8_WAIT_L(8); PG8_BAR; PG8_WAIT_L(0); PG8_MMA(0, 0, At, B0); PG8_BAR; PG8_SCHED;
            PG8_LDB(B1, 0, 1); PG8_STAGE(PG8_SB(0, 0), b2, voffB);
            PG8_BAR; PG8_WAIT_L(0); PG8_MMA(0, 1, At, B1); PG8_BAR;
            PG8_LDA(At, 0, 1); PG8_STAGE(PG8_SA(0, 0), a2, voffA);
            PG8_BAR; PG8_WAIT_L(0); PG8_MMA(1, 0, At, B0); PG8_BAR; PG8_SCHED;
            PG8_STAGE(PG8_SB(0, 1), b2 + hstepB, voffB);
            PG8_WAIT_V(6); PG8_BAR; PG8_MMA(1, 1, At, B1); PG8_BAR;
            PG8_LDB(B0, 1, 0); PG8_SCHED; PG8_LDA(At, 1, 0); PG8_STAGE(PG8_SA(0, 1), a2 + hstepA, voffA);
            PG8_WAIT_L(8); PG8_BAR; PG8_WAIT_L(0); PG8_MMA(0, 0, At, B0); PG8_BAR; PG8_SCHED;
            PG8_LDB(B1, 1, 1); PG8_STAGE(PG8_SB(1, 0), b3, voffB);
            PG8_BAR; PG8_WAIT_L(0); PG8_MMA(0, 1, At, B1); PG8_BAR;
            PG8_LDA(At, 1, 1); PG8_STAGE(PG8_SA(1, 0), a3, voffA);
            PG8_BAR; PG8_WAIT_L(0); PG8_MMA(1, 0, At, B0); PG8_BAR; PG8_SCHED;
            PG8_STAGE(PG8_SB(1, 1), b3 + hstepB, voffB);
            PG8_WAIT_V(6); PG8_BAR; PG8_MMA(1, 1, At, B1); PG8_BAR;
        }
        E(acc, cur, wr, wc, fr, fq);
        if (!has_next) break;
#pragma unroll
        for (int a = 0; a < 2; ++a)
#pragma unroll
            for (int b = 0; b < 2; ++b)
#pragma unroll
                for (int m = 0; m < 4; ++m)
#pragma unroll
                    for (int n = 0; n < 2; ++n) acc[a][b][m][n] = (f32x4){0.f, 0.f, 0.f, 0.f};
        cur = nxt; cA = nA; cB = nB; ++ui;
    }
    PG8_WAIT_V(0);
    if (wr == 0) PG8_BAR;
    PG8_BAR;
#undef PG8_SA
#undef PG8_SB
#undef PG8_STAGE
#undef PG8_LDA
#undef PG8_LDB
#undef PG8_MMA
#undef PG8_WAIT_V
#undef PG8_WAIT_L
#undef PG8_BAR
#undef PG8_SCHED
}
}
using pg8::Unit;
typedef f32x4 AccT[2][2][4][2];

struct EpiProj {
    static constexpr bool PERM = true, MIDK = false;
    unsigned char* ws; const float* rstd1; const float* bcum; const float* ropec; const float* ropes;
    DI void mid(AccT&, const Unit&, int, int, int, int) const {}
    DI void operator()(const AccT& acc, const Unit& u, int wr, int wc, int fr, int fq) const {
        const int pn = u.pn; int seg, pn0;
        if (pn < 8) { seg = pn >> 1; pn0 = seg * 2; } else if (pn == 8) { seg = 4; pn0 = 8; } else if (pn == 9) { seg = 5; pn0 = 9; }
        else if (pn < 12) { seg = 6; pn0 = 10; } else if (pn < 14) { seg = 7; pn0 = 12; } else if (pn < 18) { seg = 8; pn0 = 14; } else { seg = 9; pn0 = 18; }
        size_t segoff; int ld;
        switch (seg) { case 0: segoff = PQ_R; ld = 512; break; case 1: segoff = PK_R; ld = 512; break; case 2: segoff = PV_R; ld = 512; break; case 3: segoff = PG_R; ld = 512; break;
            case 4: segoff = PQ_G; ld = 256; break; case 5: segoff = PK_G; ld = 256; break; case 6: segoff = PV_G; ld = 512; break; case 7: segoff = PG_G; ld = 512; break;
            case 8: segoff = PM_R; ld = 1024; break; default: segoff = PM_G; ld = 1024; break; }
        bf16_t* base = (bf16_t*)(ws + segoff);
        const int lc0 = (pn - pn0) * 256 + wc * 32 + 8 * fq;
        const int row0 = u.pm * 256 + wr * 64 + fr;
        if (seg <= 1) {
            const int i0 = 16 * wc + 4 * fq;
            float lg2h[2];
#pragma unroll
            for (int bj = 0; bj < 2; ++bj) lg2h[bj] = log2f(1.f - exp2f(-5.f - (float)((pn - pn0) * 2 + bj)));
#pragma unroll
            for (int ai = 0; ai < 2; ++ai)
#pragma unroll
                for (int m = 0; m < 4; ++m) {
                    const int row = row0 + ai * 128 + m * 16; const float rs = rstd1[row];
                    int posidx, ic; if (row < TP) { posidx = row & 2047; ic = row & 63; } else { const int s = row - TP; posidx = 2048 + (s & 3); ic = s & 3; }
                    const f32x4 c4 = *(const f32x4*)(ropec + posidx * 64 + i0), s4 = *(const f32x4*)(ropes + posidx * 64 + i0);
#pragma unroll
                    for (int bj = 0; bj < 2; ++bj) {
                        const int head = (pn - pn0) * 2 + bj;
                        const float lg2 = lg2h[bj];
                        const float dec = (seg == 0) ? __builtin_amdgcn_exp2f((float)(ic + 1) * lg2) : __builtin_amdgcn_exp2f(-(float)(ic + 1) * lg2) * 0.08838834764831845f;
                        const f32x4 t1 = acc[ai][bj][m][0] * rs, t2 = acc[ai][bj][m][1] * rs;
                        const f32x4 o1 = (t1 * c4 - t2 * s4) * dec, o2 = (t1 * s4 + t2 * c4) * dec;
                        bf16_t* rp = base + (size_t)row * 512 + head * 128 + i0;
                        u32x2 w1, w2; w1.x = pk2(o1[0], o1[1]); w1.y = pk2(o1[2], o1[3]); w2.x = pk2(o2[0], o2[1]); w2.y = pk2(o2[2], o2[3]);
                        *(u32x2*)rp = w1; *(u32x2*)(rp + 64) = w2;
                    }
                }
            return;
        }
#pragma unroll
        for (int ai = 0; ai < 2; ++ai)
#pragma unroll
            for (int m = 0; m < 4; ++m) {
                const int row = row0 + ai * 128 + m * 16; const float rs = rstd1[row];
#pragma unroll
                for (int bj = 0; bj < 2; ++bj) {
                    const int lc = lc0 + bj * 128;
                    f32x4 v0 = acc[ai][bj][m][0] * rs, v1 = acc[ai][bj][m][1] * rs;
                    if (seg == 4 || seg == 5) {
                        const f32x4 b0 = *(const f32x4*)(bcum + (size_t)row * 256 + lc), b1 = *(const f32x4*)(bcum + (size_t)row * 256 + lc + 4);
                        if (seg == 4) {
#pragma unroll
                            for (int e = 0; e < 4; ++e) { v0[e] *= 0.125f * __expf(b0[e]); v1[e] *= 0.125f * __expf(b1[e]); }
                        } else {
#pragma unroll
                            for (int e = 0; e < 4; ++e) { v0[e] *= __expf(-b0[e]); v1[e] *= __expf(-b1[e]); }
                        }
                    } else if (seg == 3 || seg == 7) {
#pragma unroll
                        for (int e = 0; e < 4; ++e) { v0[e] = v0[e] * sigmoidf_(v0[e]); v1[e] = v1[e] * sigmoidf_(v1[e]); }
                    } else if (seg >= 8) {
#pragma unroll
                        for (int e = 0; e < 4; ++e) { v0[e] = sigmoidf_(v0[e]); v1[e] = sigmoidf_(v1[e]); }
                    }
                    u32x4 w; w.x = pk2(v0[0], v0[1]); w.y = pk2(v0[2], v0[3]); w.z = pk2(v1[0], v1[1]); w.w = pk2(v1[2], v1[3]);
                    __builtin_nontemporal_store(w, (u32x4*)(base + (size_t)row * ld + lc));
                }
            }
    }
};
struct EpiMix {
    static constexpr bool PERM = true, MIDK = true;
    const bf16_t* mr; const bf16_t* mg; bf16_t* mix;
    DI void mid(AccT& acc, const Unit& u, int wr, int wc, int fr, int fq) const {
        int row0 = u.pm * 256 + wr * 64 + fr, c0 = u.pn * 256 + wc * 32 + 8 * fq;
        asm volatile("" : "+v"(row0), "+v"(c0));
#pragma unroll
        for (int ai = 0; ai < 2; ++ai)
#pragma unroll
            for (int m = 0; m < 4; ++m) {
                const int row = row0 + ai * 128 + m * 16;
#pragma unroll
                for (int bj = 0; bj < 2; ++bj) {
                    const u32x4 a = *(const u32x4*)(mr + (size_t)row * 1024 + c0 + bj * 128), b = *(const u32x4*)(mg + (size_t)row * 1024 + c0 + bj * 128);
                    f32x4 r0, r1;
                    r0[0] = bflo(a.x) * __builtin_amdgcn_rcpf(fmaxf(bflo(b.x), 1e-30f)); r0[1] = bfhi(a.x) * __builtin_amdgcn_rcpf(fmaxf(bfhi(b.x), 1e-30f)); r0[2] = bflo(a.y) * __builtin_amdgcn_rcpf(fmaxf(bflo(b.y), 1e-30f)); r0[3] = bfhi(a.y) * __builtin_amdgcn_rcpf(fmaxf(bfhi(b.y), 1e-30f));
                    r1[0] = bflo(a.z) * __builtin_amdgcn_rcpf(fmaxf(bflo(b.z), 1e-30f)); r1[1] = bfhi(a.z) * __builtin_amdgcn_rcpf(fmaxf(bfhi(b.z), 1e-30f)); r1[2] = bflo(a.w) * __builtin_amdgcn_rcpf(fmaxf(bflo(b.w), 1e-30f)); r1[3] = bfhi(a.w) * __builtin_amdgcn_rcpf(fmaxf(bfhi(b.w), 1e-30f));
                    acc[ai][bj][m][0] *= r0; acc[ai][bj][m][1] *= r1;
                }
                __builtin_amdgcn_sched_barrier(0);
            }
    }
    DI void operator()(const AccT& acc, const Unit& u, int wr, int wc, int fr, int fq) const {
        const int row0 = u.pm * 256 + wr * 64 + fr, c0 = u.pn * 256 + wc * 32 + 8 * fq;
#pragma unroll
        for (int ai = 0; ai < 2; ++ai)
#pragma unroll
            for (int m = 0; m < 4; ++m) {
                const int row = row0 + ai * 128 + m * 16;
#pragma unroll
                for (int bj = 0; bj < 2; ++bj) {
                    const u32x4 b = *(const u32x4*)(mg + (size_t)row * 1024 + c0 + bj * 128);
                    const f32x4 v0 = acc[ai][bj][m][0], v1 = acc[ai][bj][m][1];
                    u32x4 w; w.x = pk2(v0[0] * bflo(b.x), v0[1] * bfhi(b.x)); w.y = pk2(v0[2] * bflo(b.y), v0[3] * bfhi(b.y));
                    w.z = pk2(v1[0] * bflo(b.z), v1[1] * bfhi(b.z)); w.w = pk2(v1[2] * bflo(b.w), v1[3] * bfhi(b.w));
                    *(u32x4*)(mix + (size_t)row * 1024 + c0 + bj * 128) = w;
                }
            }
    }
};
struct EpiH {
    static constexpr bool PERM = true, MIDK = false;
    const float* xp; const float* xs; float* h; bf16_t* hb; float* ssq;
    DI void mid(AccT&, const Unit&, int, int, int, int) const {}
    DI void operator()(const AccT& acc, const Unit& u, int wr, int wc, int fr, int fq) const {
        const int row0 = u.pm * 256 + wr * 64 + fr, c0 = u.pn * 256 + wc * 32 + 8 * fq;
#pragma unroll
        for (int ai = 0; ai < 2; ++ai)
#pragma unroll
            for (int m = 0; m < 4; ++m) {
                const int row = row0 + ai * 128 + m * 16;
                const float* xr = row < TP ? xp + (size_t)row * DM : xs + (size_t)(row - TP) * DM;
                float ss = 0.f;
#pragma unroll
                for (int bj = 0; bj < 2; ++bj) {
                    const int c = c0 + bj * 128;
                    const f32x4 v0 = acc[ai][bj][m][0] + *(const f32x4*)(xr + c), v1 = acc[ai][bj][m][1] + *(const f32x4*)(xr + c + 4);
                    u32x4 w; w.x = pk2(v0[0], v0[1]); w.y = pk2(v0[2], v0[3]); w.z = pk2(v1[0], v1[1]); w.w = pk2(v1[2], v1[3]);
                    *(u32x4*)(hb + (size_t)row * DM + c) = w;
                    ss += v0[0] * v0[0] + v0[1] * v0[1] + v0[2] * v0[2] + v0[3] * v0[3] + v1[0] * v1[0] + v1[1] * v1[1] + v1[2] * v1[2] + v1[3] * v1[3];
                }
                ss += __shfl_xor(ss, 16); ss += __shfl_xor(ss, 32);
                if (fq == 0) unsafeAtomicAdd(ssq + row, ss);
            }
    }
};
DI f32x2 gelu_pk(f32x2 v) {
    const f32x2 av = __builtin_elementwise_abs(v), d = av * 0.2316418882f + 1.0f;
    f32x2 t; t.x = __builtin_amdgcn_rcpf(d.x); t.y = __builtin_amdgcn_rcpf(d.y);
    f32x2 q = t * 0.5307027145f + (-0.7265760135f); q = q * t + 0.7107068705f; q = q * t + (-0.142248368f); q = q * t + 0.127414796f; q = q * t;
    const f32x2 s = (v * v) * (-0.72134752044f);
    f32x2 e; e.x = __builtin_amdgcn_exp2f(s.x); e.y = __builtin_amdgcn_exp2f(s.y);
    const f32x2 m = v * (q * e), r = v - m;
    f32x2 o; o.x = v.x < 0.f ? m.x : r.x; o.y = v.y < 0.f ? m.y : r.y; return o;
}
#define DPPF(old_, src_, ctrl_) __int_as_float(__builtin_amdgcn_update_dpp(__float_as_int(old_), __float_as_int(src_), (ctrl_), 0xf, 0xf, false))
struct EpiUpConv {
    static constexpr bool PERM = true, MIDK = false;
    const float* ssq; bf16_t* act; const float* cw; const float* cb; const float* cache; float* out; LAS float* xch;
    DI void mid(AccT&, const Unit&, int, int, int, int) const {}
    DI void operator()(const AccT& acc, const Unit& u, int wr, int wc, int fr, int fq) const {
        const int tokbase = u.pm * 254 - 2, cl = wc * 32 + 8 * fq, f0 = u.pn * 128 + cl;
        float sq[2][4];
#pragma unroll
        for (int ai = 0; ai < 2; ++ai)
#pragma unroll
            for (int m = 0; m < 4; ++m) { const int tok = tokbase + ai * 128 + wr * 64 + m * 16 + fr; sq[ai][m] = (tok >= 0 && tok < T_TOK) ? ssq[tok] : -1.f; }
        f32x4 cb4[2], w04[2], w14[2], w24[2];
#pragma unroll
        for (int n = 0; n < 2; ++n) { cb4[n] = *(const f32x4*)(cb + f0 + 4 * n); w04[n] = *(const f32x4*)(cw + f0 + 4 * n); w14[n] = *(const f32x4*)(cw + DFF + f0 + 4 * n); w24[n] = *(const f32x4*)(cw + 2 * DFF + f0 + 4 * n); }
        float rs[2][4];
#pragma unroll
        for (int ai = 0; ai < 2; ++ai)
#pragma unroll
            for (int m = 0; m < 4; ++m) rs[ai][m] = sq[ai][m] >= 0.f ? rsqrtf(sq[ai][m] * (1.f / DM) + EPS) : 0.f;
        if (fr >= 14) {
#pragma unroll
            for (int ai = 0; ai < 2; ++ai) { LAS float* xp = xch + ((2 * ai + wr) * 2 + (fr - 14)) * 128 + cl;
                *(LAS f32x4*)xp = acc[ai][0][3][0] * rs[ai][3]; *(LAS f32x4*)(xp + 4) = acc[ai][0][3][1] * rs[ai][3]; }
        }
        asm volatile("s_waitcnt lgkmcnt(0)" ::: "memory"); __builtin_amdgcn_s_barrier(); if (wr == 0) __builtin_amdgcn_s_barrier(); asm volatile("" ::: "memory");
        const bool samp_tile = (tokbase + 255 >= TP);
#pragma unroll
        for (int ai = 0; ai < 2; ++ai) {
            const int g = 2 * ai + wr;
            f32x4 prev[2];
#pragma unroll
            for (int m = 0; m < 4; ++m) {
                const int i = ai * 128 + wr * 64 + m * 16 + fr, tok = tokbase + i;
                int l; const bool samp = tok >= TP;
                if (!samp) l = tok & 2047; else l = (tok - TP) & 3;
                u32x4 w; f32x4 curs[2];
#pragma unroll
                for (int n = 0; n < 2; ++n) {
                    const f32x4 cur = acc[ai][0][m][n] * rs[ai][m], vv = acc[ai][1][m][n] * rs[ai][m];
                    f32x4 x1, x2;
                    if (m == 0) {
                        f32x4 h1 = {0.f, 0.f, 0.f, 0.f}, h2 = {0.f, 0.f, 0.f, 0.f};
                        if (g >= 1) { h1 = *(const LAS f32x4*)(xch + ((g - 1) * 2 + 1) * 128 + cl + 4 * n); h2 = *(const LAS f32x4*)(xch + ((g - 1) * 2 + (fr == 0 ? 0 : 1)) * 128 + cl + 4 * n); }
#pragma unroll
                        for (int e = 0; e < 4; ++e) { x1[e] = DPPF(h1[e], cur[e], 0x111); x2[e] = DPPF(h2[e], cur[e], 0x112); }
                    } else {
#pragma unroll
                        for (int e = 0; e < 4; ++e) { const float o1 = DPPF(0.f, prev[n][e], 0x121), o2 = DPPF(0.f, prev[n][e], 0x122);
                            x1[e] = DPPF(o1, cur[e], 0x111); x2[e] = DPPF(o2, cur[e], 0x112); }
                    }
                    prev[n] = cur; curs[n] = cur;
                    if (l < 2) {
                        if (samp_tile && samp) {
                            const int bidx = (tok - TP) >> 2;
                            if (tok < T_TOK) { const f32x4 c1 = *(const f32x4*)(cache + ((size_t)bidx * 2 + 1) * DFF + f0 + 4 * n), c0 = *(const f32x4*)(cache + ((size_t)bidx * 2 + l) * DFF + f0 + 4 * n);
                                x2 = c0; if (l == 0) x1 = c1; }
                        } else { x2 = (f32x4){0.f, 0.f, 0.f, 0.f}; if (l == 0) x1 = x2; }
                    }
                    const f32x4 uc = cb4[n] + w04[n] * x2 + w14[n] * x1 + w24[n] * cur;
                    const f32x2 ga = gelu_pk((f32x2){uc[0], uc[1]}), gb = gelu_pk((f32x2){uc[2], uc[3]});
                    const unsigned p0 = pk2(ga.x * vv[0], ga.y * vv[1]), p1 = pk2(gb.x * vv[2], gb.y * vv[3]);
                    if (n == 0) { w.x = p0; w.y = p1; } else { w.z = p0; w.w = p1; }
                }
                if (i >= 2 && tok < T_TOK) {
                    *(u32x4*)(act + (size_t)tok * DFF + f0) = w;
                    if (!samp) { if (l >= 2046) { float* o = out + OUT_CP + ((size_t)(tok >> 11) * 2 + (l - 2046)) * DFF + f0; *(f32x4*)o = curs[0]; *(f32x4*)(o + 4) = curs[1]; } }
                    else if (l >= 2) { float* o = out + OUT_CS + ((size_t)((tok - TP) >> 2) * 2 + (l - 2)) * DFF + f0; *(f32x4*)o = curs[0]; *(f32x4*)(o + 4) = curs[1]; }
                }
            }
        }
        if (wr == 1) { asm volatile("" ::: "memory"); __builtin_amdgcn_s_barrier(); }
    }
};

struct EpiDownNorm {
    static constexpr bool PERM = true, MIDK = false;
    const bf16_t* hb; float* y; const float* lnf; float* exch; unsigned* cnt; LAS float* xl;
    DI void mid(AccT&, const Unit&, int, int, int, int) const {}
    DI void operator()(const AccT& acc_, const Unit& u, int wr, int wc, int fr, int fq) const {
        AccT& acc = const_cast<AccT&>(acc_);
        const int lrow0 = wr * 64 + fr; int row0 = u.pm * 256 + lrow0, c0 = u.pn * 256 + wc * 32 + 8 * fq;
        asm volatile("" : "+v"(row0), "+v"(c0));
#pragma unroll
        for (int ai = 0; ai < 2; ++ai)
#pragma unroll
            for (int m = 0; m < 4; ++m) {
                const int row = row0 + ai * 128 + m * 16;
                float ss = 0.f;
#pragma unroll
                for (int bj = 0; bj < 2; ++bj) {
                    const u32x4 hv = *(const u32x4*)(hb + (size_t)row * DM + c0 + bj * 128);
                    f32x4 v0 = acc[ai][bj][m][0], v1 = acc[ai][bj][m][1];
                    v0[0] += bflo(hv.x); v0[1] += bfhi(hv.x); v0[2] += bflo(hv.y); v0[3] += bfhi(hv.y); v1[0] += bflo(hv.z); v1[1] += bfhi(hv.z); v1[2] += bflo(hv.w); v1[3] += bfhi(hv.w);
                    acc[ai][bj][m][0] = v0; acc[ai][bj][m][1] = v1;
                    ss += v0[0] * v0[0] + v0[1] * v0[1] + v0[2] * v0[2] + v0[3] * v0[3] + v1[0] * v1[0] + v1[1] * v1[1] + v1[2] * v1[2] + v1[3] * v1[3];
                }
                ss += __shfl_xor(ss, 16); ss += __shfl_xor(ss, 32);
                if (fq == 0) xl[(lrow0 + ai * 128 + m * 16) * 4 + wc] = ss;
            }
        unsigned* pc = cnt + u.pm * 32;
#define G5_PUBLISH() do { if (wc == 0) { \
            if (fq == 0) { \
                _Pragma("unroll") for (int ai = 0; ai < 2; ++ai) _Pragma("unroll") for (int m = 0; m < 4; ++m) { const int lr = lrow0 + ai * 128 + m * 16; const f32x4 q = *(const LAS f32x4*)(xl + lr * 4); \
                    __hip_atomic_store(exch + (size_t)(u.pm * 256 + lr) * 4 + u.pn, (q[0] + q[1]) + (q[2] + q[3]), __ATOMIC_RELAXED, __HIP_MEMORY_SCOPE_AGENT); } } \
            asm volatile("s_waitcnt vmcnt(0)" ::: "memory"); \
            __builtin_amdgcn_fence(__ATOMIC_RELEASE, "agent"); \
            asm volatile("s_waitcnt vmcnt(0)" ::: "memory"); \
            if (fr == 0 && fq == 0) __hip_atomic_fetch_add(pc, 1u, __ATOMIC_RELAXED, __HIP_MEMORY_SCOPE_AGENT); } } while (0)
        asm volatile("s_waitcnt lgkmcnt(0)" ::: "memory"); __builtin_amdgcn_s_barrier(); asm volatile("" ::: "memory");
        if (wr == 1) G5_PUBLISH();
        if (wr == 0) { asm volatile("s_waitcnt lgkmcnt(0)" ::: "memory"); __builtin_amdgcn_s_barrier(); asm volatile("" ::: "memory"); G5_PUBLISH(); }
#undef G5_PUBLISH
        {
            unsigned spins = 0;
            while (__hip_atomic_load(pc, __ATOMIC_RELAXED, __HIP_MEMORY_SCOPE_AGENT) < 8u && ++spins < (1u << 18)) __builtin_amdgcn_s_sleep(16);
            __builtin_amdgcn_fence(__ATOMIC_ACQUIRE, "agent"); }
        asm volatile("" : "+v"(row0), "+v"(c0));
#pragma unroll
        for (int ai = 0; ai < 2; ++ai)
#pragma unroll
            for (int m = 0; m < 4; ++m) {
                const int row = row0 + ai * 128 + m * 16;
                f32x4 q;
                q[0] = __hip_atomic_load(exch + (size_t)row * 4 + 0, __ATOMIC_RELAXED, __HIP_MEMORY_SCOPE_AGENT); q[1] = __hip_atomic_load(exch + (size_t)row * 4 + 1, __ATOMIC_RELAXED, __HIP_MEMORY_SCOPE_AGENT);
                q[2] = __hip_atomic_load(exch + (size_t)row * 4 + 2, __ATOMIC_RELAXED, __HIP_MEMORY_SCOPE_AGENT); q[3] = __hip_atomic_load(exch + (size_t)row * 4 + 3, __ATOMIC_RELAXED, __HIP_MEMORY_SCOPE_AGENT);
                const float rs = rsqrtf(((q[0] + q[1]) + (q[2] + q[3])) * (1.f / DM) + EPS);
#pragma unroll
                for (int bj = 0; bj < 2; ++bj) {
                    const int c = c0 + bj * 128;
                    const f32x4 g0 = *(const f32x4*)(lnf + c), g1 = *(const f32x4*)(lnf + c + 4);
                    *(f32x4*)(y + (size_t)row * DM + c) = acc[ai][bj][m][0] * rs * g0; *(f32x4*)(y + (size_t)row * DM + c + 4) = acc[ai][bj][m][1] * rs * g1;
                }
            }
        if (wr == 1) { asm volatile("" ::: "memory"); __builtin_amdgcn_s_barrier(); }
    }
};
struct EpiPart {
    static constexpr bool PERM = true, MIDK = false;
    bf16_t* part;
    DI void mid(AccT&, const Unit&, int, int, int, int) const {}
    DI void operator()(const AccT& acc, const Unit& u, int wr, int wc, int fr, int fq) const {
        bf16_t* base = part + (size_t)u.id * 65536 + (wr * 64 + fr) * 256 + wc * 32 + 8 * fq;
#pragma unroll
        for (int ai = 0; ai < 2; ++ai)
#pragma unroll
            for (int m = 0; m < 4; ++m)
#pragma unroll
                for (int bj = 0; bj < 2; ++bj) { const f32x4 v0 = acc[ai][bj][m][0], v1 = acc[ai][bj][m][1];
                    u32x4 w; w.x = pk2(v0[0], v0[1]); w.y = pk2(v0[2], v0[3]); w.z = pk2(v1[0], v1[1]); w.w = pk2(v1[2], v1[3]);
                    *(u32x4*)(base + (ai * 128 + m * 16) * 256 + bj * 128) = w; }
    }
};

DI void transpose_item(const float* __restrict__ src, int ldsrc, int srccol, int k0, const float* __restrict__ scale, bf16_t* dst, int lddst, int n0dst, int k0dst,
                       LAS float* scr, int lane) {
    float tv[32];
#pragma unroll
    for (int i = 0; i < 32; ++i) { const int kk = 2 * i + (lane >> 5); tv[i] = src[(size_t)(k0 + kk) * ldsrc + srccol]; }
    if (scale) {
#pragma unroll
        for (int i = 0; i < 32; ++i) tv[i] *= scale[k0 + 2 * i + (lane >> 5)];
    }
#pragma unroll
    for (int i = 0; i < 32; ++i) scr[(2 * i + (lane >> 5)) * 33 + (lane & 31)] = tv[i];
    LDS_WAIT();
    const int c = lane & 7;
#pragma unroll
    for (int j = 0; j < 4; ++j) { const int n = (lane >> 3) + 8 * j; const LAS float* s = scr + (8 * c) * 33 + n;
        u32x4 o; o.x = pk2(s[0 * 33], s[1 * 33]); o.y = pk2(s[2 * 33], s[3 * 33]); o.z = pk2(s[4 * 33], s[5 * 33]); o.w = pk2(s[6 * 33], s[7 * 33]);
        *(u32x4*)(dst + (size_t)(n0dst + n) * lddst + k0dst + 8 * c) = o; }
    LDS_WAIT();
}
DI float log_sigmoid(float z) { return fminf(z, 0.f) - __logf(1.f + __expf(-fabsf(z))); }


template <int RG> DI void xpass_unit(const Params& p, LAS unsigned char* lds, const int tok0, const int tid_, bf16_t* xb, float* rstd1, float* bcum, float* ebl) {
    constexpr int KS = 8 / RG, TU = 16 * RG, NKS = 32 / KS, HT = TU / 2;
    int tid = tid_; asm volatile("" : "+v"(tid));
    const int lane = tid & 63, wave = tid >> 6;
    LAS bf16_t* wga = (LAS bf16_t*)lds;
    LAS float* gas = (LAS float*)(lds + 33024);
    LAS float* accp = (LAS float*)(lds + 41216);
    LAS float* ssp = accp + 2048;
    LAS float* tot = ssp + 128;
    const int r16 = lane & 15, kq = lane >> 4, rg = wave % RG, kh = wave / RG, row = tok0 + rg * 16 + r16;
    const float* xr = x_row(p, row) + kh * (32 * NKS);
    bf16_t* xbr = xb + (size_t)row * DM + kh * (32 * NKS);
    const LAS bf16_t* wgr = wga + r16 * 1032 + kh * (32 * NKS);
    f32x4 acc = {0.f, 0.f, 0.f, 0.f}; float ss = 0.f;
    constexpr int BQ = NKS < 8 ? NKS : 8;
    for (int ks = 0; ks < NKS; ks += BQ) {
        f32x4 v[BQ][2];
#pragma unroll
        for (int q = 0; q < BQ; ++q) { v[q][0] = *(const f32x4*)(xr + (ks + q) * 32 + kq * 8); v[q][1] = *(const f32x4*)(xr + (ks + q) * 32 + kq * 8 + 4); }
#pragma unroll
        for (int q = 0; q < BQ; ++q) {
            const f32x4 a0 = v[q][0], a1 = v[q][1];
            ss += a0[0] * a0[0] + a0[1] * a0[1] + a0[2] * a0[2] + a0[3] * a0[3] + a1[0] * a1[0] + a1[1] * a1[1] + a1[2] * a1[2] + a1[3] * a1[3];
            u32x4 w; w.x = pk2(a0[0], a0[1]); w.y = pk2(a0[2], a0[3]); w.z = pk2(a1[0], a1[1]); w.w = pk2(a1[2], a1[3]);
            *(u32x4*)(xbr + (ks + q) * 32 + kq * 8) = w;
            const bf16x8 bfrag = *(const LAS bf16x8*)(wgr + (ks + q) * 32 + kq * 8);
            acc = __builtin_amdgcn_mfma_f32_16x16x32_bf16(__builtin_bit_cast(bf16x8, w), bfrag, acc, 0, 0, 0);
        }
    }
    ss += __shfl_xor(ss, 16); ss += __shfl_xor(ss, 32);
    if (kq == 0) ssp[kh * TU + rg * 16 + r16] = ss;
#pragma unroll
    for (int j = 0; j < 4; ++j) accp[(kh * TU + rg * 16 + kq * 4 + j) * 16 + r16] = acc[j];
    __syncthreads();
    for (int idx = tid; idx < TU * 16; idx += 512) { const int lr = idx >> 4;
        float sq = 0.f, a = 0.f;
#pragma unroll
        for (int k = 0; k < KS; ++k) { sq += ssp[k * TU + lr]; a += accp[k * TU * 16 + idx]; }
        const float rs = rsqrtf(sq * (1.f / DM) + EPS);
        gas[idx] = a * rs;
        if ((idx & 15) == 0) rstd1[tok0 + lr] = rs; }
    __syncthreads();
    {
        const int c = tid & 255, half = tid >> 8;
        float wg[16];
#pragma unroll
        for (int r = 0; r < 16; ++r) wg[r] = p.w_gate_up[r * 256 + c];
        const float bias = p.b_gate_up[c];
        const int tokb = tok0 + half * HT; const bool samp = tokb >= TP;
        float ls[HT]; float cum = 0.f;
#pragma unroll
        for (int i = 0; i < HT; ++i) {
            const LAS f32x4* gp = (const LAS f32x4*)(gas + (half * HT + i) * 16);
            const f32x4 g0 = gp[0], g1 = gp[1], g2 = gp[2], g3 = gp[3];
            float z = bias;
            z += g0[0] * wg[0] + g0[1] * wg[1] + g0[2] * wg[2] + g0[3] * wg[3] + g1[0] * wg[4] + g1[1] * wg[5] + g1[2] * wg[6] + g1[3] * wg[7];
            z += g2[0] * wg[8] + g2[1] * wg[9] + g2[2] * wg[10] + g2[3] * wg[11] + g3[0] * wg[12] + g3[1] * wg[13] + g3[2] * wg[14] + g3[3] * wg[15];
            ls[i] = log_sigmoid(z) * (1.f / 16.f); cum += ls[i];
        }
        if (half == 0) tot[c] = cum;
        __syncthreads();
        cum = (half == 1 && !samp) ? tot[c] : 0.f;
#pragma unroll
        for (int i = 0; i < HT; ++i) {
            cum = (samp && (i & 3) == 0) ? ls[i] : cum + ls[i];
            const int tok = tokb + i;
            bcum[(size_t)tok * 256 + c] = cum;
            if (samp) { if ((i & 3) == 3) ebl[(size_t)(256 + ((tok - TP) >> 2)) * 256 + c] = expf(cum); }
            else if (half == 1 && i == HT - 1) ebl[(size_t)(tok >> 6) * 256 + c] = expf(cum);
        }
    }
    __syncthreads();
}

DI void phase0(const Params& p, LAS unsigned char* lds) {
    int tid = threadIdx.x; asm volatile("" : "+v"(tid));
    const int lane = tid & 63, wave = tid >> 6;
    unsigned char* ws = p.ws;
    LAS bf16_t* wga = (LAS bf16_t*)lds;
    LAS float* gas = (LAS float*)(lds + 33024);
    LAS float* scr = (LAS float*)(lds + 41216 + wave * 8448);
    bf16_t* xb = (bf16_t*)((unsigned char*)p.out + 0);
    float* rstd1 = (float*)(ws + WS_RSTD1); float* bcum = (float*)(ws + WS_SH); float* ebl = (float*)(ws + WS_EBL);
    { const int gt = blockIdx.x * 512 + tid, ng = gridDim.x * 512;
      float* ssq2 = (float*)(ws + WS_SSQ2);
      for (int i = gt; i < T_TOK; i += ng) ssq2[i] = 0.f;
      float* rc = (float*)(ws + WS_ROPEC); float* rsn = (float*)(ws + WS_ROPES);
      for (int i = gt; i < 2052 * 64; i += ng) { const int pi = i >> 6, fi = i & 63; const double pos = (double)(pi < 2048 ? pi : 16384 + (pi - 2048));
          const double inv = exp(-(double)fi * (9.210340371976184 / 64.0)); const double ang = pos * inv; const double kk = rint(ang * 0.15915494309189535);
          const float r = (float)(ang - kk * 6.283185307179586); rc[i] = cosf(r); rsn[i] = sinf(r); } }
    {
        LAS float* accp = (LAS float*)(lds + 41216);
        LAS float* ssp = accp + 2048;
        LAS float* tot = ssp + 128;
        for (int k = tid; k < DM; k += 512) { const float g = p.ln1[k]; const float* s = p.w_in + (size_t)k * DIN + 3584;
            const f32x4 s0 = *(const f32x4*)s, s1 = *(const f32x4*)(s + 4), s2 = *(const f32x4*)(s + 8), s3 = *(const f32x4*)(s + 12);
            const float sv[16] = {s0[0], s0[1], s0[2], s0[3], s1[0], s1[1], s1[2], s1[3], s2[0], s2[1], s2[2], s2[3], s3[0], s3[1], s3[2], s3[3]};
#pragma unroll
            for (int r = 0; r < 16; r += 2) { const unsigned w = pk2(sv[r] * g, sv[r + 1] * g); wga[r * 1032 + k] = (bf16_t)(w & 0xffffu); wga[(r + 1) * 1032 + k] = (bf16_t)(w >> 16); } }
        __syncthreads();
        for (int u = blockIdx.x; u < 256; u += gridDim.x) xpass_unit<4>(p, lds, u * 64, tid, xb, rstd1, bcum, ebl);
        for (int u = blockIdx.x; u < 32; u += gridDim.x) xpass_unit<1>(p, lds, TP + u * 16, tid, xb, rstd1, bcum, ebl);
    }
    {
        const int gw = blockIdx.x * 8 + wave, ngw = gridDim.x * 8;
        constexpr int I_IN = 16 * 176, I_MX = 8 * 32, I_O = 16 * 32, I_UP = 16 * 176, I_DN = 44 * 32, NIT = I_IN + 2 * I_MX + I_O + I_UP + I_DN;
        for (int it = gw; it < NIT; it += ngw) {
            int r = it; const int nl = lane & 31;
            if (r < I_IN) { const int kb = r / 176, nb = r % 176, n = nb * 32 + nl; int sc;
                if (n < 1024) { const int pp = n & 127; sc = (n & ~127) + (((pp & 7) < 4) ? 4 * (pp >> 3) + (pp & 7) : 64 + 4 * (pp >> 3) + (pp & 7) - 4); }
                else sc = n < 3584 ? n : n + 16;
                transpose_item(p.w_in, DIN, sc, kb * 64, p.ln1, (bf16_t*)(ws + WS_WIN), DM, nb * 32, kb * 64, scr, lane); continue; }
            r -= I_IN;
            if (r < I_MX) { const int kb = r / 32, nb = r % 32; transpose_item(p.w_ret_out, DM, nb * 32 + nl, kb * 64, nullptr, (bf16_t*)(ws + WS_WMIX), DM, nb * 32, kb * 64, scr, lane); continue; }
            r -= I_MX;
            if (r < I_MX) { const int kb = r / 32, nb = r % 32; transpose_item(p.w_gla_out, DM, nb * 32 + nl, kb * 64, nullptr, (bf16_t*)(ws + WS_WMIX), DM, nb * 32, 512 + kb * 64, scr, lane); continue; }
            r -= I_MX;
            if (r < I_O) { const int kb = r / 32, nb = r % 32; transpose_item(p.w_o, DM, nb * 32 + nl, kb * 64, nullptr, (bf16_t*)(ws + WS_WO), DM, nb * 32, kb * 64, scr, lane); continue; }
            r -= I_O;
            if (r < I_UP) { const int kb = r / 176, nb = r % 176, n = nb * 32 + nl; const int sc = ((n >> 7) & 1) * DFF + (n >> 8) * 128 + (n & 127);
                transpose_item(p.w_up, NUP, sc, kb * 64, p.ln2, (bf16_t*)(ws + WS_WUP), DM, nb * 32, kb * 64, scr, lane); continue; }
            r -= I_UP;
            { const int kb = r / 32, nb = r % 32; transpose_item(p.w_down, DM, nb * 32 + nl, kb * 64, nullptr, (bf16_t*)(ws + WS_WDN), DFF, nb * 32, kb * 64, scr, lane); }
        }
    }
}

template <int DK> DI unsigned img_off(int row, int ch) { return (unsigned)(row * (2 * DK) + 16 * (ch ^ ((((row & 3) << 2) | ((row >> 2) & 3)) & (DK / 8 - 1)))); }
template <int DK> DI unsigned tr_addr(int lane, int c, int ks, int t) {
    const int h = lane >> 5, blk = (lane >> 4) & 1, q = (lane & 15) >> 2, pp = lane & 3;
    return img_off<DK>(16 * ks + 8 * h + 4 * t + q, 4 * c + 2 * blk + (pp >> 1)) + 8 * (pp & 1);
}
DI bf16x8 tr_frag(LAS unsigned char* a0, LAS unsigned char* a1) {
    const s16x4 lo = __builtin_amdgcn_ds_read_tr16_b64_v4i16((LAS s16x4*)a0), hi = __builtin_amdgcn_ds_read_tr16_b64_v4i16((LAS s16x4*)a1);
    return __builtin_shufflevector(lo, hi, 0, 1, 2, 3, 4, 5, 6, 7);
}
DI bf16x8 pack8(const f32x16& x, int s) {
    u32x4 w; w.x = pk2(x[8 * s + 0], x[8 * s + 1]); w.y = pk2(x[8 * s + 2], x[8 * s + 3]); w.z = pk2(x[8 * s + 4], x[8 * s + 5]); w.w = pk2(x[8 * s + 6], x[8 * s + 7]);
    return __builtin_bit_cast(bf16x8, w);
}
#define MFMA32(a, b, c) __builtin_amdgcn_mfma_f32_32x32x16_bf16((a), (b), (c), 0, 0, 0)

constexpr int P2_BUF = 49152, P2_QO = 0, P2_KO = 16384, P2_VO = 32768, P2_P = 98304, P2_SSQ = P2_P + 64 * 144, P2_EBL = P2_SSQ + 1024;

template <int DK, bool FULL> DI void chain_prompt(const Params& p, LAS unsigned char* lds, const int branch, const int b, const int head, const int c0, const int nc, const int nprev, const bool write_final) {
    constexpr int NDB = DK / 32, NCH = DK / 8, QLD = 4 * DK, NQI = (64 * NCH) / 512;
    int tid0 = threadIdx.x; asm volatile("" : "+v"(tid0));
    const int w = __builtin_amdgcn_readfirstlane(tid0 >> 6);
    int tid = tid0, lane = tid0 & 63, h = lane >> 5, r = lane & 31;
    unsigned char* ws = p.ws;
    const bf16_t* Q = (const bf16_t*)(ws + (branch == 0 ? PQ_R : PQ_G)) + head * DK;
    const bf16_t* K = (const bf16_t*)(ws + (branch == 0 ? PK_R : PK_G)) + head * DK;
    const bf16_t* V = (const bf16_t*)(ws + (branch == 0 ? PV_R : PV_G)) + head * 128;
    const bf16_t* G = (const bf16_t*)(ws + (branch == 0 ? PG_R : PG_G)) + head * 128;
    const float* ebl = (const float*)(ws + WS_EBL);
    bf16_t* arg = (bf16_t*)((unsigned char*)p.out + SEG1024) + branch * 512 + head * 128;
    const float* gain = (branch == 0 ? p.g_ret : p.g_gla) + head * 128;
    const int tok0 = b * 2048;
    const float lg2 = log2f(1.f - exp2f(-5.f - (float)head));
    const float ret_ebl = exp2f(64.f * lg2);
    const int chain = branch * 32 + b * 4 + head;
    float* Lbuf = (float*)p.out + (size_t)chain * 3 * 16384;
    float* Dbuf = (float*)p.out + (size_t)64 * 3 * 16384 + (size_t)chain * 3 * 64;
    f32x16 S[NDB];
#pragma unroll
    for (int d = 0; d < NDB; ++d)
#pragma unroll
        for (int i = 0; i < 16; ++i) S[d][i] = 0.f;
    f32x4 gn[4];
    if (w < 4) {
#pragma unroll
        for (int g = 0; g < 4; ++g) gn[g] = *(const f32x4*)(gain + 32 * w + 8 * g + 4 * h);
        if (FULL) {
            for (int sg = 0; sg < nprev; ++sg) {
#pragma unroll
                for (int d = 0; d < NDB; ++d)
#pragma unroll
                    for (int i = 0; i < 16; ++i) {
                        const int dd = 32 * d + (i & 3) + 8 * (i >> 2) + 4 * h;
                        const float dec = (DK == 128) ? exp2f(64.f * (float)nc * lg2) : Dbuf[sg * 64 + dd];
                        S[d][i] = (sg == 0 ? 0.f : S[d][i] * dec) + Lbuf[(size_t)sg * 16384 + (size_t)dd * 128 + 32 * w + r];
                    }
            }
        }
    }
    float dprod = 1.f;
    u32x4 rq[NQI], rk[NQI], rv[2]; float rebl = 0.f;
#define P2_LOAD(c) do { const int tb = tok0 + 64 * (c); \
        _Pragma("unroll") for (int i = 0; i < NQI; ++i) { const int idx = tid + 512 * i, rr = idx / NCH, ch = idx % NCH; \
            rq[i] = *(const u32x4*)(Q + (size_t)(tb + rr) * QLD + ch * 8); rk[i] = *(const u32x4*)(K + (size_t)(tb + rr) * QLD + ch * 8); } \
        _Pragma("unroll") for (int i = 0; i < 2; ++i) { const int idx = tid + 512 * i, rr = idx >> 4, ch = idx & 15; rv[i] = *(const u32x4*)(V + (size_t)(tb + rr) * 512 + ch * 8); } \
        if (DK == 64 && tid < 64) rebl = ebl[(size_t)(b * 32 + (c)) * 256 + head * 64 + tid]; } while (0)
#define P2_STORE(buf) do { LAS unsigned char* bb = lds + (buf) * P2_BUF; \
        _Pragma("unroll") for (int i = 0; i < NQI; ++i) { const int idx = tid + 512 * i, rr = idx / NCH, ch = idx % NCH; \
            *(LAS u32x4*)(bb + P2_QO + img_off<DK>(rr, ch)) = rq[i]; *(LAS u32x4*)(bb + P2_KO + img_off<DK>(rr, ch)) = rk[i]; } \
        _Pragma("unroll") for (int i = 0; i < 2; ++i) { const int idx = tid + 512 * i, rr = idx >> 4, ch = idx & 15; *(LAS u32x4*)(bb + P2_VO + img_off<128>(rr, ch)) = rv[i]; } \
        if (DK == 64 && tid < 64) *(LAS float*)(lds + P2_EBL + (buf) * 256 + tid * 4) = rebl; } while (0)
    P2_LOAD(c0); P2_STORE(c0 & 1);
    dprod *= rebl;
    __syncthreads();
    const int cend = c0 + nc;
    for (int c = c0; c < cend; ++c) {
        tid = tid0; asm volatile("" : "+v"(tid)); lane = tid & 63; h = lane >> 5; r = lane & 31;
        LAS unsigned char* bb = lds + (c & 1) * P2_BUF;
        LAS unsigned char* qi = bb + P2_QO; LAS unsigned char* ki = bb + P2_KO; LAS unsigned char* vi = bb + P2_VO;
        if (c + 1 < cend) { P2_LOAD(c + 1); dprod *= rebl; }
        u32x2 gt[2][4];
        if (FULL && w < 4) {
            {   const int tbg = tok0 + 64 * c;
#pragma unroll
                for (int ib = 0; ib < 2; ++ib)
#pragma unroll
                    for (int g = 0; g < 4; ++g) gt[ib][g] = *(const u32x2*)(G + (size_t)(tbg + 32 * ib + r) * 512 + 32 * w + 8 * g + 4 * h); }
        }
        if (FULL && w >= 4 && w < 7) {
            const int ws_ = w - 4;
            const int jb = (ws_ == 2) ? 1 : 0, ib = (ws_ == 0) ? 0 : 1;
            f32x16 pt;
#pragma unroll
            for (int i = 0; i < 16; ++i) pt[i] = 0.f;
#pragma unroll
            for (int s = 0; s < DK / 16; ++s) {
                const bf16x8 a = *(const LAS bf16x8*)(ki + img_off<DK>(32 * jb + r, 2 * s + h)), bq = *(const LAS bf16x8*)(qi + img_off<DK>(32 * ib + r, 2 * s + h));
                pt = MFMA32(a, bq, pt);
            }
            if (jb == ib) {
#pragma unroll
                for (int i = 0; i < 16; ++i) { const int j = (i & 3) + 8 * (i >> 2) + 4 * h; pt[i] = (j <= r) ? pt[i] : 0.f; }
            }
#pragma unroll
            for (int g = 0; g < 4; ++g) { u32x2 o; o.x = pk2(pt[4 * g], pt[4 * g + 1]); o.y = pk2(pt[4 * g + 2], pt[4 * g + 3]);
                *(LAS u32x2*)(lds + P2_P + (32 * ib + r) * 144 + (32 * jb + 8 * g + 4 * h) * 2) = o; }
        }
        f32x16 ot[2];
        bf16x8 vf[4];
        if (w < 4) {
#pragma unroll
            for (int s = 0; s < 4; ++s) vf[s] = tr_frag(vi + tr_addr<128>(lane, w, s, 0), vi + tr_addr<128>(lane, w, s, 1));
#pragma unroll
            for (int ib = 0; ib < 2; ++ib)
#pragma unroll
                for (int i = 0; i < 16; ++i) ot[ib][i] = 0.f;
            if (FULL)
#pragma unroll
            for (int d = 0; d < NDB; ++d)
#pragma unroll
                for (int s2 = 0; s2 < 2; ++s2) {
                    const bf16x8 sfr = pack8(S[d], s2);
#pragma unroll
                    for (int ib = 0; ib < 2; ++ib) {
                        const s16x4 lo = *(const LAS s16x4*)(qi + img_off<DK>(32 * ib + r, 4 * d + 2 * s2) + 8 * h), hi = *(const LAS s16x4*)(qi + img_off<DK>(32 * ib + r, 4 * d + 2 * s2 + 1) + 8 * h);
                        const bf16x8 bq = __builtin_shufflevector(lo, hi, 0, 1, 2, 3, 4, 5, 6, 7);
                        ot[ib] = MFMA32(sfr, bq, ot[ib]);
                    }
                }
#pragma unroll
            for (int d = 0; d < NDB; ++d) {
#pragma unroll
                for (int s = 0; s < 4; ++s) {
                    const bf16x8 a = tr_frag(ki + tr_addr<DK>(lane, d, s, 0), ki + tr_addr<DK>(lane, d, s, 1));
                    S[d] = MFMA32(a, vf[s], S[d]);
                }
                if (DK == 128) {
#pragma unroll
                    for (int i = 0; i < 16; ++i) S[d][i] *= ret_ebl;
                } else {
                    const LAS float* eb = (const LAS float*)(lds + P2_EBL + (c & 1) * 256) + 32 * d + 4 * h;
#pragma unroll
                    for (int g = 0; g < 4; ++g) { const f32x4 e4 = *(const LAS f32x4*)(eb + 8 * g);
#pragma unroll
                        for (int e = 0; e < 4; ++e) S[d][4 * g + e] *= e4[e]; }
                }
            }
        }
        if (FULL) __syncthreads();
        if (FULL && w < 4) {
#pragma unroll
            for (int ib = 0; ib < 2; ++ib) {
#pragma unroll
                for (int s = 0; s < (ib == 0 ? 2 : 4); ++s) {
                    const bf16x8 bp = *(const LAS bf16x8*)(lds + P2_P + (32 * ib + r) * 144 + (16 * s + 8 * h) * 2);
                    ot[ib] = MFMA32(vf[s], bp, ot[ib]);
                }
            }
#pragma unroll
            for (int ib = 0; ib < 2; ++ib) { float ss = 0.f;
#pragma unroll
                for (int i = 0; i < 16; ++i) ss += ot[ib][i] * ot[ib][i];
                ss += __shfl_xor(ss, 32);
                if (h == 0) *(LAS float*)(lds + P2_SSQ + (w * 64 + 32 * ib + r) * 4) = ss; }
        }
        if (c + 1 < cend) P2_STORE((c + 1) & 1);
        __syncthreads();
        if (FULL && w < 4) {
            asm volatile("" : "+v"(lane)); h = lane >> 5; r = lane & 31;
            const int tb = tok0 + 64 * c;
#pragma unroll
            for (int ib = 0; ib < 2; ++ib) {
                const LAS float* sq = (const LAS float*)(lds + P2_SSQ) + 32 * ib + r;
                const float tot = sq[0] + sq[64] + sq[128] + sq[192];
                const float rs = rsqrtf(tot * (1.f / 128.f) + EPS);
#pragma unroll
                for (int g = 0; g < 4; ++g) {
                    const u32x2 gg = gt[ib][g];
                    u32x2 o; o.x = pk2(ot[ib][4 * g] * rs * gn[g][0] * bflo(gg.x), ot[ib][4 * g + 1] * rs * gn[g][1] * bfhi(gg.x));
                    o.y = pk2(ot[ib][4 * g + 2] * rs * gn[g][2] * bflo(gg.y), ot[ib][4 * g + 3] * rs * gn[g][3] * bfhi(gg.y));
                    *(u32x2*)(arg + (size_t)(tb + 32 * ib + r) * 1024 + 32 * w + 8 * g + 4 * h) = o;
                }
            }
        }
    }
#undef P2_LOAD
#undef P2_STORE
    if (!FULL && DK == 64 && tid0 < 64) Dbuf[nprev * 64 + tid0] = dprod;
    if (w < 4 && (write_final || !FULL)) {
        lane = tid0 & 63; h = lane >> 5; r = lane & 31;
        float* so = FULL ? p.out + (branch == 0 ? OUT_RSP : OUT_GSP) + (size_t)(b * 4 + head) * DK * 128 : Lbuf + (size_t)nprev * 16384;
#pragma unroll
        for (int d = 0; d < NDB; ++d)
#pragma unroll
            for (int i = 0; i < 16; ++i) so[(size_t)(32 * d + (i & 3) + 8 * (i >> 2) + 4 * h) * 128 + 32 * w + r] = S[d][i];
    }
    __syncthreads();
}

template <int DK> DI void sample_unit(const Params& p, LAS unsigned char* lds, const int branch, const int b, const int head) {
    int tid = threadIdx.x; asm volatile("" : "+v"(tid));
    unsigned char* ws = p.ws;
    const bf16_t* Q = (const bf16_t*)(ws + (branch == 0 ? PQ_R : PQ_G)) + head * DK;
    const bf16_t* K = (const bf16_t*)(ws + (branch == 0 ? PK_R : PK_G)) + head * DK;
    const bf16_t* V = (const bf16_t*)(ws + (branch == 0 ? PV_R : PV_G)) + head * 128;
    const bf16_t* G = (const bf16_t*)(ws + (branch == 0 ? PG_R : PG_G)) + head * 128;
    bf16_t* arg = (bf16_t*)((unsigned char*)p.out + SEG1024) + branch * 512 + head * 128;
    const float* gain = (branch == 0 ? p.g_ret : p.g_gla) + head * 128;
    const float* sin_ = (branch == 0 ? p.state_ret : p.state_gla) + (size_t)(b * 4 + head) * DK * 128;
    float* sout = p.out + (branch == 0 ? OUT_RSS : OUT_GSS) + (size_t)(b * 4 + head) * DK * 128;
    const int tok0 = TP + 4 * b;
    LAS float* qs = (LAS float*)lds;
    LAS float* ks = qs + 4 * 128;
    LAS float* vs = ks + 4 * 128;
    LAS float* es = vs + 4 * 128;
    LAS float* Ps = es + 128;
    LAS float* ssq = Ps + 16;
    LAS float* op = ssq + 16;
    for (int i = tid; i < 4 * DK; i += 512) { const int t = i / DK, d = i % DK;
        qs[t * DK + d] = __uint_as_float((unsigned)Q[(size_t)(tok0 + t) * (4 * DK) + d] << 16); ks[t * DK + d] = __uint_as_float((unsigned)K[(size_t)(tok0 + t) * (4 * DK) + d] << 16); }
    { const int t = tid >> 7, v = tid & 127; vs[t * 128 + v] = __uint_as_float((unsigned)V[(size_t)(tok0 + t) * 512 + v] << 16); }
    if (tid < DK) {
        if (DK == 128) { const float lg2 = log2f(1.f - exp2f(-5.f - (float)head)); es[tid] = exp2f(4.f * lg2); }
        else es[tid] = ((const float*)(ws + WS_EBL))[(size_t)(256 + b) * 256 + head * 64 + tid];
    }
    __syncthreads();
    if (tid < 16) { const int i = tid >> 2, j = tid & 3; float s = 0.f; if (j <= i) { for (int d = 0; d < DK; ++d) s += qs[i * DK + d] * ks[j * DK + d]; } Ps[tid] = s; }
    {
        const int vq = tid & 31, dg = tid >> 5;
        f32x4 oa[4];
#pragma unroll
        for (int i = 0; i < 4; ++i) oa[i] = (f32x4){0.f, 0.f, 0.f, 0.f};
        f32x4 v4[4];
#pragma unroll
        for (int j = 0; j < 4; ++j) v4[j] = *(const LAS f32x4*)(vs + j * 128 + 4 * vq);
        f32x4 s0[DK / 16];
#pragma unroll
        for (int rr = 0; rr < DK / 16; ++rr) s0[rr] = *(const f32x4*)(sin_ + (size_t)(dg + 16 * rr) * 128 + 4 * vq);
#pragma unroll
        for (int rr = 0; rr < DK / 16; ++rr) {
            const int d = dg + 16 * rr;
            f32x4 sn = s0[rr];
#pragma unroll
            for (int i = 0; i < 4; ++i) { oa[i] += s0[rr] * qs[i * DK + d]; sn += v4[i] * ks[i * DK + d]; }
            sn *= es[d];
            *(f32x4*)(sout + (size_t)d * 128 + 4 * vq) = sn;
        }
#pragma unroll
        for (int i = 0; i < 4; ++i) *(LAS f32x4*)(op + (dg * 4 + i) * 128 + 4 * vq) = oa[i];
    }
    __syncthreads();
    {
        const int i = tid >> 7, v = tid & 127;
        float o = 0.f;
#pragma unroll
        for (int dg = 0; dg < 16; ++dg) o += op[(dg * 4 + i) * 128 + v];
#pragma unroll
        for (int j = 0; j < 4; ++j) o += Ps[i * 4 + j] * vs[j * 128 + v];
        const float s = wave_sum(o * o);
        if ((tid & 63) == 0) ssq[tid >> 6] = s;
        __syncthreads();
        const float rs = rsqrtf((ssq[2 * i] + ssq[2 * i + 1]) * (1.f / 128.f) + EPS);
        const float gate = __uint_as_float((unsigned)G[(size_t)(tok0 + i) * 512 + v] << 16);
        const unsigned wv = pk2(o * rs * gain[v] * gate, 0.f);
        arg[(size_t)(tok0 + i) * 1024 + v] = (bf16_t)(wv & 0xffffu);
    }
    __syncthreads();
}

template <bool FULL> DI void chain_call(const Params& p, LAS unsigned char* lds, int chain, int c0, int nc, int nprev, bool wf) {
    const int branch = chain >> 5, bh = chain & 31;
    if (branch == 0) chain_prompt<128, FULL>(p, lds, 0, bh >> 2, bh & 3, c0, nc, nprev, wf); else chain_prompt<64, FULL>(p, lds, 1, bh >> 2, bh & 3, c0, nc, nprev, wf);
}
DI void sample_call(const Params& p, LAS unsigned char* lds, int u) {
    const int branch = u >> 9, bh = u & 511;
    if (branch == 0) sample_unit<128>(p, lds, 0, bh >> 2, bh & 3); else sample_unit<64>(p, lds, 1, bh >> 2, bh & 3);
}
DI void phase2(const Params& p, LAS unsigned char* lds, const XcdBarrier& xbar) {
    const int G = gridDim.x, bx = blockIdx.x;
    if (G == 256) {
        const int chain = bx & 63, seg = bx >> 6;
        if (seg < 3) chain_call<false>(p, lds, chain, 8 * seg, 8, seg, false);
        else { sample_call(p, lds, bx - 192); sample_call(p, lds, bx - 192 + 64); }
        xcd_barrier(xbar);
        chain_call<true>(p, lds, chain, 8 * seg, 8, seg, seg == 3);
        for (int u = 128 + bx; u < 1024; u += 256) sample_call(p, lds, u);
    } else {
        for (int c = bx; c < 64; c += G) chain_call<true>(p, lds, c, 0, 32, 0, true);
        for (int u = bx; u < 1024; u += G) sample_call(p, lds, u);
    }
}

DI void phase_final(const Params& p) {
    const int lane = threadIdx.x & 63, gw = blockIdx.x * 8 + (threadIdx.x >> 6), ngw = gridDim.x * 8;
    const bf16_t* hb = (const bf16_t*)(p.ws + WS_SH);
    for (int row = TP + gw; row < T_TOK; row += ngw) {
        f32x4 v[4]; float s = 0.f;
        const bf16_t* part = (const bf16_t*)(p.ws + WS_PART) + (size_t)((row - TP) & 255) * 256 + 4 * lane;
#pragma unroll
        for (int j = 0; j < 4; ++j) {
            const u32x2 hv = *(const u32x2*)(hb + (size_t)row * DM + 256 * j + 4 * lane);
            v[j] = (f32x4){bflo(hv.x), bfhi(hv.x), bflo(hv.y), bfhi(hv.y)};
            const int su = ((row - TP) >> 8) * 4 + j;
            for (int kp = 0; kp < 11; ++kp) { const u32x2 pv = *(const u32x2*)(part + (size_t)(su * 11 + kp) * 65536); v[j] += (f32x4){bflo(pv.x), bfhi(pv.x), bflo(pv.y), bfhi(pv.y)}; }
            s += v[j][0] * v[j][0] + v[j][1] * v[j][1] + v[j][2] * v[j][2] + v[j][3] * v[j][3];
        }
        const float rs = rsqrtf(wave_sum(s) * (1.f / DM) + EPS);
#pragma unroll
        for (int j = 0; j < 4; ++j) { const f32x4 g = *(const f32x4*)(p.ln_f + 256 * j + 4 * lane); *(f32x4*)(p.out + (size_t)row * DM + 256 * j + 4 * lane) = v[j] * rs * g; }
    }
}

__global__ void __launch_bounds__(512, 2) fwd_megakernel(Params p) {
    extern __shared__ __attribute__((aligned(16))) unsigned char shm[];
    LAS unsigned char* lds = (LAS unsigned char*)shm;
    cg::grid_group grid = cg::this_grid();
    if (p.ws == nullptr) grid.sync();
    if (threadIdx.x < 4) ((LAS unsigned*)(lds + 131072 + 4096))[threadIdx.x] = 0u;
    __syncthreads();
    const XcdBarrier xbar = xcd_barrier_post((unsigned*)(p.ws + WS_BAR), (volatile LAS unsigned*)(lds + 131072 + 4096));
    unsigned char* ws = p.ws;
    const int G = gridDim.x, bx = blockIdx.x;
    bf16_t* xb = (bf16_t*)p.out;
    bf16_t* arg = (bf16_t*)((unsigned char*)p.out + SEG1024);

#ifndef PHMASK
#define PHMASK 0x1ff
#endif
#define PH(n) if ((PHMASK >> (n)) & 1)
    PH(0) phase0(p, lds);
    xcd_barrier(xbar);
#if defined(DUP_PH) && DUP_PH == 0
    phase0(p, lds);
    xcd_barrier(xbar);
#endif
    PH(1) {
        pg8::Gemm g{xb, (const bf16_t*)(ws + WS_WIN), T_TOK, NPROJ, DM, DM, DM, 256}; pg8::StaticOrder S; S.init(T_TOK, NPROJ, G, bx);
        EpiProj E{ws, (const float*)(ws + WS_RSTD1), (const float*)(ws + WS_SH), (const float*)(ws + WS_ROPEC), (const float*)(ws + WS_ROPES)};
        pg8::gemm_phase<EpiProj, pg8::StaticOrder, 16>(lds, g, S, E);
#if defined(DUP_PH) && DUP_PH == 1
        xcd_barrier(xbar);
        pg8::gemm_phase<EpiProj, pg8::StaticOrder, 16>(lds, g, S, E);
#endif
    }
    xcd_barrier(xbar);
    PH(2) phase2(p, lds, xbar);
    xcd_barrier(xbar);
#if defined(DUP_PH) && DUP_PH == 2
    phase2(p, lds, xbar);
    xcd_barrier(xbar);
#endif
    PH(3) {
        pg8::Gemm g{arg, (const bf16_t*)(ws + WS_WMIX), T_TOK, DM, DM, DM, DM, 256}; pg8::StaticOrder S; S.init(T_TOK, DM, G, bx);
        EpiMix E{(const bf16_t*)(ws + PM_R), (const bf16_t*)(ws + PM_G), (bf16_t*)(ws + WS_MIX)};
        pg8::gemm_phase<EpiMix, pg8::StaticOrder, 16>(lds, g, S, E);
#if defined(DUP_PH) && DUP_PH == 3
        xcd_barrier(xbar);
        pg8::gemm_phase<EpiMix, pg8::StaticOrder, 16>(lds, g, S, E);
#endif
    }
    xcd_barrier(xbar);
    PH(4) {
        pg8::Gemm g{(const bf16_t*)(ws + WS_MIX), (const bf16_t*)(ws + WS_WO), T_TOK, DM, DM, DM, DM, 256}; pg8::StaticOrder S; S.init(T_TOK, DM, G, bx);
        EpiH E{p.x_prompt, p.x_sample, p.out, (bf16_t*)(ws + WS_SH), (float*)(ws + WS_SSQ2)};
        pg8::gemm_phase<EpiH, pg8::StaticOrder, 16>(lds, g, S, E);
    }
    xcd_barrier(xbar);
    PH(5) {
        pg8::Gemm g{(const bf16_t*)(ws + WS_SH) - 2 * DM, (const bf16_t*)(ws + WS_WUP), T_TOK, NUP, DM, DM, DM, 254}; pg8::StaticOrder S; S.init_tiles(67, 22, G, bx);
        EpiUpConv E{(const float*)(ws + WS_SSQ2), (bf16_t*)(ws + WS_ACT), p.conv_w, p.conv_b, p.cache_conv, p.out, (LAS float*)(lds + 131072)};
        pg8::gemm_phase<EpiUpConv, pg8::StaticOrder, 16>(lds, g, S, E);
#if defined(DUP_PH) && DUP_PH == 5
        xcd_barrier(xbar);
        pg8::gemm_phase<EpiUpConv, pg8::StaticOrder, 16>(lds, g, S, E);
#endif
    }
    xcd_barrier(xbar);
    PH(7) {
        pg8::Gemm g{(const bf16_t*)(ws + WS_ACT), (const bf16_t*)(ws + WS_WDN), T_TOK, DM, DFF, DFF, DFF, 256}; pg8::StaticOrder S; S.init_tiles(64, 4, G, bx);
        EpiDownNorm E{(const bf16_t*)(ws + WS_SH), p.out, p.ln_f, (float*)(ws + WS_EXCH), (unsigned*)(ws + WS_CNT), (LAS float*)(lds + 131072)};
        pg8::gemm_phase<EpiDownNorm, pg8::StaticOrder, 44>(lds, g, S, E);
        {   pg8::PieceOrder S2{G, bx}; EpiPart E2{(bf16_t*)(ws + WS_PART)};
            pg8::gemm_phase<EpiPart, pg8::PieceOrder, 4>(lds, g, S2, E2); }
    }
    xcd_barrier(xbar);
    PH(8) phase_final(p);
}

extern "C" void kernel_launch(void* const* d_in, const int* in_sizes, int n_in, void* d_out, int out_size, void* d_ws, size_t ws_size, hipStream_t stream) {
    static int grid = 0;
    if (grid == 0) {
        if (n_in != 20 || out_size != (int)OUT_END || ws_size < WS_END) { fprintf(stderr, "kernel_launch: unexpected shapes (n_in %d, out %d, ws %zu)\n", n_in, out_size, ws_size); grid = -1; return; }
        int dev = 0, cus = 0, per_cu = 0;
        hipGetDevice(&dev);
        hipDeviceGetAttribute(&cus, hipDeviceAttributeMultiprocessorCount, dev);
        if (hipFuncSetAttribute((const void*)fwd_megakernel, hipFuncAttributeMaxDynamicSharedMemorySize, LDS_BYTES) != hipSuccess) { fprintf(stderr, "kernel_launch: hipFuncSetAttribute failed\n"); grid = -1; return; }
        hipOccupancyMaxActiveBlocksPerMultiprocessor(&per_cu, (const void*)fwd_megakernel, 512, LDS_BYTES);
        if (per_cu < 1) { fprintf(stderr, "kernel_launch: occupancy query gave %d\n", per_cu); per_cu = 1; }
        grid = cus * 1;
        (void)hipGetLastError();
    }
    if (grid < 0) return;
    Params p{};
    const float** f = (const float**)&p;
    for (int i = 0; i < 20; ++i) f[i] = (const float*)d_in[i];
    p.out = (float*)d_out; p.ws = (unsigned char*)d_ws;
    if (hipMemsetAsync((unsigned char*)d_ws + WS_BAR, 0, 16384 + 8192, stream) != hipSuccess) { fprintf(stderr, "kernel_launch: memset failed\n"); return; }
    void* args[] = {&p};
    hipError_t e = hipLaunchCooperativeKernel((const void*)fwd_megakernel, dim3(grid), dim3(512), args, LDS_BYTES, stream);
    if (e != hipSuccess) fprintf(stderr, "cooperative launch failed: %s (grid %d)\n", hipGetErrorString(e), grid);
}
```

```cpp
#include <hip/hip_runtime.h>
#include <hip/hip_cooperative_groups.h>
#include <cstdio>
namespace cg = cooperative_groups;

#define LAS __attribute__((address_space(3)))
#define DI __device__ __forceinline__
typedef unsigned short bf16_t;
typedef short bf16x8 __attribute__((ext_vector_type(8)));
typedef short s16x4 __attribute__((ext_vector_type(4)));
typedef float f32x4 __attribute__((ext_vector_type(4)));
typedef float f32x2 __attribute__((ext_vector_type(2)));
typedef float f32x16 __attribute__((ext_vector_type(16)));
typedef unsigned u32x4 __attribute__((ext_vector_type(4)));
typedef unsigned u32x2 __attribute__((ext_vector_type(2)));
typedef __bf16 bf16x2_t __attribute__((ext_vector_type(2)));

constexpr int T_TOK = 16896, TP = 16384, DM = 1024, DIN = 5648, NPROJ = 5632, DFF = 2816, NUP = 5632;
constexpr float EPS = 1e-6f;
constexpr size_t OUT_Y = 0, OUT_RSP = 17301504, OUT_RSS = OUT_RSP + 524288, OUT_GSP = OUT_RSS + 8388608, OUT_GSS = OUT_GSP + 262144,
                 OUT_CP = OUT_GSS + 4194304, OUT_CS = OUT_CP + 45056, OUT_END = OUT_CS + 720896;
constexpr size_t WS_WIN = 0, WS_WMIX = WS_WIN + (size_t)NPROJ * DM * 2, WS_WO = WS_WMIX + (size_t)DM * DM * 2, WS_WUP = WS_WO + (size_t)DM * DM * 2,
                 WS_WDN = WS_WUP + (size_t)NUP * DM * 2, WS_PROJ = WS_WDN + (size_t)DM * DFF * 2;
constexpr size_t SEG512 = (size_t)T_TOK * 512 * 2, SEG256 = (size_t)T_TOK * 256 * 2, SEG1024 = (size_t)T_TOK * 1024 * 2;
constexpr size_t PQ_R = WS_PROJ, PK_R = PQ_R + SEG512, PV_R = PK_R + SEG512, PG_R = PV_R + SEG512, PQ_G = PG_R + SEG512, PK_G = PQ_G + SEG256,
                 PV_G = PK_G + SEG256, PG_G = PV_G + SEG512, PM_R = PG_G + SEG512, PM_G = PM_R + SEG1024, WS_PROJ_END = PM_G + SEG1024;
constexpr size_t WS_MIX = PQ_R;
constexpr size_t WS_PART = WS_PROJ + (size_t)T_TOK * DFF * 2;
static_assert(WS_PART + (size_t)88 * 65536 * 4 <= WS_PROJ_END, "partials");
constexpr size_t WS_ACT = WS_PROJ;
constexpr size_t WS_SH = WS_PROJ_END;
constexpr size_t WS_RSTD1 = WS_SH + SEG1024, WS_SSQ2 = WS_RSTD1 + (size_t)T_TOK * 4, WS_EBL = WS_SSQ2 + (size_t)T_TOK * 4,
                 WS_ROPEC = WS_EBL + (size_t)384 * 256 * 4, WS_ROPES = WS_ROPEC + (size_t)2052 * 64 * 4, WS_BAR = WS_ROPES + (size_t)2052 * 64 * 4, WS_CNT = WS_BAR + 16384  ,
                 WS_EXCH = WS_CNT + 8192  , WS_END = WS_EXCH + (size_t)TP * 16;
static_assert(WS_PROJ_END - WS_PROJ == (size_t)T_TOK * NPROJ * 2, "proj layout");
static_assert(WS_END <= (size_t)256 * 1024 * 1024, "workspace");
constexpr int LDS_BYTES = 131072 + 4096 + 16;

struct Params {
    const float *x_prompt, *x_sample, *state_ret, *state_gla, *cache_conv, *ln1, *w_in, *w_gate_up, *b_gate_up, *g_ret, *g_gla, *w_ret_out, *w_gla_out,
        *w_o, *ln2, *w_up, *conv_w, *conv_b, *w_down, *ln_f;
    float* out; unsigned char* ws;
};

DI unsigned pk2(float lo, float hi) { f32x2 v = {lo, hi}; bf16x2_t b = __builtin_convertvector(v, bf16x2_t); return __builtin_bit_cast(unsigned, b); }
DI float bflo(unsigned w) { return __uint_as_float(w << 16); }
DI float bfhi(unsigned w) { return __uint_as_float(w & 0xffff0000u); }
DI float wave_sum(float v) {
#pragma unroll
    for (int o = 1; o < 64; o <<= 1) v += __shfl_xor(v, o);
    return v;
}
DI float sigmoidf_(float x) { return __builtin_amdgcn_rcpf(1.f + __expf(-x)); }
DI const float* x_row(const Params& p, int tok) { return tok < TP ? p.x_prompt + (size_t)tok * DM : p.x_sample + (size_t)(tok - TP) * DM; }
#define LDS_WAIT() asm volatile("s_waitcnt lgkmcnt(0)" ::: "memory")

#define XB_TMO      128
#define XB_XCNT(j)  (256  + 64 * (j))
#define XB_XSUB(j)  (1280 + 64 * (j))
#define XB_XGEN(j)  (2304 + 64 * (j))
#define XB_TOP      3328
#define XB_TOPGEN   3392
#define XCD_BAR_WORDS 3456
#define XB_SPIN_CAP (1u << 22)
DI unsigned xb_ld(unsigned* p) { return __hip_atomic_load(p, __ATOMIC_RELAXED, __HIP_MEMORY_SCOPE_AGENT); }
DI unsigned xb_add(unsigned* p, unsigned v) { return __hip_atomic_fetch_add(p, v, __ATOMIC_RELAXED, __HIP_MEMORY_SCOPE_AGENT); }
DI unsigned xb_xcc_id() { return (unsigned)__builtin_amdgcn_s_getreg((3 << 11) | 20) & 0xFu; }
#define XB_SPIN(cond, bar) do { unsigned _sp = 0; while (cond) { __builtin_amdgcn_s_sleep(1); \
    if ((++_sp & 255u) == 0u) { if (xb_ld(&(bar)[XB_TMO])) break; if (_sp > XB_SPIN_CAP) { atomicAdd(&(bar)[XB_TMO], 1u); break; } } } } while (0)
struct XcdBarrier { unsigned* bar; unsigned x; volatile LAS unsigned* st; };
DI XcdBarrier xcd_barrier_post(unsigned* bar, volatile LAS unsigned* st) {
    XcdBarrier b; b.bar = bar; b.x = xb_xcc_id(); b.st = st;
    if (threadIdx.x == 0) (void)xb_add(&bar[XB_XCNT(b.x)], 1u);
    return b;
}
DI void xcd_barrier_complete(unsigned* bar, unsigned x, unsigned& nloc, unsigned& nx) {
    const unsigned G = gridDim.x * gridDim.y * gridDim.z;
    unsigned sum, cnt, mine, sp = 0u;
    for (;;) {
        sum = 0u; cnt = 0u; mine = 0u;
#pragma unroll
        for (unsigned j = 0; j < 16; ++j) { const unsigned c = xb_ld(&bar[XB_XCNT(j)]); sum += c; cnt += (c > 0u) ? 1u : 0u; mine = (j == x) ? c : mine; }
        if (sum == G) break;
        __builtin_amdgcn_s_sleep(1);
        if ((++sp & 255u) == 0u) { if (xb_ld(&bar[XB_TMO])) break; if (sp > XB_SPIN_CAP) { atomicAdd(&bar[XB_TMO], 1u); break; } }
    }
    nloc = mine > 0u ? mine : 1u; nx = cnt > 0u ? cnt : 1u;
}
DI void xcd_barrier(const XcdBarrier& b) {
    asm volatile("s_waitcnt vmcnt(0)" ::: "memory");
    __syncthreads();
    if (threadIdx.x == 0) {
        unsigned* bar = b.bar;
        __builtin_amdgcn_s_waitcnt(0);
        unsigned nloc = b.st[0], nx = b.st[1];
        if (nloc == 0u) { xcd_barrier_complete(bar, b.x, nloc, nx); b.st[0] = nloc; b.st[1] = nx; }
        const unsigned old = xb_add(&bar[XB_XSUB(b.x)], 1u);
        const unsigned gen = old / nloc;
        if (old + 1u == (gen + 1u) * nloc) {
            __builtin_amdgcn_fence(__ATOMIC_RELEASE, "agent");
            asm volatile("s_waitcnt vmcnt(0)" ::: "memory");
            const unsigned og = xb_add(&bar[XB_TOP], 1u);
            const unsigned tg = og / nx;
            if (og + 1u == (tg + 1u) * nx) xb_add(&bar[XB_TOPGEN], 1u);
            else XB_SPIN(xb_ld(&bar[XB_TOPGEN]) == tg, bar);
            __builtin_amdgcn_fence(__ATOMIC_ACQUIRE, "agent");
            xb_add(&bar[XB_XGEN(b.x)], 1u);
            asm volatile("s_waitcnt vmcnt(0)" ::: "memory");
        } else {
            XB_SPIN(xb_ld(&bar[XB_XGEN(b.x)]) == gen, bar);
            __builtin_amdgcn_fence(__ATOMIC_ACQUIRE, "agent");
            asm volatile("s_waitcnt vmcnt(0)" ::: "memory");
        }
    }
    __syncthreads();
}

namespace pg8 {
constexpr int BM = 256, BK = 64, HALF = 128, HTB = HALF * BK * 2, STAGE_BYTES = 8 * HTB, NXCD = 8, WGM = 8;
DI int lds_byte(int r, int c) { const int st = (r >> 4) * 2 + (c >> 5), rr = r & 15, cc = c & 31, ob = rr * 64 + cc * 2; return st * 1024 + (ob ^ (((ob >> 9) & 1) << 5)); }
DI void stage_rc(int b, int& R, int& C) { const int st = b / 1024, sb = b % 1024, swz = sb ^ (((sb >> 9) & 1) << 5); R = (st >> 1) * 16 + swz / 64; C = (st & 1) * 32 + (swz % 64) / 2; }
DI int perm32(int rho) { const int n = rho >> 4, i = rho & 15; return 8 * (i >> 2) + 4 * n + (i & 3); }
struct Unit { int pm, pn, kt0, id; };
struct Gemm { const bf16_t* A; const bf16_t* Bt; int M, N, K, lda, ldb, mstep; };
struct StaticOrder {
    int nM, nN, nwg, G, c;
    DI void init(int M, int N, int G_, int c_) { nM = M / BM; nN = N / BM; nwg = nM * nN; G = G_; c = c_; }
    DI void init_tiles(int nM_, int nN_, int G_, int c_) { nM = nM_; nN = nN_; nwg = nM * nN; G = G_; c = c_; }
    DI bool next(int i, Unit& u) const {
        u.kt0 = 0; u.id = 0; u.pm = 0; u.pn = 0;
        const long L = (long)i * G + c; if (L >= nwg) return false;
        int wgid = (int)L; { const int q = nwg / NXCD, r = nwg % NXCD, xcd = wgid % NXCD, off = wgid / NXCD; wgid = (xcd < r ? xcd * (q + 1) : r * (q + 1) + (xcd - r) * q) + off; }
        const int nig = WGM * nN, gid = wgid / nig, fm = gid * WGM, gsz = (nM - fm) < WGM ? (nM - fm) : WGM;
        u.pm = fm + ((wgid % nig) % gsz); u.pn = (wgid % nig) / gsz; return true;
    }
};
struct PieceOrder {
    int G, c;
    DI bool next(int i, Unit& u) const {
        const int pid = c + i * G; const int su = pid / 11;
        u.pm = 64 + (su >> 2); u.pn = su & 3; u.kt0 = (pid - su * 11) * 4; u.id = pid;
        return pid < 88;
    }
};
template <class Epi, class Sched, int NT>
DI void gemm_phase(LAS unsigned char* lds, const Gemm g, const Sched& S, const Epi& E) {
    int tid = threadIdx.x; asm volatile("" : "+v"(tid));
    const int wid = __builtin_amdgcn_readfirstlane(tid >> 6), lane = tid & 63, wr = wid >> 2, wc = wid & 3, fr = lane & 15, fq = lane >> 4;
    constexpr int nt = NT;
    unsigned voffA[2], voffB[2];
#pragma unroll
    for (int i = 0; i < 2; ++i) { int R, C; stage_rc(tid * 16 + i * 8192, R, C); const int Rb = Epi::PERM ? ((R & ~31) + perm32(R & 31)) : R;
        voffA[i] = (unsigned)(R * g.lda + C) * 2u; voffB[i] = (unsigned)(Rb * g.ldb + C) * 2u; }
    const size_t kstep = (size_t)(BK * 2);
    const size_t hstepA = (size_t)HALF * g.lda * 2, hstepB = (size_t)HALF * g.ldb * 2;
    const size_t tstepA = (size_t)g.mstep * g.lda * 2, tstepB = 2 * hstepB;
    const unsigned ldsw = (unsigned)wid * 1024u;
    const int aoff = lds_byte(wr * 64 + fr, fq * 8), boff = lds_byte(wc * 32 + fr, fq * 8);
#define PG8_SA(b, h) (((b) * 2 + (h)) * HTB)
#define PG8_SB(b, h) ((4 + (b) * 2 + (h)) * HTB)
#define PG8_STAGE(bufoff, gbase, voff) do { _Pragma("unroll") for (int _i = 0; _i < 2; ++_i) \
        __builtin_amdgcn_global_load_lds((const unsigned*)((const char*)(gbase) + (voff)[_i]), (LAS unsigned*)(lds + (bufoff) + ldsw + _i * 8192), 16, 0, 0); } while (0)
#define PG8_LDA(dst, b, h) do { _Pragma("unroll") for (int m = 0; m < 4; ++m) _Pragma("unroll") for (int k = 0; k < 2; ++k) dst[m][k] = *(const LAS bf16x8*)(lds + PG8_SA(b, h) + aoff + m * 2048 + k * 1024); } while (0)
#define PG8_LDB(dst, b, h) do { _Pragma("unroll") for (int n = 0; n < 2; ++n) _Pragma("unroll") for (int k = 0; k < 2; ++k) dst[n][k] = *(const LAS bf16x8*)(lds + PG8_SB(b, h) + boff + n * 2048 + k * 1024); } while (0)
#define PG8_MMA(ai, bj, At, Bt) do { __builtin_amdgcn_s_setprio(1); _Pragma("unroll") for (int m = 0; m < 4; ++m) _Pragma("unroll") for (int n = 0; n < 2; ++n) _Pragma("unroll") for (int k = 0; k < 2; ++k) \
        acc[ai][bj][m][n] = __builtin_amdgcn_mfma_f32_16x16x32_bf16(Bt[n][k], At[m][k], acc[ai][bj][m][n], 0, 0, 0); __builtin_amdgcn_s_setprio(0); } while (0)
#define PG8_WAIT_V(n) asm volatile("s_waitcnt vmcnt(" #n ")" ::: "memory")
#define PG8_WAIT_L(n) asm volatile("s_waitcnt lgkmcnt(" #n ")" ::: "memory")
#define PG8_BAR __builtin_amdgcn_s_barrier()
#define PG8_SCHED __builtin_amdgcn_sched_barrier(0)
    Unit cur, nxt; int ui = 0;
    if (!S.next(0, cur)) return;
    f32x4 acc[2][2][4][2];
#pragma unroll
    for (int a = 0; a < 2; ++a)
#pragma unroll
        for (int b = 0; b < 2; ++b)
#pragma unroll
            for (int m = 0; m < 4; ++m)
#pragma unroll
                for (int n = 0; n < 2; ++n) acc[a][b][m][n] = (f32x4){0.f, 0.f, 0.f, 0.f};
    bf16x8 At[4][2], B0[2][2], B1[2][2];
    const char* cA = (const char*)g.A + (size_t)cur.pm * tstepA + (size_t)cur.kt0 * kstep; const char* cB = (const char*)g.Bt + (size_t)cur.pn * tstepB + (size_t)cur.kt0 * kstep;
    PG8_STAGE(PG8_SB(0, 0), cB, voffB); PG8_STAGE(PG8_SA(0, 0), cA, voffA); PG8_STAGE(PG8_SB(0, 1), cB + hstepB, voffB); PG8_STAGE(PG8_SA(0, 1), cA + hstepA, voffA);
    if (wr == 1) PG8_BAR;
    PG8_WAIT_V(4); PG8_BAR;
    PG8_STAGE(PG8_SB(1, 0), cB + kstep, voffB); PG8_STAGE(PG8_SA(1, 0), cA + kstep, voffA); PG8_STAGE(PG8_SB(1, 1), cB + hstepB + kstep, voffB);
    PG8_WAIT_V(6); PG8_BAR;
    for (;;) {
        const bool has_next = S.next(ui + 1, nxt);
        const char* nA = has_next ? (const char*)g.A + (size_t)nxt.pm * tstepA + (size_t)nxt.kt0 * kstep : cA; const char* nB = has_next ? (const char*)g.Bt + (size_t)nxt.pn * tstepB + (size_t)nxt.kt0 * kstep : cB;
        for (int t = 0; t < nt; t += 2) {
            const bool last = (t == nt - 2);
            const char* a1 = cA + (size_t)(t + 1) * kstep;
            const char* a2 = last ? nA : cA + (size_t)(t + 2) * kstep; const char* b2 = last ? nB : cB + (size_t)(t + 2) * kstep;
            const char* a3 = a2 + kstep; const char* b3 = b2 + kstep;
            if constexpr (Epi::MIDK) { if (t == (nt >> 1)) E.mid(acc, cur, wr, wc, fr, fq); }
            PG8_LDB(B0, 0, 0); PG8_SCHED; PG8_LDA(At, 0, 0); PG8_STAGE(PG8_SA(1, 1), a1 + hstepA, voffA);
            PG8_WAIT_L(8); PG8_BAR; PG8_WAIT_L(0); PG8_MMA(0, 0, At, B0); PG8_BAR; PG8_SCHED;
            PG8_LDB(B1, 0, 1); PG8_STAGE(PG8_SB(0, 0), b2, voffB);
            PG8_BAR; PG8_WAIT_L(0); PG8_MMA(0, 1, At, B1); PG8_BAR;
            PG8_LDA(At, 0, 1); PG8_STAGE(PG8_SA(0, 0), a2, voffA);
            PG8_BAR; PG8_WAIT_L(0); PG8_MMA(1, 0, At, B0); PG8_BAR; PG8_SCHED;
            PG8_STAGE(PG8_SB(0, 1), b2 + hstepB, voffB);
            PG8_WAIT_V(6); PG8_BAR; PG8_MMA(1, 1, At, B1); PG8_BAR;
            PG8_LDB(B0, 1, 0); PG8_SCHED; PG8_LDA(At, 1, 0); PG8_STAGE(PG8_SA(0, 1), a2 + hstepA, voffA);
            PG8_WAIT_L(8); PG8_BAR; PG8_WAIT_L(0); PG8_MMA(0, 0, At, B0); PG8_BAR; PG8_SCHED;
            PG8_LDB(B1, 1, 1); PG8_STAGE(PG8_SB(1, 0), b3, voffB);
            PG8_BAR; PG8_WAIT_L(0); PG8_MMA(0, 1, At, B1); PG8_BAR;
            PG8_LDA(At, 1, 1); PG8_STAGE(PG8_SA(1, 0), a3, voffA);
            PG8_BAR; PG8_WAIT_L(0); PG8_MMA(1, 0, At, B0); PG8_BAR; PG8_SCHED;
            PG8_STAGE(PG8_SB(1, 1), b3 + hstepB, voffB);
            PG8_WAIT_V(6); PG8_BAR; PG8_MMA(1, 1, At, B1); PG8_BAR;
        }
        E(acc, cur, wr, wc, fr, fq);
        if (!has_next) break;
#pragma unroll
        for (int a = 0; a < 2; ++a)
#pragma unroll
            for (int b = 0; b < 2; ++b)
#pragma unroll
                for (int m = 0; m < 4; ++m)
#pragma unroll
                    for (int n = 0; n < 2; ++n) acc[a][b][m][n] = (f32x4){0.f, 0.f, 0.f, 0.f};
        cur = nxt; cA = nA; cB = nB; ++ui;
    }
    PG8_WAIT_V(0);
    if (wr == 0) PG8_BAR;
    PG8_BAR;
#undef PG8_SA
#undef PG8_SB
#undef PG8_STAGE
#undef PG8_LDA
#undef PG8_LDB
#undef PG8_MMA
#undef PG8_WAIT_V
#undef PG8_WAIT_L
#undef PG8_BAR
#undef PG8_SCHED
}
}
using pg8::Unit;
typedef f32x4 AccT[2][2][4][2];

struct EpiProj {
    static constexpr bool PERM = true, MIDK = false;
    unsigned char* ws; const float* rstd1; const float* bcum; const float* ropec; const float* ropes;
    DI void mid(AccT&, const Unit&, int, int, int, int) const {}
    DI void operator()(const AccT& acc, const Unit& u, int wr, int wc, int fr, int fq) const {
        const int pn = u.pn; int seg, pn0;
        if (pn < 8) { seg = pn >> 1; pn0 = seg * 2; } else if (pn == 8) { seg = 4; pn0 = 8; } else if (pn == 9) { seg = 5; pn0 = 9; }
        else if (pn < 12) { seg = 6; pn0 = 10; } else if (pn < 14) { seg = 7; pn0 = 12; } else if (pn < 18) { seg = 8; pn0 = 14; } else { seg = 9; pn0 = 18; }
        size_t segoff; int ld;
        switch (seg) { case 0: segoff = PQ_R; ld = 512; break; case 1: segoff = PK_R; ld = 512; break; case 2: segoff = PV_R; ld = 512; break; case 3: segoff = PG_R; ld = 512; break;
            case 4: segoff = PQ_G; ld = 256; break; case 5: segoff = PK_G; ld = 256; break; case 6: segoff = PV_G; ld = 512; break; case 7: segoff = PG_G; ld = 512; break;
            case 8: segoff = PM_R; ld = 1024; break; default: segoff = PM_G; ld = 1024; break; }
        bf16_t* base = (bf16_t*)(ws + segoff);
        const int lc0 = (pn - pn0) * 256 + wc * 32 + 8 * fq;
        const int row0 = u.pm * 256 + wr * 64 + fr;
        if (seg <= 1) {
            const int i0 = 16 * wc + 4 * fq;
            float lg2h[2];
#pragma unroll
            for (int bj = 0; bj < 2; ++bj) lg2h[bj] = log2f(1.f - exp2f(-5.f - (float)((pn - pn0) * 2 + bj)));
#pragma unroll
            for (int ai = 0; ai < 2; ++ai)
#pragma unroll
                for (int m = 0; m < 4; ++m) {
                    const int row = row0 + ai * 128 + m * 16; const float rs = rstd1[row];
                    int posidx, ic; if (row < TP) { posidx = row & 2047; ic = row & 63; } else { const int s = row - TP; posidx = 2048 + (s & 3); ic = s & 3; }
                    const f32x4 c4 = *(const f32x4*)(ropec + posidx * 64 + i0), s4 = *(const f32x4*)(ropes + posidx * 64 + i0);
#pragma unroll
                    for (int bj = 0; bj < 2; ++bj) {
                        const int head = (pn - pn0) * 2 + bj;
                        const float lg2 = lg2h[bj];
                        const float dec = (seg == 0) ? __builtin_amdgcn_exp2f((float)(ic + 1) * lg2) : __builtin_amdgcn_exp2f(-(float)(ic + 1) * lg2) * 0.08838834764831845f;
                        const f32x4 t1 = acc[ai][bj][m][0] * rs, t2 = acc[ai][bj][m][1] * rs;
                        const f32x4 o1 = (t1 * c4 - t2 * s4) * dec, o2 = (t1 * s4 + t2 * c4) * dec;
                        bf16_t* rp = base + (size_t)row * 512 + head * 128 + i0;
                        u32x2 w1, w2; w1.x = pk2(o1[0], o1[1]); w1.y = pk2(o1[2], o1[3]); w2.x = pk2(o2[0], o2[1]); w2.y = pk2(o2[2], o2[3]);
                        *(u32x2*)rp = w1; *(u32x2*)(rp + 64) = w2;
                    }
                }
            return;
        }
#pragma unroll
        for (int ai = 0; ai < 2; ++ai)
#pragma unroll
            for (int m = 0; m < 4; ++m) {
                const int row = row0 + ai * 128 + m * 16; const float rs = rstd1[row];
#pragma unroll
                for (int bj = 0; bj < 2; ++bj) {
                    const int lc = lc0 + bj * 128;
                    f32x4 v0 = acc[ai][bj][m][0] * rs, v1 = acc[ai][bj][m][1] * rs;
                    if (seg == 4 || seg == 5) {
                        const f32x4 b0 = *(const f32x4*)(bcum + (size_t)row * 256 + lc), b1 = *(const f32x4*)(bcum + (size_t)row * 256 + lc + 4);
                        if (seg == 4) {
#pragma unroll
                            for (int e = 0; e < 4; ++e) { v0[e] *= 0.125f * __expf(b0[e]); v1[e] *= 0.125f * __expf(b1[e]); }
                        } else {
#pragma unroll
                            for (int e = 0; e < 4; ++e) { v0[e] *= __expf(-b0[e]); v1[e] *= __expf(-b1[e]); }
                        }
                    } else if (seg == 3 || seg == 7) {
#pragma unroll
                        for (int e = 0; e < 4; ++e) { v0[e] = v0[e] * sigmoidf_(v0[e]); v1[e] = v1[e] * sigmoidf_(v1[e]); }
                    } else if (seg >= 8) {
#pragma unroll
                        for (int e = 0; e < 4; ++e) { v0[e] = sigmoidf_(v0[e]); v1[e] = sigmoidf_(v1[e]); }
                    }
                    u32x4 w; w.x = pk2(v0[0], v0[1]); w.y = pk2(v0[2], v0[3]); w.z = pk2(v1[0], v1[1]); w.w = pk2(v1[2], v1[3]);
                    __builtin_nontemporal_store(w, (u32x4*)(base + (size_t)row * ld + lc));
                }
            }
    }
};
struct EpiMix {
    static constexpr bool PERM = true, MIDK = true;
    const bf16_t* mr; const bf16_t* mg; bf16_t* mix;
    DI void mid(AccT& acc, const Unit& u, int wr, int wc, int fr, int fq) const {
        int row0 = u.pm * 256 + wr * 64 + fr, c0 = u.pn * 256 + wc * 32 + 8 * fq;
        asm volatile("" : "+v"(row0), "+v"(c0));
#pragma unroll
        for (int ai = 0; ai < 2; ++ai)
#pragma unroll
            for (int m = 0; m < 4; ++m) {
                const int row = row0 + ai * 128 + m * 16;
#pragma unroll
                for (int bj = 0; bj < 2; ++bj) {
                    const u32x4 a = *(const u32x4*)(mr + (size_t)row * 1024 + c0 + bj * 128), b = *(const u32x4*)(mg + (size_t)row * 1024 + c0 + bj * 128);
                    f32x4 r0, r1;
                    r0[0] = bflo(a.x) * __builtin_amdgcn_rcpf(fmaxf(bflo(b.x), 1e-30f)); r0[1] = bfhi(a.x) * __builtin_amdgcn_rcpf(fmaxf(bfhi(b.x), 1e-30f)); r0[2] = bflo(a.y) * __builtin_amdgcn_rcpf(fmaxf(bflo(b.y), 1e-30f)); r0[3] = bfhi(a.y) * __builtin_amdgcn_rcpf(fmaxf(bfhi(b.y), 1e-30f));
                    r1[0] = bflo(a.z) * __builtin_amdgcn_rcpf(fmaxf(bflo(b.z), 1e-30f)); r1[1] = bfhi(a.z) * __builtin_amdgcn_rcpf(fmaxf(bfhi(b.z), 1e-30f)); r1[2] = bflo(a.w) * __builtin_amdgcn_rcpf(fmaxf(bflo(b.w), 1e-30f)); r1[3] = bfhi(a.w) * __builtin_amdgcn_rcpf(fmaxf(bfhi(b.w), 1e-30f));
                    acc[ai][bj][m][0] *= r0; acc[ai][bj][m][1] *= r1;
                }
                __builtin_amdgcn_sched_barrier(0);
            }
    }
    DI void operator()(const AccT& acc, const Unit& u, int wr, int wc, int fr, int fq) const {
        const int row0 = u.pm * 256 + wr * 64 + fr, c0 = u.pn * 256 + wc * 32 + 8 * fq;
#pragma unroll
        for (int ai = 0; ai < 2; ++ai)
#pragma unroll
            for (int m = 0; m < 4; ++m) {
                const int row = row0 + ai * 128 + m * 16;
#pragma unroll
                for (int bj = 0; bj < 2; ++bj) {
                    const u32x4 b = *(const u32x4*)(mg + (size_t)row * 1024 + c0 + bj * 128);
                    const f32x4 v0 = acc[ai][bj][m][0], v1 = acc[ai][bj][m][1];
                    u32x4 w; w.x = pk2(v0[0] * bflo(b.x), v0[1] * bfhi(b.x)); w.y = pk2(v0[2] * bflo(b.y), v0[3] * bfhi(b.y));
                    w.z = pk2(v1[0] * bflo(b.z), v1[1] * bfhi(b.z)); w.w = pk2(v1[2] * bflo(b.w), v1[3] * bfhi(b.w));
                    *(u32x4*)(mix + (size_t)row * 1024 + c0 + bj * 128) = w;
                }
            }
    }
};
struct EpiH {
    static constexpr bool PERM = true, MIDK = false;
    const float* xp; const float* xs; float* h; bf16_t* hb; float* ssq;
    DI void mid(AccT&, const Unit&, int, int, int, int) const {}
    DI void operator()(const AccT& acc, const Unit& u, int wr, int wc, int fr, int fq) const {
        const int row0 = u.pm * 256 + wr * 64 + fr, c0 = u.pn * 256 + wc * 32 + 8 * fq;
#pragma unroll
        for (int ai = 0; ai < 2; ++ai)
#pragma unroll
            for (int m = 0; m < 4; ++m) {
                const int row = row0 + ai * 128 + m * 16;
                const float* xr = row < TP ? xp + (size_t)row * DM : xs + (size_t)(row - TP) * DM;
                float ss = 0.f;
#pragma unroll
                for (int bj = 0; bj < 2; ++bj) {
                    const int c = c0 + bj * 128;
                    const f32x4 v0 = acc[ai][bj][m][0] + *(const f32x4*)(xr + c), v1 = acc[ai][bj][m][1] + *(const f32x4*)(xr + c + 4);
                    u32x4 w; w.x = pk2(v0[0], v0[1]); w.y = pk2(v0[2], v0[3]); w.z = pk2(v1[0], v1[1]); w.w = pk2(v1[2], v1[3]);
                    *(u32x4*)(hb + (size_t)row * DM + c) = w;
                    ss += v0[0] * v0[0] + v0[1] * v0[1] + v0[2] * v0[2] + v0[3] * v0[3] + v1[0] * v1[0] + v1[1] * v1[1] + v1[2] * v1[2] + v1[3] * v1[3];
                }
                ss += __shfl_xor(ss, 16); ss += __shfl_xor(ss, 32);
                if (fq == 0) unsafeAtomicAdd(ssq + row, ss);
            }
    }
};
DI f32x2 gelu_pk(f32x2 v) {
    const f32x2 av = __builtin_elementwise_abs(v), d = av * 0.2316418882f + 1.0f;
    f32x2 t; t.x = __builtin_amdgcn_rcpf(d.x); t.y = __builtin_amdgcn_rcpf(d.y);
    f32x2 q = t * 0.5307027145f + (-0.7265760135f); q = q * t + 0.7107068705f; q = q * t + (-0.142248368f); q = q * t + 0.127414796f; q = q * t;
    const f32x2 s = (v * v) * (-0.72134752044f);
    f32x2 e; e.x = __builtin_amdgcn_exp2f(s.x); e.y = __builtin_amdgcn_exp2f(s.y);
    const f32x2 m = v * (q * e), r = v - m;
    f32x2 o; o.x = v.x < 0.f ? m.x : r.x; o.y = v.y < 0.f ? m.y : r.y; return o;
}
#define DPPF(old_, src_, ctrl_) __int_as_float(__builtin_amdgcn_update_dpp(__float_as_int(old_), __float_as_int(src_), (ctrl_), 0xf, 0xf, false))
struct EpiUpConv {
    static constexpr bool PERM = true, MIDK = false;
    const float* ssq; bf16_t* act; const float* cw; const float* cb; const float* cache; float* out; LAS float* xch;
    DI void mid(AccT&, const Unit&, int, int, int, int) const {}
    DI void operator()(const AccT& acc, const Unit& u, int wr, int wc, int fr, int fq) const {
        const int tokbase = u.pm * 254 - 2, cl = wc * 32 + 8 * fq, f0 = u.pn * 128 + cl;
        float sq[2][4];
#pragma unroll
        for (int ai = 0; ai < 2; ++ai)
#pragma unroll
            for (int m = 0; m < 4; ++m) { const int tok = tokbase + ai * 128 + wr * 64 + m * 16 + fr; sq[ai][m] = (tok >= 0 && tok < T_TOK) ? ssq[tok] : -1.f; }
        f32x4 cb4[2], w04[2], w14[2], w24[2];
#pragma unroll
        for (int n = 0; n < 2; ++n) { cb4[n] = *(const f32x4*)(cb + f0 + 4 * n); w04[n] = *(const f32x4*)(cw + f0 + 4 * n); w14[n] = *(const f32x4*)(cw + DFF + f0 + 4 * n); w24[n] = *(const f32x4*)(cw + 2 * DFF + f0 + 4 * n); }
        float rs[2][4];
#pragma unroll
        for (int ai = 0; ai < 2; ++ai)
#pragma unroll
            for (int m = 0; m < 4; ++m) rs[ai][m] = sq[ai][m] >= 0.f ? rsqrtf(sq[ai][m] * (1.f / DM) + EPS) : 0.f;
        if (fr >= 14) {
#pragma unroll
            for (int ai = 0; ai < 2; ++ai) { LAS float* xp = xch + ((2 * ai + wr) * 2 + (fr - 14)) * 128 + cl;
                *(LAS f32x4*)xp = acc[ai][0][3][0] * rs[ai][3]; *(LAS f32x4*)(xp + 4) = acc[ai][0][3][1] * rs[ai][3]; }
        }
        asm volatile("s_waitcnt lgkmcnt(0)" ::: "memory"); __builtin_amdgcn_s_barrier(); if (wr == 0) __builtin_amdgcn_s_barrier(); asm volatile("" ::: "memory");
        const bool samp_tile = (tokbase + 255 >= TP);
#pragma unroll
        for (int ai = 0; ai < 2; ++ai) {
            const int g = 2 * ai + wr;
            f32x4 prev[2];
#pragma unroll
            for (int m = 0; m < 4; ++m) {
                const int i = ai * 128 + wr * 64 + m * 16 + fr, tok = tokbase + i;
                int l; const bool samp = tok >= TP;
                if (!samp) l = tok & 2047; else l = (tok - TP) & 3;
                u32x4 w; f32x4 curs[2];
#pragma unroll
                for (int n = 0; n < 2; ++n) {
                    const f32x4 cur = acc[ai][0][m][n] * rs[ai][m], vv = acc[ai][1][m][n] * rs[ai][m];
                    f32x4 x1, x2;
                    if (m == 0) {
                        f32x4 h1 = {0.f, 0.f, 0.f, 0.f}, h2 = {0.f, 0.f, 0.f, 0.f};
                        if (g >= 1) { h1 = *(const LAS f32x4*)(xch + ((g - 1) * 2 + 1) * 128 + cl + 4 * n); h2 = *(const LAS f32x4*)(xch + ((g - 1) * 2 + (fr == 0 ? 0 : 1)) * 128 + cl + 4 * n); }
#pragma unroll
                        for (int e = 0; e < 4; ++e) { x1[e] = DPPF(h1[e], cur[e], 0x111); x2[e] = DPPF(h2[e], cur[e], 0x112); }
                    } else {
#pragma unroll
                        for (int e = 0; e < 4; ++e) { const float o1 = DPPF(0.f, prev[n][e], 0x121), o2 = DPPF(0.f, prev[n][e], 0x122);
                            x1[e] = DPPF(o1, cur[e], 0x111); x2[e] = DPPF(o2, cur[e], 0x112); }
                    }
                    prev[n] = cur; curs[n] = cur;
                    if (l < 2) {
                        if (samp_tile && samp) {
                            const int bidx = (tok - TP) >> 2;
                            if (tok < T_TOK) { const f32x4 c1 = *(const f32x4*)(cache + ((size_t)bidx * 2 + 1) * DFF + f0 + 4 * n), c0 = *(const f32x4*)(cache + ((size_t)bidx * 2 + l) * DFF + f0 + 4 * n);
                                x2 = c0; if (l == 0) x1 = c1; }
                        } else { x2 = (f32x4){0.f, 0.f, 0.f, 0.f}; if (l == 0) x1 = x2; }
                    }
                    const f32x4 uc = cb4[n] + w04[n] * x2 + w14[n] * x1 + w24[n] * cur;
                    const f32x2 ga = gelu_pk((f32x2){uc[0], uc[1]}), gb = gelu_pk((f32x2){uc[2], uc[3]});
                    const unsigned p0 = pk2(ga.x * vv[0], ga.y * vv[1]), p1 = pk2(gb.x * vv[2], gb.y * vv[3]);
                    if (n == 0) { w.x = p0; w.y = p1; } else { w.z = p0; w.w = p1; }
                }
                if (i >= 2 && tok < T_TOK) {
                    *(u32x4*)(act + (size_t)tok * DFF + f0) = w;
                    if (!samp) { if (l >= 2046) { float* o = out + OUT_CP + ((size_t)(tok >> 11) * 2 + (l - 2046)) * DFF + f0; *(f32x4*)o = curs[0]; *(f32x4*)(o + 4) = curs[1]; } }
                    else if (l >= 2) { float* o = out + OUT_CS + ((size_t)((tok - TP) >> 2) * 2 + (l - 2)) * DFF + f0; *(f32x4*)o = curs[0]; *(f32x4*)(o + 4) = curs[1]; }
                }
            }
        }
        if (wr == 1) { asm volatile("" ::: "memory"); __builtin_amdgcn_s_barrier(); }
    }
};

struct EpiDownNorm {
    static constexpr bool PERM = true, MIDK = false;
    const bf16_t* hb; float* y; const float* lnf; float* exch; unsigned* cnt; LAS float* xl;
    DI void mid(AccT&, const Unit&, int, int, int, int) const {}
    DI void operator()(const AccT& acc_, const Unit& u, int wr, int wc, int fr, int fq) const {
        AccT& acc = const_cast<AccT&>(acc_);
        const int lrow0 = wr * 64 + fr; int row0 = u.pm * 256 + lrow0, c0 = u.pn * 256 + wc * 32 + 8 * fq;
        asm volatile("" : "+v"(row0), "+v"(c0));
#pragma unroll
        for (int ai = 0; ai < 2; ++ai)
#pragma unroll
            for (int m = 0; m < 4; ++m) {
                const int row = row0 + ai * 128 + m * 16;
                float ss = 0.f;
#pragma unroll
                for (int bj = 0; bj < 2; ++bj) {
                    const u32x4 hv = *(const u32x4*)(hb + (size_t)row * DM + c0 + bj * 128);
                    f32x4 v0 = acc[ai][bj][m][0], v1 = acc[ai][bj][m][1];
                    v0[0] += bflo(hv.x); v0[1] += bfhi(hv.x); v0[2] += bflo(hv.y); v0[3] += bfhi(hv.y); v1[0] += bflo(hv.z); v1[1] += bfhi(hv.z); v1[2] += bflo(hv.w); v1[3] += bfhi(hv.w);
                    acc[ai][bj][m][0] = v0; acc[ai][bj][m][1] = v1;
                    ss += v0[0] * v0[0] + v0[1] * v0[1] + v0[2] * v0[2] + v0[3] * v0[3] + v1[0] * v1[0] + v1[1] * v1[1] + v1[2] * v1[2] + v1[3] * v1[3];
                }
                ss += __shfl_xor(ss, 16); ss += __shfl_xor(ss, 32);
                if (fq == 0) xl[(lrow0 + ai * 128 + m * 16) * 4 + wc] = ss;
            }
        unsigned* pc = cnt + u.pm * 32;
#define G5_PUBLISH() do { if (wc == 0) { \
            if (fq == 0) { \
                _Pragma("unroll") for (int ai = 0; ai < 2; ++ai) _Pragma("unroll") for (int m = 0; m < 4; ++m) { const int lr = lrow0 + ai * 128 + m * 16; const f32x4 q = *(const LAS f32x4*)(xl + lr * 4); \
                    __hip_atomic_store(exch + (size_t)(u.pm * 256 + lr) * 4 + u.pn, (q[0] + q[1]) + (q[2] + q[3]), __ATOMIC_RELAXED, __HIP_MEMORY_SCOPE_AGENT); } } \
            asm volatile("s_waitcnt vmcnt(0)" ::: "memory"); \
            __builtin_amdgcn_fence(__ATOMIC_RELEASE, "agent"); \
            asm volatile("s_waitcnt vmcnt(0)" ::: "memory"); \
            if (fr == 0 && fq == 0) __hip_atomic_fetch_add(pc, 1u, __ATOMIC_RELAXED, __HIP_MEMORY_SCOPE_AGENT); } } while (0)
        asm volatile("s_waitcnt lgkmcnt(0)" ::: "memory"); __builtin_amdgcn_s_barrier(); asm volatile("" ::: "memory");
        if (wr == 1) G5_PUBLISH();
        if (wr == 0) { asm volatile("s_waitcnt lgkmcnt(0)" ::: "memory"); __builtin_amdgcn_s_barrier(); asm volatile("" ::: "memory"); G5_PUBLISH(); }
#undef G5_PUBLISH
        {
            unsigned spins = 0;
            while (__hip_atomic_load(pc, __ATOMIC_RELAXED, __HIP_MEMORY_SCOPE_AGENT) < 8u && ++spins < (1u << 18)) __builtin_amdgcn_s_sleep(16);
            __builtin_amdgcn_fence(__ATOMIC_ACQUIRE, "agent"); }
        asm volatile("" : "+v"(row0), "+v"(c0));
#pragma unroll
        for (int ai = 0; ai < 2; ++ai)
#pragma unroll
            for (int m = 0; m < 4; ++m) {
                const int row = row0 + ai * 128 + m * 16;
                f32x4 q;
                q[0] = __hip_atomic_load(exch + (size_t)row * 4 + 0, __ATOMIC_RELAXED, __HIP_MEMORY_SCOPE_AGENT); q[1] = __hip_atomic_load(exch + (size_t)row * 4 + 1, __ATOMIC_RELAXED, __HIP_MEMORY_SCOPE_AGENT);
                q[2] = __hip_atomic_load(exch + (size_t)row * 4 + 2, __ATOMIC_RELAXED, __HIP_MEMORY_SCOPE_AGENT); q[3] = __hip_atomic_load(exch + (size_t)row * 4 + 3, __ATOMIC_RELAXED, __HIP_MEMORY_SCOPE_AGENT);
                const float rs = rsqrtf(((q[0] + q[1]) + (q[2] + q[3])) * (1.f / DM) + EPS);
#pragma unroll
                for (int bj = 0; bj < 2; ++bj) {
                    const int c = c0 + bj * 128;
                    const f32x4 g0 = *(const f32x4*)(lnf + c), g1 = *(const f32x4*)(lnf + c + 4);
                    *(f32x4*)(y + (size_t)row * DM + c) = acc[ai][bj][m][0] * rs * g0; *(f32x4*)(y + (size_t)row * DM + c + 4) = acc[ai][bj][m][1] * rs * g1;
                }
            }
        if (wr == 1) { asm volatile("" ::: "memory"); __builtin_amdgcn_s_barrier(); }
    }
};
struct EpiPart {
    static constexpr bool PERM = true, MIDK = false;
    bf16_t* part;
    DI void mid(AccT&, const Unit&, int, int, int, int) const {}
    DI void operator()(const AccT& acc, const Unit& u, int wr, int wc, int fr, int fq) const {
        bf16_t* base = part + (size_t)u.id * 65536 + (wr * 64 + fr) * 256 + wc * 32 + 8 * fq;
#pragma unroll
        for (int ai = 0; ai < 2; ++ai)
#pragma unroll
            for (int m = 0; m < 4; ++m)
#pragma unroll
                for (int bj = 0; bj < 2; ++bj) { const f32x4 v0 = acc[ai][bj][m][0], v1 = acc[ai][bj][m][1];
                    u32x4 w; w.x = pk2(v0[0], v0[1]); w.y = pk2(v0[2], v0[3]); w.z = pk2(v1[0], v1[1]); w.w = pk2(v1[2], v1[3]);
                    *(u32x4*)(base + (ai * 128 + m * 16) * 256 + bj * 128) = w; }
    }
};

DI void transpose_item(const float* __restrict__ src, int ldsrc, int srccol, int k0, const float* __restrict__ scale, bf16_t* dst, int lddst, int n0dst, int k0dst,
                       LAS float* scr, int lane) {
    float tv[32];
#pragma unroll
    for (int i = 0; i < 32; ++i) { const int kk = 2 * i + (lane >> 5); tv[i] = src[(size_t)(k0 + kk) * ldsrc + srccol]; }
    if (scale) {
#pragma unroll
        for (int i = 0; i < 32; ++i) tv[i] *= scale[k0 + 2 * i + (lane >> 5)];
    }
#pragma unroll
    for (int i = 0; i < 32; ++i) scr[(2 * i + (lane >> 5)) * 33 + (lane & 31)] = tv[i];
    LDS_WAIT();
    const int c = lane & 7;
#pragma unroll
    for (int j = 0; j < 4; ++j) { const int n = (lane >> 3) + 8 * j; const LAS float* s = scr + (8 * c) * 33 + n;
        u32x4 o; o.x = pk2(s[0 * 33], s[1 * 33]); o.y = pk2(s[2 * 33], s[3 * 33]); o.z = pk2(s[4 * 33], s[5 * 33]); o.w = pk2(s[6 * 33], s[7 * 33]);
        *(u32x4*)(dst + (size_t)(n0dst + n) * lddst + k0dst + 8 * c) = o; }
    LDS_WAIT();
}
DI float log_sigmoid(float z) { return fminf(z, 0.f) - __logf(1.f + __expf(-fabsf(z))); }


template <int RG> DI void xpass_unit(const Params& p, LAS unsigned char* lds, const int tok0, const int tid_, bf16_t* xb, float* rstd1, float* bcum, float* ebl) {
    constexpr int KS = 8 / RG, TU = 16 * RG, NKS = 32 / KS, HT = TU / 2;
    int tid = tid_; asm volatile("" : "+v"(tid));
    const int lane = tid & 63, wave = tid >> 6;
    LAS bf16_t* wga = (LAS bf16_t*)lds;
    LAS float* gas = (LAS float*)(lds + 33024);
    LAS float* accp = (LAS float*)(lds + 41216);
    LAS float* ssp = accp + 2048;
    LAS float* tot = ssp + 128;
    const int r16 = lane & 15, kq = lane >> 4, rg = wave % RG, kh = wave / RG, row = tok0 + rg * 16 + r16;
    const float* xr = x_row(p, row) + kh * (32 * NKS);
    bf16_t* xbr = xb + (size_t)row * DM + kh * (32 * NKS);
    const LAS bf16_t* wgr = wga + r16 * 1032 + kh * (32 * NKS);
    f32x4 acc = {0.f, 0.f, 0.f, 0.f}; float ss = 0.f;
    constexpr int BQ = NKS < 8 ? NKS : 8;
    for (int ks = 0; ks < NKS; ks += BQ) {
        f32x4 v[BQ][2];
#pragma unroll
        for (int q = 0; q < BQ; ++q) { v[q][0] = *(const f32x4*)(xr + (ks + q) * 32 + kq * 8); v[q][1] = *(const f32x4*)(xr + (ks + q) * 32 + kq * 8 + 4); }
#pragma unroll
        for (int q = 0; q < BQ; ++q) {
            const f32x4 a0 = v[q][0], a1 = v[q][1];
            ss += a0[0] * a0[0] + a0[1] * a0[1] + a0[2] * a0[2] + a0[3] * a0[3] + a1[0] * a1[0] + a1[1] * a1[1] + a1[2] * a1[2] + a1[3] * a1[3];
            u32x4 w; w.x = pk2(a0[0], a0[1]); w.y = pk2(a0[2], a0[3]); w.z = pk2(a1[0], a1[1]); w.w = pk2(a1[2], a1[3]);
            *(u32x4*)(xbr + (ks + q) * 32 + kq * 8) = w;
            const bf16x8 bfrag = *(const LAS bf16x8*)(wgr + (ks + q) * 32 + kq * 8);
            acc = __builtin_amdgcn_mfma_f32_16x16x32_bf16(__builtin_bit_cast(bf16x8, w), bfrag, acc, 0, 0, 0);
        }
    }
    ss += __shfl_xor(ss, 16); ss += __shfl_xor(ss, 32);
    if (kq == 0) ssp[kh * TU + rg * 16 + r16] = ss;
#pragma unroll
    for (int j = 0; j < 4; ++j) accp[(kh * TU + rg * 16 + kq * 4 + j) * 16 + r16] = acc[j];
    __syncthreads();
    for (int idx = tid; idx < TU * 16; idx += 512) { const int lr = idx >> 4;
        float sq = 0.f, a = 0.f;
#pragma unroll
        for (int k = 0; k < KS; ++k) { sq += ssp[k * TU + lr]; a += accp[k * TU * 16 + idx]; }
        const float rs = rsqrtf(sq * (1.f / DM) + EPS);
        gas[idx] = a * rs;
        if ((idx & 15) == 0) rstd1[tok0 + lr] = rs; }
    __syncthreads();
    {
        const int c = tid & 255, half = tid >> 8;
        float wg[16];
#pragma unroll
        for (int r = 0; r < 16; ++r) wg[r] = p.w_gate_up[r * 256 + c];
        const float bias = p.b_gate_up[c];
        const int tokb = tok0 + half * HT; const bool samp = tokb >= TP;
        float ls[HT]; float cum = 0.f;
#pragma unroll
        for (int i = 0; i < HT; ++i) {
            const LAS f32x4* gp = (const LAS f32x4*)(gas + (half * HT + i) * 16);
            const f32x4 g0 = gp[0], g1 = gp[1], g2 = gp[2], g3 = gp[3];
            float z = bias;
            z += g0[0] * wg[0] + g0[1] * wg[1] + g0[2] * wg[2] + g0[3] * wg[3] + g1[0] * wg[4] + g1[1] * wg[5] + g1[2] * wg[6] + g1[3] * wg[7];
            z += g2[0] * wg[8] + g2[1] * wg[9] + g2[2] * wg[10] + g2[3] * wg[11] + g3[0] * wg[12] + g3[1] * wg[13] + g3[2] * wg[14] + g3[3] * wg[15];
            ls[i] = log_sigmoid(z) * (1.f / 16.f); cum += ls[i];
        }
        if (half == 0) tot[c] = cum;
        __syncthreads();
        cum = (half == 1 && !samp) ? tot[c] : 0.f;
#pragma unroll
        for (int i = 0; i < HT; ++i) {
            cum = (samp && (i & 3) == 0) ? ls[i] : cum + ls[i];
            const int tok = tokb + i;
            bcum[(size_t)tok * 256 + c] = cum;
            if (samp) { if ((i & 3) == 3) ebl[(size_t)(256 + ((tok - TP) >> 2)) * 256 + c] = expf(cum); }
            else if (half == 1 && i == HT - 1) ebl[(size_t)(tok >> 6) * 256 + c] = expf(cum);
        }
    }
    __syncthreads();
}

constexpr int W_I_IN = 16 * 176, W_I_MX = 8 * 32, W_I_O = 16 * 32, W_I_UP = 16 * 176, W_I_DN = 44 * 32, W_NIT = W_I_IN + 2 * W_I_MX + W_I_O + W_I_UP + W_I_DN;
DI void weight_items(const Params& p, LAS unsigned char* lds, const int gw, const int ngw, const int it_lo, const int it_hi) {
    int tid = threadIdx.x; asm volatile("" : "+v"(tid));
    const int lane = tid & 63, wave = tid >> 6;
    unsigned char* ws = p.ws;
    LAS float* scr = (LAS float*)(lds + 41216 + wave * 8448);
    constexpr int I_IN = W_I_IN, I_MX = W_I_MX, I_O = W_I_O, I_UP = W_I_UP;
    for (int it = it_lo + gw; it < it_hi; it += ngw) {
        int r = it; const int nl = lane & 31;
        if (r < I_IN) { const int kb = r / 176, nb = r % 176, n = nb * 32 + nl; int sc;
            if (n < 1024) { const int pp = n & 127; sc = (n & ~127) + (((pp & 7) < 4) ? 4 * (pp >> 3) + (pp & 7) : 64 + 4 * (pp >> 3) + (pp & 7) - 4); }
            else sc = n < 3584 ? n : n + 16;
            transpose_item(p.w_in, DIN, sc, kb * 64, p.ln1, (bf16_t*)(ws + WS_WIN), DM, nb * 32, kb * 64, scr, lane); continue; }
        r -= I_IN;
        if (r < I_MX) { const int kb = r / 32, nb = r % 32; transpose_item(p.w_ret_out, DM, nb * 32 + nl, kb * 64, nullptr, (bf16_t*)(ws + WS_WMIX), DM, nb * 32, kb * 64, scr, lane); continue; }
        r -= I_MX;
        if (r < I_MX) { const int kb = r / 32, nb = r % 32; transpose_item(p.w_gla_out, DM, nb * 32 + nl, kb * 64, nullptr, (bf16_t*)(ws + WS_WMIX), DM, nb * 32, 512 + kb * 64, scr, lane); continue; }
        r -= I_MX;
        if (r < I_O) { const int kb = r / 32, nb = r % 32; transpose_item(p.w_o, DM, nb * 32 + nl, kb * 64, nullptr, (bf16_t*)(ws + WS_WO), DM, nb * 32, kb * 64, scr, lane); continue; }
        r -= I_O;
        if (r < I_UP) { const int kb = r / 176, nb = r % 176, n = nb * 32 + nl; const int sc = ((n >> 7) & 1) * DFF + (n >> 8) * 128 + (n & 127);
            transpose_item(p.w_up, NUP, sc, kb * 64, p.ln2, (bf16_t*)(ws + WS_WUP), DM, nb * 32, kb * 64, scr, lane); continue; }
        r -= I_UP;
        { const int kb = r / 32, nb = r % 32; transpose_item(p.w_down, DM, nb * 32 + nl, kb * 64, nullptr, (bf16_t*)(ws + WS_WDN), DFF, nb * 32, kb * 64, scr, lane); }
    }
}

DI void phase0(const Params& p, LAS unsigned char* lds) {
    int tid = threadIdx.x; asm volatile("" : "+v"(tid));
    const int lane = tid & 63, wave = tid >> 6;
    unsigned char* ws = p.ws;
    LAS bf16_t* wga = (LAS bf16_t*)lds;
    LAS float* gas = (LAS float*)(lds + 33024);
    LAS float* scr = (LAS float*)(lds + 41216 + wave * 8448);
    bf16_t* xb = (bf16_t*)((unsigned char*)p.out + 0);
    float* rstd1 = (float*)(ws + WS_RSTD1); float* bcum = (float*)(ws + WS_SH); float* ebl = (float*)(ws + WS_EBL);
    { const int gt = blockIdx.x * 512 + tid, ng = gridDim.x * 512;
      float* ssq2 = (float*)(ws + WS_SSQ2);
      for (int i = gt; i < T_TOK; i += ng) ssq2[i] = 0.f;
      float* rc = (float*)(ws + WS_ROPEC); float* rsn = (float*)(ws + WS_ROPES);
      for (int i = gt; i < 2052 * 64; i += ng) { const int pi = i >> 6, fi = i & 63; const double pos = (double)(pi < 2048 ? pi : 16384 + (pi - 2048));
          const double inv = exp(-(double)fi * (9.210340371976184 / 64.0)); const double ang = pos * inv; const double kk = rint(ang * 0.15915494309189535);
          const float r = (float)(ang - kk * 6.283185307179586); rc[i] = cosf(r); rsn[i] = sinf(r); } }
    {
        LAS float* accp = (LAS float*)(lds + 41216);
        LAS float* ssp = accp + 2048;
        LAS float* tot = ssp + 128;
        for (int k = tid; k < DM; k += 512) { const float g = p.ln1[k]; const float* s = p.w_in + (size_t)k * DIN + 3584;
            const f32x4 s0 = *(const f32x4*)s, s1 = *(const f32x4*)(s + 4), s2 = *(const f32x4*)(s + 8), s3 = *(const f32x4*)(s + 12);
            const float sv[16] = {s0[0], s0[1], s0[2], s0[3], s1[0], s1[1], s1[2], s1[3], s2[0], s2[1], s2[2], s2[3], s3[0], s3[1], s3[2], s3[3]};
#pragma unroll
            for (int r = 0; r < 16; r += 2) { const unsigned w = pk2(sv[r] * g, sv[r + 1] * g); wga[r * 1032 + k] = (bf16_t)(w & 0xffffu); wga[(r + 1) * 1032 + k] = (bf16_t)(w >> 16); } }
        __syncthreads();
        for (int u = blockIdx.x; u < 256; u += gridDim.x) xpass_unit<4>(p, lds, u * 64, tid, xb, rstd1, bcum, ebl);
        for (int u = blockIdx.x; u < 32; u += gridDim.x) xpass_unit<1>(p, lds, TP + u * 16, tid, xb, rstd1, bcum, ebl);
    }
    weight_items(p, lds, blockIdx.x * 8 + wave, gridDim.x * 8, 0, gridDim.x == 256 ? 16 * 176 : W_NIT);
}

template <int DK> DI unsigned img_off(int row, int ch) { return (unsigned)(row * (2 * DK) + 16 * (ch ^ ((((row & 3) << 2) | ((row >> 2) & 3)) & (DK / 8 - 1)))); }
template <int DK> DI unsigned tr_addr(int lane, int c, int ks, int t) {
    const int h = lane >> 5, blk = (lane >> 4) & 1, q = (lane & 15) >> 2, pp = lane & 3;
    return img_off<DK>(16 * ks + 8 * h + 4 * t + q, 4 * c + 2 * blk + (pp >> 1)) + 8 * (pp & 1);
}
DI bf16x8 tr_frag(LAS unsigned char* a0, LAS unsigned char* a1) {
    const s16x4 lo = __builtin_amdgcn_ds_read_tr16_b64_v4i16((LAS s16x4*)a0), hi = __builtin_amdgcn_ds_read_tr16_b64_v4i16((LAS s16x4*)a1);
    return __builtin_shufflevector(lo, hi, 0, 1, 2, 3, 4, 5, 6, 7);
}
DI bf16x8 pack8(const f32x16& x, int s) {
    u32x4 w; w.x = pk2(x[8 * s + 0], x[8 * s + 1]); w.y = pk2(x[8 * s + 2], x[8 * s + 3]); w.z = pk2(x[8 * s + 4], x[8 * s + 5]); w.w = pk2(x[8 * s + 6], x[8 * s + 7]);
    return __builtin_bit_cast(bf16x8, w);
}
#define MFMA32(a, b, c) __builtin_amdgcn_mfma_f32_32x32x16_bf16((a), (b), (c), 0, 0, 0)

constexpr int P2_BUF = 49152, P2_QO = 0, P2_KO = 16384, P2_VO = 32768, P2_P = 98304, P2_SSQ = P2_P + 64 * 144, P2_EBL = P2_SSQ + 1024;

template <int DK, bool FULL> DI void chain_prompt(const Params& p, LAS unsigned char* lds, const int branch, const int b, const int head, const int c0, const int nc, const int nprev, const bool write_final) {
    constexpr int NDB = DK / 32, NCH = DK / 8, QLD = 4 * DK, NQI = (64 * NCH) / 512;
    int tid0 = threadIdx.x; asm volatile("" : "+v"(tid0));
    const int w = __builtin_amdgcn_readfirstlane(tid0 >> 6);
    int tid = tid0, lane = tid0 & 63, h = lane >> 5, r = lane & 31;
    unsigned char* ws = p.ws;
    const bf16_t* Q = (const bf16_t*)(ws + (branch == 0 ? PQ_R : PQ_G)) + head * DK;
    const bf16_t* K = (const bf16_t*)(ws + (branch == 0 ? PK_R : PK_G)) + head * DK;
    const bf16_t* V = (const bf16_t*)(ws + (branch == 0 ? PV_R : PV_G)) + head * 128;
    const bf16_t* G = (const bf16_t*)(ws + (branch == 0 ? PG_R : PG_G)) + head * 128;
    const float* ebl = (const float*)(ws + WS_EBL);
    bf16_t* arg = (bf16_t*)((unsigned char*)p.out + SEG1024) + branch * 512 + head * 128;
    const float* gain = (branch == 0 ? p.g_ret : p.g_gla) + head * 128;
    const int tok0 = b * 2048;
    const float lg2 = log2f(1.f - exp2f(-5.f - (float)head));
    const float ret_ebl = exp2f(64.f * lg2);
    const int chain = branch * 32 + b * 4 + head;
    float* Lbuf = (float*)p.out + (size_t)chain * 3 * 16384;
    float* Dbuf = (float*)p.out + (size_t)64 * 3 * 16384 + (size_t)chain * 3 * 64;
    f32x16 S[NDB];
#pragma unroll
    for (int d = 0; d < NDB; ++d)
#pragma unroll
        for (int i = 0; i < 16; ++i) S[d][i] = 0.f;
    f32x4 gn[4];
    if (w < 4) {
#pragma unroll
        for (int g = 0; g < 4; ++g) gn[g] = *(const f32x4*)(gain + 32 * w + 8 * g + 4 * h);
        if (FULL) {
            for (int sg = 0; sg < nprev; ++sg) {
#pragma unroll
                for (int d = 0; d < NDB; ++d)
#pragma unroll
                    for (int i = 0; i < 16; ++i) {
                        const int dd = 32 * d + (i & 3) + 8 * (i >> 2) + 4 * h;
                        const float dec = (DK == 128) ? exp2f(64.f * (float)nc * lg2) : Dbuf[sg * 64 + dd];
                        S[d][i] = (sg == 0 ? 0.f : S[d][i] * dec) + Lbuf[(size_t)sg * 16384 + (size_t)dd * 128 + 32 * w + r];
                    }
            }
        }
    }
    float dprod = 1.f;
    u32x4 rq[NQI], rk[NQI], rv[2]; float rebl = 0.f;
#define P2_LOAD(c) do { const int tb = tok0 + 64 * (c); \
        _Pragma("unroll") for (int i = 0; i < NQI; ++i) { const int idx = tid + 512 * i, rr = idx / NCH, ch = idx % NCH; \
            rq[i] = *(const u32x4*)(Q + (size_t)(tb + rr) * QLD + ch * 8); rk[i] = *(const u32x4*)(K + (size_t)(tb + rr) * QLD + ch * 8); } \
        _Pragma("unroll") for (int i = 0; i < 2; ++i) { const int idx = tid + 512 * i, rr = idx >> 4, ch = idx & 15; rv[i] = *(const u32x4*)(V + (size_t)(tb + rr) * 512 + ch * 8); } \
        if (DK == 64 && tid < 64) rebl = ebl[(size_t)(b * 32 + (c)) * 256 + head * 64 + tid]; } while (0)
#define P2_STORE(buf) do { LAS unsigned char* bb = lds + (buf) * P2_BUF; \
        _Pragma("unroll") for (int i = 0; i < NQI; ++i) { const int idx = tid + 512 * i, rr = idx / NCH, ch = idx % NCH; \
            *(LAS u32x4*)(bb + P2_QO + img_off<DK>(rr, ch)) = rq[i]; *(LAS u32x4*)(bb + P2_KO + img_off<DK>(rr, ch)) = rk[i]; } \
        _Pragma("unroll") for (int i = 0; i < 2; ++i) { const int idx = tid + 512 * i, rr = idx >> 4, ch = idx & 15; *(LAS u32x4*)(bb + P2_VO + img_off<128>(rr, ch)) = rv[i]; } \
        if (DK == 64 && tid < 64) *(LAS float*)(lds + P2_EBL + (buf) * 256 + tid * 4) = rebl; } while (0)
    P2_LOAD(c0); P2_STORE(c0 & 1);
    dprod *= rebl;
    __syncthreads();
    const int cend = c0 + nc;
    for (int c = c0; c < cend; ++c) {
        tid = tid0; asm volatile("" : "+v"(tid)); lane = tid & 63; h = lane >> 5; r = lane & 31;
        LAS unsigned char* bb = lds + (c & 1) * P2_BUF;
        LAS unsigned char* qi = bb + P2_QO; LAS unsigned char* ki = bb + P2_KO; LAS unsigned char* vi = bb + P2_VO;
        if (c + 1 < cend) { P2_LOAD(c + 1); dprod *= rebl; }
        u32x2 gt[2][4];
        if (FULL && w < 4) {
            {   const int tbg = tok0 + 64 * c;
#pragma unroll
                for (int ib = 0; ib < 2; ++ib)
#pragma unroll
                    for (int g = 0; g < 4; ++g) gt[ib][g] = *(const u32x2*)(G + (size_t)(tbg + 32 * ib + r) * 512 + 32 * w + 8 * g + 4 * h); }
        }
        if (FULL && w >= 4 && w < 7) {
            const int ws_ = w - 4;
            const int jb = (ws_ == 2) ? 1 : 0, ib = (ws_ == 0) ? 0 : 1;
            f32x16 pt;
#pragma unroll
            for (int i = 0; i < 16; ++i) pt[i] = 0.f;
#pragma unroll
            for (int s = 0; s < DK / 16; ++s) {
                const bf16x8 a = *(const LAS bf16x8*)(ki + img_off<DK>(32 * jb + r, 2 * s + h)), bq = *(const LAS bf16x8*)(qi + img_off<DK>(32 * ib + r, 2 * s + h));
                pt = MFMA32(a, bq, pt);
            }
            if (jb == ib) {
#pragma unroll
                for (int i = 0; i < 16; ++i) { const int j = (i & 3) + 8 * (i >> 2) + 4 * h; pt[i] = (j <= r) ? pt[i] : 0.f; }
            }
#pragma unroll
            for (int g = 0; g < 4; ++g) { u32x2 o; o.x = pk2(pt[4 * g], pt[4 * g + 1]); o.y = pk2(pt[4 * g + 2], pt[4 * g + 3]);
                *(LAS u32x2*)(lds + P2_P + (32 * ib + r) * 144 + (32 * jb + 8 * g + 4 * h) * 2) = o; }
        }
        f32x16 ot[2];
        bf16x8 vf[4];
        if (w < 4) {
#pragma unroll
            for (int s = 0; s < 4; ++s) vf[s] = tr_frag(vi + tr_addr<128>(lane, w, s, 0), vi + tr_addr<128>(lane, w, s, 1));
#pragma unroll
            for (int ib = 0; ib < 2; ++ib)
#pragma unroll
                for (int i = 0; i < 16; ++i) ot[ib][i] = 0.f;
            if (FULL)
#pragma unroll
            for (int d = 0; d < NDB; ++d)
#pragma unroll
                for (int s2 = 0; s2 < 2; ++s2) {
                    const bf16x8 sfr = pack8(S[d], s2);
#pragma unroll
                    for (int ib = 0; ib < 2; ++ib) {
                        const s16x4 lo = *(const LAS s16x4*)(qi + img_off<DK>(32 * ib + r, 4 * d + 2 * s2) + 8 * h), hi = *(const LAS s16x4*)(qi + img_off<DK>(32 * ib + r, 4 * d + 2 * s2 + 1) + 8 * h);
                        const bf16x8 bq = __builtin_shufflevector(lo, hi, 0, 1, 2, 3, 4, 5, 6, 7);
                        ot[ib] = MFMA32(sfr, bq, ot[ib]);
                    }
                }
#pragma unroll
            for (int d = 0; d < NDB; ++d) {
#pragma unroll
                for (int s = 0; s < 4; ++s) {
                    const bf16x8 a = tr_frag(ki + tr_addr<DK>(lane, d, s, 0), ki + tr_addr<DK>(lane, d, s, 1));
                    S[d] = MFMA32(a, vf[s], S[d]);
                }
                if (DK == 128) {
#pragma unroll
                    for (int i = 0; i < 16; ++i) S[d][i] *= ret_ebl;
                } else {
                    const LAS float* eb = (const LAS float*)(lds + P2_EBL + (c & 1) * 256) + 32 * d + 4 * h;
#pragma unroll
                    for (int g = 0; g < 4; ++g) { const f32x4 e4 = *(const LAS f32x4*)(eb + 8 * g);
#pragma unroll
                        for (int e = 0; e < 4; ++e) S[d][4 * g + e] *= e4[e]; }
                }
            }
        }
        if (FULL) __syncthreads();
        if (FULL && w < 4) {
#pragma unroll
            for (int ib = 0; ib < 2; ++ib) {
#pragma unroll
                for (int s = 0; s < (ib == 0 ? 2 : 4); ++s) {
                    const bf16x8 bp = *(const LAS bf16x8*)(lds + P2_P + (32 * ib + r) * 144 + (16 * s + 8 * h) * 2);
                    ot[ib] = MFMA32(vf[s], bp, ot[ib]);
                }
            }
#pragma unroll
            for (int ib = 0; ib < 2; ++ib) { float ss = 0.f;
#pragma unroll
                for (int i = 0; i < 16; ++i) ss += ot[ib][i] * ot[ib][i];
                ss += __shfl_xor(ss, 32);
                if (h == 0) *(LAS float*)(lds + P2_SSQ + (w * 64 + 32 * ib + r) * 4) = ss; }
        }
        if (c + 1 < cend) P2_STORE((c + 1) & 1);
        __syncthreads();
        if (FULL && w < 4) {
            asm volatile("" : "+v"(lane)); h = lane >> 5; r = lane & 31;
            const int tb = tok0 + 64 * c;
#pragma unroll
            for (int ib = 0; ib < 2; ++ib) {
                const LAS float* sq = (const LAS float*)(lds + P2_SSQ) + 32 * ib + r;
                const float tot = sq[0] + sq[64] + sq[128] + sq[192];
                const float rs = rsqrtf(tot * (1.f / 128.f) + EPS);
#pragma unroll
                for (int g = 0; g < 4; ++g) {
                    const u32x2 gg = gt[ib][g];
                    u32x2 o; o.x = pk2(ot[ib][4 * g] * rs * gn[g][0] * bflo(gg.x), ot[ib][4 * g + 1] * rs * gn[g][1] * bfhi(gg.x));
                    o.y = pk2(ot[ib][4 * g + 2] * rs * gn[g][2] * bflo(gg.y), ot[ib][4 * g + 3] * rs * gn[g][3] * bfhi(gg.y));
                    *(u32x2*)(arg + (size_t)(tb + 32 * ib + r) * 1024 + 32 * w + 8 * g + 4 * h) = o;
                }
            }
        }
    }
#undef P2_LOAD
#undef P2_STORE
    if (!FULL && DK == 64 && tid0 < 64) Dbuf[nprev * 64 + tid0] = dprod;
    if (w < 4 && (write_final || !FULL)) {
        lane = tid0 & 63; h = lane >> 5; r = lane & 31;
        float* so = FULL ? p.out + (branch == 0 ? OUT_RSP : OUT_GSP) + (size_t)(b * 4 + head) * DK * 128 : Lbuf + (size_t)nprev * 16384;
#pragma unroll
        for (int d = 0; d < NDB; ++d)
#pragma unroll
            for (int i = 0; i < 16; ++i) so[(size_t)(32 * d + (i & 3) + 8 * (i >> 2) + 4 * h) * 128 + 32 * w + r] = S[d][i];
    }
    __syncthreads();
}

template <int DK> DI void sample_unit(const Params& p, LAS unsigned char* lds, const int branch, const int b, const int head) {
    int tid = threadIdx.x; asm volatile("" : "+v"(tid));
    unsigned char* ws = p.ws;
    const bf16_t* Q = (const bf16_t*)(ws + (branch == 0 ? PQ_R : PQ_G)) + head * DK;
    const bf16_t* K = (const bf16_t*)(ws + (branch == 0 ? PK_R : PK_G)) + head * DK;
    const bf16_t* V = (const bf16_t*)(ws + (branch == 0 ? PV_R : PV_G)) + head * 128;
    const bf16_t* G = (const bf16_t*)(ws + (branch == 0 ? PG_R : PG_G)) + head * 128;
    bf16_t* arg = (bf16_t*)((unsigned char*)p.out + SEG1024) + branch * 512 + head * 128;
    const float* gain = (branch == 0 ? p.g_ret : p.g_gla) + head * 128;
    const float* sin_ = (branch == 0 ? p.state_ret : p.state_gla) + (size_t)(b * 4 + head) * DK * 128;
    float* sout = p.out + (branch == 0 ? OUT_RSS : OUT_GSS) + (size_t)(b * 4 + head) * DK * 128;
    const int tok0 = TP + 4 * b;
    LAS float* qs = (LAS float*)lds;
    LAS float* ks = qs + 4 * 128;
    LAS float* vs = ks + 4 * 128;
    LAS float* es = vs + 4 * 128;
    LAS float* Ps = es + 128;
    LAS float* ssq = Ps + 16;
    LAS float* op = ssq + 16;
    for (int i = tid; i < 4 * DK; i += 512) { const int t = i / DK, d = i % DK;
        qs[t * DK + d] = __uint_as_float((unsigned)Q[(size_t)(tok0 + t) * (4 * DK) + d] << 16); ks[t * DK + d] = __uint_as_float((unsigned)K[(size_t)(tok0 + t) * (4 * DK) + d] << 16); }
    { const int t = tid >> 7, v = tid & 127; vs[t * 128 + v] = __uint_as_float((unsigned)V[(size_t)(tok0 + t) * 512 + v] << 16); }
    if (tid < DK) {
        if (DK == 128) { const float lg2 = log2f(1.f - exp2f(-5.f - (float)head)); es[tid] = exp2f(4.f * lg2); }
        else es[tid] = ((const float*)(ws + WS_EBL))[(size_t)(256 + b) * 256 + head * 64 + tid];
    }
    __syncthreads();
    if (tid < 16) { const int i = tid >> 2, j = tid & 3; float s = 0.f; if (j <= i) { for (int d = 0; d < DK; ++d) s += qs[i * DK + d] * ks[j * DK + d]; } Ps[tid] = s; }
    {
        const int vq = tid & 31, dg = tid >> 5;
        f32x4 oa[4];
#pragma unroll
        for (int i = 0; i < 4; ++i) oa[i] = (f32x4){0.f, 0.f, 0.f, 0.f};
        f32x4 v4[4];
#pragma unroll
        for (int j = 0; j < 4; ++j) v4[j] = *(const LAS f32x4*)(vs + j * 128 + 4 * vq);
        f32x4 s0[DK / 16];
#pragma unroll
        for (int rr = 0; rr < DK / 16; ++rr) s0[rr] = *(const f32x4*)(sin_ + (size_t)(dg + 16 * rr) * 128 + 4 * vq);
#pragma unroll
        for (int rr = 0; rr < DK / 16; ++rr) {
            const int d = dg + 16 * rr;
            f32x4 sn = s0[rr];
#pragma unroll
            for (int i = 0; i < 4; ++i) { oa[i] += s0[rr] * qs[i * DK + d]; sn += v4[i] * ks[i * DK + d]; }
            sn *= es[d];
            *(f32x4*)(sout + (size_t)d * 128 + 4 * vq) = sn;
        }
#pragma unroll
        for (int i = 0; i < 4; ++i) *(LAS f32x4*)(op + (dg * 4 + i) * 128 + 4 * vq) = oa[i];
    }
    __syncthreads();
    {
        const int i = tid >> 7, v = tid & 127;
        float o = 0.f;
#pragma unroll
        for (int dg = 0; dg < 16; ++dg) o += op[(dg * 4 + i) * 128 + v];
#pragma unroll
        for (int j = 0; j < 4; ++j) o += Ps[i * 4 + j] * vs[j * 128 + v];
        const float s = wave_sum(o * o);
        if ((tid & 63) == 0) ssq[tid >> 6] = s;
        __syncthreads();
        const float rs = rsqrtf((ssq[2 * i] + ssq[2 * i + 1]) * (1.f / 128.f) + EPS);
        const float gate = __uint_as_float((unsigned)G[(size_t)(tok0 + i) * 512 + v] << 16);
        const unsigned wv = pk2(o * rs * gain[v] * gate, 0.f);
        arg[(size_t)(tok0 + i) * 1024 + v] = (bf16_t)(wv & 0xffffu);
    }
    __syncthreads();
}

template <bool FULL> DI void chain_call(const Params& p, LAS unsigned char* lds, int chain, int c0, int nc, int nprev, bool wf) {
    const int branch = chain >> 5, bh = chain & 31;
    if (branch == 0) chain_prompt<128, FULL>(p, lds, 0, bh >> 2, bh & 3, c0, nc, nprev, wf); else chain_prompt<64, FULL>(p, lds, 1, bh >> 2, bh & 3, c0, nc, nprev, wf);
}
DI void sample_call(const Params& p, LAS unsigned char* lds, int u) {
    const int branch = u >> 9, bh = u & 511;
    if (branch == 0) sample_unit<128>(p, lds, 0, bh >> 2, bh & 3); else sample_unit<64>(p, lds, 1, bh >> 2, bh & 3);
}
DI void phase2(const Params& p, LAS unsigned char* lds, const XcdBarrier& xbar) {
    const int G = gridDim.x, bx = blockIdx.x;
    if (G == 256) {
        const int chain = bx & 63, seg = bx >> 6;
        if (seg < 3) chain_call<false>(p, lds, chain, 8 * seg, 8, seg, false);
        else { sample_call(p, lds, bx - 192); sample_call(p, lds, bx - 192 + 64); }
        xcd_barrier(xbar);
        chain_call<true>(p, lds, chain, 8 * seg, 8, seg, seg == 3);
        for (int u = 128 + bx; u < 1024; u += 256) sample_call(p, lds, u);
    } else {
        for (int c = bx; c < 64; c += G) chain_call<true>(p, lds, c, 0, 32, 0, true);
        for (int u = bx; u < 1024; u += G) sample_call(p, lds, u);
    }
}

DI void phase_final(const Params& p) {
    const int lane = threadIdx.x & 63, gw = blockIdx.x * 8 + (threadIdx.x >> 6), ngw = gridDim.x * 8;
    const bf16_t* hb = (const bf16_t*)(p.ws + WS_SH);
    for (int row = TP + gw; row < T_TOK; row += ngw) {
        f32x4 v[4]; float s = 0.f;
        const bf16_t* part = (const bf16_t*)(p.ws + WS_PART) + (size_t)((row - TP) & 255) * 256 + 4 * lane;
#pragma unroll
        for (int j = 0; j < 4; ++j) {
            const u32x2 hv = *(const u32x2*)(hb + (size_t)row * DM + 256 * j + 4 * lane);
            v[j] = (f32x4){bflo(hv.x), bfhi(hv.x), bflo(hv.y), bfhi(hv.y)};
            const int su = ((row - TP) >> 8) * 4 + j;
            for (int kp = 0; kp < 11; ++kp) { const u32x2 pv = *(const u32x2*)(part + (size_t)(su * 11 + kp) * 65536); v[j] += (f32x4){bflo(pv.x), bfhi(pv.x), bflo(pv.y), bfhi(pv.y)}; }
            s += v[j][0] * v[j][0] + v[j][1] * v[j][1] + v[j][2] * v[j][2] + v[j][3] * v[j][3];
        }
        const float rs = rsqrtf(wave_sum(s) * (1.f / DM) + EPS);
#pragma unroll
        for (int j = 0; j < 4; ++j) { const f32x4 g = *(const f32x4*)(p.ln_f + 256 * j + 4 * lane); *(f32x4*)(p.out + (size_t)row * DM + 256 * j + 4 * lane) = v[j] * rs * g; }
    }
}

__global__ void __launch_bounds__(512, 2) fwd_megakernel(Params p) {
    extern __shared__ __attribute__((aligned(16))) unsigned char shm[];
    LAS unsigned char* lds = (LAS unsigned char*)shm;
    cg::grid_group grid = cg::this_grid();
    if (p.ws == nullptr) grid.sync();
    if (threadIdx.x < 4) ((LAS unsigned*)(lds + 131072 + 4096))[threadIdx.x] = 0u;
    __syncthreads();
    const XcdBarrier xbar = xcd_barrier_post((unsigned*)(p.ws + WS_BAR), (volatile LAS unsigned*)(lds + 131072 + 4096));
    unsigned char* ws = p.ws;
    const int G = gridDim.x, bx = blockIdx.x;
    bf16_t* xb = (bf16_t*)p.out;
    bf16_t* arg = (bf16_t*)((unsigned char*)p.out + SEG1024);

#ifndef PHMASK
#define PHMASK 0x1ff
#endif
#define PH(n) if ((PHMASK >> (n)) & 1)
    PH(0) phase0(p, lds);
    xcd_barrier(xbar);
#if defined(DUP_PH) && DUP_PH == 0
    phase0(p, lds);
    xcd_barrier(xbar);
#endif
    PH(1) {
        pg8::Gemm g{xb, (const bf16_t*)(ws + WS_WIN), T_TOK, NPROJ, DM, DM, DM, 256}; pg8::StaticOrder S; S.init(T_TOK, NPROJ, G, bx);
        EpiProj E{ws, (const float*)(ws + WS_RSTD1), (const float*)(ws + WS_SH), (const float*)(ws + WS_ROPEC), (const float*)(ws + WS_ROPES)};
        pg8::gemm_phase<EpiProj, pg8::StaticOrder, 16>(lds, g, S, E);
        if (G == 256 && bx >= 172)
            weight_items(p, lds, (bx - 172) * 8 + (int)(threadIdx.x >> 6), 84 * 8, W_I_IN, W_NIT);
#if defined(DUP_PH) && DUP_PH == 1
        xcd_barrier(xbar);
        pg8::gemm_phase<EpiProj, pg8::StaticOrder, 16>(lds, g, S, E);
#endif
    }
    xcd_barrier(xbar);
    PH(2) phase2(p, lds, xbar);
    xcd_barrier(xbar);
#if defined(DUP_PH) && DUP_PH == 2
    phase2(p, lds, xbar);
    xcd_barrier(xbar);
#endif
    PH(3) {
        pg8::Gemm g{arg, (const bf16_t*)(ws + WS_WMIX), T_TOK, DM, DM, DM, DM, 256}; pg8::StaticOrder S; S.init(T_TOK, DM, G, bx);
        EpiMix E{(const bf16_t*)(ws + PM_R), (const bf16_t*)(ws + PM_G), (bf16_t*)(ws + WS_MIX)};
        pg8::gemm_phase<EpiMix, pg8::StaticOrder, 16>(lds, g, S, E);
#if defined(DUP_PH) && DUP_PH == 3
        xcd_barrier(xbar);
        pg8::gemm_phase<EpiMix, pg8::StaticOrder, 16>(lds, g, S, E);
#endif
    }
    xcd_barrier(xbar);
    PH(4) {
        pg8::Gemm g{(const bf16_t*)(ws + WS_MIX), (const bf16_t*)(ws + WS_WO), T_TOK, DM, DM, DM, DM, 256}; pg8::StaticOrder S; S.init(T_TOK, DM, G, bx);
        EpiH E{p.x_prompt, p.x_sample, p.out, (bf16_t*)(ws + WS_SH), (float*)(ws + WS_SSQ2)};
        pg8::gemm_phase<EpiH, pg8::StaticOrder, 16>(lds, g, S, E);
    }
    xcd_barrier(xbar);
    PH(5) {
        pg8::Gemm g{(const bf16_t*)(ws + WS_SH) - 2 * DM, (const bf16_t*)(ws + WS_WUP), T_TOK, NUP, DM, DM, DM, 254}; pg8::StaticOrder S; S.init_tiles(67, 22, G, bx);
        EpiUpConv E{(const float*)(ws + WS_SSQ2), (bf16_t*)(ws + WS_ACT), p.conv_w, p.conv_b, p.cache_conv, p.out, (LAS float*)(lds + 131072)};
        pg8::gemm_phase<EpiUpConv, pg8::StaticOrder, 16>(lds, g, S, E);
#if defined(DUP_PH) && DUP_PH == 5
        xcd_barrier(xbar);
        pg8::gemm_phase<EpiUpConv, pg8::StaticOrder, 16>(lds, g, S, E);
#endif
    }
    xcd_barrier(xbar);
    PH(7) {
        pg8::Gemm g{(const bf16_t*)(ws + WS_ACT), (const bf16_t*)(ws + WS_WDN), T_TOK, DM, DFF, DFF, DFF, 256}; pg8::StaticOrder S; S.init_tiles(64, 4, G, bx);
        EpiDownNorm E{(const bf16_t*)(ws + WS_SH), p.out, p.ln_f, (float*)(ws + WS_EXCH), (unsigned*)(ws + WS_CNT), (LAS float*)(lds + 131072)};
        pg8::gemm_phase<EpiDownNorm, pg8::StaticOrder, 44>(lds, g, S, E);
        {   pg8::PieceOrder S2{G, bx}; EpiPart E2{(bf16_t*)(ws + WS_PART)};
            pg8::gemm_phase<EpiPart, pg8::PieceOrder, 4>(lds, g, S2, E2); }
    }
    xcd_barrier(xbar);
    PH(8) phase_final(p);
}

extern "C" void kernel_launch(void* const* d_in, const int* in_sizes, int n_in, void* d_out, int out_size, void* d_ws, size_t ws_size, hipStream_t stream) {
    static int grid = 0;
    if (grid == 0) {
        if (n_in != 20 || out_size != (int)OUT_END || ws_size < WS_END) { fprintf(stderr, "kernel_launch: unexpected shapes (n_in %d, out %d, ws %zu)\n", n_in, out_size, ws_size); grid = -1; return; }
        int dev = 0, cus = 0, per_cu = 0;
        hipGetDevice(&dev);
        hipDeviceGetAttribute(&cus, hipDeviceAttributeMultiprocessorCount, dev);
        if (hipFuncSetAttribute((const void*)fwd_megakernel, hipFuncAttributeMaxDynamicSharedMemorySize, LDS_BYTES) != hipSuccess) { fprintf(stderr, "kernel_launch: hipFuncSetAttribute failed\n"); grid = -1; return; }
        hipOccupancyMaxActiveBlocksPerMultiprocessor(&per_cu, (const void*)fwd_megakernel, 512, LDS_BYTES);
        if (per_cu < 1) { fprintf(stderr, "kernel_launch: occupancy query gave %d\n", per_cu); per_cu = 1; }
        grid = cus * 1;
        (void)hipGetLastError();
    }
    if (grid < 0) return;
    Params p{};
    const float** f = (const float**)&p;
    for (int i = 0; i < 20; ++i) f[i] = (const float*)d_in[i];
    p.out = (float*)d_out; p.ws = (unsigned char*)d_ws;
    if (hipMemsetAsync((unsigned char*)d_ws + WS_BAR, 0, 16384 + 8192, stream) != hipSuccess) { fprintf(stderr, "kernel_launch: memset failed\n"); return; }
    void* args[] = {&p};
    hipError_t e = hipLaunchCooperativeKernel((const void*)fwd_megakernel, dim3(grid), dim3(512), args, LDS_BYTES, stream);
    if (e != hipSuccess) fprintf(stderr, "cooperative launch failed: %s (grid %d)\n", hipGetErrorString(e), grid);
}
```
